# Optimizing an MI355X kernel written in HIP

```python
import math
import jax, jax.numpy as jnp
from jax import lax
import numpy as np

D_MODEL = 1024
BATCH = 32
SEQ = 2048
DEPTH = 4

HEAD_DIM = 64
NORM_EPS = 1e-6
NEG = -1e30
N_EVEN = (DEPTH + 1) // 2
N_ODD = DEPTH // 2

A_HEADS = 8
A_PATTERNS = ((128, 1), (512, 4), (2048, 16))
A_WIDTH = A_HEADS * HEAD_DIM

B_HEADS = 8
B_Q_LORA = D_MODEL // 4
B_KV_LORA = D_MODEL // 8
B_NOPE = HEAD_DIM
B_ROPE = HEAD_DIM // 2
B_V = HEAD_DIM
B_QBLOCK = 128
ROPE_THETA = 10000.0
B_WIDTH = B_HEADS * B_V

IN_E_WIDTH = 3 * A_WIDTH + B_Q_LORA + B_KV_LORA + B_ROPE
MIX_E_WIDTH = A_WIDTH + B_WIDTH

C_HEADS = D_MODEL // HEAD_DIM
C_WIDTH = C_HEADS * HEAD_DIM
GRID_W = 64
NA_ROWS = 8
NA_COLS = 16
NA_KEY_COLS = 2 * NA_COLS

D_FF = ((8 * D_MODEL // 3 + 255) // 256) * 256
N_EXPERTS = 8
TOP_K = 2
D_FF_EXPERT = 7 * D_MODEL // 2

kernel_name = "hybrid_dilated_mla_natten_moe_encoder"


def rms_norm(x, g):
    xf = x.astype(jnp.float32)
    y = xf * lax.rsqrt(jnp.mean(xf * xf, axis=-1, keepdims=True) + NORM_EPS)
    return (y * g.astype(jnp.float32)).astype(x.dtype)


def swiglu(x, w_gate, w_up, w_down):
    return (jax.nn.silu(x @ w_gate) * (x @ w_up)) @ w_down


def alibi_slopes(n):
    return jnp.asarray(np.array([2.0 ** (-8.0 * (h + 1) / n) for h in range(n)], np.float32))


def dilated_window_branch(q, k, v, window, dilation, slopes):
    b, s, h, dh = q.shape
    r = window // (2 * dilation)
    L = s // dilation
    n = b * dilation

    def by_residue(t):
        return t.reshape(b, L, dilation, h, dh).transpose(0, 2, 1, 3, 4).reshape(n, L, h, dh)

    qs, ks, vs = by_residue(q), by_residue(k), by_residue(v)
    blk = r
    nb = -(-L // blk)
    lp = nb * blk
    qp = jnp.pad(qs, ((0, 0), (0, lp - L), (0, 0), (0, 0))).reshape(n, nb, blk, h, dh)
    pad_kv = ((0, 0), (blk, lp - L + blk), (0, 0), (0, 0))
    kp = jnp.pad(ks, pad_kv).reshape(n, nb + 2, blk, h, dh)
    vp = jnp.pad(vs, pad_kv).reshape(n, nb + 2, blk, h, dh)

    def band(t):
        return jnp.concatenate([t[:, :-2], t[:, 1:-1], t[:, 2:]], axis=2)

    kb, vb = band(kp), band(vp)
    qi = np.arange(lp).reshape(nb, blk)
    kj = (np.arange(nb)[:, None] * blk - blk) + np.arange(3 * blk)[None]
    rel = kj[:, None, :] - qi[:, :, None]
    valid = (np.abs(rel) <= r) & (kj[:, None, :] >= 0) & (kj[:, None, :] < L)
    dist = jnp.asarray((np.abs(rel) * dilation).astype(np.float32))

    scores = jnp.einsum('nbqhd,nbkhd->nhbqk', qp, kb).astype(jnp.float32) * (dh ** -0.5)
    scores = scores - slopes[None, :, None, None, None] * dist[None, None]
    scores = jnp.where(jnp.asarray(valid)[None, None], scores, NEG)
    lse = jax.nn.logsumexp(scores, axis=-1)
    p = jnp.exp(scores - lse[..., None])
    out = jnp.einsum('nhbqk,nbkhd->nbqhd', p.astype(v.dtype), vb).reshape(n, lp, h, dh)[:, :L]
    lse = lse.transpose(0, 2, 3, 1).reshape(n, lp, h)[:, :L]
    out = out.reshape(b, dilation, L, h, dh).transpose(0, 2, 1, 3, 4).reshape(b, s, h, dh)
    lse = lse.reshape(b, dilation, L, h).transpose(0, 2, 1, 3).reshape(b, s, h)
    return out, lse


def dilated_mixture_attention(q, k, v):
    slopes = alibi_slopes(q.shape[2])
    outs, lses = [], []
    for window, dilation in A_PATTERNS:
        o, l = dilated_window_branch(q, k, v, window, dilation, slopes)
        outs.append(o)
        lses.append(l)
    w = jax.nn.softmax(jnp.stack(lses, axis=0), axis=0)
    out = w[0][..., None].astype(q.dtype) * outs[0]
    for g in range(1, len(outs)):
        out = out + w[g][..., None].astype(q.dtype) * outs[g]
    return out


def rope(x, pos):
    half = x.shape[-1] // 2
    freqs = ROPE_THETA ** (-jnp.arange(half, dtype=jnp.float32) / half)
    ang = pos[:, None].astype(jnp.float32) * freqs[None]
    cos, sin = jnp.cos(ang)[:, None, :], jnp.sin(ang)[:, None, :]
    xf = x.astype(jnp.float32)
    x1, x2 = xf[..., :half], xf[..., half:]
    return jnp.concatenate([x1 * cos - x2 * sin, x1 * sin + x2 * cos], axis=-1).astype(x.dtype)


def latent_attention(q_lat, kv_lat, k_rope, q_norm, w_uq, kv_norm, w_ukv):
    b, s, _ = q_lat.shape
    pos = jnp.arange(s)
    q = (rms_norm(q_lat, q_norm) @ w_uq).reshape(b, s, B_HEADS, B_NOPE + B_ROPE)
    q_nope, q_pe = q[..., :B_NOPE], rope(q[..., B_NOPE:], pos)
    kv = (rms_norm(kv_lat, kv_norm) @ w_ukv).reshape(b, s, B_HEADS, B_NOPE + B_V)
    k_nope, v = kv[..., :B_NOPE], kv[..., B_NOPE:]
    k_pe = rope(k_rope[:, :, None, :], pos)[:, :, 0]
    scale = (B_NOPE + B_ROPE) ** -0.5
    nblk = s // B_QBLOCK
    qn = q_nope.reshape(b, nblk, B_QBLOCK, B_HEADS, B_NOPE).transpose(1, 0, 2, 3, 4)
    qr = q_pe.reshape(b, nblk, B_QBLOCK, B_HEADS, B_ROPE).transpose(1, 0, 2, 3, 4)

    def block(args):
        qn_b, qr_b = args
        sc = (jnp.einsum('bqhd,bkhd->bhqk', qn_b, k_nope)
              + jnp.einsum('bqhr,bkr->bhqk', qr_b, k_pe)).astype(jnp.float32) * scale
        p = jax.nn.softmax(sc, axis=-1)
        return jnp.einsum('bhqk,bkhd->bqhd', p.astype(v.dtype), v)

    out = lax.map(block, (qn, qr))
    return out.transpose(1, 0, 2, 3, 4).reshape(b, s, B_HEADS * B_V)


def neighborhood_attention(q, k, v, rpb):
    b, s, h, dh = q.shape
    rows = s // GRID_W
    kr = min(NA_ROWS, rows)
    n_cb = GRID_W // NA_COLS
    qb = q.reshape(b, rows, n_cb, NA_COLS, h, dh)
    kg = k.reshape(b, rows, GRID_W, h, dh)
    vg = v.reshape(b, rows, GRID_W, h, dh)

    q_c0 = np.arange(n_cb) * NA_COLS
    k_c0 = np.clip(q_c0 - NA_COLS // 2, 0, GRID_W - NA_KEY_COLS)
    key_cols = k_c0[:, None] + np.arange(NA_KEY_COLS)[None]
    q_cols = q_c0[:, None] + np.arange(NA_COLS)[None]
    col_start = np.clip(q_cols - NA_COLS // 2, 0, GRID_W - NA_COLS)
    col_ok = (key_cols[:, None, :] >= col_start[..., None]) & (key_cols[:, None, :] < col_start[..., None] + NA_COLS)
    col_idx = np.clip(key_cols[:, None, :] - q_cols[:, :, None] + NA_COLS - 1, 0, 2 * NA_COLS - 2)
    col_ok = jnp.asarray(col_ok)[None, None, :, :, None, :]
    rpb_f = rpb.astype(jnp.float32)
    scale = dh ** -0.5

    def one_row(i):
        rs = jnp.clip(i - kr // 2, 0, rows - kr)
        k_slab = lax.dynamic_slice_in_dim(kg, rs, kr, axis=1)[:, :, key_cols]
        v_slab = lax.dynamic_slice_in_dim(vg, rs, kr, axis=1)[:, :, key_cols]
        q_row = lax.dynamic_index_in_dim(qb, i, axis=1, keepdims=False)
        sc = jnp.einsum('bcqhd,brckhd->bhcqrk', q_row, k_slab).astype(jnp.float32) * scale
        row_idx = rs + jnp.arange(kr) - i + NA_ROWS - 1
        bias = rpb_f[:, row_idx][:, :, col_idx].transpose(0, 2, 3, 1, 4)
        sc = jnp.where(col_ok, sc + bias[None], NEG)
        p = jax.nn.softmax(sc.reshape(b, h, n_cb, NA_COLS, kr * NA_KEY_COLS), axis=-1)
        p = p.reshape(b, h, n_cb, NA_COLS, kr, NA_KEY_COLS).astype(v.dtype)
        return jnp.einsum('bhcqrk,brckhd->bcqhd', p, v_slab)

    out = lax.map(one_row, jnp.arange(rows))
    return out.transpose(1, 0, 2, 3, 4, 5).reshape(b, s, h * dh)


def moe_swiglu(x, w_router, w_gate, w_up, w_down):
    b, s, d = x.shape
    xt = x.reshape(b * s, d)
    logits = (xt @ w_router).astype(jnp.float32)
    top_val, top_idx = lax.top_k(logits, TOP_K)
    top_w = jax.nn.softmax(top_val, axis=-1)
    gates = jnp.sum(jax.nn.one_hot(top_idx, N_EXPERTS, dtype=jnp.float32) * top_w[..., None], axis=1)
    gates = gates.astype(x.dtype)
    y = jnp.zeros_like(xt)
    for e in range(N_EXPERTS):
        y = y + gates[:, e:e + 1] * swiglu(xt, w_gate[e], w_up[e], w_down[e])
    return y.reshape(b, s, d)


def setup_inputs(seed: int = 0) -> dict:
    key = jax.random.key(seed)
    keys = iter(jax.random.split(key, 32))
    f32 = jnp.float32

    def normal(shape, fan_in):
        return jax.random.normal(next(keys), shape, f32) * (fan_in ** -0.5)

    def gain(shape):
        return 1.0 + 0.05 * jax.random.normal(next(keys), shape, f32)

    return {
        "x": jax.random.normal(next(keys), (BATCH, SEQ, D_MODEL), f32),
        "ln_mix_e": gain((N_EVEN, D_MODEL)),
        "w_in_e": normal((N_EVEN, D_MODEL, IN_E_WIDTH), D_MODEL),
        "mla_q_norm": gain((N_EVEN, B_Q_LORA)),
        "mla_w_uq": normal((N_EVEN, B_Q_LORA, B_HEADS * (B_NOPE + B_ROPE)), B_Q_LORA),
        "mla_kv_norm": gain((N_EVEN, B_KV_LORA)),
        "mla_w_ukv": normal((N_EVEN, B_KV_LORA, B_HEADS * (B_NOPE + B_V)), B_KV_LORA),
        "w_out_e": normal((N_EVEN, MIX_E_WIDTH, D_MODEL), MIX_E_WIDTH),
        "ln_ffn_e": gain((N_EVEN, D_MODEL)),
        "ffn_w_gate": normal((N_EVEN, D_MODEL, D_FF), D_MODEL),
        "ffn_w_up": normal((N_EVEN, D_MODEL, D_FF), D_MODEL),
        "ffn_w_down": normal((N_EVEN, D_FF, D_MODEL), D_FF),
        "ln_mix_o": gain((N_ODD, D_MODEL)),
        "na_w_qkv": normal((N_ODD, D_MODEL, 3 * C_WIDTH), D_MODEL),
        "na_rpb": 0.1 * jax.random.normal(next(keys), (N_ODD, C_HEADS, 2 * NA_ROWS - 1, 2 * NA_COLS - 1), f32),
        "na_w_out": normal((N_ODD, C_WIDTH, D_MODEL), C_WIDTH),
        "ln_ffn_o": gain((N_ODD, D_MODEL)),
        "moe_router": normal((N_ODD, D_MODEL, N_EXPERTS), D_MODEL),
        "moe_w_gate": normal((N_ODD, N_EXPERTS, D_MODEL, D_FF_EXPERT), D_MODEL),
        "moe_w_up": normal((N_ODD, N_EXPERTS, D_MODEL, D_FF_EXPERT), D_MODEL),
        "moe_w_down": normal((N_ODD, N_EXPERTS, D_FF_EXPERT, D_MODEL), D_FF_EXPERT),
        "ln_final": gain((D_MODEL,)),
    }


def reference(x, ln_mix_e, w_in_e, mla_q_norm, mla_w_uq, mla_kv_norm, mla_w_ukv, w_out_e,
              ln_ffn_e, ffn_w_gate, ffn_w_up, ffn_w_down, ln_mix_o, na_w_qkv, na_rpb, na_w_out,
              ln_ffn_o, moe_router, moe_w_gate, moe_w_up, moe_w_down, ln_final):
    b, s, _ = x.shape
    split_e = [A_WIDTH, 2 * A_WIDTH, 3 * A_WIDTH, 3 * A_WIDTH + B_Q_LORA, 3 * A_WIDTH + B_Q_LORA + B_KV_LORA]
    for layer in range(DEPTH):
        if layer % 2 == 0:
            i = layer // 2
            h = rms_norm(x, ln_mix_e[i])
            proj = h @ w_in_e[i]
            qa, ka, va, q_lat, kv_lat, k_rope = jnp.split(proj, split_e, axis=-1)
            qa = qa.reshape(b, s, A_HEADS, HEAD_DIM)
            ka = ka.reshape(b, s, A_HEADS, HEAD_DIM)
            va = va.reshape(b, s, A_HEADS, HEAD_DIM)
            oa = dilated_mixture_attention(qa, ka, va).reshape(b, s, A_WIDTH)
            ob = latent_attention(q_lat, kv_lat, k_rope, mla_q_norm[i], mla_w_uq[i],
                                  mla_kv_norm[i], mla_w_ukv[i])
            x = x + jnp.concatenate([oa, ob], axis=-1) @ w_out_e[i]
            x = x + swiglu(rms_norm(x, ln_ffn_e[i]), ffn_w_gate[i], ffn_w_up[i], ffn_w_down[i])
        else:
            j = layer // 2
            h = rms_norm(x, ln_mix_o[j])
            qc, kc, vc = jnp.split(h @ na_w_qkv[j], 3, axis=-1)
            qc = qc.reshape(b, s, C_HEADS, HEAD_DIM)
            kc = kc.reshape(b, s, C_HEADS, HEAD_DIM)
            vc = vc.reshape(b, s, C_HEADS, HEAD_DIM)
            x = x + neighborhood_attention(qc, kc, vc, na_rpb[j]) @ na_w_out[j]
            x = x + moe_swiglu(rms_norm(x, ln_ffn_o[j]), moe_router[j], moe_w_gate[j],
                               moe_w_up[j], moe_w_down[j])
    return rms_norm(x, ln_final)
```

```cpp
#include <hip/hip_runtime.h>
#include <cstdio>
#include <cstdint>
#define MK_MULTI 0
namespace pg8 {
#define PG8_LAS __attribute__((address_space(3)))
#define PG8_GAS __attribute__((address_space(1)))
typedef unsigned short bf16_t;
typedef short bf16x8 __attribute__((ext_vector_type(8)));
typedef float f32x4 __attribute__((ext_vector_type(4)));
typedef unsigned u32x4 __attribute__((ext_vector_type(4)));
typedef int v4i_t __attribute__((ext_vector_type(4)));
typedef int v8i_t __attribute__((ext_vector_type(8)));
constexpr int BM = 256, BK = 64, HALF = 128, HTB = HALF * BK * 2  , STAGE_BYTES = 8 * HTB, NXCD = 8, WGM = 8, EPI_SC_OFF = STAGE_BYTES + 1024  ;

__host__ __device__ __forceinline__ int lds_byte(int r, int c) { const int st = (r >> 4) * 2 + (c >> 5), rr = r & 15, cc = c & 31, ob = rr * 64 + cc * 2; return st * 1024 + (ob ^ (((ob >> 9) & 1) << 5)); }
__host__ __device__ __forceinline__ void stage_rc(int b, int& R, int& C) { const int st = b / 1024, sb = b % 1024, swz = sb ^ (((sb >> 9) & 1) << 5); R = (st >> 1) * 16 + swz / 64; C = (st & 1) * 32 + (swz % 64) / 2; }
__host__ __device__ __forceinline__ int perm32(int rho) { const int n = rho >> 4, i = rho & 15; return 8 * (i >> 2) + 4 * n + (i & 3); }

struct Unit { int pm, pn, pc; };
struct Gemm { const bf16_t* A; const bf16_t* Bt; int lda, ldb, K; };

struct StaticOrder {
    int nM, nN, nwg, G, c;
    __host__ __device__ void init(int M, int N, int G_, int c_) { nM = M / BM; nN = N / BM; nwg = nM * nN; G = G_; c = c_; }
    __host__ __device__ bool next(int i, Unit& u) const {
        const long L = (long)i * G + c; if (L >= nwg) return false;
        int wgid = (int)L; { const int q = nwg / NXCD, r = nwg % NXCD, xcd = wgid % NXCD, off = wgid / NXCD; wgid = (xcd < r ? xcd * (q + 1) : r * (q + 1) + (xcd - r) * q) + off; }
        const int nig = WGM * nN, gid = wgid / nig, fm = gid * WGM, gsz = (nM - fm) < WGM ? (nM - fm) : WGM;
        u.pm = fm + ((wgid % nig) % gsz); u.pn = (wgid % nig) / gsz; u.pc = u.pn; return true;
    }
    __device__ __forceinline__ void a_ready(const Unit&) const {}
    __device__ __forceinline__ void done(const Unit&) const {}
};
struct GroupedOrder {
    int t0, t1, t2, t3, t4, t5, t6, RT, nN, G, c;
    __device__ bool next(int i, Unit& u) const {
        const int nwg = RT * nN; const long L = (long)i * G + c; if (L >= nwg) return false;
        int wgid = (int)L; { const int q = nwg / NXCD, r = nwg % NXCD, xcd = wgid % NXCD, off = wgid / NXCD; wgid = (xcd < r ? xcd * (q + 1) : r * (q + 1) + (xcd - r) * q) + off; }
        const int nig = WGM * nN, gid = wgid / nig, fm = gid * WGM, gsz = (RT - fm) < WGM ? (RT - fm) : WGM, w = wgid - gid * nig;
        const int rt = fm + (w % gsz), j = w / gsz;
        const int e = (rt >= t0) + (rt >= t1) + (rt >= t2) + (rt >= t3) + (rt >= t4) + (rt >= t5) + (rt >= t6);
        u.pm = rt; u.pn = e * nN + j; u.pc = j; return true;
    }
    __device__ __forceinline__ void a_ready(const Unit&) const {}
    __device__ __forceinline__ void done(const Unit&) const {}
};

__device__ __forceinline__ unsigned cvt_pk_bf16(float lo, float hi) { unsigned r; asm volatile("v_cvt_pk_bf16_f32 %0, %1, %2" : "=v"(r) : "v"(lo), "v"(hi)); return r; }

struct EpiBf16 {
    static constexpr bool PERM = true, AFTER_DRAIN = false, PREFETCH = false;
    bf16_t* O; int ldc;
    __device__ __forceinline__ void operator()(const f32x4 (&acc)[2][2][4][2], const Unit& u, int wr, int wc, int fr, int fq) const {
        const int row0 = u.pm * BM + wr * 64 + fr, col0 = u.pc * BM + wc * 32 + 8 * fq;
#pragma unroll
        for (int ai = 0; ai < 2; ++ai)
#pragma unroll
            for (int m = 0; m < 4; ++m) { bf16_t* rowp = O + (size_t)(row0 + ai * HALF + m * 16) * ldc + col0;
#pragma unroll
                for (int bj = 0; bj < 2; ++bj) { const f32x4 v0 = acc[ai][bj][m][0], v1 = acc[ai][bj][m][1];
                    u32x4 w; w.x = cvt_pk_bf16(v0[0], v0[1]); w.y = cvt_pk_bf16(v0[2], v0[3]); w.z = cvt_pk_bf16(v1[0], v1[1]); w.w = cvt_pk_bf16(v1[2], v1[3]);
                    *(PG8_GAS u32x4*)(rowp + bj * HALF) = w; } }
    }
};
struct EpiSwiglu {
    static constexpr bool PERM = true, AFTER_DRAIN = false, PREFETCH = false;
    bf16_t* O; int ldc;
    __device__ __forceinline__ void operator()(const f32x4 (&acc)[2][2][4][2], const Unit& u, int wr, int wc, int fr, int fq) const {
        const int row0 = u.pm * BM + wr * 64 + fr, col0 = u.pc * HALF + wc * 32 + 8 * fq;
#pragma unroll
        for (int ai = 0; ai < 2; ++ai)
#pragma unroll
            for (int m = 0; m < 4; ++m) { bf16_t* rowp = O + (size_t)(row0 + ai * HALF + m * 16) * ldc + col0;
                float r[8];
#pragma unroll
                for (int n = 0; n < 2; ++n)
#pragma unroll
                    for (int k = 0; k < 4; ++k) { const float g = acc[ai][0][m][n][k], up = acc[ai][1][m][n][k];
                        r[n * 4 + k] = g * __builtin_amdgcn_rcpf(1.0f + __expf(-g)) * up; }
                u32x4 w; w.x = cvt_pk_bf16(r[0], r[1]); w.y = cvt_pk_bf16(r[2], r[3]); w.z = cvt_pk_bf16(r[4], r[5]); w.w = cvt_pk_bf16(r[6], r[7]);
                *(PG8_GAS u32x4*)rowp = w; }
    }
};
__device__ __forceinline__ unsigned cvt4_fp8(float a, float b, float c, float d) { int r = 0; r = __builtin_amdgcn_cvt_pk_fp8_f32(a, b, r, false); r = __builtin_amdgcn_cvt_pk_fp8_f32(c, d, r, true); return (unsigned)r; }
struct EpiSwigluF8 {
    static constexpr bool PERM = true, AFTER_DRAIN = false, PREFETCH = false;
    unsigned char* O; int ldc; float sc;
    __device__ __forceinline__ void operator()(const f32x4 (&acc)[2][2][4][2], const Unit& u, int wr, int wc, int fr, int fq) const {
        const int row0 = u.pm * BM + wr * 64 + fr, col0 = u.pc * HALF + wc * 32 + 8 * fq;
        const float c1 = -1.4426950408889634f * sc, k2 = 1.0f / (sc * sc);
#pragma unroll
        for (int ai = 0; ai < 2; ++ai)
#pragma unroll
            for (int m = 0; m < 4; ++m) { unsigned char* rowp = O + (size_t)(row0 + ai * HALF + m * 16) * ldc + col0;
                typedef unsigned u32x2_t __attribute__((ext_vector_type(2)));
                u32x2_t w;
#pragma unroll
                for (int n = 0; n < 2; ++n) { const f32x4 ag = acc[ai][0][m][n], au = acc[ai][1][m][n];
                    const f32x4 x = ag * c1; f32x4 tt;
#pragma unroll
                    for (int k = 0; k < 4; ++k) tt[k] = __builtin_amdgcn_exp2f(x[k]);
                    const f32x4 d = tt * k2 + k2; f32x4 r;
#pragma unroll
                    for (int k = 0; k < 4; ++k) r[k] = __builtin_amdgcn_rcpf(d[k]);
                    const f32x4 o = (ag * au) * r;
                    w[n] = cvt4_fp8(o[0], o[1], o[2], o[3]); }
                *(PG8_GAS u32x2_t*)rowp = w; }
    }
};
struct EpiBf16S {
    static constexpr bool PERM = true, AFTER_DRAIN = false, PREFETCH = false;
    bf16_t* O; int ldc; float sc;
    __device__ __forceinline__ void operator()(const f32x4 (&acc)[2][2][4][2], const Unit& u, int wr, int wc, int fr, int fq) const {
        const int row0 = u.pm * BM + wr * 64 + fr, col0 = u.pc * BM + wc * 32 + 8 * fq;
#pragma unroll
        for (int ai = 0; ai < 2; ++ai)
#pragma unroll
            for (int m = 0; m < 4; ++m) { bf16_t* rowp = O + (size_t)(row0 + ai * HALF + m * 16) * ldc + col0;
#pragma unroll
                for (int bj = 0; bj < 2; ++bj) { const f32x4 v0 = acc[ai][bj][m][0] * sc, v1 = acc[ai][bj][m][1] * sc;
                    u32x4 w; w.x = cvt_pk_bf16(v0[0], v0[1]); w.y = cvt_pk_bf16(v0[2], v0[3]); w.z = cvt_pk_bf16(v1[0], v1[1]); w.w = cvt_pk_bf16(v1[2], v1[3]);
                    *(PG8_GAS u32x4*)(rowp + bj * HALF) = w; } }
    }
};
struct EpiBf16I8 {
    static constexpr bool PERM = true, AFTER_DRAIN = false, PREFETCH = true;
    bf16_t* O; int ldc; const float* sa; const float* sb;
    __device__ __forceinline__ void prefetch(const Unit& u, PG8_LAS unsigned char* blk, int wid, int lane) const {
        const float* src = (wid < 4) ? sa + u.pm * BM + wid * 64 + lane : sb + u.pn * BM + (wid - 4) * 64 + lane;
        __builtin_amdgcn_global_load_lds((const unsigned*)src, (PG8_LAS unsigned*)(blk + wid * 256), 4, 0, 0);
    }
    __device__ __forceinline__ void run(const f32x4 (&acc)[2][2][4][2], const Unit& u, int wr, int wc, int fr, int fq, const PG8_LAS float* scl) const {
        const int row0 = u.pm * BM + wr * 64 + fr, col0 = u.pc * BM + wc * 32 + 8 * fq, lrow0 = wr * 64 + fr, bcol0 = 256 + wc * 32 + 8 * fq;
        f32x4 sc[2][2];
#pragma unroll
        for (int bj = 0; bj < 2; ++bj)
#pragma unroll
            for (int n = 0; n < 2; ++n) sc[bj][n] = *(const PG8_LAS f32x4*)(scl + bcol0 + bj * HALF + 4 * n);
#pragma unroll
        for (int ai = 0; ai < 2; ++ai)
#pragma unroll
            for (int m = 0; m < 4; ++m) { const int row = row0 + ai * HALF + m * 16; bf16_t* rowp = O + (size_t)row * ldc + col0; const float s = scl[lrow0 + ai * HALF + m * 16];
#pragma unroll
                for (int bj = 0; bj < 2; ++bj) { f32x4 v[2];
#pragma unroll
                    for (int n = 0; n < 2; ++n) { f32x4 fa;
#pragma unroll
                        for (int k = 0; k < 4; ++k) { const float f = acc[ai][bj][m][n][k]; fa[k] = (float)__builtin_bit_cast(int, f); }
                        v[n] = fa * (sc[bj][n] * s); }
                    u32x4 w; w.x = cvt_pk_bf16(v[0][0], v[0][1]); w.y = cvt_pk_bf16(v[0][2], v[0][3]); w.z = cvt_pk_bf16(v[1][0], v[1][1]); w.w = cvt_pk_bf16(v[1][2], v[1][3]);
                    *(PG8_GAS u32x4*)(rowp + bj * HALF) = w; } }
    }
};
struct EpiBf16I8H {
    static constexpr bool PERM = true, AFTER_DRAIN = false, PREFETCH = true;
    bf16_t* O; int nrows; const float* sa; const float* sb;
    __device__ __forceinline__ void prefetch(const Unit& u, PG8_LAS unsigned char* blk, int wid, int lane) const {
        const float* src = (wid < 4) ? sa + u.pm * BM + wid * 64 + lane : sb + u.pn * BM + (wid - 4) * 64 + lane;
        __builtin_amdgcn_global_load_lds((const unsigned*)src, (PG8_LAS unsigned*)(blk + wid * 256), 4, 0, 0);
    }
    __device__ __forceinline__ void run(const f32x4 (&acc)[2][2][4][2], const Unit& u, int wr, int wc, int fr, int fq, const PG8_LAS float* scl) const {
        const int row0 = u.pm * BM + wr * 64 + fr, col0 = u.pc * BM + wc * 32 + 8 * fq, lrow0 = wr * 64 + fr, bcol0 = 256 + wc * 32 + 8 * fq;
        f32x4 sc[2][2];
#pragma unroll
        for (int bj = 0; bj < 2; ++bj)
#pragma unroll
            for (int n = 0; n < 2; ++n) sc[bj][n] = *(const PG8_LAS f32x4*)(scl + bcol0 + bj * HALF + 4 * n);
#pragma unroll
        for (int ai = 0; ai < 2; ++ai)
#pragma unroll
            for (int m = 0; m < 4; ++m) { const int row = row0 + ai * HALF + m * 16; const float s = scl[lrow0 + ai * HALF + m * 16];
#pragma unroll
                for (int bj = 0; bj < 2; ++bj) { f32x4 v[2];
#pragma unroll
                    for (int n = 0; n < 2; ++n) { f32x4 fa;
#pragma unroll
                        for (int k = 0; k < 4; ++k) { const float f = acc[ai][bj][m][n][k]; fa[k] = (float)__builtin_bit_cast(int, f); }
                        v[n] = fa * (sc[bj][n] * s); }
                    u32x4 w; w.x = cvt_pk_bf16(v[0][0], v[0][1]); w.y = cvt_pk_bf16(v[0][2], v[0][3]); w.z = cvt_pk_bf16(v[1][0], v[1][1]); w.w = cvt_pk_bf16(v[1][2], v[1][3]);
                    const int cc = col0 + bj * HALF; *(PG8_GAS u32x4*)(O + ((size_t)(cc >> 6) * nrows + row) * 64 + (cc & 63)) = w; } }
    }
};
struct EpiSwigluI8 {
    static constexpr bool PERM = true, AFTER_DRAIN = false, PREFETCH = true;
    bf16_t* O; int ldc; const float* sa; const float* sb;
    __device__ __forceinline__ void prefetch(const Unit& u, PG8_LAS unsigned char* blk, int wid, int lane) const {
        const float* src = (wid < 4) ? sa + u.pm * BM + wid * 64 + lane : sb + u.pn * BM + (wid - 4) * 64 + lane;
        __builtin_amdgcn_global_load_lds((const unsigned*)src, (PG8_LAS unsigned*)(blk + wid * 256), 4, 0, 0);
    }
    __device__ __forceinline__ void run(const f32x4 (&acc)[2][2][4][2], const Unit& u, int wr, int wc, int fr, int fq, const PG8_LAS float* scl) const {
        const int row0 = u.pm * BM + wr * 64 + fr, col0 = u.pc * HALF + wc * 32 + 8 * fq, lrow0 = wr * 64 + fr, bcol0 = 256 + wc * 32 + 8 * fq;
        f32x4 c1[2], c2[2]; float one = 1.0f; asm volatile("" : "+v"(one));
#pragma unroll
        for (int n = 0; n < 2; ++n) { const f32x4 sg = *(const PG8_LAS f32x4*)(scl + bcol0 + 4 * n), su = *(const PG8_LAS f32x4*)(scl + bcol0 + HALF + 4 * n); c1[n] = sg * -1.4426950408889634f; c2[n] = sg * su; }
#pragma unroll
        for (int ai = 0; ai < 2; ++ai)
#pragma unroll
            for (int m = 0; m < 4; ++m) { const int row = row0 + ai * HALF + m * 16; bf16_t* rowp = O + (size_t)row * ldc + col0; const float s = scl[lrow0 + ai * HALF + m * 16], s2 = s * s;
                u32x4 w;
#pragma unroll
                for (int n = 0; n < 2; ++n) { f32x4 fa, fu;
#pragma unroll
                    for (int k = 0; k < 4; ++k) { const float fg = acc[ai][0][m][n][k], fv = acc[ai][1][m][n][k]; fa[k] = (float)__builtin_bit_cast(int, fg); fu[k] = (float)__builtin_bit_cast(int, fv); }
                    const f32x4 x = fa * (c1[n] * s); f32x4 tt, r;
#pragma unroll
                    for (int k = 0; k < 4; ++k) tt[k] = __builtin_amdgcn_exp2f(x[k]);
                    const f32x4 d = tt * one + one;
#pragma unroll
                    for (int k = 0; k < 4; ++k) r[k] = __builtin_amdgcn_rcpf(d[k]);
                    const f32x4 o = ((fa * fu) * (c2[n] * s2)) * r;
                    if (n == 0) { w.x = cvt_pk_bf16(o[0], o[1]); w.y = cvt_pk_bf16(o[2], o[3]); } else { w.z = cvt_pk_bf16(o[0], o[1]); w.w = cvt_pk_bf16(o[2], o[3]); } }
                *(PG8_GAS u32x4*)rowp = w; }
    }
};
struct EpiNull { static constexpr bool PERM = true, AFTER_DRAIN = false, PREFETCH = false; int dummy;
    __device__ __forceinline__ void operator()(const f32x4 (&acc)[2][2][4][2], const Unit& u, int wr, int wc, int fr, int fq) const { float s = 0.f;
#pragma unroll
        for (int a = 0; a < 2; ++a)
#pragma unroll
            for (int b = 0; b < 2; ++b)
#pragma unroll
                for (int m = 0; m < 4; ++m)
#pragma unroll
                    for (int n = 0; n < 2; ++n) s += acc[a][b][m][n][0] + acc[a][b][m][n][1] + acc[a][b][m][n][2] + acc[a][b][m][n][3];
        asm volatile("" :: "v"(s)); }
};
struct EpiResidB {
    static constexpr bool PERM = true, AFTER_DRAIN = false, PREFETCH = false;
    const bf16_t* base; bf16_t* out; int ldc;
    __device__ __forceinline__ void operator()(const f32x4 (&acc)[2][2][4][2], const Unit& u, int wr, int wc, int fr, int fq) const {
        const int row0 = u.pm * BM + wr * 64 + fr, col0 = u.pc * BM + wc * 32 + 8 * fq;
#pragma unroll
        for (int ai = 0; ai < 2; ++ai)
#pragma unroll
            for (int m = 0; m < 4; ++m) { const size_t ro = (size_t)(row0 + ai * HALF + m * 16) * ldc + col0;
#pragma unroll
                for (int bj = 0; bj < 2; ++bj) { const u32x4 b = *(const PG8_GAS u32x4*)(base + ro + bj * HALF); const f32x4 v0 = acc[ai][bj][m][0], v1 = acc[ai][bj][m][1];
                    u32x4 w; w.x = cvt_pk_bf16(v0[0] + __builtin_bit_cast(float, b.x << 16), v0[1] + __builtin_bit_cast(float, b.x & 0xffff0000u)); w.y = cvt_pk_bf16(v0[2] + __builtin_bit_cast(float, b.y << 16), v0[3] + __builtin_bit_cast(float, b.y & 0xffff0000u));
                    w.z = cvt_pk_bf16(v1[0] + __builtin_bit_cast(float, b.z << 16), v1[1] + __builtin_bit_cast(float, b.z & 0xffff0000u)); w.w = cvt_pk_bf16(v1[2] + __builtin_bit_cast(float, b.w << 16), v1[3] + __builtin_bit_cast(float, b.w & 0xffff0000u));
                    *(PG8_GAS u32x4*)(out + ro + bj * HALF) = w; } }
    }
};
struct EpiResid {
    static constexpr bool PERM = false, AFTER_DRAIN = false, PREFETCH = false;
    const float* base; float* out; int ldc;
    __device__ __forceinline__ void operator()(const f32x4 (&acc)[2][2][4][2], const Unit& u, int wr, int wc, int fr, int fq) const {
        const int row0 = u.pm * BM + wr * 64 + fr, col0 = u.pc * BM + wc * 32 + 4 * fq;
#pragma unroll
        for (int ai = 0; ai < 2; ++ai)
#pragma unroll
            for (int m = 0; m < 4; ++m) { const size_t ro = (size_t)(row0 + ai * HALF + m * 16) * ldc + col0;
#pragma unroll
                for (int bj = 0; bj < 2; ++bj)
#pragma unroll
                    for (int n = 0; n < 2; ++n) { const size_t o = ro + bj * HALF + n * 16;
                        const f32x4 b = *(const PG8_GAS f32x4*)(base + o); *(PG8_GAS f32x4*)(out + o) = b + acc[ai][bj][m][n]; } }
    }
};
template <class Epi, class Sched, bool ALIGN_EPI = false, bool SP2 = false, int DT = 0>
__device__ __forceinline__ void gemm_phase(PG8_LAS unsigned char* lds, const Gemm g, const Sched& S, const Epi& E, int tid_in) {
    int tid_ = tid_in; asm volatile("" : "+v"(tid_));
    const int tid = tid_, wid = __builtin_amdgcn_readfirstlane(tid >> 6), lane = tid & 63, wr = wid >> 2, wc = wid & 3, fr = lane & 15, fq = lane >> 4;
    const int K = g.K, nt = K / BK;
    unsigned voffA[2], voffB[2];
#pragma unroll
    for (int i = 0; i < 2; ++i) { int R, C; stage_rc(tid * 16 + i * 8192, R, C); const int Rb = Epi::PERM ? ((R & ~31) + perm32(R & 31)) : R;
        voffA[i] = (unsigned)(R * g.lda + C) * 2u; voffB[i] = (unsigned)(Rb * g.ldb + C) * 2u; }
    const size_t kstep = (size_t)(BK * 2);
    const size_t hstepA = (size_t)HALF * g.lda * 2, hstepB = (size_t)HALF * g.ldb * 2;
    const size_t tstepA = 2 * hstepA, tstepB = 2 * hstepB;
    const unsigned ldsw = (unsigned)wid * 1024u;
    const int aoff = lds_byte(wr * 64 + fr, fq * 8), boff = lds_byte(wc * 32 + fr, fq * 8);
#define PG8_SA(b, h) (((b) * 2 + (h)) * HTB)
#define PG8_SB(b, h) ((4 + (b) * 2 + (h)) * HTB)
#define PG8_STAGE(bufoff, gbase, voff) do { _Pragma("unroll") for (int _i = 0; _i < 2; ++_i) \
        __builtin_amdgcn_global_load_lds((const unsigned*)((const char*)(gbase) + (voff)[_i]), (PG8_LAS unsigned*)(lds + (bufoff) + ldsw + _i * 8192), 16, 0, 0); } while (0)
#define PG8_LD16(base, off) (*(const PG8_LAS v4i_t*)((base) + (off)))
#define PG8_LDA(dst, b, h) do { if constexpr (DT == 1) { _Pragma("unroll") for (int m = 0; m < 4; ++m) A8[m] = __builtin_shufflevector(PG8_LD16(abase8, ((b) * 2 + (h)) * HTB + m * 2048), PG8_LD16(abase8, ((b) * 2 + (h)) * HTB + m * 2048 + 1024), 0, 1, 2, 3, 4, 5, 6, 7); } \
        else { _Pragma("unroll") for (int m = 0; m < 4; ++m) _Pragma("unroll") for (int k = 0; k < 2; ++k) dst[m][k] = *(const PG8_LAS bf16x8*)(lds + PG8_SA(b, h) + aoff + m * 2048 + k * 1024); } } while (0)
#define PG8_LDB(dst, b, h) do { if constexpr (DT == 1) { _Pragma("unroll") for (int n = 0; n < 2; ++n) dst##8[n] = __builtin_shufflevector(PG8_LD16(bbase8, ((b) * 2 + (h)) * HTB + n * 2048), PG8_LD16(bbase8, ((b) * 2 + (h)) * HTB + n * 2048 + 1024), 0, 1, 2, 3, 4, 5, 6, 7); } \
        else { _Pragma("unroll") for (int n = 0; n < 2; ++n) _Pragma("unroll") for (int k = 0; k < 2; ++k) dst[n][k] = *(const PG8_LAS bf16x8*)(lds + PG8_SB(b, h) + boff + n * 2048 + k * 1024); } } while (0)
#define PG8_MMA(ai, bj, At, Bt, first) do { __builtin_amdgcn_s_setprio(1); \
        if constexpr (DT == 1) { if (first) { _Pragma("unroll") for (int m = 0; m < 4; ++m) _Pragma("unroll") for (int n = 0; n < 2; ++n) \
            asm volatile("v_mfma_f32_16x16x128_f8f6f4 %0, %1, %2, 0" : "=v"(acc[ai][bj][m][n]) : "v"(Bt##8[n]), "v"(A8[m])); } \
          else { _Pragma("unroll") for (int m = 0; m < 4; ++m) _Pragma("unroll") for (int n = 0; n < 2; ++n) \
            asm volatile("v_mfma_f32_16x16x128_f8f6f4 %0, %1, %2, %0" : "+v"(acc[ai][bj][m][n]) : "v"(Bt##8[n]), "v"(A8[m])); } } \
        else if constexpr (DT == 2) {   \
          if (first) { _Pragma("unroll") for (int m = 0; m < 4; ++m) _Pragma("unroll") for (int n = 0; n < 2; ++n) \
            asm volatile("v_mfma_i32_16x16x64_i8 %0, %1, %2, 0" : "=v"(acc[ai][bj][m][n]) : "v"(Bt[n][0]), "v"(At[m][0])); } \
          else { _Pragma("unroll") for (int m = 0; m < 4; ++m) _Pragma("unroll") for (int n = 0; n < 2; ++n) \
            asm volatile("v_mfma_i32_16x16x64_i8 %0, %1, %2, %0" : "+v"(acc[ai][bj][m][n]) : "v"(Bt[n][0]), "v"(At[m][0])); } \
          _Pragma("unroll") for (int m = 0; m < 4; ++m) _Pragma("unroll") for (int n = 0; n < 2; ++n) \
            asm volatile("v_mfma_i32_16x16x64_i8 %0, %1, %2, %0" : "+v"(acc[ai][bj][m][n]) : "v"(Bt[n][1]), "v"(At[m][1])); } \
        else { _Pragma("unroll") for (int m = 0; m < 4; ++m) _Pragma("unroll") for (int n = 0; n < 2; ++n) _Pragma("unroll") for (int k = 0; k < 2; ++k) \
            acc[ai][bj][m][n] = __builtin_amdgcn_mfma_f32_16x16x32_bf16(Bt[n][k], At[m][k], acc[ai][bj][m][n], 0, 0, 0); } \
        __builtin_amdgcn_s_setprio(0); } while (0)
#define PG8_WAIT_V(n) asm volatile("s_waitcnt vmcnt(" #n ")" ::: "memory")
#define PG8_WAIT_L(n) asm volatile("s_waitcnt lgkmcnt(" #n ")" ::: "memory")
#define PG8_BAR __builtin_amdgcn_s_barrier()
#define PG8_SCHED __builtin_amdgcn_sched_barrier(0)
    Unit cur, nxt; int ui = 0;
    if (!S.next(0, cur)) return;
    f32x4 acc[2][2][4][2];
    if constexpr (DT == 0) {
#pragma unroll
        for (int a = 0; a < 2; ++a)
#pragma unroll
            for (int b = 0; b < 2; ++b)
#pragma unroll
                for (int m = 0; m < 4; ++m)
#pragma unroll
                    for (int n = 0; n < 2; ++n) acc[a][b][m][n] = (f32x4){0.f, 0.f, 0.f, 0.f};
    }
    PG8_LAS unsigned char* abase8 = lds + aoff; PG8_LAS unsigned char* bbase8 = lds + 4 * HTB + boff; asm volatile("" : "+v"(abase8), "+v"(bbase8));
    bf16x8 At[4][2], B0[2][2], B1[2][2]; v8i_t A8[4], B08[2], B18[2];
    const char* cA = (const char*)g.A + (size_t)cur.pm * tstepA; const char* cB = (const char*)g.Bt + (size_t)cur.pn * tstepB;
    S.a_ready(cur);
    if constexpr (Epi::PREFETCH) E.prefetch(cur, lds + EPI_SC_OFF, wid, lane);
    if constexpr (SP2) {
        PG8_STAGE(PG8_SB(0, 0), cB, voffB); PG8_STAGE(PG8_SB(0, 1), cB + hstepB, voffB); PG8_STAGE(PG8_SA(0, 0), cA, voffA); PG8_STAGE(PG8_SA(0, 1), cA + hstepA, voffA);
        if (wr == 1) PG8_BAR;
        PG8_WAIT_V(2); PG8_BAR;
        PG8_STAGE(PG8_SB(1, 0), cB + kstep, voffB); PG8_STAGE(PG8_SA(1, 0), cA + kstep, voffA); PG8_STAGE(PG8_SB(1, 1), cB + hstepB + kstep, voffB);
        PG8_WAIT_V(6); PG8_BAR;
    } else {
        PG8_STAGE(PG8_SB(0, 0), cB, voffB); PG8_STAGE(PG8_SA(0, 0), cA, voffA); PG8_STAGE(PG8_SB(0, 1), cB + hstepB, voffB); PG8_STAGE(PG8_SA(0, 1), cA + hstepA, voffA);
        if (wr == 1) PG8_BAR;
        PG8_WAIT_V(4); PG8_BAR;
        PG8_STAGE(PG8_SB(1, 0), cB + kstep, voffB); PG8_STAGE(PG8_SA(1, 0), cA + kstep, voffA); PG8_STAGE(PG8_SB(1, 1), cB + hstepB + kstep, voffB);
        PG8_WAIT_V(6); PG8_BAR;
    }
    for (;;) {
        const bool has_next = S.next(ui + 1, nxt);
        const char* nA = has_next ? (const char*)g.A + (size_t)nxt.pm * tstepA : cA; const char* nB = has_next ? (const char*)g.Bt + (size_t)nxt.pn * tstepB : cB;
#define PG8_ITER(FIRST) \
            const bool last = (t == nt - 2); \
            const char* a1 = cA + (size_t)(t + 1) * kstep; \
            const char* a2 = last ? nA : cA + (size_t)(t + 2) * kstep; const char* b2 = last ? nB : cB + (size_t)(t + 2) * kstep; \
            const char* a3 = a2 + kstep; const char* b3 = b2 + kstep; \
            if (last && has_next) S.a_ready(nxt); \
            if constexpr (SP2) { \
            PG8_LDB(B0, 0, 0); PG8_LDB(B1, 0, 1); PG8_SCHED; PG8_LDA(At, 0, 0); PG8_STAGE(PG8_SA(1, 1), a1 + hstepA, voffA); \
            PG8_WAIT_V(8); PG8_WAIT_L(0); PG8_BAR; PG8_MMA(0, 0, At, B0, FIRST); PG8_MMA(0, 1, At, B1, FIRST); PG8_BAR; PG8_SCHED; \
            PG8_LDA(At, 0, 1); PG8_STAGE(PG8_SB(0, 0), b2, voffB); PG8_STAGE(PG8_SB(0, 1), b2 + hstepB, voffB); PG8_STAGE(PG8_SA(0, 0), a2, voffA); \
            PG8_WAIT_V(8); PG8_WAIT_L(0); PG8_BAR; PG8_MMA(1, 0, At, B0, FIRST); PG8_MMA(1, 1, At, B1, FIRST); PG8_BAR; PG8_SCHED; \
            PG8_LDB(B0, 1, 0); PG8_LDB(B1, 1, 1); PG8_SCHED; PG8_LDA(At, 1, 0); PG8_STAGE(PG8_SA(0, 1), a2 + hstepA, voffA); \
            PG8_WAIT_V(8); PG8_WAIT_L(0); PG8_BAR; PG8_MMA(0, 0, At, B0, false); PG8_MMA(0, 1, At, B1, false); PG8_BAR; PG8_SCHED; \
            PG8_LDA(At, 1, 1); PG8_STAGE(PG8_SB(1, 0), b3, voffB); PG8_STAGE(PG8_SB(1, 1), b3 + hstepB, voffB); PG8_STAGE(PG8_SA(1, 0), a3, voffA); \
            PG8_WAIT_V(8); PG8_WAIT_L(0); PG8_BAR; PG8_MMA(1, 0, At, B0, false); PG8_MMA(1, 1, At, B1, false); PG8_BAR; PG8_SCHED; \
            } else { \
            PG8_LDB(B0, 0, 0); PG8_SCHED; PG8_LDA(At, 0, 0); PG8_STAGE(PG8_SA(1, 1), a1 + hstepA, voffA); \
            PG8_WAIT_L(8); PG8_BAR; PG8_WAIT_L(0); PG8_MMA(0, 0, At, B0, FIRST); PG8_BAR; PG8_SCHED; \
            PG8_LDB(B1, 0, 1); PG8_STAGE(PG8_SB(0, 0), b2, voffB); \
            PG8_BAR; PG8_WAIT_L(0); PG8_MMA(0, 1, At, B1, FIRST); PG8_BAR; \
            PG8_LDA(At, 0, 1); PG8_STAGE(PG8_SA(0, 0), a2, voffA); \
            PG8_BAR; PG8_WAIT_L(0); PG8_MMA(1, 0, At, B0, FIRST); PG8_BAR; PG8_SCHED; \
            PG8_STAGE(PG8_SB(0, 1), b2 + hstepB, voffB); \
            PG8_WAIT_V(6); PG8_BAR; PG8_MMA(1, 1, At, B1, FIRST); PG8_BAR; \
            PG8_LDB(B0, 1, 0); PG8_SCHED; PG8_LDA(At, 1, 0); PG8_STAGE(PG8_SA(0, 1), a2 + hstepA, voffA); \
            PG8_WAIT_L(8); PG8_BAR; PG8_WAIT_L(0); PG8_MMA(0, 0, At, B0, false); PG8_BAR; PG8_SCHED; \
            PG8_LDB(B1, 1, 1); PG8_STAGE(PG8_SB(1, 0), b3, voffB); \
            PG8_BAR; PG8_WAIT_L(0); PG8_MMA(0, 1, At, B1, false); PG8_BAR; \
            PG8_LDA(At, 1, 1); PG8_STAGE(PG8_SA(1, 0), a3, voffA); \
            PG8_BAR; PG8_WAIT_L(0); PG8_MMA(1, 0, At, B0, false); PG8_BAR; PG8_SCHED; \
            PG8_STAGE(PG8_SB(1, 1), b3 + hstepB, voffB); \
            PG8_WAIT_V(6); PG8_BAR; PG8_MMA(1, 1, At, B1, false); PG8_BAR; \
            }
        int t = 0;
        if constexpr (DT != 0) { PG8_ITER(true) t = 2; }
#pragma clang loop unroll(disable)
        for (; t < nt; t += 2) {
            PG8_ITER(false)
        }
#undef PG8_ITER
        if constexpr (DT != 0) asm volatile("s_nop 15\n\ts_nop 15" ::: "memory");
        if constexpr (ALIGN_EPI) { if (wr == 0) PG8_BAR; }
        if constexpr (Epi::PREFETCH) { E.run(acc, cur, wr, wc, fr, fq, (const PG8_LAS float*)(lds + EPI_SC_OFF + (ui & 1) * 2048)); S.done(cur);
            if (has_next) E.prefetch(nxt, lds + EPI_SC_OFF + ((ui + 1) & 1) * 2048, wid, lane); }
        else if constexpr (!Epi::AFTER_DRAIN) { E(acc, cur, wr, wc, fr, fq); S.done(cur); }
        if (!has_next) break;
        if constexpr (DT == 0) {
#pragma unroll
        for (int a = 0; a < 2; ++a)
#pragma unroll
            for (int b = 0; b < 2; ++b)
#pragma unroll
                for (int m = 0; m < 4; ++m)
#pragma unroll
                    for (int n = 0; n < 2; ++n) acc[a][b][m][n] = (f32x4){0.f, 0.f, 0.f, 0.f};
        }
        cur = nxt; cA = nA; cB = nB; ++ui;
        if constexpr (ALIGN_EPI) { if (wr == 1) PG8_BAR; }
    }
    PG8_WAIT_V(0);
    if constexpr (!ALIGN_EPI) { if (wr == 0) PG8_BAR; }
    PG8_BAR;
    if constexpr (Epi::AFTER_DRAIN) { E.fused(acc, cur, wr, wc, fr, fq, lds, wid, lane); S.done(cur); }
#undef PG8_SA
#undef PG8_SB
#undef PG8_STAGE
#undef PG8_LD16
#undef PG8_LDA
#undef PG8_LDB
#undef PG8_MMA
#undef PG8_WAIT_V
#undef PG8_WAIT_L
#undef PG8_BAR
#undef PG8_SCHED
}
}
constexpr int NWAVES = 8;
constexpr int NB = 32, SEQ = 2048, DM = 1024, NTOK = NB * SEQ;
constexpr int IN_E = 1952, IN_E_PAD = 2048, DFF = 2816, DFFX = 3584, NEXP = 8;
constexpr int MOE_CHUNK = 15360, N_CHUNK = (NTOK + MOE_CHUNK - 1) / MOE_CHUNK, CHUNK_SLOTS = 2 * MOE_CHUNK + NEXP * 256;
constexpr float NORM_EPS = 1e-6f, LOG2E = 1.4426950408889634f;

constexpr size_t MiB = 1u << 20;
constexpr size_t WS_CTL = 0, CTL_ZERO_BYTES = 1 * MiB;
constexpr size_t WS_ROPE = 1 * MiB;
constexpr size_t WS_ROUTE_I = 2 * MiB;
constexpr size_t WS_ROUTE_W = 3 * MiB;
constexpr size_t WS_WEV = 4 * MiB, EV_STRIDE = 24 * MiB;
constexpr size_t EV_WIN = 0, EV_WUQ = 4 * MiB, EV_WUKV = 4 * MiB + 512 * 1024, EV_WOUT = 5 * MiB, EV_WGU = 7 * MiB, EV_WD = 18 * MiB;
constexpr size_t WS_WOD = 52 * MiB, OD_STRIDE = 8 * MiB;
constexpr size_t OD_WQKV = 0, OD_WO = 6 * MiB;
constexpr size_t WS_MWGU = 68 * MiB;
constexpr size_t WS_MWD = 180 * MiB;
constexpr size_t WS_H = 236 * MiB;
constexpr size_t WS_BIG = 364 * MiB;
constexpr size_t WS_PROJ = WS_BIG, WS_QM = WS_BIG + 256 * MiB, WS_KVM = WS_BIG + 352 * MiB, WS_KPE = WS_BIG + 480 * MiB;
constexpr size_t WS_ACT = WS_BIG;
constexpr size_t WS_QKV = WS_BIG;
constexpr size_t WS_YALL = WS_BIG, WS_HG8 = WS_BIG + 32 * MiB, WS_MACT = WS_BIG + 320 * MiB;
constexpr size_t WS_DP1 = 848 * MiB, WS_DP2 = 912 * MiB, WS_DL1 = 976 * MiB, WS_DL2 = 978 * MiB;
constexpr size_t WS_SA = 980 * MiB;
constexpr size_t WS_SB = 981 * MiB;
constexpr size_t WS_END = 982 * MiB;
static_assert(WS_MACT + 2 * (size_t)CHUNK_SLOTS * DFFX <= WS_DP1 + 132 * MiB && WS_KPE + (size_t)NTOK * 64 <= WS_DP1 && WS_YALL + (size_t)N_CHUNK * CHUNK_SLOTS * DM * 2 <= WS_MACT && (size_t)CHUNK_SLOTS * DM == 32 * MiB, "ws map");
constexpr int CW_BAR = 4096;
constexpr int CW_WMAX = 12288;
constexpr int CW_CNT = 16384;

constexpr int RING_BYTES = 131072, LDSCTL_OFF = RING_BYTES, MISC_OFF = LDSCTL_OFF + 320, LDS_BYTES = 163840, RPB_OFF = 132096;

#define GAS __attribute__((address_space(1)))
#define LAS __attribute__((address_space(3)))
typedef unsigned short bf16;
typedef unsigned v4u __attribute__((ext_vector_type(4)));
typedef unsigned v2u __attribute__((ext_vector_type(2)));
typedef int v4i __attribute__((ext_vector_type(4)));
typedef float f32x4 __attribute__((ext_vector_type(4)));
typedef float f32x2 __attribute__((ext_vector_type(2)));
#define LDS_WAIT() asm volatile("s_waitcnt lgkmcnt(0)" ::: "memory")
#define VM_WAIT() asm volatile("s_waitcnt vmcnt(0)" ::: "memory")
__device__ __forceinline__ unsigned f2bf(float f) { unsigned u = __builtin_bit_cast(unsigned, f); return (u + 0x7fffu + ((u >> 16) & 1u)) >> 16; }
#if defined(__HIP_DEVICE_COMPILE__)
#define GLOBAL_AS __attribute__((address_space(1)))
#else
#define GLOBAL_AS
#endif
__device__ __forceinline__ unsigned pk2(float lo, float hi) { return f2bf(lo) | (f2bf(hi) << 16); }
__device__ __forceinline__ float bflo(unsigned w) { return __builtin_bit_cast(float, w << 16); }
__device__ __forceinline__ float bfhi(unsigned w) { return __builtin_bit_cast(float, w & 0xffff0000u); }
template <int CTRL> __device__ __forceinline__ float dppf(float v) { return __builtin_bit_cast(float, __builtin_amdgcn_mov_dpp(__builtin_bit_cast(int, v), CTRL, 0xF, 0xF, true)); }
__device__ __forceinline__ void swap16(unsigned& a, unsigned& b) { asm("s_nop 1\n\tv_permlane16_swap_b32 %0, %1\n\ts_nop 1" : "+v"(a), "+v"(b)); }
__device__ __forceinline__ void swap32(unsigned& a, unsigned& b) { asm("s_nop 1\n\tv_permlane32_swap_b32 %0, %1\n\ts_nop 1" : "+v"(a), "+v"(b)); }
__device__ __forceinline__ float wsum_all(float v) {
    v += dppf<0xB1>(v); v += dppf<0x4E>(v); v += dppf<0x141>(v); v += dppf<0x140>(v);
    unsigned a = __builtin_bit_cast(unsigned, v), b = a; swap16(a, b); v = __builtin_bit_cast(float, a) + __builtin_bit_cast(float, b);
    a = __builtin_bit_cast(unsigned, v); b = a; swap32(a, b); return __builtin_bit_cast(float, a) + __builtin_bit_cast(float, b);
}
__device__ __forceinline__ float wmax_all(float v) {
    v = fmaxf(v, dppf<0xB1>(v)); v = fmaxf(v, dppf<0x4E>(v)); v = fmaxf(v, dppf<0x141>(v)); v = fmaxf(v, dppf<0x140>(v));
    unsigned a = __builtin_bit_cast(unsigned, v), b = a; swap16(a, b); v = fmaxf(__builtin_bit_cast(float, a), __builtin_bit_cast(float, b));
    a = __builtin_bit_cast(unsigned, v); b = a; swap32(a, b); return fmaxf(__builtin_bit_cast(float, a), __builtin_bit_cast(float, b));
}
constexpr int LDX = 2048;
__device__ __forceinline__ f32x4 ldx4(const bf16* row, int idx) { const v2u w = ((const GLOBAL_AS v2u*)row)[idx]; return (f32x4){bflo(w.x), bfhi(w.x), bflo(w.y), bfhi(w.y)}; }
__device__ __forceinline__ void stx4(bf16* row, int idx, f32x4 v) { v2u w; w.x = pk2(v.x, v.y); w.y = pk2(v.z, v.w); ((GLOBAL_AS v2u*)row)[idx] = w; }
__device__ __forceinline__ float ex2(float x) { return __builtin_amdgcn_exp2f(x); }

#define XB_TMO      128
#define XB_XCNT(j)  (256  + 64 * (j))
#define XB_XSUB(j)  (1280 + 64 * (j))
#define XB_XGEN(j)  (2304 + 64 * (j))
#define XB_TOP      3328
#define XB_TOPGEN   3392
#define XCD_BAR_WORDS 3456
#define XB_SPIN_CAP (1u << 22)

__device__ __forceinline__ unsigned xb_ld(unsigned* p)              { return __hip_atomic_load(p, __ATOMIC_RELAXED, __HIP_MEMORY_SCOPE_AGENT); }
__device__ __forceinline__ unsigned xb_add(unsigned* p, unsigned v) { return __hip_atomic_fetch_add(p, v, __ATOMIC_RELAXED, __HIP_MEMORY_SCOPE_AGENT); }
__device__ __forceinline__ unsigned xb_xcc_id() { return (unsigned)__builtin_amdgcn_s_getreg((3 << 11) | 20) & 0xFu; }
#define XB_SPIN(cond, bar) do { unsigned _sp = 0; while (cond) { __builtin_amdgcn_s_sleep(1); \
    if ((++_sp & 255u) == 0u) { if (xb_ld(&(bar)[XB_TMO])) break; if (_sp > XB_SPIN_CAP) { atomicAdd(&(bar)[XB_TMO], 1u); break; } } } } while (0)

struct XcdBarrier {
    unsigned* bar; unsigned x;
    volatile LAS unsigned* st;
};

__device__ __forceinline__ XcdBarrier xcd_barrier_post(unsigned* bar, volatile LAS unsigned* st) {
    XcdBarrier b; b.bar = bar; b.x = xb_xcc_id(); b.st = st;
    if (threadIdx.x == 0) (void)xb_add(&bar[XB_XCNT(b.x)], 1u);
    return b;
}
__device__ __forceinline__ void xcd_barrier_complete(unsigned* bar, unsigned x, unsigned& nloc, unsigned& nx) {
    const unsigned G = gridDim.x * gridDim.y * gridDim.z;
    unsigned sum, cnt, mine, sp = 0u;
    for (;;) {
        sum = 0u; cnt = 0u; mine = 0u;
#pragma unroll
        for (unsigned j = 0; j < 16; ++j) { const unsigned c = xb_ld(&bar[XB_XCNT(j)]); sum += c; cnt += (c > 0u) ? 1u : 0u; mine = (j == x) ? c : mine; }
        if (sum == G) break;
        __builtin_amdgcn_s_sleep(1);
        if ((++sp & 255u) == 0u) { if (xb_ld(&bar[XB_TMO])) break; if (sp > XB_SPIN_CAP) { atomicAdd(&bar[XB_TMO], 1u); break; } }
    }
    nloc = mine > 0u ? mine : 1u; nx = cnt > 0u ? cnt : 1u;
}

__device__ __forceinline__ void xcd_barrier(const XcdBarrier& b, int tid) {
    asm volatile("s_waitcnt vmcnt(0)" ::: "memory");
    __syncthreads();
    if (tid == 0) {
        unsigned* bar = b.bar;
        __builtin_amdgcn_s_waitcnt(0);
        unsigned nloc = b.st[0], nx = b.st[1];
        if (nloc == 0u) { xcd_barrier_complete(bar, b.x, nloc, nx); b.st[0] = nloc; b.st[1] = nx; }
        const unsigned old = xb_add(&bar[XB_XSUB(b.x)], 1u);
        const unsigned gen = old / nloc;
        if (old + 1u == (gen + 1u) * nloc) {
            __builtin_amdgcn_fence(__ATOMIC_RELEASE, "agent");
            asm volatile("s_waitcnt vmcnt(0)" ::: "memory");
            const unsigned og = xb_add(&bar[XB_TOP], 1u);
            const unsigned tg = og / nx;
            if (og + 1u == (tg + 1u) * nx) xb_add(&bar[XB_TOPGEN], 1u);
            else XB_SPIN(xb_ld(&bar[XB_TOPGEN]) == tg, bar);
            __builtin_amdgcn_fence(__ATOMIC_ACQUIRE, "agent");
            xb_add(&bar[XB_XGEN(b.x)], 1u);
            asm volatile("s_waitcnt vmcnt(0)" ::: "memory");
        } else {
            XB_SPIN(xb_ld(&bar[XB_XGEN(b.x)]) == gen, bar);
            __builtin_amdgcn_fence(__ATOMIC_ACQUIRE, "agent");
            asm volatile("s_waitcnt vmcnt(0)" ::: "memory");
        }
    }
    __syncthreads();
}
__device__ __forceinline__ float wave_sum(float v, int lane) {
#pragma unroll
    for (int o = 1; o < 64; o <<= 1) v += __builtin_bit_cast(float, __builtin_amdgcn_ds_bpermute((lane ^ o) << 2, __builtin_bit_cast(int, v)));
    return v;
}
__device__ __forceinline__ void cvt_item(const float* W, int N, bf16* WT, int ldo, int dst_row0, int k0, int n0, LAS float* scr, int lane) {
    float wv[32];
#pragma unroll
    for (int i = 0; i < 32; ++i) wv[i] = W[(size_t)(k0 + 2 * i + (lane >> 5)) * N + n0 + (lane & 31)];
#pragma unroll
    for (int i = 0; i < 32; ++i) scr[(2 * i + (lane >> 5)) * 33 + (lane & 31)] = wv[i];
    LDS_WAIT(); asm volatile("" ::: "memory");
    const int c = lane & 7;
#pragma unroll
    for (int j = 0; j < 4; ++j) { const int n = (lane >> 3) + 8 * j; const LAS float* s = scr + (8 * c) * 33 + n;
        v4u o; o.x = pk2(s[0 * 33], s[1 * 33]); o.y = pk2(s[2 * 33], s[3 * 33]); o.z = pk2(s[4 * 33], s[5 * 33]); o.w = pk2(s[6 * 33], s[7 * 33]);
        *(GLOBAL_AS v4u*)(WT + (size_t)(dst_row0 + n) * ldo + k0 + 8 * c) = o; }
    LDS_WAIT(); asm volatile("" ::: "memory");
}
__device__ __forceinline__ void cvt_item8(const float* W, int N, unsigned char* WT, int ldo, int dst_row0, int k0, int n0, LAS float* scr, int lane, float scale) {
    float wv[32];
#pragma unroll
    for (int i = 0; i < 32; ++i) wv[i] = W[(size_t)(k0 + 2 * i + (lane >> 5)) * N + n0 + (lane & 31)];
#pragma unroll
    for (int i = 0; i < 32; ++i) scr[(2 * i + (lane >> 5)) * 33 + (lane & 31)] = wv[i] * scale;
    LDS_WAIT(); asm volatile("" ::: "memory");
    const int c = lane & 3;
#pragma unroll
    for (int j = 0; j < 2; ++j) { const int n = (lane >> 2) + 16 * j; const LAS float* s = scr + (16 * c) * 33 + n;
        v4u o; o.x = pg8::cvt4_fp8(s[0 * 33], s[1 * 33], s[2 * 33], s[3 * 33]); o.y = pg8::cvt4_fp8(s[4 * 33], s[5 * 33], s[6 * 33], s[7 * 33]);
        o.z = pg8::cvt4_fp8(s[8 * 33], s[9 * 33], s[10 * 33], s[11 * 33]); o.w = pg8::cvt4_fp8(s[12 * 33], s[13 * 33], s[14 * 33], s[15 * 33]);
        *(GLOBAL_AS v4u*)(WT + (size_t)(dst_row0 + n) * ldo + k0 + 16 * c) = o; }
    LDS_WAIT(); asm volatile("" ::: "memory");
}
__device__ __forceinline__ void cvt_job8(const float* W, int K, int N, unsigned char* WT, int ldo, int rowmap, int item, LAS float* scr, int lane, float scale) {
    const int nblk = N / 32, kb = item / nblk, nb = item % nblk, n0 = 32 * nb;
    int dr = n0; if (rowmap) dr = (n0 >> 7) * 256 + (n0 & 127) + (rowmap == 2 ? 128 : 0);
    cvt_item8(W, N, WT, ldo, dr, 64 * kb, n0, scr, lane, scale);
}
__device__ __forceinline__ unsigned pack4_i8(float a, float b, float c, float d) {
    const int qa = (int)__builtin_rintf(a), qb = (int)__builtin_rintf(b), qc = (int)__builtin_rintf(c), qd = (int)__builtin_rintf(d);
    return (unsigned)(qa & 255) | ((unsigned)(qb & 255) << 8) | ((unsigned)(qc & 255) << 16) | ((unsigned)(qd & 255) << 24);
}
__device__ __forceinline__ void cvt_item_i8(const float* W, int N, unsigned char* WT, int ldo, int dst_row0, int k0, int n0, LAS float* scr, int lane, float inv) {
    float wv[32];
#pragma unroll
    for (int i = 0; i < 32; ++i) wv[i] = W[(size_t)(k0 + 2 * i + (lane >> 5)) * N + n0 + (lane & 31)];
#pragma unroll
    for (int i = 0; i < 32; ++i) scr[(2 * i + (lane >> 5)) * 33 + (lane & 31)] = __builtin_amdgcn_fmed3f(wv[i] * inv, -127.0f, 127.0f);
    LDS_WAIT(); asm volatile("" ::: "memory");
    const int c = lane & 3;
#pragma unroll
    for (int j = 0; j < 2; ++j) { const int n = (lane >> 2) + 16 * j; const LAS float* s = scr + (16 * c) * 33 + n;
        v4u o; o.x = pack4_i8(s[0 * 33], s[1 * 33], s[2 * 33], s[3 * 33]); o.y = pack4_i8(s[4 * 33], s[5 * 33], s[6 * 33], s[7 * 33]);
        o.z = pack4_i8(s[8 * 33], s[9 * 33], s[10 * 33], s[11 * 33]); o.w = pack4_i8(s[12 * 33], s[13 * 33], s[14 * 33], s[15 * 33]);
        *(GLOBAL_AS v4u*)(WT + (size_t)(dst_row0 + n) * ldo + k0 + 16 * c) = o; }
    LDS_WAIT(); asm volatile("" ::: "memory");
}
__device__ __forceinline__ void cvt_job_i8(const float* W, int K, int N, unsigned char* WT, int ldo, int item, LAS float* scr, int lane, float inv, int rowmap = 0) {
    const int nblk = N / 32, kb = item / nblk, nb = item % nblk, n0 = 32 * nb;
    int dr = n0; if (rowmap) dr = (n0 >> 7) * 256 + (n0 & 127) + (rowmap == 2 ? 128 : 0);
    cvt_item_i8(W, N, WT, ldo, dr, 64 * kb, n0, scr, lane, inv);
}
__device__ __forceinline__ void cvt_job(const float* W, int K, int N, bf16* WT, int ldo, int rowmap, int item, LAS float* scr, int lane) {
    const int nblk = N / 32, kb = item / nblk, nb = item % nblk, n0 = 32 * nb;
    int dr = n0; if (rowmap) dr = (n0 >> 7) * 256 + (n0 & 127) + (rowmap == 2 ? 128 : 0);
    cvt_item(W, N, WT, ldo, dr, 64 * kb, n0, scr, lane);
}
__device__ const double ROPE_F[16] = {0.15915494309189535, 0.08949940160889101, 0.050329212104487035, 0.0283021958306234, 0.015915494309189534, 0.008949940160889102, 0.005032921210448704, 0.00283021958306234,
    0.0015915494309189536, 0.0008949940160889102, 0.0005032921210448703, 0.00028302195830623395, 0.00015915494309189535, 8.949940160889102e-05, 5.0329212104487035e-05, 2.8302195830623396e-05};

struct Ctx {
    float* out; unsigned char* ws; LAS unsigned char* lds; int tid, lane, wave, G, gw, NGW;
};

__device__ __forceinline__ void cvt_strip_i8(const float* W, int K, int N, unsigned char* WT, int ldo, float* sb, int rowmap, int strip, LAS float* scr, int lane) {
    const int n0 = 32 * strip; int dr = n0; if (rowmap) dr = (n0 >> 7) * 256 + (n0 & 127) + (rowmap == 2 ? 128 : 0);
    const float* col = W + n0 + (lane & 31) + (size_t)(lane >> 5) * N;
    float mx = 0.f;
    for (int k0 = 0; k0 < K; k0 += 64) { float wv[32];
#pragma unroll
        for (int i = 0; i < 32; ++i) wv[i] = col[(size_t)(k0 + 2 * i) * N];
#pragma unroll
        for (int i = 0; i < 32; ++i) mx = fmaxf(mx, fabsf(wv[i])); }
    mx = fmaxf(mx, __builtin_bit_cast(float, __builtin_amdgcn_ds_bpermute((lane ^ 32) << 2, __builtin_bit_cast(int, mx))));
    mx = fmaxf(mx, 1e-30f); const float inv = 127.0f / mx;
    if (lane < 32) sb[dr + lane] = mx * (1.0f / 127.0f);
    for (int k0 = 0; k0 < K; k0 += 64) { float wv[32];
#pragma unroll
        for (int i = 0; i < 32; ++i) wv[i] = col[(size_t)(k0 + 2 * i) * N];
#pragma unroll
        for (int i = 0; i < 32; ++i) scr[(2 * i + (lane >> 5)) * 33 + (lane & 31)] = wv[i] * inv;
        LDS_WAIT(); asm volatile("" ::: "memory");
        const int c = lane & 3;
#pragma unroll
        for (int j = 0; j < 2; ++j) { const int n = (lane >> 2) + 16 * j; const LAS float* s = scr + (16 * c) * 33 + n;
            v4u o; o.x = pack4_i8(s[0 * 33], s[1 * 33], s[2 * 33], s[3 * 33]); o.y = pack4_i8(s[4 * 33], s[5 * 33], s[6 * 33], s[7 * 33]);
            o.z = pack4_i8(s[8 * 33], s[9 * 33], s[10 * 33], s[11 * 33]); o.w = pack4_i8(s[12 * 33], s[13 * 33], s[14 * 33], s[15 * 33]);
            *(GLOBAL_AS v4u*)(WT + (size_t)(dr + n) * ldo + k0 + 16 * c) = o; }
        LDS_WAIT(); asm volatile("" ::: "memory"); }
}
__device__ __forceinline__ void cvt_strip_i8_wg(const float* W, int N, unsigned char* WT, int ldo, float* sb, int rowmap, int strip, LAS unsigned char* lds, int wave, int lane) {
    const int n0 = 32 * strip; int dr = n0; if (rowmap) dr = (n0 >> 7) * 256 + (n0 & 127) + (rowmap == 2 ? 128 : 0);
    const float* col = W + n0 + (lane & 31) + (size_t)(lane >> 5) * N;
    LAS float* scr = (LAS float*)(lds + wave * 16384); LAS float* pm = (LAS float*)(lds + 12288);
    float wv[2][32]; float mx = 0.f;
#pragma unroll
    for (int c = 0; c < 2; ++c)
#pragma unroll
        for (int i = 0; i < 32; ++i) wv[c][i] = col[(size_t)(64 * (2 * wave + c) + 2 * i) * N];
#pragma unroll
    for (int c = 0; c < 2; ++c)
#pragma unroll
        for (int i = 0; i < 32; ++i) mx = fmaxf(mx, fabsf(wv[c][i]));
    mx = fmaxf(mx, __builtin_bit_cast(float, __builtin_amdgcn_ds_bpermute((lane ^ 32) << 2, __builtin_bit_cast(int, mx))));
    if (lane < 32) pm[wave * 32 + lane] = mx;
    __syncthreads();
    float g = 0.f;
#pragma unroll
    for (int w = 0; w < 8; ++w) g = fmaxf(g, pm[w * 32 + (lane & 31)]);
    g = fmaxf(g, 1e-30f); const float inv = 127.0f / g;
    if (wave == 0 && lane < 32) sb[dr + lane] = g * (1.0f / 127.0f);
#pragma unroll
    for (int c = 0; c < 2; ++c) { const int k0 = 64 * (2 * wave + c);
#pragma unroll
        for (int i = 0; i < 32; ++i) scr[(2 * i + (lane >> 5)) * 33 + (lane & 31)] = wv[c][i] * inv;
        LDS_WAIT(); asm volatile("" ::: "memory");
        const int cc = lane & 3;
#pragma unroll
        for (int j = 0; j < 2; ++j) { const int n = (lane >> 2) + 16 * j; const LAS float* s = scr + (16 * cc) * 33 + n;
            v4u o; o.x = pack4_i8(s[0 * 33], s[1 * 33], s[2 * 33], s[3 * 33]); o.y = pack4_i8(s[4 * 33], s[5 * 33], s[6 * 33], s[7 * 33]);
            o.z = pack4_i8(s[8 * 33], s[9 * 33], s[10 * 33], s[11 * 33]); o.w = pack4_i8(s[12 * 33], s[13 * 33], s[14 * 33], s[15 * 33]);
            *(GLOBAL_AS v4u*)(WT + (size_t)(dr + n) * ldo + k0 + 16 * cc) = o; }
        LDS_WAIT(); asm volatile("" ::: "memory"); }
    __syncthreads();
}
template <class A> __device__ __forceinline__ void p0_prologue(const Ctx& C, const A& IN) {
    LAS float* scr = (LAS float*)(C.lds + C.wave * 16384);
    GLOBAL_AS float* sball = (GLOBAL_AS float*)(C.ws + WS_SB);
    constexpr int S0 = IN_E / 32, S4 = DFF / 32, S7 = 3072 / 32, NSTRIPS = 2 * (S0 + 2 * S4 + S7);
    constexpr int I1 = 4 * 24, I2 = 2 * 32, I3 = 16 * 32, I6 = 44 * 32, I8 = 16 * 32;
    constexpr int NITEMS = 2 * (I1 + I2 + I3 + I6 + I8);
    for (int st = blockIdx.x; st < NSTRIPS; st += C.G) {
        int r = st;
        if (r < 2 * S0) { const int ly = r / S0, q = r % S0; cvt_strip_i8_wg(IN.in[2] + (size_t)ly * DM * IN_E, IN_E, C.ws + WS_WEV + ly * EV_STRIDE + EV_WIN, DM, sball + ly * 8192, 0, q, C.lds, C.wave, C.lane); continue; } r -= 2 * S0;
        if (r < 2 * S4) { const int ly = r / S4, q = r % S4; cvt_strip_i8_wg(IN.in[9] + (size_t)ly * DM * DFF, DFF, C.ws + WS_WEV + ly * EV_STRIDE + EV_WGU, DM, sball + ly * 8192 + 2048, 1, q, C.lds, C.wave, C.lane); continue; } r -= 2 * S4;
        if (r < 2 * S4) { const int ly = r / S4, q = r % S4; cvt_strip_i8_wg(IN.in[10] + (size_t)ly * DM * DFF, DFF, C.ws + WS_WEV + ly * EV_STRIDE + EV_WGU, DM, sball + ly * 8192 + 2048, 2, q, C.lds, C.wave, C.lane); continue; } r -= 2 * S4;
        { const int ly = r / S7, q = r % S7; cvt_strip_i8_wg(IN.in[13] + (size_t)ly * DM * 3072, 3072, C.ws + WS_WOD + ly * OD_STRIDE + OD_WQKV, DM, sball + 16384 + ly * 4096, 0, q, C.lds, C.wave, C.lane); }
    }
    for (int it = C.gw; it < NITEMS; it += C.NGW) {
        int r = it;
        if (r < 2 * I1) { const int ly = r / I1, q = r % I1; cvt_job(IN.in[4] + (size_t)ly * 256 * 768, 256, 768, (bf16*)(C.ws + WS_WEV + ly * EV_STRIDE + EV_WUQ), 256, 0, q, scr, C.lane); continue; } r -= 2 * I1;
        if (r < 2 * I2) { const int ly = r / I2, q = r % I2; cvt_job(IN.in[6] + (size_t)ly * 128 * 1024, 128, 1024, (bf16*)(C.ws + WS_WEV + ly * EV_STRIDE + EV_WUKV), 256, 0, q, scr, C.lane); continue; } r -= 2 * I2;
        if (r < 2 * I3) { const int ly = r / I3, q = r % I3; cvt_job(IN.in[7] + (size_t)ly * DM * DM, DM, DM, (bf16*)(C.ws + WS_WEV + ly * EV_STRIDE + EV_WOUT), DM, 0, q, scr, C.lane); continue; } r -= 2 * I3;
        if (r < 2 * I6) { const int ly = r / I6, q = r % I6; cvt_job(IN.in[11] + (size_t)ly * DFF * DM, DFF, DM, (bf16*)(C.ws + WS_WEV + ly * EV_STRIDE + EV_WD), DFF, 0, q, scr, C.lane); continue; } r -= 2 * I6;
        { const int ly = r / I8, q = r % I8; cvt_job(IN.in[15] + (size_t)ly * DM * DM, DM, DM, (bf16*)(C.ws + WS_WOD + ly * OD_STRIDE + OD_WO), DM, 0, q, scr, C.lane); }
    }
    const int gt = blockIdx.x * (NWAVES * 64) + C.tid, NGT = C.G * NWAVES * 64;
    for (int i = gt; i < 2 * 6144; i += NGT) { const int ly = i / 6144, q = i % 6144; ((GLOBAL_AS v4u*)(C.ws + WS_WEV + ly * EV_STRIDE + EV_WIN + (size_t)IN_E * DM))[q] = (v4u){0u, 0u, 0u, 0u}; }
    for (int i = gt; i < 2 * 96; i += NGT) ((GLOBAL_AS float*)(C.ws + WS_SB))[(i / 96) * 8192 + IN_E + (i % 96)] = 0.f;
    for (int i = gt; i < 2 * 16384; i += NGT) { const int ly = i / 16384, q = i % 16384, row = q >> 4, cc = q & 15; ((GLOBAL_AS v4u*)(C.ws + WS_WEV + ly * EV_STRIDE + EV_WUKV + (size_t)row * 512 + 256))[cc] = (v4u){0u, 0u, 0u, 0u}; }
    GLOBAL_AS float* rope = (GLOBAL_AS float*)(C.ws + WS_ROPE);
    for (int i = gt; i < SEQ * 16; i += NGT) { const int t = i >> 4, k = i & 15; double fr = (double)t * ROPE_F[k]; fr -= floor(fr); const float f = (float)fr;
        rope[2 * i] = __builtin_amdgcn_cosf(f); rope[2 * i + 1] = __builtin_amdgcn_sinf(f); }
}
template <class A> __device__ __forceinline__ void moe_weights(const Ctx& C, const A& IN, int j) {
    LAS float* scr = (LAS float*)(C.lds + C.wave * 16384);
    constexpr int IG = 16 * 112, ID = 56 * 32;
    constexpr int NITEMS = NEXP * (2 * IG + ID);
    for (int it = C.gw; it < NITEMS; it += C.NGW) {
        const int e = it / (2 * IG + ID); int r = it % (2 * IG + ID);
        const size_t eo = ((size_t)j * NEXP + e) * (size_t)DM * DFFX;
        if (r < IG) { cvt_job8(IN.in[18] + eo, DM, DFFX, C.ws + WS_MWGU + (size_t)e * 7168 * DM, DM, 1, r, scr, C.lane, 32.0f); continue; } r -= IG;
        if (r < IG) { cvt_job8(IN.in[19] + eo, DM, DFFX, C.ws + WS_MWGU + (size_t)e * 7168 * DM, DM, 2, r, scr, C.lane, 32.0f); continue; } r -= IG;
        cvt_job8(IN.in[20] + eo, DFFX, DM, C.ws + WS_MWD + (size_t)e * DM * DFFX, DFFX, 0, r, scr, C.lane, 32.0f);
    }
}
template <int OUT = 0, bool XF32 = false>
__device__ __forceinline__ void norm_phase(const Ctx& C, const void* x, const float* g, bf16* H, bf16* xb = nullptr) {
    constexpr int NR = 4;
    f32x4 gg[4];
#pragma unroll
    for (int j = 0; j < 4; ++j) gg[j] = ((const GLOBAL_AS f32x4*)g)[64 * j + C.lane];
    for (int m0 = C.gw; m0 < NTOK; m0 += NR * C.NGW) {
        f32x4 v[NR][4]; float s[NR];
#pragma unroll
        for (int r = 0; r < NR; ++r) { const int m = min(m0 + r * C.NGW, NTOK - 1);
            if (XF32) { const GLOBAL_AS f32x4* xr = (const GLOBAL_AS f32x4*)((const GLOBAL_AS float*)x + (size_t)m * DM) + C.lane;
#pragma unroll
                for (int j = 0; j < 4; ++j) v[r][j] = xr[64 * j]; }
            else { const bf16* xr = (const bf16*)x + (size_t)m * LDX;
#pragma unroll
                for (int j = 0; j < 4; ++j) v[r][j] = ldx4(xr, 64 * j + C.lane); } }
#pragma unroll
        for (int r = 0; r < NR; ++r) { float a = 0.f;
#pragma unroll
            for (int j = 0; j < 4; ++j) a += (v[r][j].x * v[r][j].x + v[r][j].y * v[r][j].y) + (v[r][j].z * v[r][j].z + v[r][j].w * v[r][j].w);
            s[r] = a; }
#pragma unroll
        for (int r = 0; r < NR; ++r) s[r] = wsum_all(s[r]);
#pragma unroll
        for (int r = 0; r < NR; ++r) { const int m = m0 + r * C.NGW; if (m < NTOK) { const float rstd = 1.0f / sqrtf(s[r] * (1.0f / DM) + NORM_EPS);
            if (XF32) {
#pragma unroll
                for (int j = 0; j < 4; ++j) stx4(xb + (size_t)m * LDX, 64 * j + C.lane, v[r][j]); }
            if (OUT == 2) { f32x4 y[4]; float am = 0.f;
#pragma unroll
                for (int j = 0; j < 4; ++j) { y[j] = v[r][j] * rstd * gg[j]; am = fmaxf(fmaxf(am, fmaxf(fabsf(y[j].x), fabsf(y[j].y))), fmaxf(fabsf(y[j].z), fabsf(y[j].w))); }
                am = fmaxf(wmax_all(am), 1e-20f); const float inv = 127.0f / am; GLOBAL_AS unsigned* o4 = (GLOBAL_AS unsigned*)((unsigned char*)H + (size_t)m * DM) + C.lane;
#pragma unroll
                for (int j = 0; j < 4; ++j) o4[64 * j] = pack4_i8(y[j].x * inv, y[j].y * inv, y[j].z * inv, y[j].w * inv);
                if (C.lane == 0) ((GLOBAL_AS float*)(C.ws + WS_SA))[m] = am * (1.0f / 127.0f); }
            else if (OUT == 1) { GLOBAL_AS unsigned* o4 = (GLOBAL_AS unsigned*)((unsigned char*)H + (size_t)m * DM) + C.lane;
#pragma unroll
                for (int j = 0; j < 4; ++j) { const f32x4 y = v[r][j] * rstd * gg[j]; o4[64 * j] = pg8::cvt4_fp8(y.x, y.y, y.z, y.w); } }
            else { GLOBAL_AS unsigned long long* o8 = (GLOBAL_AS unsigned long long*)(H + (size_t)m * DM) + C.lane;
#pragma unroll
                for (int j = 0; j < 4; ++j) { const f32x4 y = v[r][j] * rstd * gg[j]; o8[64 * j] = (unsigned long long)pk2(y.x, y.y) | ((unsigned long long)pk2(y.z, y.w) << 32); } } } }
    }
}
__device__ __forceinline__ void norm_phase_b(const Ctx& C, const bf16* x, const float* g, bf16* H) {
    f32x4 gg[4];
#pragma unroll
    for (int j = 0; j < 4; ++j) gg[j] = ((const GLOBAL_AS f32x4*)g)[64 * j + C.lane];
    for (int m0 = C.gw; m0 < NTOK; m0 += 8 * C.NGW) {
        v2u w[8][4]; float s[8];
#pragma unroll
        for (int r = 0; r < 8; ++r) { const int m = min(m0 + r * C.NGW, NTOK - 1); const GLOBAL_AS v2u* xr = (const GLOBAL_AS v2u*)(x + (size_t)m * LDX) + C.lane;
#pragma unroll
            for (int j = 0; j < 4; ++j) w[r][j] = xr[64 * j]; }
#pragma unroll
        for (int r = 0; r < 8; ++r) { float a = 0.f;
#pragma unroll
            for (int j = 0; j < 4; ++j) { const float e0 = bflo(w[r][j].x), e1 = bfhi(w[r][j].x), e2 = bflo(w[r][j].y), e3 = bfhi(w[r][j].y); a += (e0 * e0 + e1 * e1) + (e2 * e2 + e3 * e3); }
            s[r] = a; }
#pragma unroll
        for (int r = 0; r < 8; ++r) s[r] = wsum_all(s[r]);
#pragma unroll
        for (int r = 0; r < 8; ++r) { const int m = m0 + r * C.NGW; if (m < NTOK) { const float rstd = 1.0f / sqrtf(s[r] * (1.0f / DM) + NORM_EPS);
            f32x4 y[4]; float am = 0.f;
#pragma unroll
            for (int j = 0; j < 4; ++j) { const f32x4 v = (f32x4){bflo(w[r][j].x), bfhi(w[r][j].x), bflo(w[r][j].y), bfhi(w[r][j].y)}; y[j] = v * rstd * gg[j];
                am = fmaxf(fmaxf(am, fmaxf(fabsf(y[j].x), fabsf(y[j].y))), fmaxf(fabsf(y[j].z), fabsf(y[j].w))); }
            am = fmaxf(wmax_all(am), 1e-20f); const float inv = 127.0f / am; GLOBAL_AS unsigned* o4 = (GLOBAL_AS unsigned*)((unsigned char*)H + (size_t)m * DM) + C.lane;
#pragma unroll
            for (int j = 0; j < 4; ++j) o4[64 * j] = pack4_i8(y[j].x * inv, y[j].y * inv, y[j].z * inv, y[j].w * inv);
            if (C.lane == 0) ((GLOBAL_AS float*)(C.ws + WS_SA))[m] = am * (1.0f / 127.0f); } }
    }
}
__device__ __forceinline__ void final_norm_phase(const Ctx& C, float* x, const float* g) {
    f32x4 gg[4];
#pragma unroll
    for (int j = 0; j < 4; ++j) gg[j] = ((const GLOBAL_AS f32x4*)g)[64 * j + C.lane];
    for (int m = C.gw; m < NTOK; m += C.NGW) {
        GLOBAL_AS f32x4* xr = (GLOBAL_AS f32x4*)(x + (size_t)m * DM) + C.lane; f32x4 v[4]; float s = 0.f;
#pragma unroll
        for (int j = 0; j < 4; ++j) { v[j] = xr[64 * j]; s += (v[j].x * v[j].x + v[j].y * v[j].y) + (v[j].z * v[j].z + v[j].w * v[j].w); }
        const float rstd = 1.0f / sqrtf(wave_sum(s, C.lane) * (1.0f / DM) + NORM_EPS);
#pragma unroll
        for (int j = 0; j < 4; ++j) xr[64 * j] = v[j] * rstd * gg[j];
    }
}
__device__ __forceinline__ void mla_prep_phase(const Ctx& C, bf16* PROJ, const float* qn, const float* kvn, bf16* KPE) {
    const GLOBAL_AS float* rope = (const GLOBAL_AS float*)(C.ws + WS_ROPE);
    const f32x4 gq = ((const GLOBAL_AS f32x4*)qn)[C.lane]; const f32x2 gk = ((const GLOBAL_AS f32x2*)kvn)[C.lane];
    for (int m0 = C.gw; m0 < NTOK; m0 += 8 * C.NGW) {
        v2u w[8]; unsigned w2[8]; unsigned r1[8], r2[8]; float sq[8], sk[8];
#pragma unroll
        for (int r = 0; r < 8; ++r) { const int m = min(m0 + r * C.NGW, NTOK - 1); const bf16* row = PROJ + (size_t)m * IN_E_PAD;
            w[r] = ((const GLOBAL_AS v2u*)(row + 1536))[C.lane]; w2[r] = ((const GLOBAL_AS unsigned*)(row + 1792))[C.lane]; r1[r] = row[1920 + (C.lane & 15)]; r2[r] = row[1936 + (C.lane & 15)]; }
#pragma unroll
        for (int r = 0; r < 8; ++r) { const float a0 = bflo(w[r].x), a1 = bfhi(w[r].x), a2 = bflo(w[r].y), a3 = bfhi(w[r].y), b0 = bflo(w2[r]), b1 = bfhi(w2[r]);
            sq[r] = wsum_all((a0 * a0 + a1 * a1) + (a2 * a2 + a3 * a3)); sk[r] = wsum_all(b0 * b0 + b1 * b1); }
#pragma unroll
        for (int r = 0; r < 8; ++r) { const int m = m0 + r * C.NGW; if (m < NTOK) { bf16* row = PROJ + (size_t)m * IN_E_PAD;
            const float rq = 1.0f / sqrtf(sq[r] * (1.0f / 256) + NORM_EPS), rk = 1.0f / sqrtf(sk[r] * (1.0f / 128) + NORM_EPS);
            v2u o; o.x = pk2(bflo(w[r].x) * rq * gq.x, bfhi(w[r].x) * rq * gq.y); o.y = pk2(bflo(w[r].y) * rq * gq.z, bfhi(w[r].y) * rq * gq.w); ((GLOBAL_AS v2u*)(row + 1536))[C.lane] = o;
            ((GLOBAL_AS unsigned*)(row + 1792))[C.lane] = pk2(bflo(w2[r]) * rk * gk.x, bfhi(w2[r]) * rk * gk.y);
            if (C.lane < 16) { const int t = m & (SEQ - 1); const float x1 = bflo(r1[r]), x2 = bflo(r2[r]);
                const float cs = rope[(t * 16 + C.lane) * 2], sn = rope[(t * 16 + C.lane) * 2 + 1];
                KPE[(size_t)m * 32 + C.lane] = (bf16)f2bf(x1 * cs - x2 * sn); KPE[(size_t)m * 32 + 16 + C.lane] = (bf16)f2bf(x1 * sn + x2 * cs); } } }
    }
}
#define LD8(dst, off, p) do { const v4u w_ = *(const GLOBAL_AS v4u*)(p); dst[(off) + 0] = bflo(w_.x); dst[(off) + 1] = bfhi(w_.x); dst[(off) + 2] = bflo(w_.y); dst[(off) + 3] = bfhi(w_.y); \
    dst[(off) + 4] = bflo(w_.z); dst[(off) + 5] = bfhi(w_.z); dst[(off) + 6] = bflo(w_.w); dst[(off) + 7] = bfhi(w_.w); } while (0)
__device__ __forceinline__ float dot8(const float* q, const v4u w) {
    return ((q[0] * bflo(w.x) + q[1] * bfhi(w.x)) + (q[2] * bflo(w.y) + q[3] * bfhi(w.y))) + ((q[4] * bflo(w.z) + q[5] * bfhi(w.z)) + (q[6] * bflo(w.w) + q[7] * bfhi(w.w)));
}
__device__ __forceinline__ void fma8(float* o, float p, const v4u w) {
    o[0] += p * bflo(w.x); o[1] += p * bfhi(w.x); o[2] += p * bflo(w.y); o[3] += p * bfhi(w.y); o[4] += p * bflo(w.z); o[5] += p * bfhi(w.z); o[6] += p * bflo(w.w); o[7] += p * bfhi(w.w);
}
__device__ __forceinline__ void store_o64(bf16* dst, const float* o, float inv) {
#pragma unroll
    for (int c = 0; c < 8; ++c) { v4u w; w.x = pk2(o[8 * c] * inv, o[8 * c + 1] * inv); w.y = pk2(o[8 * c + 2] * inv, o[8 * c + 3] * inv); w.z = pk2(o[8 * c + 4] * inv, o[8 * c + 5] * inv); w.w = pk2(o[8 * c + 6] * inv, o[8 * c + 7] * inv);
        ((GLOBAL_AS v4u*)dst)[c] = w; }
}
__device__ __forceinline__ void dil_naive_item(const bf16* PROJ, bf16* OC, int item, int tid) {
    const int b = item >> 5, h = (item >> 2) & 7, t = (item & 3) * 512 + tid;
    const bf16* base = PROJ + (size_t)b * SEQ * IN_E_PAD;
    float q[64], o[64];
#pragma unroll
    for (int c = 0; c < 8; ++c) LD8(q, 8 * c, base + (size_t)t * IN_E_PAD + h * 64 + 8 * c);
#pragma unroll
    for (int d = 0; d < 64; ++d) { q[d] *= 0.125f * LOG2E; o[d] = 0.f; }
    const float slope = ex2(-(float)(h + 1)) * LOG2E;
    float m = -INFINITY, l = 0.f;
    for (int g = 0; g < 3; ++g) { const int dl = 1 << (2 * g);
        for (int j = -64; j <= 64; ++j) { const int s = t + j * dl; if (s < 0 || s >= SEQ) continue;
            const bf16* kr = base + (size_t)s * IN_E_PAD + 512 + h * 64;
            float sc = 0.f;
#pragma unroll
            for (int c = 0; c < 8; ++c) sc += dot8(q + 8 * c, ((const GLOBAL_AS v4u*)kr)[c]);
            sc -= slope * (float)((j < 0 ? -j : j) * dl);
            const float mn = fmaxf(m, sc), al = ex2(m - mn), p = ex2(sc - mn); m = mn; l = l * al + p;
#pragma unroll
            for (int d = 0; d < 64; ++d) o[d] *= al;
#pragma unroll
            for (int c = 0; c < 8; ++c) fma8(o + 8 * c, p, ((const GLOBAL_AS v4u*)(kr + 512))[c]);
        } }
    store_o64(OC + ((size_t)b * SEQ + t) * DM + h * 64, o, 1.0f / l);
}
__device__ __forceinline__ void mla_naive_item(const bf16* QM, const bf16* KVM, const bf16* KPE, const float* rope, bf16* OC, int item, int tid) {
    const int b = item >> 6, h = (item >> 3) & 7, vh = (item >> 2) & 1, t = (item & 3) * 512 + tid;
    const size_t row = (size_t)b * SEQ + t;
    float q[96], o[32];
#pragma unroll
    for (int c = 0; c < 12; ++c) LD8(q, 8 * c, QM + row * 768 + h * 96 + 8 * c);
#pragma unroll
    for (int i = 0; i < 16; ++i) { const float cs = rope[(t * 16 + i) * 2], sn = rope[(t * 16 + i) * 2 + 1], x1 = q[64 + i], x2 = q[80 + i]; q[64 + i] = x1 * cs - x2 * sn; q[80 + i] = x1 * sn + x2 * cs; }
    const float scl = 0.10206207261596575f * LOG2E;
#pragma unroll
    for (int d = 0; d < 96; ++d) q[d] *= scl;
#pragma unroll
    for (int d = 0; d < 32; ++d) o[d] = 0.f;
    float m = -INFINITY, l = 0.f;
    const bf16* kvb = KVM + (size_t)b * SEQ * 1024 + h * 128; const bf16* kpb = KPE + (size_t)b * SEQ * 32;
    for (int s = 0; s < SEQ; s += 2) {
        float sc[2];
#pragma unroll
        for (int kk = 0; kk < 2; ++kk) { const GLOBAL_AS v4u* kr = (const GLOBAL_AS v4u*)(kvb + (size_t)(s + kk) * 1024); const GLOBAL_AS v4u* pr = (const GLOBAL_AS v4u*)(kpb + (size_t)(s + kk) * 32); float a = 0.f;
#pragma unroll
            for (int c = 0; c < 8; ++c) a += dot8(q + 8 * c, kr[c]);
#pragma unroll
            for (int c = 0; c < 4; ++c) a += dot8(q + 64 + 8 * c, pr[c]);
            sc[kk] = a; }
        const float mn = fmaxf(m, fmaxf(sc[0], sc[1])), al = ex2(m - mn); m = mn; l *= al;
#pragma unroll
        for (int d = 0; d < 32; ++d) o[d] *= al;
#pragma unroll
        for (int kk = 0; kk < 2; ++kk) { const float p = ex2(sc[kk] - mn); l += p; const GLOBAL_AS v4u* vr = (const GLOBAL_AS v4u*)(kvb + (size_t)(s + kk) * 1024 + 64 + vh * 32);
#pragma unroll
            for (int c = 0; c < 4; ++c) fma8(o + 8 * c, p, vr[c]); }
    }
    const float inv = 1.0f / l; bf16* dst = OC + row * DM + 512 + h * 64 + vh * 32;
#pragma unroll
    for (int c = 0; c < 4; ++c) { v4u w; w.x = pk2(o[8 * c] * inv, o[8 * c + 1] * inv); w.y = pk2(o[8 * c + 2] * inv, o[8 * c + 3] * inv); w.z = pk2(o[8 * c + 4] * inv, o[8 * c + 5] * inv); w.w = pk2(o[8 * c + 6] * inv, o[8 * c + 7] * inv);
        ((GLOBAL_AS v4u*)dst)[c] = w; }
}
__device__ __forceinline__ void na_naive_item(const bf16* QKV, const float* rpb, bf16* O, int item, int tid) {
    const int b = item >> 6, h = (item >> 2) & 15, t = (item & 3) * 512 + tid;
    const int i = t >> 6, c0 = t & 63; const int rs = min(max(i - 4, 0), 24), cs = min(max(c0 - 8, 0), 48);
    const bf16* base = QKV + (size_t)b * SEQ * 3072 + h * 64;
    float q[64], o[64];
#pragma unroll
    for (int c = 0; c < 8; ++c) LD8(q, 8 * c, base + (size_t)t * 3072 + 8 * c);
#pragma unroll
    for (int d = 0; d < 64; ++d) { q[d] *= 0.125f * LOG2E; o[d] = 0.f; }
    float m = -INFINITY, l = 0.f;
    for (int r = 0; r < 8; ++r)
        for (int k = 0; k < 16; ++k) { const int kt = (rs + r) * 64 + cs + k;
            const bf16* kr = base + (size_t)kt * 3072 + 1024;
            float sc = rpb[(h * 15 + (rs + r - i + 7)) * 31 + (cs + k - c0 + 15)] * LOG2E;
#pragma unroll
            for (int c = 0; c < 8; ++c) sc += dot8(q + 8 * c, ((const GLOBAL_AS v4u*)kr)[c]);
            const float mn = fmaxf(m, sc), al = ex2(m - mn), p = ex2(sc - mn); m = mn; l = l * al + p;
#pragma unroll
            for (int d = 0; d < 64; ++d) o[d] *= al;
#pragma unroll
            for (int c = 0; c < 8; ++c) fma8(o + 8 * c, p, ((const GLOBAL_AS v4u*)(kr + 1024))[c]);
        }
    store_o64(O + ((size_t)b * SEQ + t) * DM + h * 64, o, 1.0f / l);
}
__device__ __forceinline__ void route_phase(const Ctx& C, const bf16* x, const float* g, const float* wr, unsigned char* H8, unsigned* cnt  ) {
    LAS float* wl = (LAS float*)C.lds;
    for (int i = C.tid; i < 8192; i += NWAVES * 64) wl[(i & 7) * 1024 + (i >> 3)] = wr[i];
    __syncthreads();
    GLOBAL_AS v4i* route_i = (GLOBAL_AS v4i*)(C.ws + WS_ROUTE_I); GLOBAL_AS f32x2* route_w = (GLOBAL_AS f32x2*)(C.ws + WS_ROUTE_W);
    f32x4 gg[4];
#pragma unroll
    for (int j = 0; j < 4; ++j) gg[j] = ((const GLOBAL_AS f32x4*)g)[64 * j + C.lane];
    for (int base = C.gw * 32; base < NTOK; base += C.NGW * 32) {
        int my_e0 = 0, my_e1 = 0; float my_w0 = 0.f, my_w1 = 0.f;
        for (int i = 0; i < 32; i += 4) {
            v2u xw[4][4]; float s[4]; float lg[4][8]; f32x4 y[4][4];
#pragma unroll
            for (int r = 0; r < 4; ++r) { const GLOBAL_AS v2u* xr = (const GLOBAL_AS v2u*)(x + (size_t)(base + i + r) * LDX) + C.lane;
#pragma unroll
                for (int j = 0; j < 4; ++j) xw[r][j] = xr[64 * j]; }
#pragma unroll
            for (int r = 0; r < 4; ++r) { float a = 0.f;
#pragma unroll
                for (int j = 0; j < 4; ++j) { const v2u c = xw[r][j]; y[r][j] = (f32x4){bflo(c.x), bfhi(c.x), bflo(c.y), bfhi(c.y)}; a += (y[r][j].x * y[r][j].x + y[r][j].y * y[r][j].y) + (y[r][j].z * y[r][j].z + y[r][j].w * y[r][j].w); }
                s[r] = a; }
#pragma unroll
            for (int r = 0; r < 4; ++r) s[r] = wsum_all(s[r]);
#pragma unroll
            for (int r = 0; r < 4; ++r) { const float rstd = 1.0f / sqrtf(s[r] * (1.0f / DM) + NORM_EPS);
                GLOBAL_AS unsigned* o4 = (GLOBAL_AS unsigned*)(H8 + (size_t)(base + i + r) * DM) + C.lane;
#pragma unroll
                for (int e = 0; e < 8; ++e) lg[r][e] = 0.f;
#pragma unroll
                for (int j = 0; j < 4; ++j) { y[r][j] = y[r][j] * rstd * gg[j]; o4[64 * j] = pg8::cvt4_fp8(y[r][j].x, y[r][j].y, y[r][j].z, y[r][j].w); } }
#pragma unroll
            for (int j = 0; j < 4; ++j)
#pragma unroll
                for (int e = 0; e < 8; ++e) { const f32x4 w = *(const LAS f32x4*)(wl + e * 1024 + 4 * (64 * j + C.lane));
#pragma unroll
                    for (int r = 0; r < 4; ++r) lg[r][e] += (y[r][j].x * w.x + y[r][j].y * w.y) + (y[r][j].z * w.z + y[r][j].w * w.w); }
#pragma unroll
            for (int r = 0; r < 4; ++r)
#pragma unroll
                for (int e = 0; e < 8; ++e) lg[r][e] = wsum_all(lg[r][e]);
#pragma unroll
            for (int r = 0; r < 4; ++r) {
                int e0 = 0; float v0 = lg[r][0];
#pragma unroll
                for (int e = 1; e < 8; ++e) if (lg[r][e] > v0) { v0 = lg[r][e]; e0 = e; }
                int e1 = -1; float v1 = -INFINITY;
#pragma unroll
                for (int e = 0; e < 8; ++e) if (e != e0 && (e1 < 0 || lg[r][e] > v1)) { v1 = lg[r][e]; e1 = e; }
                const float ex = __expf(v1 - v0), w0 = 1.0f / (1.0f + ex), w1 = ex * w0;
                if (C.lane == i + r) { my_e0 = e0; my_e1 = e1; my_w0 = w0; my_w1 = w1; } }
        }
        const int chunk = base / MOE_CHUNK; const bool act = C.lane < 32; int pos0 = 0, pos1 = 0;
        const unsigned long long lt = (1ull << C.lane) - 1ull;
#pragma unroll
        for (int e = 0; e < 8; ++e) {
            const unsigned long long m0 = __ballot(act && my_e0 == e), m1 = __ballot(act && my_e1 == e);
            const int n0 = __popcll(m0), n1 = __popcll(m1);
            unsigned bs = 0; if (C.lane == 0 && (n0 + n1) > 0) bs = atomicAdd(cnt + (chunk * 8 + e) * 64, (unsigned)(n0 + n1));
            bs = (unsigned)__builtin_amdgcn_readfirstlane((int)bs);
            if (act && my_e0 == e) pos0 = (int)bs + __popcll(m0 & lt);
            if (act && my_e1 == e) pos1 = (int)bs + n0 + __popcll(m1 & lt);
        }
        if (act) { route_i[base + C.lane] = (v4i){my_e0, my_e1, pos0, pos1}; route_w[base + C.lane] = (f32x2){my_w0, my_w1}; }
    }
}
__device__ __forceinline__ int seg_base(const unsigned* cnt, int chunk, int e) {
    int acc = 0;
#pragma unroll
    for (int k = 0; k < 8; ++k) { const int n = (int)__hip_atomic_load(cnt + (chunk * 8 + k) * 64, __ATOMIC_RELAXED, __HIP_MEMORY_SCOPE_AGENT); if (k < e) acc += (n + 255) >> 8; }
    return acc * 256;
}
__device__ __forceinline__ void gather_all_phase(const Ctx& C, const unsigned char* H8, unsigned char* HG8, const unsigned* cnt) {
    GLOBAL_AS v4i* route_i = (GLOBAL_AS v4i*)(C.ws + WS_ROUTE_I);
    LAS int* segt = (LAS int*)C.lds;
    if (C.tid < N_CHUNK * 8) segt[C.tid] = seg_base(cnt, C.tid >> 3, C.tid & 7);
    __syncthreads();
    for (int m0 = C.gw; m0 < NTOK; m0 += 8 * C.NGW) {
        v4i ri[8]; v4u a[8];
#pragma unroll
        for (int r = 0; r < 8; ++r) { const int m = min(m0 + r * C.NGW, NTOK - 1); ri[r] = route_i[m]; a[r] = ((const GLOBAL_AS v4u*)(H8 + (size_t)m * DM))[C.lane]; }
#pragma unroll
        for (int r = 0; r < 8; ++r) { const int m = m0 + r * C.NGW; if (m < NTOK) { const int ch = m / MOE_CHUNK;
            const int s0 = segt[ch * 8 + ri[r].x] + ri[r].z, s1 = segt[ch * 8 + ri[r].y] + ri[r].w;
            unsigned char* base = HG8 + (size_t)ch * 2 * CHUNK_SLOTS * DM;
            ((GLOBAL_AS v4u*)(base + (size_t)s0 * DM))[C.lane] = a[r]; ((GLOBAL_AS v4u*)(base + (size_t)s1 * DM))[C.lane] = a[r];
            if (C.lane == 0) { v4i o = ri[r]; o.z = s0; o.w = s1; route_i[m] = o; } } }
    }
}
template <bool LAST>
__device__ __forceinline__ void combine_all_phase(const Ctx& C, bf16* x, float* out, const bf16* Y, const float* g, bf16* Hn) {
    const GLOBAL_AS v4i* route_i = (const GLOBAL_AS v4i*)(C.ws + WS_ROUTE_I); const GLOBAL_AS f32x2* route_w = (const GLOBAL_AS f32x2*)(C.ws + WS_ROUTE_W);
    f32x4 gg[4];
#pragma unroll
    for (int j = 0; j < 4; ++j) gg[j] = ((const GLOBAL_AS f32x4*)g)[64 * j + C.lane];
    for (int m0 = C.gw; m0 < NTOK; m0 += 4 * C.NGW) {
        v4i ri[4]; f32x2 rw[4]; v2u ya[4][4], yb[4][4], xw[4][4]; float s[4];
#pragma unroll
        for (int r = 0; r < 4; ++r) { const int m = min(m0 + r * C.NGW, NTOK - 1); ri[r] = route_i[m]; rw[r] = route_w[m];
            const GLOBAL_AS v2u* xr = (const GLOBAL_AS v2u*)(x + (size_t)m * LDX) + C.lane;
#pragma unroll
            for (int j = 0; j < 4; ++j) xw[r][j] = xr[64 * j]; }
#pragma unroll
        for (int r = 0; r < 4; ++r) { const int m = min(m0 + r * C.NGW, NTOK - 1); const bf16* base = Y + (size_t)(m / MOE_CHUNK) * CHUNK_SLOTS * DM;
            const GLOBAL_AS v2u* y0 = (const GLOBAL_AS v2u*)(base + (size_t)ri[r].z * DM) + C.lane; const GLOBAL_AS v2u* y1 = (const GLOBAL_AS v2u*)(base + (size_t)ri[r].w * DM) + C.lane;
#pragma unroll
            for (int j = 0; j < 4; ++j) { ya[r][j] = y0[64 * j]; yb[r][j] = y1[64 * j]; } }
#pragma unroll
        for (int r = 0; r < 4; ++r) { const int m = m0 + r * C.NGW; f32x4 v[4]; float acc = 0.f;
#pragma unroll
            for (int j = 0; j < 4; ++j) { const v2u a = ya[r][j], b = yb[r][j], c = xw[r][j]; f32x4 t = (f32x4){bflo(c.x), bfhi(c.x), bflo(c.y), bfhi(c.y)};
                t.x += rw[r].x * bflo(a.x) + rw[r].y * bflo(b.x); t.y += rw[r].x * bfhi(a.x) + rw[r].y * bfhi(b.x); t.z += rw[r].x * bflo(a.y) + rw[r].y * bflo(b.y); t.w += rw[r].x * bfhi(a.y) + rw[r].y * bfhi(b.y);
                v[j] = t; acc += (t.x * t.x + t.y * t.y) + (t.z * t.z + t.w * t.w); }
            const float rstd = 1.0f / sqrtf(wsum_all(acc) * (1.0f / DM) + NORM_EPS);
            if (m < NTOK) {
                if (LAST) { GLOBAL_AS f32x4* xr = (GLOBAL_AS f32x4*)(out + (size_t)m * DM) + C.lane;
#pragma unroll
                    for (int j = 0; j < 4; ++j) xr[64 * j] = v[j] * rstd * gg[j];
                } else { f32x4 y[4]; float am = 0.f;
#pragma unroll
                    for (int j = 0; j < 4; ++j) { stx4(x + (size_t)m * LDX, 64 * j + C.lane, v[j]); y[j] = v[j] * rstd * gg[j]; am = fmaxf(fmaxf(am, fmaxf(fabsf(y[j].x), fabsf(y[j].y))), fmaxf(fabsf(y[j].z), fabsf(y[j].w))); }
                    am = fmaxf(wmax_all(am), 1e-20f); const float inv = 127.0f / am; GLOBAL_AS unsigned* o4 = (GLOBAL_AS unsigned*)((unsigned char*)Hn + (size_t)m * DM) + C.lane;
#pragma unroll
                    for (int j = 0; j < 4; ++j) o4[64 * j] = pack4_i8(y[j].x * inv, y[j].y * inv, y[j].z * inv, y[j].w * inv);
                    if (C.lane == 0) ((GLOBAL_AS float*)(C.ws + WS_SA))[m] = am * (1.0f / 127.0f);
                } } }
    }
}
__device__ __forceinline__ void grouped_order(pg8::GroupedOrder& S, const unsigned* cnt, int chunk, int nN, int G, int c) {
    int te[8]; int acc = 0;
#pragma unroll
    for (int k = 0; k < 8; ++k) { const int n = __builtin_amdgcn_readfirstlane((int)__hip_atomic_load(cnt + (chunk * 8 + k) * 64, __ATOMIC_RELAXED, __HIP_MEMORY_SCOPE_AGENT)); acc += (n + 255) >> 8; te[k] = acc; }
    S.t0 = te[0]; S.t1 = te[1]; S.t2 = te[2]; S.t3 = te[3]; S.t4 = te[4]; S.t5 = te[5]; S.t6 = te[6]; S.RT = te[7]; S.nN = nN; S.G = G; S.c = c;
}
namespace att {
typedef short bf16x8 __attribute__((ext_vector_type(8)));
typedef short s16x4 __attribute__((ext_vector_type(4)));
typedef short v4i16_t __attribute__((ext_vector_type(4)));
typedef float f32x16 __attribute__((ext_vector_type(16)));
typedef float f32x2_t __attribute__((ext_vector_type(2)));
typedef __bf16 bf16x2_t __attribute__((ext_vector_type(2)));
typedef unsigned u32x4 __attribute__((ext_vector_type(4)));
__device__ __forceinline__ unsigned cvtpk(float lo, float hi) { f32x2_t v = {lo, hi}; bf16x2_t b = __builtin_convertvector(v, bf16x2_t); return __builtin_bit_cast(unsigned, b); }
__device__ __forceinline__ s16x4 vtr(const LAS unsigned char* p) { return __builtin_bit_cast(s16x4, __builtin_amdgcn_ds_read_tr16_b64_v4i16((LAS v4i16_t*)p)); }
#define VTR_ISSUE(dst, addr, OFF) asm volatile("ds_read_b64_tr_b16 %0, %1 offset:%2" : "=&v"(dst) : "v"(addr), "i"(OFF))
__device__ __forceinline__ void vtr_wait8(s16x4& a, s16x4& b, s16x4& c, s16x4& d, s16x4& e, s16x4& f, s16x4& g, s16x4& h) {
    asm volatile("s_waitcnt lgkmcnt(0)" : "+v"(a), "+v"(b), "+v"(c), "+v"(d), "+v"(e), "+v"(f), "+v"(g), "+v"(h)); }
#define VTR_PACK(lo, hi) ((bf16x8){lo[0], lo[1], lo[2], lo[3], hi[0], hi[1], hi[2], hi[3]})
__device__ __forceinline__ void xhalf_swap(unsigned& a, unsigned& b) { asm volatile("s_nop 1\n\tv_permlane32_swap_b32 %0, %1\n\ts_nop 1" : "+v"(a), "+v"(b)); }
__device__ __forceinline__ float xhalf_max(float v) { unsigned a = __builtin_bit_cast(unsigned, v), b = a; xhalf_swap(a, b); return fmaxf(__builtin_bit_cast(float, a), __builtin_bit_cast(float, b)); }
__device__ __forceinline__ float xhalf_sum(float v) { unsigned a = __builtin_bit_cast(unsigned, v), b = a; xhalf_swap(a, b); return __builtin_bit_cast(float, a) + __builtin_bit_cast(float, b); }
#define ATT_MFMA(a, b, c) __builtin_amdgcn_mfma_f32_32x32x16_bf16((a), (b), (c), 0, 0, 0)
__device__ __forceinline__ void sm_step(const f32x16& s, float c, float& m, float& l, f32x16& o0, f32x16& o1, bf16x8& p0, bf16x8& p1) {
    float mx = fmaxf(fmaxf(fmaxf(s[0], s[1]), fmaxf(s[2], s[3])), fmaxf(fmaxf(s[4], s[5]), fmaxf(s[6], s[7])));
    mx = fmaxf(mx, fmaxf(fmaxf(fmaxf(s[8], s[9]), fmaxf(s[10], s[11])), fmaxf(fmaxf(s[12], s[13]), fmaxf(s[14], s[15]))));
    mx = xhalf_max(mx);
    const float mn = fmaxf(m, mx * c), al = ex2(m - mn); m = mn;
    float pe[16]; float ls = 0.f;
#pragma unroll
    for (int i = 0; i < 16; ++i) { pe[i] = ex2(__builtin_fmaf(s[i], c, -mn)); ls += pe[i]; }
    l = l * al + ls;
#pragma unroll
    for (int i = 0; i < 16; ++i) { o0[i] *= al; o1[i] *= al; }
    u32x4 a, b; a.x = cvtpk(pe[0], pe[1]); a.y = cvtpk(pe[2], pe[3]); a.z = cvtpk(pe[4], pe[5]); a.w = cvtpk(pe[6], pe[7]);
    b.x = cvtpk(pe[8], pe[9]); b.y = cvtpk(pe[10], pe[11]); b.z = cvtpk(pe[12], pe[13]); b.w = cvtpk(pe[14], pe[15]);
    p0 = __builtin_bit_cast(bf16x8, a); p1 = __builtin_bit_cast(bf16x8, b);
}
constexpr int MLA_KB = 12 * 64 * 16, MLA_BUF = MLA_KB + 64 * 128;
__device__ __forceinline__ void mla_unit(const bf16* QM, const bf16* KVM, const bf16* KPE, const float* rope, bf16* OC, int unit, LAS unsigned char* lds, int tid) {
    const int lane = tid & 63, wave = __builtin_amdgcn_readfirstlane(tid >> 6), r32 = lane & 31, hh = lane >> 5;
    const int b = unit >> 5, h = (unit >> 2) & 7, qt = unit & 3, q0 = qt * 512 + wave * 64;
    const float c = 0.10206207261596575f * LOG2E;
    bf16x8 qf[2][6];
#pragma unroll
    for (int qb = 0; qb < 2; ++qb) { const int t = q0 + qb * 32 + r32; const bf16* src = QM + ((size_t)b * SEQ + t) * 768 + h * 96 + hh * 8;
#pragma unroll
        for (int ks = 0; ks < 6; ++ks) qf[qb][ks] = *(const bf16x8*)(src + 16 * ks);
        const f32x4* rp = (const f32x4*)(rope + (t * 16 + 8 * hh) * 2);
        bf16x8 a4 = qf[qb][4], a5 = qf[qb][5];
#pragma unroll
        for (int jj = 0; jj < 4; ++jj) { const f32x4 cs = rp[jj];
            const float x1a = bflo((unsigned)(unsigned short)a4[2 * jj]), x2a = bflo((unsigned)(unsigned short)a5[2 * jj]), x1b = bflo((unsigned)(unsigned short)a4[2 * jj + 1]), x2b = bflo((unsigned)(unsigned short)a5[2 * jj + 1]);
            a4[2 * jj] = (short)f2bf(x1a * cs.x - x2a * cs.y); a5[2 * jj] = (short)f2bf(x1a * cs.y + x2a * cs.x);
            a4[2 * jj + 1] = (short)f2bf(x1b * cs.z - x2b * cs.w); a5[2 * jj + 1] = (short)f2bf(x1b * cs.w + x2b * cs.z); }
        qf[qb][4] = a4; qf[qb][5] = a5; }
    f32x16 o[2][2];
#pragma unroll
    for (int i = 0; i < 16; ++i) { o[0][0][i] = 0.f; o[0][1][i] = 0.f; o[1][0][i] = 0.f; o[1][1][i] = 0.f; }
    float m0 = -INFINITY, m1 = -INFINITY, l0 = 0.f, l1 = 0.f;
    const bf16* kvb = KVM + (size_t)b * SEQ * 1024 + h * 128;
    const bf16* gk0 = kvb + (size_t)lane * 1024 + wave * 8;
    const bf16* gk1 = KPE + ((size_t)b * SEQ + lane) * 32 + (wave & 3) * 8;
    const int vkey = wave * 8 + (lane >> 3), vcc = (lane & 7) ^ (((vkey >> 1) & 1) << 2);
    const bf16* gv = kvb + (size_t)vkey * 1024 + 64 + vcc * 8;
    const bool two = wave < 4;
    const int lk0 = wave * 1024, lk1 = (8 + wave) * 1024, lv = MLA_KB + wave * 1024;
#define MLA_STAGE(bufp, jt) do { const size_t go_ = (size_t)(jt) * 64; \
        __builtin_amdgcn_global_load_lds((const unsigned*)(gk0 + go_ * 1024), (LAS unsigned*)((bufp) + lk0), 16, 0, 0); \
        if (two) __builtin_amdgcn_global_load_lds((const unsigned*)(gk1 + go_ * 32), (LAS unsigned*)((bufp) + lk1), 16, 0, 0); \
        __builtin_amdgcn_global_load_lds((const unsigned*)(gv + go_ * 1024), (LAS unsigned*)((bufp) + lv), 16, 0, 0); } while (0)
    const int ka = (hh * 64 + r32) * 16;
    const int i16 = lane & 15, q4 = i16 >> 2, p4 = i16 & 3, cb = (lane >> 4) & 1;
    const int vrow = (4 * hh + q4) * 128 + (p4 & 1) * 8;
    const int va0 = MLA_KB + vrow + (((0 ^ (q4 >> 1)) * 4 + cb * 2 + (p4 >> 1)) * 16), va1 = MLA_KB + vrow + (((1 ^ (q4 >> 1)) * 4 + cb * 2 + (p4 >> 1)) * 16);
    MLA_STAGE(lds, 0);
    asm volatile("s_waitcnt vmcnt(0)" ::: "memory");
    __syncthreads();
    for (int j = 0; j < SEQ / 64; ++j) {
        const LAS unsigned char* buf = lds + (j & 1) * MLA_BUF; LAS unsigned char* nbuf = lds + ((j + 1) & 1) * MLA_BUF;
        if ((j + 1) < SEQ / 64) MLA_STAGE(nbuf, j + 1);
#pragma unroll
        for (int kb = 0; kb < 2; ++kb) {
            bf16x8 p00, p01, p10, p11;
            { f32x16 s0, s1; bf16x8 kf[6];
#pragma unroll
              for (int ks = 0; ks < 6; ++ks) kf[ks] = *(const LAS bf16x8*)(buf + ka + ks * 2048 + kb * 512);
#pragma unroll
              for (int i = 0; i < 16; ++i) { s0[i] = 0.f; s1[i] = 0.f; }
#pragma unroll
              for (int ks = 0; ks < 6; ++ks) { s0 = ATT_MFMA(kf[ks], qf[0][ks], s0); s1 = ATT_MFMA(kf[ks], qf[1][ks], s1); }
              sm_step(s0, c, m0, l0, o[0][0], o[0][1], p00, p01);
              sm_step(s1, c, m1, l1, o[1][0], o[1][1], p10, p11); }
            { const unsigned a0 = (unsigned)(size_t)(buf + va0), a1 = (unsigned)(size_t)(buf + va1);
              s16x4 l00, h00, l01, h01, l10, h10, l11, h11;
              if (kb == 0) { VTR_ISSUE(l00, a0, 0); VTR_ISSUE(h00, a0, 1024); VTR_ISSUE(l01, a0, 2048); VTR_ISSUE(h01, a0, 3072); VTR_ISSUE(l10, a1, 0); VTR_ISSUE(h10, a1, 1024); VTR_ISSUE(l11, a1, 2048); VTR_ISSUE(h11, a1, 3072); }
              else         { VTR_ISSUE(l00, a0, 4096); VTR_ISSUE(h00, a0, 5120); VTR_ISSUE(l01, a0, 6144); VTR_ISSUE(h01, a0, 7168); VTR_ISSUE(l10, a1, 4096); VTR_ISSUE(h10, a1, 5120); VTR_ISSUE(l11, a1, 6144); VTR_ISSUE(h11, a1, 7168); }
              vtr_wait8(l00, h00, l01, h01, l10, h10, l11, h11);
              const bf16x8 v00 = VTR_PACK(l00, h00), v01 = VTR_PACK(l01, h01), v10 = VTR_PACK(l10, h10), v11 = VTR_PACK(l11, h11);
              o[0][0] = ATT_MFMA(v00, p00, o[0][0]); o[1][0] = ATT_MFMA(v00, p10, o[1][0]); o[0][1] = ATT_MFMA(v10, p00, o[0][1]); o[1][1] = ATT_MFMA(v10, p10, o[1][1]);
              o[0][0] = ATT_MFMA(v01, p01, o[0][0]); o[1][0] = ATT_MFMA(v01, p11, o[1][0]); o[0][1] = ATT_MFMA(v11, p01, o[0][1]); o[1][1] = ATT_MFMA(v11, p11, o[1][1]); }
        }
        asm volatile("s_waitcnt vmcnt(0)" ::: "memory");
        __syncthreads();
    }
#undef MLA_STAGE
    const float i0 = 1.0f / xhalf_sum(l0), i1 = 1.0f / xhalf_sum(l1);
#pragma unroll
    for (int qb = 0; qb < 2; ++qb) { const float inv = qb == 0 ? i0 : i1; bf16* dst = OC + ((size_t)b * SEQ + q0 + qb * 32 + r32) * DM + 512 + h * 64 + 4 * hh;
#pragma unroll
        for (int db = 0; db < 2; ++db)
#pragma unroll
            for (int g = 0; g < 4; ++g) { v2u w; w.x = cvtpk(o[qb][db][4 * g] * inv, o[qb][db][4 * g + 1] * inv); w.y = cvtpk(o[qb][db][4 * g + 2] * inv, o[qb][db][4 * g + 3] * inv);
                *(v2u*)(dst + db * 32 + 8 * g) = w; } }
}
__device__ __forceinline__ void stage32(LAS unsigned char* buf, const bf16* kp, const bf16* vp, size_t rs, int lane) {
    const bf16* v0 = vp + (size_t)(lane >> 3) * rs + ((lane & 7) ^ (((lane >> 4) & 1) << 2)) * 8;
#pragma unroll
    for (int i = 0; i < 4; ++i) { const int key = 8 * i + (lane >> 3); __builtin_amdgcn_global_load_lds((const unsigned*)(kp + (size_t)key * rs + ((lane & 7) ^ ((key >> 1) & 7)) * 8), (LAS unsigned*)(buf + i * 1024), 16, 0, 0); }
#pragma unroll
    for (int i = 0; i < 4; ++i) __builtin_amdgcn_global_load_lds((const unsigned*)(v0 + (size_t)(8 * i) * rs), (LAS unsigned*)(buf + 4096 + i * 1024), 16, 0, 0);
}
__device__ __forceinline__ void stageK(LAS unsigned char* kb, const bf16* kp, size_t rs, int lane) {
#pragma unroll
    for (int i = 0; i < 4; ++i) { const int key = 8 * i + (lane >> 3); __builtin_amdgcn_global_load_lds((const unsigned*)(kp + (size_t)key * rs + ((lane & 7) ^ ((key >> 1) & 7)) * 8), (LAS unsigned*)(kb + i * 1024), 16, 0, 0); }
}
__device__ __forceinline__ void stageV(LAS unsigned char* vb, const bf16* vp, size_t rs, int lane) {
    const bf16* v0 = vp + (size_t)(lane >> 3) * rs + ((lane & 7) ^ (((lane >> 4) & 1) << 2)) * 8;
#pragma unroll
    for (int i = 0; i < 4; ++i) __builtin_amdgcn_global_load_lds((const unsigned*)(v0 + (size_t)(8 * i) * rs), (LAS unsigned*)(vb + i * 1024), 16, 0, 0);
}
__device__ __forceinline__ f32x16 qk32(const LAS unsigned char* buf, const bf16x8 (&qf)[4], int r32, int hh) {
    f32x16 s; bf16x8 kf[4];
#pragma unroll
    for (int ks = 0; ks < 4; ++ks) kf[ks] = *(const LAS bf16x8*)(buf + r32 * 128 + (((2 * ks + hh) ^ ((r32 >> 1) & 7)) << 4));
#pragma unroll
    for (int i = 0; i < 16; ++i) s[i] = 0.f;
#pragma unroll
    for (int ks = 0; ks < 4; ++ks) s = ATT_MFMA(kf[ks], qf[ks], s);
    return s;
}
__device__ __forceinline__ void qk32x2(const LAS unsigned char* buf, const bf16x8 (&q0)[4], const bf16x8 (&q1)[4], f32x16& s0, f32x16& s1, int r32, int hh) {
    bf16x8 kf[4];
#pragma unroll
    for (int ks = 0; ks < 4; ++ks) kf[ks] = *(const LAS bf16x8*)(buf + r32 * 128 + (((2 * ks + hh) ^ ((r32 >> 1) & 7)) << 4));
#pragma unroll
    for (int i = 0; i < 16; ++i) { s0[i] = 0.f; s1[i] = 0.f; }
#pragma unroll
    for (int ks = 0; ks < 4; ++ks) { s0 = ATT_MFMA(kf[ks], q0[ks], s0); s1 = ATT_MFMA(kf[ks], q1[ks], s1); }
}
__device__ __forceinline__ void sm_step2(const float (&t)[16], float& m, float& l, f32x16& o0, f32x16& o1, bf16x8& p0, bf16x8& p1) {
    float mx = fmaxf(fmaxf(fmaxf(t[0], t[1]), fmaxf(t[2], t[3])), fmaxf(fmaxf(t[4], t[5]), fmaxf(t[6], t[7])));
    mx = fmaxf(mx, fmaxf(fmaxf(fmaxf(t[8], t[9]), fmaxf(t[10], t[11])), fmaxf(fmaxf(t[12], t[13]), fmaxf(t[14], t[15]))));
    mx = xhalf_max(mx);
    const float mn = fmaxf(m, mx), ms = (mn == -INFINITY) ? 0.f : mn, al = ex2(m - ms); m = mn;
    float pe[16]; float ls = 0.f;
#pragma unroll
    for (int i = 0; i < 16; ++i) { pe[i] = ex2(t[i] - ms); ls += pe[i]; }
    l = l * al + ls;
#pragma unroll
    for (int i = 0; i < 16; ++i) { o0[i] *= al; o1[i] *= al; }
    u32x4 a, b; a.x = cvtpk(pe[0], pe[1]); a.y = cvtpk(pe[2], pe[3]); a.z = cvtpk(pe[4], pe[5]); a.w = cvtpk(pe[6], pe[7]);
    b.x = cvtpk(pe[8], pe[9]); b.y = cvtpk(pe[10], pe[11]); b.z = cvtpk(pe[12], pe[13]); b.w = cvtpk(pe[14], pe[15]);
    p0 = __builtin_bit_cast(bf16x8, a); p1 = __builtin_bit_cast(bf16x8, b);
}
__device__ __forceinline__ void vfrag4(const LAS unsigned char* buf, int va0, int va1, bf16x8& v00, bf16x8& v01, bf16x8& v10, bf16x8& v11) {
    const unsigned a0 = (unsigned)(size_t)(buf + va0), a1 = (unsigned)(size_t)(buf + va1);
    s16x4 l00, h00, l01, h01, l10, h10, l11, h11;
    VTR_ISSUE(l00, a0, 0); VTR_ISSUE(h00, a0, 1024); VTR_ISSUE(l01, a0, 2048); VTR_ISSUE(h01, a0, 3072); VTR_ISSUE(l10, a1, 0); VTR_ISSUE(h10, a1, 1024); VTR_ISSUE(l11, a1, 2048); VTR_ISSUE(h11, a1, 3072);
    vtr_wait8(l00, h00, l01, h01, l10, h10, l11, h11);
    v00 = VTR_PACK(l00, h00); v01 = VTR_PACK(l01, h01); v10 = VTR_PACK(l10, h10); v11 = VTR_PACK(l11, h11);
}
#define ATT_VADDR() const int i16 = lane & 15, q4 = i16 >> 2, p4 = i16 & 3, cb = (lane >> 4) & 1; const int vrow = 4096 + (4 * hh + q4) * 128 + (p4 & 1) * 8; \
    const int va0 = vrow + (((0 ^ (q4 >> 1)) * 4 + cb * 2 + (p4 >> 1)) * 16), va1 = vrow + (((1 ^ (q4 >> 1)) * 4 + cb * 2 + (p4 >> 1)) * 16)
#define ATT_WAIT_V(n) asm volatile("s_waitcnt vmcnt(" #n ")" ::: "memory")

__device__ __forceinline__ void qrow_put(LAS unsigned char* tb, const v4u (&q)[4], int lane) {
#pragma unroll
    for (int i = 0; i < 4; ++i) { const int row = 8 * i + (lane >> 3); *(LAS v4u*)(tb + row * 128 + (((lane & 7) ^ ((row >> 1) & 7)) << 4)) = q[i]; }
}
__device__ __forceinline__ void qfrag_get(const LAS unsigned char* tb, bf16x8 (&qf)[4], int r32, int hh) {
#pragma unroll
    for (int ks = 0; ks < 4; ++ks) qf[ks] = *(const LAS bf16x8*)(tb + r32 * 128 + (((2 * ks + hh) ^ ((r32 >> 1) & 7)) << 4));
    asm volatile("s_waitcnt lgkmcnt(0)" : "+v"(qf[0]), "+v"(qf[1]), "+v"(qf[2]), "+v"(qf[3]) :: "memory");
}
__device__ __forceinline__ void ostage(LAS unsigned char* tb, const f32x16& o0, const f32x16& o1, float inv, int r32, int hh) {
#pragma unroll
    for (int db = 0; db < 2; ++db)
#pragma unroll
        for (int g = 0; g < 4; ++g) { const f32x16& o = db == 0 ? o0 : o1; v2u w; w.x = cvtpk(o[4 * g] * inv, o[4 * g + 1] * inv); w.y = cvtpk(o[4 * g + 2] * inv, o[4 * g + 3] * inv);
            *(LAS v2u*)(tb + r32 * 128 + (((db * 4 + g) ^ (r32 & 7)) << 4) + hh * 8) = w; }
}
__device__ __forceinline__ v4u orow(const LAS unsigned char* tb, int lane, int i) { return *(const LAS v4u*)(tb + i * 1024 + lane * 16); }
__device__ __forceinline__ int orow_chunk(int lane, int i) { return (lane & 7) ^ ((8 * i + (lane >> 3)) & 7); }
template <bool FINAL>
__device__ __forceinline__ void dil_tile(const bf16* PROJ, int dl, int idx, bf16* DPo, float* DLo, const bf16* DP1, const float* DL1, const bf16* DP2, const float* DL2, bf16* OC, LAS unsigned char* wl, int lane) {
    const int r32 = lane & 31, hh = lane >> 5;
    const int L = SEQ / dl, nch = L >> 6, ich = idx % nch, rho = (idx / nch) % dl, bh = idx >> 5, h = bh & 7, b = bh >> 3, i0 = ich << 6;
    const bf16* base = PROJ + ((size_t)b * SEQ + rho) * IN_E_PAD + h * 64;
    const size_t rs = (size_t)dl * IN_E_PAD;
    bf16x8 qf[2][4]; v4u qraw[2][4];
#pragma unroll
    for (int qb = 0; qb < 2; ++qb)
#pragma unroll
        for (int i = 0; i < 4; ++i) qraw[qb][i] = *(const v4u*)(base + (size_t)(i0 + qb * 32 + 8 * i + (lane >> 3)) * rs + (lane & 7) * 8);
    ATT_VADDR();
    const float c = 0.125f * LOG2E, sl = ex2(-(float)(h + 1)) * LOG2E * (float)dl;
    f32x16 o[2][2];
#pragma unroll
    for (int i = 0; i < 16; ++i) { o[0][0][i] = 0.f; o[0][1][i] = 0.f; o[1][0][i] = 0.f; o[1][1][i] = 0.f; }
    float m0 = -INFINITY, m1 = -INFINITY, l0 = 0.f, l1 = 0.f;
    const int klo = (i0 >= 64) ? 0 : 2, khi = (i0 + 128 <= L) ? 6 : 4;
    { const int ik0 = i0 - 64 + 32 * klo; stage32(wl, base + 512 + (size_t)ik0 * rs, base + 1024 + (size_t)ik0 * rs, rs, lane); }
    qrow_put(wl + 8192, qraw[0], lane); qrow_put(wl + 12288, qraw[1], lane); qfrag_get(wl + 8192, qf[0], r32, hh); qfrag_get(wl + 12288, qf[1], r32, hh);
    for (int kbi = klo; kbi < khi; ++kbi) {
        const LAS unsigned char* buf = wl + ((kbi - klo) & 1) * 8192;
        if (kbi + 1 < khi) { const int ik0 = i0 - 64 + 32 * (kbi + 1); stage32(wl + ((kbi + 1 - klo) & 1) * 8192, base + 512 + (size_t)ik0 * rs, base + 1024 + (size_t)ik0 * rs, rs, lane); ATT_WAIT_V(8); }
        else ATT_WAIT_V(0);
        const bool use0 = kbi <= 4, use1 = kbi >= 1;
        bf16x8 p00, p01, p10, p11;
        f32x16 sa, sb; qk32x2(buf, qf[0], qf[1], sa, sb, r32, hh);
        if (use0) { float t[16]; const float e0 = (float)((32 * kbi - 64) + 4 * hh - r32);
#pragma unroll
            for (int i = 0; i < 16; ++i) { const float ad = __builtin_fabsf(e0 + (float)((i & 3) + 8 * (i >> 2))); t[i] = ad <= 64.0f ? __builtin_fmaf(sa[i], c, -sl * ad) : -INFINITY; }
            sm_step2(t, m0, l0, o[0][0], o[0][1], p00, p01); }
        if (use1) { float t[16]; const float e0 = (float)((32 * kbi - 96) + 4 * hh - r32);
#pragma unroll
            for (int i = 0; i < 16; ++i) { const float ad = __builtin_fabsf(e0 + (float)((i & 3) + 8 * (i >> 2))); t[i] = ad <= 64.0f ? __builtin_fmaf(sb[i], c, -sl * ad) : -INFINITY; }
            sm_step2(t, m1, l1, o[1][0], o[1][1], p10, p11); }
        { bf16x8 v00, v01, v10, v11; vfrag4(buf, va0, va1, v00, v01, v10, v11);
          if (use0) { o[0][0] = ATT_MFMA(v00, p00, o[0][0]); o[0][1] = ATT_MFMA(v10, p00, o[0][1]); }
          if (use1) { o[1][0] = ATT_MFMA(v00, p10, o[1][0]); o[1][1] = ATT_MFMA(v10, p10, o[1][1]); }
          if (use0) { o[0][0] = ATT_MFMA(v01, p01, o[0][0]); o[0][1] = ATT_MFMA(v11, p01, o[0][1]); }
          if (use1) { o[1][0] = ATT_MFMA(v01, p11, o[1][0]); o[1][1] = ATT_MFMA(v11, p11, o[1][1]); } }
    }
    const float lt0 = xhalf_sum(l0), lt1 = xhalf_sum(l1);
#pragma unroll
    for (int qb = 0; qb < 2; ++qb) { const float lt = qb == 0 ? lt0 : lt1, mm = qb == 0 ? m0 : m1;
        const size_t tok = (size_t)b * SEQ + rho + (size_t)dl * (i0 + qb * 32 + r32);
        const float lse = mm + __builtin_amdgcn_logf(lt);
        if (!FINAL) {
            ostage(wl + qb * 4096, o[qb][0], o[qb][1], 1.0f / lt, r32, hh);
            if (hh == 0) DLo[(size_t)h * NTOK + tok] = lse;
        } else {
            const float a1 = DL1[(size_t)h * NTOK + tok], a2 = DL2[(size_t)h * NTOK + tok], mx = fmaxf(lse, fmaxf(a1, a2));
            const float e0 = ex2(lse - mx), e1 = ex2(a1 - mx), e2 = ex2(a2 - mx), es = 1.0f / (e0 + e1 + e2);
            ostage(wl + qb * 4096, o[qb][0], o[qb][1], e0 * es / lt, r32, hh);
            if (hh == 0) *(LAS f32x2*)(wl + 8192 + (qb * 32 + r32) * 8) = (f32x2){e1 * es, e2 * es};
        }
    }
    asm volatile("s_waitcnt lgkmcnt(0)" ::: "memory");
#pragma unroll
    for (int qb = 0; qb < 2; ++qb)
#pragma unroll
        for (int i = 0; i < 4; ++i) { const int r = 8 * i + (lane >> 3), ch = orow_chunk(lane, i);
            const size_t tok = (size_t)b * SEQ + rho + (size_t)dl * (i0 + qb * 32 + r);
            const v4u w = orow(wl + qb * 4096, lane, i);
            if (!FINAL) *(v4u*)(DPo + tok * 512 + h * 64 + ch * 8) = w;
            else { const f32x2 ww = *(const LAS f32x2*)(wl + 8192 + (qb * 32 + r) * 8);
                const v4u x1 = *(const v4u*)(DP1 + tok * 512 + h * 64 + ch * 8), x2 = *(const v4u*)(DP2 + tok * 512 + h * 64 + ch * 8);
                v4u y;
                y.x = cvtpk(bflo(w.x) + bflo(x1.x) * ww.x + bflo(x2.x) * ww.y, bfhi(w.x) + bfhi(x1.x) * ww.x + bfhi(x2.x) * ww.y);
                y.y = cvtpk(bflo(w.y) + bflo(x1.y) * ww.x + bflo(x2.y) * ww.y, bfhi(w.y) + bfhi(x1.y) * ww.x + bfhi(x2.y) * ww.y);
                y.z = cvtpk(bflo(w.z) + bflo(x1.z) * ww.x + bflo(x2.z) * ww.y, bfhi(w.z) + bfhi(x1.z) * ww.x + bfhi(x2.z) * ww.y);
                y.w = cvtpk(bflo(w.w) + bflo(x1.w) * ww.x + bflo(x2.w) * ww.y, bfhi(w.w) + bfhi(x1.w) * ww.x + bfhi(x2.w) * ww.y);
                *(v4u*)(OC + tok * DM + h * 64 + ch * 8) = y; } }
    asm volatile("s_waitcnt lgkmcnt(0)" ::: "memory");
}
__device__ __forceinline__ void na_tile(const bf16* QKV, const LAS float* rpb  , bf16* O, int idx, LAS unsigned char* wl, int lane) {
    asm volatile("" : "+v"(lane));
    const int r32 = lane & 31, hh = lane >> 5;
    const int cbk = idx & 3, iq = (idx >> 2) & 7, h = (idx >> 5) & 15, b = idx >> 9;
    const int qc = 16 * cbk + (r32 & 15), qr0 = 4 * iq + (r32 >> 4), qr1 = qr0 + 2;
    const bf16* qbase = QKV + ((size_t)h * NTOK + (size_t)b * SEQ) * 64; const bf16* kbase = qbase + (size_t)16 * NTOK * 64; const bf16* vbase = kbase + (size_t)16 * NTOK * 64;
    bf16x8 qf[2][4]; v4u qraw[2][4];
#pragma unroll
    for (int qb = 0; qb < 2; ++qb)
#pragma unroll
        for (int i = 0; i < 4; ++i) { const int r = 8 * i + (lane >> 3); qraw[qb][i] = *(const v4u*)(qbase + (size_t)((4 * iq + 2 * qb + (r >> 4)) * 64 + 16 * cbk + (r & 15)) * 64 + (lane & 7) * 8); }
    ATT_VADDR();
    const float c = 0.125f * LOG2E;
    const int csq = min(max(qc - 8, 0), 48), rs0 = min(max(qr0 - 4, 0), 24), rs1 = min(max(qr1 - 4, 0), 24);
    const int rA0 = min(max(4 * iq - 4, 0), 24), rB0 = min(max(4 * iq - 3, 0), 24) + 8, rA1 = min(max(4 * iq - 2, 0), 24), rB1 = min(max(4 * iq - 1, 0), 24) + 8;
    const int kc0 = min(max(16 * cbk - 8, 0), 32);
    const LAS float* rp = rpb + h * (15 * 31);
    f32x16 o[2][2];
#pragma unroll
    for (int i = 0; i < 16; ++i) { o[0][0][i] = 0.f; o[0][1][i] = 0.f; o[1][0][i] = 0.f; o[1][1][i] = 0.f; }
    float m0 = -INFINITY, m1 = -INFINITY, l0 = 0.f, l1 = 0.f;
    const int cd0 = kc0 + 4 * hh - csq, bc0 = kc0 + 4 * hh - qc + 15;
#define NA_ROW(kr_) ((size_t)((kr_) * 64 + kc0) * 64)
    stageK(wl, kbase + NA_ROW(rA0), 64, lane); stageV(wl + 8192, vbase + NA_ROW(rA0), 64, lane); stageK(wl + 4096, kbase + NA_ROW(rA0 + 1), 64, lane);
    qrow_put(wl + 12288, qraw[0], lane); qfrag_get(wl + 12288, qf[0], r32, hh); qrow_put(wl + 12288, qraw[1], lane); qfrag_get(wl + 12288, qf[1], r32, hh);
    ATT_WAIT_V(4);
    f32x16 sa, sb; qk32x2(wl, qf[0], qf[1], sa, sb, r32, hh);
    for (int kr = rA0; kr < rB1; ++kr) {
        const int j = kr - rA0; const bool n1 = kr + 1 < rB1, n2 = kr + 2 < rB1;
        if (n2) stageK(wl + (j & 1) * 4096, kbase + NA_ROW(kr + 2), 64, lane);
        if (n1) stageV(wl + 8192 + ((j + 1) & 1) * 4096, vbase + NA_ROW(kr + 1), 64, lane);
        if (n2) ATT_WAIT_V(8); else if (n1) ATT_WAIT_V(4); else ATT_WAIT_V(0);
        f32x16 na, nb;
        if (n1) qk32x2(wl + ((j + 1) & 1) * 4096, qf[0], qf[1], na, nb, r32, hh);
        const LAS unsigned char* buf = wl + 4096 + (j & 1) * 4096;
        const bool use0 = kr < rB0, use1 = kr >= rA1;
        bf16x8 p00, p01, p10, p11;
        if (use0) { float t[16]; const bool rok = (kr >= rs0) && (kr < rs0 + 8); const LAS float* bp = rp + (rok ? (kr - qr0 + 7) * 31 + bc0 : 0);
#pragma unroll
            for (int i = 0; i < 16; ++i) { const int dd = (i & 3) + 8 * (i >> 2); t[i] = bp[dd]; }
#pragma unroll
            for (int i = 0; i < 16; ++i) { const int dd = (i & 3) + 8 * (i >> 2); const bool ok = rok && ((unsigned)(cd0 + dd) < 16u); t[i] = ok ? __builtin_fmaf(sa[i], c, t[i]) : -INFINITY; }
            sm_step2(t, m0, l0, o[0][0], o[0][1], p00, p01); }
        if (use1) { float t[16]; const bool rok = (kr >= rs1) && (kr < rs1 + 8); const LAS float* bp = rp + (rok ? (kr - qr1 + 7) * 31 + bc0 : 0);
#pragma unroll
            for (int i = 0; i < 16; ++i) { const int dd = (i & 3) + 8 * (i >> 2); t[i] = bp[dd]; }
#pragma unroll
            for (int i = 0; i < 16; ++i) { const int dd = (i & 3) + 8 * (i >> 2); const bool ok = rok && ((unsigned)(cd0 + dd) < 16u); t[i] = ok ? __builtin_fmaf(sb[i], c, t[i]) : -INFINITY; }
            sm_step2(t, m1, l1, o[1][0], o[1][1], p10, p11); }
        { bf16x8 v00, v01, v10, v11; vfrag4(buf, va0, va1, v00, v01, v10, v11);
          if (use0) { o[0][0] = ATT_MFMA(v00, p00, o[0][0]); o[0][1] = ATT_MFMA(v10, p00, o[0][1]); }
          if (use1) { o[1][0] = ATT_MFMA(v00, p10, o[1][0]); o[1][1] = ATT_MFMA(v10, p10, o[1][1]); }
          if (use0) { o[0][0] = ATT_MFMA(v01, p01, o[0][0]); o[0][1] = ATT_MFMA(v11, p01, o[0][1]); }
          if (use1) { o[1][0] = ATT_MFMA(v01, p11, o[1][0]); o[1][1] = ATT_MFMA(v11, p11, o[1][1]); } }
        if (n1) { sa = na; sb = nb; }
    }
#undef NA_ROW
    const float i0 = 1.0f / xhalf_sum(l0), i1 = 1.0f / xhalf_sum(l1);
    ostage(wl, o[0][0], o[0][1], i0, r32, hh); ostage(wl + 4096, o[1][0], o[1][1], i1, r32, hh);
    asm volatile("s_waitcnt lgkmcnt(0)" ::: "memory");
#pragma unroll
    for (int qb = 0; qb < 2; ++qb)
#pragma unroll
        for (int i = 0; i < 4; ++i) { const int r = 8 * i + (lane >> 3);
            const v4u w = orow(wl + qb * 4096, lane, i);
            *(v4u*)(O + ((size_t)b * SEQ + (4 * iq + 2 * qb + (r >> 4)) * 64 + 16 * cbk + (r & 15)) * DM + h * 64 + orow_chunk(lane, i) * 8) = w; }
    asm volatile("s_waitcnt lgkmcnt(0)" ::: "memory");
}
}
#ifndef MK_MULTI
#define MK_MULTI 0
#endif
constexpr int NPH = 45;
struct Args { const float* in[22]; float* out; unsigned char* ws; int ph_lo, ph_hi; };
__global__ void __launch_bounds__(NWAVES * 64, 2) fwd(Args args) {
    extern __shared__ __attribute__((aligned(16))) unsigned char lds_raw[];
    Ctx C;
    C.out = args.out; C.ws = args.ws; C.lds = (LAS unsigned char*)lds_raw;
    C.tid = threadIdx.x; C.lane = C.tid & 63; C.wave = __builtin_amdgcn_readfirstlane(C.tid >> 6); C.G = gridDim.x; C.gw = blockIdx.x * NWAVES + C.wave; C.NGW = C.G * NWAVES;
    volatile LAS unsigned* MISC = (volatile LAS unsigned*)(C.lds + MISC_OFF);
    for (int u = C.tid; u < (LDS_BYTES - LDSCTL_OFF) / 4; u += NWAVES * 64) ((LAS unsigned*)(C.lds + LDSCTL_OFF))[u] = 0u;
    __syncthreads();
    XcdBarrier bar = xcd_barrier_post((unsigned*)(args.ws + WS_CTL) + CW_BAR, MISC + 8);
    const int lo = args.ph_lo, hi = args.ph_hi; int ph = 0; const int wave_s = C.wave;
#define PH_BEGIN { asm volatile("" : "+s"(ph)); const bool run_ = (ph >= lo && ph < hi); if (run_) { unsigned char* ws = args.ws; float* xo = args.out; int l_; asm volatile("v_mbcnt_lo_u32_b32 %0, -1, 0\n\tv_mbcnt_hi_u32_b32 %0, -1, %0" : "=v"(l_)); asm volatile("" : "+s"(ws), "+s"(xo)); \
        C.ws = ws; C.out = xo; C.lane = l_; C.wave = wave_s; C.tid = wave_s * 64 + l_; { int gw_ = blockIdx.x * NWAVES + wave_s, g_ = gridDim.x; asm volatile("" : "+s"(gw_), "+s"(g_)); C.gw = gw_; C.G = g_; C.NGW = g_ * NWAVES; } unsigned* ctl = (unsigned*)(ws + WS_CTL); (void)ctl;
#define PH_END } if (run_ && ph + 1 < hi) { XcdBarrier b2_ = bar; asm volatile("" : "+s"(b2_.bar)); int l2_; asm volatile("v_mbcnt_lo_u32_b32 %0, -1, 0\n\tv_mbcnt_hi_u32_b32 %0, -1, %0" : "=v"(l2_)); xcd_barrier(b2_, wave_s * 64 + l2_); } ++ph; }
#define H ((bf16*)(ws + WS_H))
#define XB ((bf16*)xo)
#define PROJ ((bf16*)(ws + WS_PROJ))
#define QM ((bf16*)(ws + WS_QM))
#define KVM ((bf16*)(ws + WS_KVM))
#define KPE ((bf16*)(ws + WS_KPE))
#define ACT ((bf16*)(ws + WS_ACT))
#define QKV ((bf16*)(ws + WS_QKV))
#define HG8 (ws + WS_HG8)
#define YALL ((bf16*)(ws + WS_YALL))
#define MACT (ws + WS_MACT)
#define wev (ws + WS_WEV + lp * EV_STRIDE)
#define wod (ws + WS_WOD + lp * OD_STRIDE)
#define cnt (ctl + CW_CNT + lp * N_CHUNK * 8 * 64)
#define xin (lp == 0 ? args.in[0] : (const float*)xo)
#define GEMM(EPI, ORD, g, S, E) pg8::gemm_phase<EPI, ORD, true, true, 0>(C.lds, g, S, E, C.tid)
#define GEMM8(EPI, ORD, g, S, E) pg8::gemm_phase<EPI, ORD, false, true, 1>(C.lds, g, S, E, C.tid)
#define GEMMI8(EPI, ORD, g, S, E) pg8::gemm_phase<EPI, ORD, false, true, 2>(C.lds, g, S, E, C.tid)

    PH_BEGIN p0_prologue(C, args); norm_phase<2, true>(C, args.in[0], args.in[1], H, XB); PH_END

    for (int lp = 0; lp < 2; ++lp) {
        PH_BEGIN { pg8::Gemm g{H, (const bf16*)(wev + EV_WIN), DM / 2, DM / 2, DM / 2}; pg8::StaticOrder S; S.init(NTOK, IN_E_PAD, C.G, (int)blockIdx.x); pg8::EpiBf16I8 E{PROJ, IN_E_PAD, (const float*)(ws + WS_SA), (const float*)(ws + WS_SB) + lp * 8192}; GEMMI8(pg8::EpiBf16I8, pg8::StaticOrder, g, S, E); } PH_END
        PH_BEGIN mla_prep_phase(C, PROJ, args.in[3] + lp * 256, args.in[5] + lp * 128, KPE); PH_END
        PH_BEGIN { { pg8::Gemm g{PROJ + 1536, (const bf16*)(wev + EV_WUQ), IN_E_PAD, 256, 256}; pg8::StaticOrder S; S.init(NTOK, 768, C.G, (int)blockIdx.x); pg8::EpiBf16 E{QM, 768}; GEMM(pg8::EpiBf16, pg8::StaticOrder, g, S, E); }
                   { pg8::Gemm g{PROJ + 1792, (const bf16*)(wev + EV_WUKV), IN_E_PAD, 256, 256}; pg8::StaticOrder S; S.init(NTOK, 1024, C.G, (int)blockIdx.x); pg8::EpiBf16 E{KVM, 1024}; GEMM(pg8::EpiBf16, pg8::StaticOrder, g, S, E); } } PH_END
        PH_BEGIN { const float* rope = (const float*)(ws + WS_ROPE);
                   for (int it = blockIdx.x; it < 1024; it += C.G) att::mla_unit(QM, KVM, KPE, rope, H, it, C.lds, C.tid);
                   LAS unsigned char* wl = C.lds + C.wave * 16384;
                   for (int it = C.gw; it < 8192; it += C.NGW) att::dil_tile<false>(PROJ, 1, it, (bf16*)(ws + WS_DP1), (float*)(ws + WS_DL1), nullptr, nullptr, nullptr, nullptr, nullptr, wl, C.lane);
                   for (int it = C.gw; it < 8192; it += C.NGW) att::dil_tile<false>(PROJ, 4, it, (bf16*)(ws + WS_DP2), (float*)(ws + WS_DL2), nullptr, nullptr, nullptr, nullptr, nullptr, wl, C.lane); } PH_END
        PH_BEGIN { LAS unsigned char* wl = C.lds + C.wave * 16384;
                   for (int it = C.gw; it < 8192; it += C.NGW) att::dil_tile<true>(PROJ, 16, it, nullptr, nullptr, (const bf16*)(ws + WS_DP1), (const float*)(ws + WS_DL1), (const bf16*)(ws + WS_DP2), (const float*)(ws + WS_DL2), H, wl, C.lane); } PH_END
        PH_BEGIN { pg8::Gemm g{H, (const bf16*)(wev + EV_WOUT), DM, DM, DM}; pg8::StaticOrder S; S.init(NTOK, DM, C.G, (int)blockIdx.x); pg8::EpiResidB E{(const pg8::bf16_t*)XB, (pg8::bf16_t*)XB, LDX}; GEMM(pg8::EpiResidB, pg8::StaticOrder, g, S, E); } PH_END
        PH_BEGIN norm_phase_b(C, XB, args.in[8] + lp * DM, H); PH_END
        PH_BEGIN { pg8::Gemm g{H, (const bf16*)(wev + EV_WGU), DM / 2, DM / 2, DM / 2}; pg8::StaticOrder S; S.init(NTOK, 2 * DFF, C.G, (int)blockIdx.x); pg8::EpiSwigluI8 E{ACT, DFF, (const float*)(ws + WS_SA), (const float*)(ws + WS_SB) + lp * 8192 + 2048}; GEMMI8(pg8::EpiSwigluI8, pg8::StaticOrder, g, S, E); } PH_END
        PH_BEGIN { pg8::Gemm g{ACT, (const bf16*)(wev + EV_WD), DFF, DFF, DFF}; pg8::StaticOrder S; S.init(NTOK, DM, C.G, (int)blockIdx.x); pg8::EpiResidB E{(const pg8::bf16_t*)XB, (pg8::bf16_t*)XB, LDX}; GEMM(pg8::EpiResidB, pg8::StaticOrder, g, S, E); } PH_END

        PH_BEGIN norm_phase_b(C, XB, args.in[12] + lp * DM, H); moe_weights(C, args, lp); PH_END
        PH_BEGIN { pg8::Gemm g{H, (const bf16*)(wod + OD_WQKV), DM / 2, DM / 2, DM / 2}; pg8::StaticOrder S; S.init(NTOK, 3072, C.G, (int)blockIdx.x); pg8::EpiBf16I8H E{QKV, NTOK, (const float*)(ws + WS_SA), (const float*)(ws + WS_SB) + 16384 + lp * 4096}; GEMMI8(pg8::EpiBf16I8H, pg8::StaticOrder, g, S, E); } PH_END
        PH_BEGIN { const float* rpb = args.in[14] + lp * 16 * 15 * 31; LAS float* rl = (LAS float*)(C.lds + RPB_OFF);
                   for (int i = C.tid; i < 16 * 15 * 31; i += NWAVES * 64) rl[i] = rpb[i] * 1.4426950408889634f;
                   __syncthreads();
                   LAS unsigned char* wl = C.lds + C.wave * 16384;
                   for (int it = C.gw; it < 16384; it += C.NGW) att::na_tile(QKV, rl, H, it, wl, C.lane); } PH_END
        PH_BEGIN { pg8::Gemm g{H, (const bf16*)(wod + OD_WO), DM, DM, DM}; pg8::StaticOrder S; S.init(NTOK, DM, C.G, (int)blockIdx.x); pg8::EpiResidB E{(const pg8::bf16_t*)XB, (pg8::bf16_t*)XB, LDX}; GEMM(pg8::EpiResidB, pg8::StaticOrder, g, S, E); } PH_END
        PH_BEGIN route_phase(C, XB, args.in[16] + lp * DM, args.in[17] + lp * DM * NEXP, (unsigned char*)H, cnt); PH_END
        PH_BEGIN gather_all_phase(C, (const unsigned char*)H, HG8, cnt); PH_END
#define MOE_GU(ch_) { pg8::Gemm g{(const bf16*)(HG8 + (size_t)(ch_) * 2 * CHUNK_SLOTS * DM), (const bf16*)(ws + WS_MWGU), DM / 2, DM / 2, DM / 2}; pg8::GroupedOrder S; grouped_order(S, cnt, (ch_), 28, C.G, (int)blockIdx.x); \
            pg8::EpiSwigluF8 E{MACT + (size_t)((ch_) & 1) * CHUNK_SLOTS * DFFX, DFFX, 1.0f / 32.0f}; GEMM8(pg8::EpiSwigluF8, pg8::GroupedOrder, g, S, E); }
#define MOE_DOWN(ch_) { pg8::Gemm g{(const bf16*)(MACT + (size_t)((ch_) & 1) * CHUNK_SLOTS * DFFX), (const bf16*)(ws + WS_MWD), DFFX / 2, DFFX / 2, DFFX / 2}; pg8::GroupedOrder S; grouped_order(S, cnt, (ch_), 4, C.G, (int)blockIdx.x); \
            pg8::EpiBf16S E{YALL + (size_t)(ch_) * CHUNK_SLOTS * DM, DM, 1.0f / 32.0f}; GEMM8(pg8::EpiBf16S, pg8::GroupedOrder, g, S, E); }
        PH_BEGIN MOE_GU(0) PH_END
        for (int ch = 1; ch < N_CHUNK; ++ch) {
            PH_BEGIN MOE_DOWN(ch - 1) MOE_GU(ch) PH_END
        }
        PH_BEGIN MOE_DOWN(N_CHUNK - 1) PH_END
#undef MOE_GU
#undef MOE_DOWN
        PH_BEGIN { if (lp == 0) combine_all_phase<false>(C, XB, xo, YALL, args.in[1] + DM, H); else combine_all_phase<true>(C, XB, xo, YALL, args.in[21], H); } PH_END
    }
#undef PH_BEGIN
#undef PH_END
#undef GEMM
#undef XB
#undef H
#undef PROJ
#undef QM
#undef KVM
#undef KPE
#undef ACT
#undef QKV
#undef HG8
#undef YALL
#undef GEMM8
#undef GEMMI8
#undef MACT
#undef wev
#undef wod
#undef cnt
#undef xin
}

extern "C" void kernel_launch(void* const* d_in, const int* in_sizes, int n_in, void* d_out, int out_size, void* d_ws, size_t ws_size, hipStream_t stream) {
    static int grid = 0;
    if (grid == 0) {
        if (n_in != 22 || in_sizes[0] != NTOK * DM || out_size != NTOK * DM || ws_size < WS_END) { fprintf(stderr, "kernel_launch: unexpected shapes (n_in %d, in0 %d, out %d, ws %zu); nothing launched\n", n_in, n_in > 0 ? in_sizes[0] : -1, out_size, ws_size); grid = -1; return; }
        int dev = 0, cus = 0, per_cu = 0;
        if (hipGetDevice(&dev) != hipSuccess || hipDeviceGetAttribute(&cus, hipDeviceAttributeMultiprocessorCount, dev) != hipSuccess) { grid = -1; return; }
        if (hipFuncSetAttribute((const void*)fwd, hipFuncAttributeMaxDynamicSharedMemorySize, LDS_BYTES) != hipSuccess) { fprintf(stderr, "kernel_launch: hipFuncSetAttribute failed\n"); grid = -1; return; }
        if (hipOccupancyMaxActiveBlocksPerMultiprocessor(&per_cu, (const void*)fwd, NWAVES * 64, LDS_BYTES) != hipSuccess || per_cu < 1) { fprintf(stderr, "kernel_launch: occupancy query says %d blocks per CU\n", per_cu); }
        (void)hipGetLastError();
        grid = cus;
    }
    if (grid < 0) return;
    if (hipMemsetAsync((char*)d_ws + WS_CTL, 0, CTL_ZERO_BYTES, stream) != hipSuccess) return;
    Args a{};
    for (int i = 0; i < 22; ++i) a.in[i] = (const float*)d_in[i];
    a.out = (float*)d_out; a.ws = (unsigned char*)d_ws;
#if MK_MULTI
    for (int p = 0; p < NPH; ++p) { a.ph_lo = p; a.ph_hi = p + 1; hipLaunchKernelGGL(fwd, dim3(grid), dim3(NWAVES * 64), LDS_BYTES, stream, a); }
#else
    a.ph_lo = 0; a.ph_hi = NPH; hipLaunchKernelGGL(fwd, dim3(grid), dim3(NWAVES * 64), LDS_BYTES, stream, a);
#endif
}
```

```cpp
#include <hip/hip_runtime.h>
#include <cstdio>
#include <cstdint>
#define MK_MULTI 0
namespace pg8 {
#define PG8_LAS __attribute__((address_space(3)))
#define PG8_GAS __attribute__((address_space(1)))
typedef unsigned short bf16_t;
typedef short bf16x8 __attribute__((ext_vector_type(8)));
typedef float f32x4 __attribute__((ext_vector_type(4)));
typedef unsigned u32x4 __attribute__((ext_vector_type(4)));
typedef int v4i_t __attribute__((ext_vector_type(4)));
typedef int v8i_t __attribute__((ext_vector_type(8)));
constexpr int BM = 256, BK = 64, HALF = 128, HTB = HALF * BK * 2  , STAGE_BYTES = 8 * HTB, NXCD = 8, WGM = 8, EPI_SC_OFF = STAGE_BYTES + 1024  ;

__host__ __device__ __forceinline__ int lds_byte(int r, int c) { const int st = (r >> 4) * 2 + (c >> 5), rr = r & 15, cc = c & 31, ob = rr * 64 + cc * 2; return st * 1024 + (ob ^ (((ob >> 9) & 1) << 5)); }
__host__ __device__ __forceinline__ void stage_rc(int b, int& R, int& C) { const int st = b / 1024, sb = b % 1024, swz = sb ^ (((sb >> 9) & 1) << 5); R = (st >> 1) * 16 + swz / 64; C = (st & 1) * 32 + (swz % 64) / 2; }
__host__ __device__ __forceinline__ int perm32(int rho) { const int n = rho >> 4, i = rho & 15; return 8 * (i >> 2) + 4 * n + (i & 3); }

struct Unit { int pm, pn, pc; };
struct Gemm { const bf16_t* A; const bf16_t* Bt; int lda, ldb, K; };

struct StaticOrder {
    int nM, nN, nwg, G, c;
    __host__ __device__ void init(int M, int N, int G_, int c_) { nM = M / BM; nN = N / BM; nwg = nM * nN; G = G_; c = c_; }
    __host__ __device__ bool next(int i, Unit& u) const {
        const long L = (long)i * G + c; if (L >= nwg) return false;
        int wgid = (int)L; { const int q = nwg / NXCD, r = nwg % NXCD, xcd = wgid % NXCD, off = wgid / NXCD; wgid = (xcd < r ? xcd * (q + 1) : r * (q + 1) + (xcd - r) * q) + off; }
        const int nig = WGM * nN, gid = wgid / nig, fm = gid * WGM, gsz = (nM - fm) < WGM ? (nM - fm) : WGM;
        u.pm = fm + ((wgid % nig) % gsz); u.pn = (wgid % nig) / gsz; u.pc = u.pn; return true;
    }
    __device__ __forceinline__ void a_ready(const Unit&) const {}
    __device__ __forceinline__ void done(const Unit&) const {}
};
struct GroupedOrder {
    int t0, t1, t2, t3, t4, t5, t6, RT, nN, G, c;
    __device__ bool next(int i, Unit& u) const {
        const int nwg = RT * nN; const long L = (long)i * G + c; if (L >= nwg) return false;
        int wgid = (int)L; { const int q = nwg / NXCD, r = nwg % NXCD, xcd = wgid % NXCD, off = wgid / NXCD; wgid = (xcd < r ? xcd * (q + 1) : r * (q + 1) + (xcd - r) * q) + off; }
        const int nig = WGM * nN, gid = wgid / nig, fm = gid * WGM, gsz = (RT - fm) < WGM ? (RT - fm) : WGM, w = wgid - gid * nig;
        const int rt = fm + (w % gsz), j = w / gsz;
        const int e = (rt >= t0) + (rt >= t1) + (rt >= t2) + (rt >= t3) + (rt >= t4) + (rt >= t5) + (rt >= t6);
        u.pm = rt; u.pn = e * nN + j; u.pc = j; return true;
    }
    __device__ __forceinline__ void a_ready(const Unit&) const {}
    __device__ __forceinline__ void done(const Unit&) const {}
};

__device__ __forceinline__ unsigned cvt_pk_bf16(float lo, float hi) { unsigned r; asm volatile("v_cvt_pk_bf16_f32 %0, %1, %2" : "=v"(r) : "v"(lo), "v"(hi)); return r; }

struct EpiBf16 {
    static constexpr bool PERM = true, AFTER_DRAIN = false, PREFETCH = false;
    bf16_t* O; int ldc;
    __device__ __forceinline__ void operator()(const f32x4 (&acc)[2][2][4][2], const Unit& u, int wr, int wc, int fr, int fq) const {
        const int row0 = u.pm * BM + wr * 64 + fr, col0 = u.pc * BM + wc * 32 + 8 * fq;
#pragma unroll
        for (int ai = 0; ai < 2; ++ai)
#pragma unroll
            for (int m = 0; m < 4; ++m) { bf16_t* rowp = O + (size_t)(row0 + ai * HALF + m * 16) * ldc + col0;
#pragma unroll
                for (int bj = 0; bj < 2; ++bj) { const f32x4 v0 = acc[ai][bj][m][0], v1 = acc[ai][bj][m][1];
                    u32x4 w; w.x = cvt_pk_bf16(v0[0], v0[1]); w.y = cvt_pk_bf16(v0[2], v0[3]); w.z = cvt_pk_bf16(v1[0], v1[1]); w.w = cvt_pk_bf16(v1[2], v1[3]);
                    *(PG8_GAS u32x4*)(rowp + bj * HALF) = w; } }
    }
};
struct EpiSwiglu {
    static constexpr bool PERM = true, AFTER_DRAIN = false, PREFETCH = false;
    bf16_t* O; int ldc;
    __device__ __forceinline__ void operator()(const f32x4 (&acc)[2][2][4][2], const Unit& u, int wr, int wc, int fr, int fq) const {
        const int row0 = u.pm * BM + wr * 64 + fr, col0 = u.pc * HALF + wc * 32 + 8 * fq;
#pragma unroll
        for (int ai = 0; ai < 2; ++ai)
#pragma unroll
            for (int m = 0; m < 4; ++m) { bf16_t* rowp = O + (size_t)(row0 + ai * HALF + m * 16) * ldc + col0;
                float r[8];
#pragma unroll
                for (int n = 0; n < 2; ++n)
#pragma unroll
                    for (int k = 0; k < 4; ++k) { const float g = acc[ai][0][m][n][k], up = acc[ai][1][m][n][k];
                        r[n * 4 + k] = g * __builtin_amdgcn_rcpf(1.0f + __expf(-g)) * up; }
                u32x4 w; w.x = cvt_pk_bf16(r[0], r[1]); w.y = cvt_pk_bf16(r[2], r[3]); w.z = cvt_pk_bf16(r[4], r[5]); w.w = cvt_pk_bf16(r[6], r[7]);
                *(PG8_GAS u32x4*)rowp = w; }
    }
};
__device__ __forceinline__ unsigned cvt4_fp8(float a, float b, float c, float d) { int r = 0; r = __builtin_amdgcn_cvt_pk_fp8_f32(a, b, r, false); r = __builtin_amdgcn_cvt_pk_fp8_f32(c, d, r, true); return (unsigned)r; }
struct EpiSwigluF8 {
    static constexpr bool PERM = true, AFTER_DRAIN = false, PREFETCH = false;
    unsigned char* O; int ldc; float sc;
    __device__ __forceinline__ void operator()(const f32x4 (&acc)[2][2][4][2], const Unit& u, int wr, int wc, int fr, int fq) const {
        const int row0 = u.pm * BM + wr * 64 + fr, col0 = u.pc * HALF + wc * 32 + 8 * fq;
        const float c1 = -1.4426950408889634f * sc, k2 = 1.0f / (sc * sc);
#pragma unroll
        for (int ai = 0; ai < 2; ++ai)
#pragma unroll
            for (int m = 0; m < 4; ++m) { unsigned char* rowp = O + (size_t)(row0 + ai * HALF + m * 16) * ldc + col0;
                typedef unsigned u32x2_t __attribute__((ext_vector_type(2)));
                u32x2_t w;
#pragma unroll
                for (int n = 0; n < 2; ++n) { const f32x4 ag = acc[ai][0][m][n], au = acc[ai][1][m][n];
                    const f32x4 x = ag * c1; f32x4 tt;
#pragma unroll
                    for (int k = 0; k < 4; ++k) tt[k] = __builtin_amdgcn_exp2f(x[k]);
                    const f32x4 d = tt * k2 + k2; f32x4 r;
#pragma unroll
                    for (int k = 0; k < 4; ++k) r[k] = __builtin_amdgcn_rcpf(d[k]);
                    const f32x4 o = (ag * au) * r;
                    w[n] = cvt4_fp8(o[0], o[1], o[2], o[3]); }
                *(PG8_GAS u32x2_t*)rowp = w; }
    }
};
struct EpiBf16S {
    static constexpr bool PERM = true, AFTER_DRAIN = false, PREFETCH = false;
    bf16_t* O; int ldc; float sc;
    __device__ __forceinline__ void operator()(const f32x4 (&acc)[2][2][4][2], const Unit& u, int wr, int wc, int fr, int fq) const {
        const int row0 = u.pm * BM + wr * 64 + fr, col0 = u.pc * BM + wc * 32 + 8 * fq;
#pragma unroll
        for (int ai = 0; ai < 2; ++ai)
#pragma unroll
            for (int m = 0; m < 4; ++m) { bf16_t* rowp = O + (size_t)(row0 + ai * HALF + m * 16) * ldc + col0;
#pragma unroll
                for (int bj = 0; bj < 2; ++bj) { const f32x4 v0 = acc[ai][bj][m][0] * sc, v1 = acc[ai][bj][m][1] * sc;
                    u32x4 w; w.x = cvt_pk_bf16(v0[0], v0[1]); w.y = cvt_pk_bf16(v0[2], v0[3]); w.z = cvt_pk_bf16(v1[0], v1[1]); w.w = cvt_pk_bf16(v1[2], v1[3]);
                    *(PG8_GAS u32x4*)(rowp + bj * HALF) = w; } }
    }
};
struct EpiBf16I8 {
    static constexpr bool PERM = true, AFTER_DRAIN = false, PREFETCH = true;
    bf16_t* O; int ldc; const float* sa; const float* sb;
    __device__ __forceinline__ void prefetch(const Unit& u, PG8_LAS unsigned char* blk, int wid, int lane) const {
        const float* src = (wid < 4) ? sa + u.pm * BM + wid * 64 + lane : sb + u.pn * BM + (wid - 4) * 64 + lane;
        __builtin_amdgcn_global_load_lds((const unsigned*)src, (PG8_LAS unsigned*)(blk + wid * 256), 4, 0, 0);
    }
    __device__ __forceinline__ void run(const f32x4 (&acc)[2][2][4][2], const Unit& u, int wr, int wc, int fr, int fq, const PG8_LAS float* scl) const {
        const int row0 = u.pm * BM + wr * 64 + fr, col0 = u.pc * BM + wc * 32 + 8 * fq, lrow0 = wr * 64 + fr, bcol0 = 256 + wc * 32 + 8 * fq;
        f32x4 sc[2][2];
#pragma unroll
        for (int bj = 0; bj < 2; ++bj)
#pragma unroll
            for (int n = 0; n < 2; ++n) sc[bj][n] = *(const PG8_LAS f32x4*)(scl + bcol0 + bj * HALF + 4 * n);
#pragma unroll
        for (int ai = 0; ai < 2; ++ai)
#pragma unroll
            for (int m = 0; m < 4; ++m) { const int row = row0 + ai * HALF + m * 16; bf16_t* rowp = O + (size_t)row * ldc + col0; const float s = scl[lrow0 + ai * HALF + m * 16];
#pragma unroll
                for (int bj = 0; bj < 2; ++bj) { f32x4 v[2];
#pragma unroll
                    for (int n = 0; n < 2; ++n) { f32x4 fa;
#pragma unroll
                        for (int k = 0; k < 4; ++k) { const float f = acc[ai][bj][m][n][k]; fa[k] = (float)__builtin_bit_cast(int, f); }
                        v[n] = fa * (sc[bj][n] * s); }
                    u32x4 w; w.x = cvt_pk_bf16(v[0][0], v[0][1]); w.y = cvt_pk_bf16(v[0][2], v[0][3]); w.z = cvt_pk_bf16(v[1][0], v[1][1]); w.w = cvt_pk_bf16(v[1][2], v[1][3]);
                    *(PG8_GAS u32x4*)(rowp + bj * HALF) = w; } }
    }
};
struct EpiBf16I8H {
    static constexpr bool PERM = true, AFTER_DRAIN = false, PREFETCH = true;
    bf16_t* O; int nrows; const float* sa; const float* sb;
    __device__ __forceinline__ void prefetch(const Unit& u, PG8_LAS unsigned char* blk, int wid, int lane) const {
        const float* src = (wid < 4) ? sa + u.pm * BM + wid * 64 + lane : sb + u.pn * BM + (wid - 4) * 64 + lane;
        __builtin_amdgcn_global_load_lds((const unsigned*)src, (PG8_LAS unsigned*)(blk + wid * 256), 4, 0, 0);
    }
    __device__ __forceinline__ void run(const f32x4 (&acc)[2][2][4][2], const Unit& u, int wr, int wc, int fr, int fq, const PG8_LAS float* scl) const {
        const int row0 = u.pm * BM + wr * 64 + fr, col0 = u.pc * BM + wc * 32 + 8 * fq, lrow0 = wr * 64 + fr, bcol0 = 256 + wc * 32 + 8 * fq;
        f32x4 sc[2][2];
#pragma unroll
        for (int bj = 0; bj < 2; ++bj)
#pragma unroll
            for (int n = 0; n < 2; ++n) sc[bj][n] = *(const PG8_LAS f32x4*)(scl + bcol0 + bj * HALF + 4 * n);
#pragma unroll
        for (int ai = 0; ai < 2; ++ai)
#pragma unroll
            for (int m = 0; m < 4; ++m) { const int row = row0 + ai * HALF + m * 16; const float s = scl[lrow0 + ai * HALF + m * 16];
#pragma unroll
                for (int bj = 0; bj < 2; ++bj) { f32x4 v[2];
#pragma unroll
                    for (int n = 0; n < 2; ++n) { f32x4 fa;
#pragma unroll
                        for (int k = 0; k < 4; ++k) { const float f = acc[ai][bj][m][n][k]; fa[k] = (float)__builtin_bit_cast(int, f); }
                        v[n] = fa * (sc[bj][n] * s); }
                    u32x4 w; w.x = cvt_pk_bf16(v[0][0], v[0][1]); w.y = cvt_pk_bf16(v[0][2], v[0][3]); w.z = cvt_pk_bf16(v[1][0], v[1][1]); w.w = cvt_pk_bf16(v[1][2], v[1][3]);
                    const int cc = col0 + bj * HALF; *(PG8_GAS u32x4*)(O + ((size_t)(cc >> 6) * nrows + row) * 64 + (cc & 63)) = w; } }
    }
};
struct EpiSwigluI8 {
    static constexpr bool PERM = true, AFTER_DRAIN = false, PREFETCH = true;
    bf16_t* O; int ldc; const float* sa; const float* sb;
    __device__ __forceinline__ void prefetch(const Unit& u, PG8_LAS unsigned char* blk, int wid, int lane) const {
        const float* src = (wid < 4) ? sa + u.pm * BM + wid * 64 + lane : sb + u.pn * BM + (wid - 4) * 64 + lane;
        __builtin_amdgcn_global_load_lds((const unsigned*)src, (PG8_LAS unsigned*)(blk + wid * 256), 4, 0, 0);
    }
    __device__ __forceinline__ void run(const f32x4 (&acc)[2][2][4][2], const Unit& u, int wr, int wc, int fr, int fq, const PG8_LAS float* scl) const {
        const int row0 = u.pm * BM + wr * 64 + fr, col0 = u.pc * HALF + wc * 32 + 8 * fq, lrow0 = wr * 64 + fr, bcol0 = 256 + wc * 32 + 8 * fq;
        f32x4 c1[2], c2[2]; float one = 1.0f; asm volatile("" : "+v"(one));
#pragma unroll
        for (int n = 0; n < 2; ++n) { const f32x4 sg = *(const PG8_LAS f32x4*)(scl + bcol0 + 4 * n), su = *(const PG8_LAS f32x4*)(scl + bcol0 + HALF + 4 * n); c1[n] = sg * -1.4426950408889634f; c2[n] = sg * su; }
#pragma unroll
        for (int ai = 0; ai < 2; ++ai)
#pragma unroll
            for (int m = 0; m < 4; ++m) { const int row = row0 + ai * HALF + m * 16; bf16_t* rowp = O + (size_t)row * ldc + col0; const float s = scl[lrow0 + ai * HALF + m * 16], s2 = s * s;
                u32x4 w;
#pragma unroll
                for (int n = 0; n < 2; ++n) { f32x4 fa, fu;
#pragma unroll
                    for (int k = 0; k < 4; ++k) { const float fg = acc[ai][0][m][n][k], fv = acc[ai][1][m][n][k]; fa[k] = (float)__builtin_bit_cast(int, fg); fu[k] = (float)__builtin_bit_cast(int, fv); }
                    const f32x4 x = fa * (c1[n] * s); f32x4 tt, r;
#pragma unroll
                    for (int k = 0; k < 4; ++k) tt[k] = __builtin_amdgcn_exp2f(x[k]);
                    const f32x4 d = tt * one + one;
#pragma unroll
                    for (int k = 0; k < 4; ++k) r[k] = __builtin_amdgcn_rcpf(d[k]);
                    const f32x4 o = ((fa * fu) * (c2[n] * s2)) * r;
                    if (n == 0) { w.x = cvt_pk_bf16(o[0], o[1]); w.y = cvt_pk_bf16(o[2], o[3]); } else { w.z = cvt_pk_bf16(o[0], o[1]); w.w = cvt_pk_bf16(o[2], o[3]); } }
                *(PG8_GAS u32x4*)rowp = w; }
    }
};
struct EpiNull { static constexpr bool PERM = true, AFTER_DRAIN = false, PREFETCH = false; int dummy;
    __device__ __forceinline__ void operator()(const f32x4 (&acc)[2][2][4][2], const Unit& u, int wr, int wc, int fr, int fq) const { float s = 0.f;
#pragma unroll
        for (int a = 0; a < 2; ++a)
#pragma unroll
            for (int b = 0; b < 2; ++b)
#pragma unroll
                for (int m = 0; m < 4; ++m)
#pragma unroll
                    for (int n = 0; n < 2; ++n) s += acc[a][b][m][n][0] + acc[a][b][m][n][1] + acc[a][b][m][n][2] + acc[a][b][m][n][3];
        asm volatile("" :: "v"(s)); }
};
struct EpiResidB {
    static constexpr bool PERM = true, AFTER_DRAIN = false, PREFETCH = false;
    const bf16_t* base; bf16_t* out; int ldc;
    __device__ __forceinline__ void operator()(const f32x4 (&acc)[2][2][4][2], const Unit& u, int wr, int wc, int fr, int fq) const {
        const int row0 = u.pm * BM + wr * 64 + fr, col0 = u.pc * BM + wc * 32 + 8 * fq;
#pragma unroll
        for (int ai = 0; ai < 2; ++ai)
#pragma unroll
            for (int m = 0; m < 4; ++m) { const size_t ro = (size_t)(row0 + ai * HALF + m * 16) * ldc + col0;
#pragma unroll
                for (int bj = 0; bj < 2; ++bj) { const u32x4 b = *(const PG8_GAS u32x4*)(base + ro + bj * HALF); const f32x4 v0 = acc[ai][bj][m][0], v1 = acc[ai][bj][m][1];
                    u32x4 w; w.x = cvt_pk_bf16(v0[0] + __builtin_bit_cast(float, b.x << 16), v0[1] + __builtin_bit_cast(float, b.x & 0xffff0000u)); w.y = cvt_pk_bf16(v0[2] + __builtin_bit_cast(float, b.y << 16), v0[3] + __builtin_bit_cast(float, b.y & 0xffff0000u));
                    w.z = cvt_pk_bf16(v1[0] + __builtin_bit_cast(float, b.z << 16), v1[1] + __builtin_bit_cast(float, b.z & 0xffff0000u)); w.w = cvt_pk_bf16(v1[2] + __builtin_bit_cast(float, b.w << 16), v1[3] + __builtin_bit_cast(float, b.w & 0xffff0000u));
                    *(PG8_GAS u32x4*)(out + ro + bj * HALF) = w; } }
    }
};
struct EpiResid {
    static constexpr bool PERM = false, AFTER_DRAIN = false, PREFETCH = false;
    const float* base; float* out; int ldc;
    __device__ __forceinline__ void operator()(const f32x4 (&acc)[2][2][4][2], const Unit& u, int wr, int wc, int fr, int fq) const {
        const int row0 = u.pm * BM + wr * 64 + fr, col0 = u.pc * BM + wc * 32 + 4 * fq;
#pragma unroll
        for (int ai = 0; ai < 2; ++ai)
#pragma unroll
            for (int m = 0; m < 4; ++m) { const size_t ro = (size_t)(row0 + ai * HALF + m * 16) * ldc + col0;
#pragma unroll
                for (int bj = 0; bj < 2; ++bj)
#pragma unroll
                    for (int n = 0; n < 2; ++n) { const size_t o = ro + bj * HALF + n * 16;
                        const f32x4 b = *(const PG8_GAS f32x4*)(base + o); *(PG8_GAS f32x4*)(out + o) = b + acc[ai][bj][m][n]; } }
    }
};
template <class Epi, class Sched, bool ALIGN_EPI = false, bool SP2 = false, int DT = 0>
__device__ __forceinline__ void gemm_phase(PG8_LAS unsigned char* lds, const Gemm g, const Sched& S, const Epi& E, int tid_in) {
    int tid_ = tid_in; asm volatile("" : "+v"(tid_));
    const int tid = tid_, wid = __builtin_amdgcn_readfirstlane(tid >> 6), lane = tid & 63, wr = wid >> 2, wc = wid & 3, fr = lane & 15, fq = lane >> 4;
    const int K = g.K, nt = K / BK;
    unsigned voffA[2], voffB[2];
#pragma unroll
    for (int i = 0; i < 2; ++i) { int R, C; stage_rc(tid * 16 + i * 8192, R, C); const int Rb = Epi::PERM ? ((R & ~31) + perm32(R & 31)) : R;
        voffA[i] = (unsigned)(R * g.lda + C) * 2u; voffB[i] = (unsigned)(Rb * g.ldb + C) * 2u; }
    const size_t kstep = (size_t)(BK * 2);
    const size_t hstepA = (size_t)HALF * g.lda * 2, hstepB = (size_t)HALF * g.ldb * 2;
    const size_t tstepA = 2 * hstepA, tstepB = 2 * hstepB;
    const unsigned ldsw = (unsigned)wid * 1024u;
    const int aoff = lds_byte(wr * 64 + fr, fq * 8), boff = lds_byte(wc * 32 + fr, fq * 8);
#define PG8_SA(b, h) (((b) * 2 + (h)) * HTB)
#define PG8_SB(b, h) ((4 + (b) * 2 + (h)) * HTB)
#define PG8_STAGE(bufoff, gbase, voff) do { _Pragma("unroll") for (int _i = 0; _i < 2; ++_i) \
        __builtin_amdgcn_global_load_lds((const unsigned*)((const char*)(gbase) + (voff)[_i]), (PG8_LAS unsigned*)(lds + (bufoff) + ldsw + _i * 8192), 16, 0, 0); } while (0)
#define PG8_LD16(base, off) (*(const PG8_LAS v4i_t*)((base) + (off)))
#define PG8_LDA(dst, b, h) do { if constexpr (DT == 1) { _Pragma("unroll") for (int m = 0; m < 4; ++m) A8[m] = __builtin_shufflevector(PG8_LD16(abase8, ((b) * 2 + (h)) * HTB + m * 2048), PG8_LD16(abase8, ((b) * 2 + (h)) * HTB + m * 2048 + 1024), 0, 1, 2, 3, 4, 5, 6, 7); } \
        else { _Pragma("unroll") for (int m = 0; m < 4; ++m) _Pragma("unroll") for (int k = 0; k < 2; ++k) dst[m][k] = *(const PG8_LAS bf16x8*)(lds + PG8_SA(b, h) + aoff + m * 2048 + k * 1024); } } while (0)
#define PG8_LDB(dst, b, h) do { if constexpr (DT == 1) { _Pragma("unroll") for (int n = 0; n < 2; ++n) dst##8[n] = __builtin_shufflevector(PG8_LD16(bbase8, ((b) * 2 + (h)) * HTB + n * 2048), PG8_LD16(bbase8, ((b) * 2 + (h)) * HTB + n * 2048 + 1024), 0, 1, 2, 3, 4, 5, 6, 7); } \
        else { _Pragma("unroll") for (int n = 0; n < 2; ++n) _Pragma("unroll") for (int k = 0; k < 2; ++k) dst[n][k] = *(const PG8_LAS bf16x8*)(lds + PG8_SB(b, h) + boff + n * 2048 + k * 1024); } } while (0)
#define PG8_MMA(ai, bj, At, Bt, first) do { __builtin_amdgcn_s_setprio(1); \
        if constexpr (DT == 1) { if (first) { _Pragma("unroll") for (int m = 0; m < 4; ++m) _Pragma("unroll") for (int n = 0; n < 2; ++n) \
            asm volatile("v_mfma_f32_16x16x128_f8f6f4 %0, %1, %2, 0" : "=v"(acc[ai][bj][m][n]) : "v"(Bt##8[n]), "v"(A8[m])); } \
          else { _Pragma("unroll") for (int m = 0; m < 4; ++m) _Pragma("unroll") for (int n = 0; n < 2; ++n) \
            asm volatile("v_mfma_f32_16x16x128_f8f6f4 %0, %1, %2, %0" : "+v"(acc[ai][bj][m][n]) : "v"(Bt##8[n]), "v"(A8[m])); } } \
        else if constexpr (DT == 2) {   \
          if (first) { _Pragma("unroll") for (int m = 0; m < 4; ++m) _Pragma("unroll") for (int n = 0; n < 2; ++n) \
            asm volatile("v_mfma_i32_16x16x64_i8 %0, %1, %2, 0" : "=v"(acc[ai][bj][m][n]) : "v"(Bt[n][0]), "v"(At[m][0])); } \
          else { _Pragma("unroll") for (int m = 0; m < 4; ++m) _Pragma("unroll") for (int n = 0; n < 2; ++n) \
            asm volatile("v_mfma_i32_16x16x64_i8 %0, %1, %2, %0" : "+v"(acc[ai][bj][m][n]) : "v"(Bt[n][0]), "v"(At[m][0])); } \
          _Pragma("unroll") for (int m = 0; m < 4; ++m) _Pragma("unroll") for (int n = 0; n < 2; ++n) \
            asm volatile("v_mfma_i32_16x16x64_i8 %0, %1, %2, %0" : "+v"(acc[ai][bj][m][n]) : "v"(Bt[n][1]), "v"(At[m][1])); } \
        else { _Pragma("unroll") for (int m = 0; m < 4; ++m) _Pragma("unroll") for (int n = 0; n < 2; ++n) _Pragma("unroll") for (int k = 0; k < 2; ++k) \
            acc[ai][bj][m][n] = __builtin_amdgcn_mfma_f32_16x16x32_bf16(Bt[n][k], At[m][k], acc[ai][bj][m][n], 0, 0, 0); } \
        __builtin_amdgcn_s_setprio(0); } while (0)
#define PG8_WAIT_V(n) asm volatile("s_waitcnt vmcnt(" #n ")" ::: "memory")
#define PG8_WAIT_L(n) asm volatile("s_waitcnt lgkmcnt(" #n ")" ::: "memory")
#define PG8_BAR __builtin_amdgcn_s_barrier()
#define PG8_SCHED __builtin_amdgcn_sched_barrier(0)
    Unit cur, nxt; int ui = 0;
    if (!S.next(0, cur)) return;
    f32x4 acc[2][2][4][2];
    if constexpr (DT == 0) {
#pragma unroll
        for (int a = 0; a < 2; ++a)
#pragma unroll
            for (int b = 0; b < 2; ++b)
#pragma unroll
                for (int m = 0; m < 4; ++m)
#pragma unroll
                    for (int n = 0; n < 2; ++n) acc[a][b][m][n] = (f32x4){0.f, 0.f, 0.f, 0.f};
    }
    PG8_LAS unsigned char* abase8 = lds + aoff; PG8_LAS unsigned char* bbase8 = lds + 4 * HTB + boff; asm volatile("" : "+v"(abase8), "+v"(bbase8));
    bf16x8 At[4][2], B0[2][2], B1[2][2]; v8i_t A8[4], B08[2], B18[2];
    const char* cA = (const char*)g.A + (size_t)cur.pm * tstepA; const char* cB = (const char*)g.Bt + (size_t)cur.pn * tstepB;
    S.a_ready(cur);
    if constexpr (Epi::PREFETCH) E.prefetch(cur, lds + EPI_SC_OFF, wid, lane);
    if constexpr (SP2) {
        PG8_STAGE(PG8_SB(0, 0), cB, voffB); PG8_STAGE(PG8_SB(0, 1), cB + hstepB, voffB); PG8_STAGE(PG8_SA(0, 0), cA, voffA); PG8_STAGE(PG8_SA(0, 1), cA + hstepA, voffA);
        if (wr == 1) PG8_BAR;
        PG8_WAIT_V(2); PG8_BAR;
        PG8_STAGE(PG8_SB(1, 0), cB + kstep, voffB); PG8_STAGE(PG8_SA(1, 0), cA + kstep, voffA); PG8_STAGE(PG8_SB(1, 1), cB + hstepB + kstep, voffB);
        PG8_WAIT_V(6); PG8_BAR;
    } else {
        PG8_STAGE(PG8_SB(0, 0), cB, voffB); PG8_STAGE(PG8_SA(0, 0), cA, voffA); PG8_STAGE(PG8_SB(0, 1), cB + hstepB, voffB); PG8_STAGE(PG8_SA(0, 1), cA + hstepA, voffA);
        if (wr == 1) PG8_BAR;
        PG8_WAIT_V(4); PG8_BAR;
        PG8_STAGE(PG8_SB(1, 0), cB + kstep, voffB); PG8_STAGE(PG8_SA(1, 0), cA + kstep, voffA); PG8_STAGE(PG8_SB(1, 1), cB + hstepB + kstep, voffB);
        PG8_WAIT_V(6); PG8_BAR;
    }
    for (;;) {
        const bool has_next = S.next(ui + 1, nxt);
        const char* nA = has_next ? (const char*)g.A + (size_t)nxt.pm * tstepA : cA; const char* nB = has_next ? (const char*)g.Bt + (size_t)nxt.pn * tstepB : cB;
#define PG8_ITER(FIRST) \
            const bool last = (t == nt - 2); \
            const char* a1 = cA + (size_t)(t + 1) * kstep; \
            const char* a2 = last ? nA : cA + (size_t)(t + 2) * kstep; const char* b2 = last ? nB : cB + (size_t)(t + 2) * kstep; \
            const char* a3 = a2 + kstep; const char* b3 = b2 + kstep; \
            if (last && has_next) S.a_ready(nxt); \
            if constexpr (SP2) { \
            PG8_LDB(B0, 0, 0); PG8_LDB(B1, 0, 1); PG8_SCHED; PG8_LDA(At, 0, 0); PG8_STAGE(PG8_SA(1, 1), a1 + hstepA, voffA); \
            PG8_WAIT_V(8); PG8_WAIT_L(0); PG8_BAR; PG8_MMA(0, 0, At, B0, FIRST); PG8_MMA(0, 1, At, B1, FIRST); PG8_BAR; PG8_SCHED; \
            PG8_LDA(At, 0, 1); PG8_STAGE(PG8_SB(0, 0), b2, voffB); PG8_STAGE(PG8_SB(0, 1), b2 + hstepB, voffB); PG8_STAGE(PG8_SA(0, 0), a2, voffA); \
            PG8_WAIT_V(8); PG8_WAIT_L(0); PG8_BAR; PG8_MMA(1, 0, At, B0, FIRST); PG8_MMA(1, 1, At, B1, FIRST); PG8_BAR; PG8_SCHED; \
            PG8_LDB(B0, 1, 0); PG8_LDB(B1, 1, 1); PG8_SCHED; PG8_LDA(At, 1, 0); PG8_STAGE(PG8_SA(0, 1), a2 + hstepA, voffA); \
            PG8_WAIT_V(8); PG8_WAIT_L(0); PG8_BAR; PG8_MMA(0, 0, At, B0, false); PG8_MMA(0, 1, At, B1, false); PG8_BAR; PG8_SCHED; \
            PG8_LDA(At, 1, 1); PG8_STAGE(PG8_SB(1, 0), b3, voffB); PG8_STAGE(PG8_SB(1, 1), b3 + hstepB, voffB); PG8_STAGE(PG8_SA(1, 0), a3, voffA); \
            PG8_WAIT_V(8); PG8_WAIT_L(0); PG8_BAR; PG8_MMA(1, 0, At, B0, false); PG8_MMA(1, 1, At, B1, false); PG8_BAR; PG8_SCHED; \
            } else { \
            PG8_LDB(B0, 0, 0); PG8_SCHED; PG8_LDA(At, 0, 0); PG8_STAGE(PG8_SA(1, 1), a1 + hstepA, voffA); \
            PG8_WAIT_L(8); PG8_BAR; PG8_WAIT_L(0); PG8_MMA(0, 0, At, B0, FIRST); PG8_BAR; PG8_SCHED; \
            PG8_LDB(B1, 0, 1); PG8_STAGE(PG8_SB(0, 0), b2, voffB); \
            PG8_BAR; PG8_WAIT_L(0); PG8_MMA(0, 1, At, B1, FIRST); PG8_BAR; \
            PG8_LDA(At, 0, 1); PG8_STAGE(PG8_SA(0, 0), a2, voffA); \
            PG8_BAR; PG8_WAIT_L(0); PG8_MMA(1, 0, At, B0, FIRST); PG8_BAR; PG8_SCHED; \
            PG8_STAGE(PG8_SB(0, 1), b2 + hstepB, voffB); \
            PG8_WAIT_V(6); PG8_BAR; PG8_MMA(1, 1, At, B1, FIRST); PG8_BAR; \
            PG8_LDB(B0, 1, 0); PG8_SCHED; PG8_LDA(At, 1, 0); PG8_STAGE(PG8_SA(0, 1), a2 + hstepA, voffA); \
            PG8_WAIT_L(8); PG8_BAR; PG8_WAIT_L(0); PG8_MMA(0, 0, At, B0, false); PG8_BAR; PG8_SCHED; \
            PG8_LDB(B1, 1, 1); PG8_STAGE(PG8_SB(1, 0), b3, voffB); \
            PG8_BAR; PG8_WAIT_L(0); PG8_MMA(0, 1, At, B1, false); PG8_BAR; \
            PG8_LDA(At, 1, 1); PG8_STAGE(PG8_SA(1, 0), a3, voffA); \
            PG8_BAR; PG8_WAIT_L(0); PG8_MMA(1, 0, At, B0, false); PG8_BAR; PG8_SCHED; \
            PG8_STAGE(PG8_SB(1, 1), b3 + hstepB, voffB); \
            PG8_WAIT_V(6); PG8_BAR; PG8_MMA(1, 1, At, B1, false); PG8_BAR; \
            }
        int t = 0;
        if constexpr (DT != 0) { PG8_ITER(true) t = 2; }
#pragma clang loop unroll(disable)
        for (; t < nt; t += 2) {
            PG8_ITER(false)
        }
#undef PG8_ITER
        if constexpr (DT != 0) asm volatile("s_nop 15\n\ts_nop 15" ::: "memory");
        if constexpr (ALIGN_EPI) { if (wr == 0) PG8_BAR; }
        if constexpr (Epi::PREFETCH) { E.run(acc, cur, wr, wc, fr, fq, (const PG8_LAS float*)(lds + EPI_SC_OFF + (ui & 1) * 2048)); S.done(cur);
            if (has_next) E.prefetch(nxt, lds + EPI_SC_OFF + ((ui + 1) & 1) * 2048, wid, lane); }
        else if constexpr (!Epi::AFTER_DRAIN) { E(acc, cur, wr, wc, fr, fq); S.done(cur); }
        if (!has_next) break;
        if constexpr (DT == 0) {
#pragma unroll
        for (int a = 0; a < 2; ++a)
#pragma unroll
            for (int b = 0; b < 2; ++b)
#pragma unroll
                for (int m = 0; m < 4; ++m)
#pragma unroll
                    for (int n = 0; n < 2; ++n) acc[a][b][m][n] = (f32x4){0.f, 0.f, 0.f, 0.f};
        }
        cur = nxt; cA = nA; cB = nB; ++ui;
        if constexpr (ALIGN_EPI) { if (wr == 1) PG8_BAR; }
    }
    PG8_WAIT_V(0);
    if constexpr (!ALIGN_EPI) { if (wr == 0) PG8_BAR; }
    PG8_BAR;
    if constexpr (Epi::AFTER_DRAIN) { E.fused(acc, cur, wr, wc, fr, fq, lds, wid, lane); S.done(cur); }
#undef PG8_SA
#undef PG8_SB
#undef PG8_STAGE
#undef PG8_LD16
#undef PG8_LDA
#undef PG8_LDB
#undef PG8_MMA
#undef PG8_WAIT_V
#undef PG8_WAIT_L
#undef PG8_BAR
#undef PG8_SCHED
}
}
constexpr int NWAVES = 8;
constexpr int NB = 32, SEQ = 2048, DM = 1024, NTOK = NB * SEQ;
constexpr int IN_E = 1952, IN_E_PAD = 2048, DFF = 2816, DFFX = 3584, NEXP = 8;
constexpr int MOE_CHUNK = 15360, N_CHUNK = (NTOK + MOE_CHUNK - 1) / MOE_CHUNK, CHUNK_SLOTS = 2 * MOE_CHUNK + NEXP * 256;
constexpr float NORM_EPS = 1e-6f, LOG2E = 1.4426950408889634f;

constexpr size_t MiB = 1u << 20;
constexpr size_t WS_CTL = 0, CTL_ZERO_BYTES = 1 * MiB;
constexpr size_t WS_ROPE = 1 * MiB;
constexpr size_t WS_ROUTE_I = 2 * MiB;
constexpr size_t WS_ROUTE_W = 3 * MiB;
constexpr size_t WS_WEV = 4 * MiB, EV_STRIDE = 24 * MiB;
constexpr size_t EV_WIN = 0, EV_WUQ = 4 * MiB, EV_WUKV = 4 * MiB + 512 * 1024, EV_WOUT = 5 * MiB, EV_WGU = 7 * MiB, EV_WD = 18 * MiB;
constexpr size_t WS_WOD = 52 * MiB, OD_STRIDE = 8 * MiB;
constexpr size_t OD_WQKV = 0, OD_WO = 6 * MiB;
constexpr size_t WS_MWGU = 68 * MiB;
constexpr size_t WS_MWD = 180 * MiB;
constexpr size_t WS_H = 236 * MiB;
constexpr size_t WS_BIG = 364 * MiB;
constexpr size_t WS_PROJ = WS_BIG, WS_QM = WS_BIG + 256 * MiB, WS_KVM = WS_BIG + 352 * MiB, WS_KPE = WS_BIG + 480 * MiB;
constexpr size_t WS_ACT = WS_BIG;
constexpr size_t WS_QKV = WS_BIG;
constexpr size_t WS_YALL = WS_BIG, WS_HG8 = WS_BIG + 32 * MiB, WS_MACT = WS_BIG + 320 * MiB;
constexpr size_t WS_DP1 = 848 * MiB, WS_DP2 = 912 * MiB, WS_DL1 = 976 * MiB, WS_DL2 = 978 * MiB;
constexpr size_t WS_SA = 980 * MiB;
constexpr size_t WS_SB = 981 * MiB;
constexpr size_t WS_END = 982 * MiB;
static_assert(WS_MACT + 2 * (size_t)CHUNK_SLOTS * DFFX <= WS_DP1 + 132 * MiB && WS_KPE + (size_t)NTOK * 64 <= WS_DP1 && WS_YALL + (size_t)N_CHUNK * CHUNK_SLOTS * DM * 2 <= WS_MACT && (size_t)CHUNK_SLOTS * DM == 32 * MiB, "ws map");
constexpr int CW_BAR = 4096;
constexpr int CW_WMAX = 12288;
constexpr int CW_CNT = 16384;

constexpr int RING_BYTES = 131072, LDSCTL_OFF = RING_BYTES, MISC_OFF = LDSCTL_OFF + 320, LDS_BYTES = 163840, RPB_OFF = 132096;

#define GAS __attribute__((address_space(1)))
#define LAS __attribute__((address_space(3)))
typedef unsigned short bf16;
typedef unsigned v4u __attribute__((ext_vector_type(4)));
typedef unsigned v2u __attribute__((ext_vector_type(2)));
typedef int v4i __attribute__((ext_vector_type(4)));
typedef float f32x4 __attribute__((ext_vector_type(4)));
typedef float f32x2 __attribute__((ext_vector_type(2)));
#define LDS_WAIT() asm volatile("s_waitcnt lgkmcnt(0)" ::: "memory")
#define VM_WAIT() asm volatile("s_waitcnt vmcnt(0)" ::: "memory")
__device__ __forceinline__ unsigned f2bf(float f) { unsigned u = __builtin_bit_cast(unsigned, f); return (u + 0x7fffu + ((u >> 16) & 1u)) >> 16; }
#if defined(__HIP_DEVICE_COMPILE__)
#define GLOBAL_AS __attribute__((address_space(1)))
#else
#define GLOBAL_AS
#endif
__device__ __forceinline__ unsigned pk2(float lo, float hi) { return f2bf(lo) | (f2bf(hi) << 16); }
__device__ __forceinline__ float bflo(unsigned w) { return __builtin_bit_cast(float, w << 16); }
__device__ __forceinline__ float bfhi(unsigned w) { return __builtin_bit_cast(float, w & 0xffff0000u); }
template <int CTRL> __device__ __forceinline__ float dppf(float v) { return __builtin_bit_cast(float, __builtin_amdgcn_mov_dpp(__builtin_bit_cast(int, v), CTRL, 0xF, 0xF, true)); }
__device__ __forceinline__ void swap16(unsigned& a, unsigned& b) { asm("s_nop 1\n\tv_permlane16_swap_b32 %0, %1\n\ts_nop 1" : "+v"(a), "+v"(b)); }
__device__ __forceinline__ void swap32(unsigned& a, unsigned& b) { asm("s_nop 1\n\tv_permlane32_swap_b32 %0, %1\n\ts_nop 1" : "+v"(a), "+v"(b)); }
__device__ __forceinline__ float wsum_all(float v) {
    v += dppf<0xB1>(v); v += dppf<0x4E>(v); v += dppf<0x141>(v); v += dppf<0x140>(v);
    unsigned a = __builtin_bit_cast(unsigned, v), b = a; swap16(a, b); v = __builtin_bit_cast(float, a) + __builtin_bit_cast(float, b);
    a = __builtin_bit_cast(unsigned, v); b = a; swap32(a, b); return __builtin_bit_cast(float, a) + __builtin_bit_cast(float, b);
}
__device__ __forceinline__ float wmax_all(float v) {
    v = fmaxf(v, dppf<0xB1>(v)); v = fmaxf(v, dppf<0x4E>(v)); v = fmaxf(v, dppf<0x141>(v)); v = fmaxf(v, dppf<0x140>(v));
    unsigned a = __builtin_bit_cast(unsigned, v), b = a; swap16(a, b); v = fmaxf(__builtin_bit_cast(float, a), __builtin_bit_cast(float, b));
    a = __builtin_bit_cast(unsigned, v); b = a; swap32(a, b); return fmaxf(__builtin_bit_cast(float, a), __builtin_bit_cast(float, b));
}
constexpr int LDX = 2048;
__device__ __forceinline__ f32x4 ldx4(const bf16* row, int idx) { const v2u w = ((const GLOBAL_AS v2u*)row)[idx]; return (f32x4){bflo(w.x), bfhi(w.x), bflo(w.y), bfhi(w.y)}; }
__device__ __forceinline__ void stx4(bf16* row, int idx, f32x4 v) { v2u w; w.x = pk2(v.x, v.y); w.y = pk2(v.z, v.w); ((GLOBAL_AS v2u*)row)[idx] = w; }
__device__ __forceinline__ float ex2(float x) { return __builtin_amdgcn_exp2f(x); }

#define XB_TMO      128
#define XB_XCNT(j)  (256  + 64 * (j))
#define XB_XSUB(j)  (1280 + 64 * (j))
#define XB_XGEN(j)  (2304 + 64 * (j))
#define XB_TOP      3328
#define XB_TOPGEN   3392
#define XCD_BAR_WORDS 3456
#define XB_SPIN_CAP (1u << 22)

__device__ __forceinline__ unsigned xb_ld(unsigned* p)              { return __hip_atomic_load(p, __ATOMIC_RELAXED, __HIP_MEMORY_SCOPE_AGENT); }
__device__ __forceinline__ unsigned xb_add(unsigned* p, unsigned v) { return __hip_atomic_fetch_add(p, v, __ATOMIC_RELAXED, __HIP_MEMORY_SCOPE_AGENT); }
__device__ __forceinline__ unsigned xb_xcc_id() { return (unsigned)__builtin_amdgcn_s_getreg((3 << 11) | 20) & 0xFu; }
#define XB_SPIN(cond, bar) do { unsigned _sp = 0; while (cond) { __builtin_amdgcn_s_sleep(1); \
    if ((++_sp & 255u) == 0u) { if (xb_ld(&(bar)[XB_TMO])) break; if (_sp > XB_SPIN_CAP) { atomicAdd(&(bar)[XB_TMO], 1u); break; } } } } while (0)

struct XcdBarrier {
    unsigned* bar; unsigned x;
    volatile LAS unsigned* st;
};

__device__ __forceinline__ XcdBarrier xcd_barrier_post(unsigned* bar, volatile LAS unsigned* st) {
    XcdBarrier b; b.bar = bar; b.x = xb_xcc_id(); b.st = st;
    if (threadIdx.x == 0) (void)xb_add(&bar[XB_XCNT(b.x)], 1u);
    return b;
}
__device__ __forceinline__ void xcd_barrier_complete(unsigned* bar, unsigned x, unsigned& nloc, unsigned& nx) {
    const unsigned G = gridDim.x * gridDim.y * gridDim.z;
    unsigned sum, cnt, mine, sp = 0u;
    for (;;) {
        sum = 0u; cnt = 0u; mine = 0u;
#pragma unroll
        for (unsigned j = 0; j < 16; ++j) { const unsigned c = xb_ld(&bar[XB_XCNT(j)]); sum += c; cnt += (c > 0u) ? 1u : 0u; mine = (j == x) ? c : mine; }
        if (sum == G) break;
        __builtin_amdgcn_s_sleep(1);
        if ((++sp & 255u) == 0u) { if (xb_ld(&bar[XB_TMO])) break; if (sp > XB_SPIN_CAP) { atomicAdd(&bar[XB_TMO], 1u); break; } }
    }
    nloc = mine > 0u ? mine : 1u; nx = cnt > 0u ? cnt : 1u;
}

__device__ __forceinline__ void xcd_barrier(const XcdBarrier& b, int tid) {
    asm volatile("s_waitcnt vmcnt(0)" ::: "memory");
    __syncthreads();
    if (tid == 0) {
        unsigned* bar = b.bar;
        __builtin_amdgcn_s_waitcnt(0);
        unsigned nloc = b.st[0], nx = b.st[1];
        if (nloc == 0u) { xcd_barrier_complete(bar, b.x, nloc, nx); b.st[0] = nloc; b.st[1] = nx; }
        const unsigned old = xb_add(&bar[XB_XSUB(b.x)], 1u);
        const unsigned gen = old / nloc;
        if (old + 1u == (gen + 1u) * nloc) {
            __builtin_amdgcn_fence(__ATOMIC_RELEASE, "agent");
            asm volatile("s_waitcnt vmcnt(0)" ::: "memory");
            const unsigned og = xb_add(&bar[XB_TOP], 1u);
            const unsigned tg = og / nx;
            if (og + 1u == (tg + 1u) * nx) xb_add(&bar[XB_TOPGEN], 1u);
            else XB_SPIN(xb_ld(&bar[XB_TOPGEN]) == tg, bar);
            __builtin_amdgcn_fence(__ATOMIC_ACQUIRE, "agent");
            xb_add(&bar[XB_XGEN(b.x)], 1u);
            asm volatile("s_waitcnt vmcnt(0)" ::: "memory");
        } else {
            XB_SPIN(xb_ld(&bar[XB_XGEN(b.x)]) == gen, bar);
            __builtin_amdgcn_fence(__ATOMIC_ACQUIRE, "agent");
            asm volatile("s_waitcnt vmcnt(0)" ::: "memory");
        }
    }
    __syncthreads();
}
__device__ __forceinline__ float wave_sum(float v, int lane) {
#pragma unroll
    for (int o = 1; o < 64; o <<= 1) v += __builtin_bit_cast(float, __builtin_amdgcn_ds_bpermute((lane ^ o) << 2, __builtin_bit_cast(int, v)));
    return v;
}
__device__ __forceinline__ void cvt_item(const float* W, int N, bf16* WT, int ldo, int dst_row0, int k0, int n0, LAS float* scr, int lane) {
    float wv[32];
#pragma unroll
    for (int i = 0; i < 32; ++i) wv[i] = W[(size_t)(k0 + 2 * i + (lane >> 5)) * N + n0 + (lane & 31)];
#pragma unroll
    for (int i = 0; i < 32; ++i) scr[(2 * i + (lane >> 5)) * 33 + (lane & 31)] = wv[i];
    LDS_WAIT(); asm volatile("" ::: "memory");
    const int c = lane & 7;
#pragma unroll
    for (int j = 0; j < 4; ++j) { const int n = (lane >> 3) + 8 * j; const LAS float* s = scr + (8 * c) * 33 + n;
        v4u o; o.x = pk2(s[0 * 33], s[1 * 33]); o.y = pk2(s[2 * 33], s[3 * 33]); o.z = pk2(s[4 * 33], s[5 * 33]); o.w = pk2(s[6 * 33], s[7 * 33]);
        *(GLOBAL_AS v4u*)(WT + (size_t)(dst_row0 + n) * ldo + k0 + 8 * c) = o; }
    LDS_WAIT(); asm volatile("" ::: "memory");
}
__device__ __forceinline__ void cvt_item8(const float* W, int N, unsigned char* WT, int ldo, int dst_row0, int k0, int n0, LAS float* scr, int lane, float scale) {
    float wv[32];
#pragma unroll
    for (int i = 0; i < 32; ++i) wv[i] = W[(size_t)(k0 + 2 * i + (lane >> 5)) * N + n0 + (lane & 31)];
#pragma unroll
    for (int i = 0; i < 32; ++i) scr[(2 * i + (lane >> 5)) * 33 + (lane & 31)] = wv[i] * scale;
    LDS_WAIT(); asm volatile("" ::: "memory");
    const int c = lane & 3;
#pragma unroll
    for (int j = 0; j < 2; ++j) { const int n = (lane >> 2) + 16 * j; const LAS float* s = scr + (16 * c) * 33 + n;
        v4u o; o.x = pg8::cvt4_fp8(s[0 * 33], s[1 * 33], s[2 * 33], s[3 * 33]); o.y = pg8::cvt4_fp8(s[4 * 33], s[5 * 33], s[6 * 33], s[7 * 33]);
        o.z = pg8::cvt4_fp8(s[8 * 33], s[9 * 33], s[10 * 33], s[11 * 33]); o.w = pg8::cvt4_fp8(s[12 * 33], s[13 * 33], s[14 * 33], s[15 * 33]);
        *(GLOBAL_AS v4u*)(WT + (size_t)(dst_row0 + n) * ldo + k0 + 16 * c) = o; }
    LDS_WAIT(); asm volatile("" ::: "memory");
}
__device__ __forceinline__ void cvt_job8(const float* W, int K, int N, unsigned char* WT, int ldo, int rowmap, int item, LAS float* scr, int lane, float scale) {
    const int nblk = N / 32, kb = item / nblk, nb = item % nblk, n0 = 32 * nb;
    int dr = n0; if (rowmap) dr = (n0 >> 7) * 256 + (n0 & 127) + (rowmap == 2 ? 128 : 0);
    cvt_item8(W, N, WT, ldo, dr, 64 * kb, n0, scr, lane, scale);
}
__device__ __forceinline__ unsigned pack4_i8(float a, float b, float c, float d) {
    const int qa = (int)__builtin_rintf(a), qb = (int)__builtin_rintf(b), qc = (int)__builtin_rintf(c), qd = (int)__builtin_rintf(d);
    return (unsigned)(qa & 255) | ((unsigned)(qb & 255) << 8) | ((unsigned)(qc & 255) << 16) | ((unsigned)(qd & 255) << 24);
}
__device__ __forceinline__ void cvt_item_i8(const float* W, int N, unsigned char* WT, int ldo, int dst_row0, int k0, int n0, LAS float* scr, int lane, float inv) {
    float wv[32];
#pragma unroll
    for (int i = 0; i < 32; ++i) wv[i] = W[(size_t)(k0 + 2 * i + (lane >> 5)) * N + n0 + (lane & 31)];
#pragma unroll
    for (int i = 0; i < 32; ++i) scr[(2 * i + (lane >> 5)) * 33 + (lane & 31)] = __builtin_amdgcn_fmed3f(wv[i] * inv, -127.0f, 127.0f);
    LDS_WAIT(); asm volatile("" ::: "memory");
    const int c = lane & 3;
#pragma unroll
    for (int j = 0; j < 2; ++j) { const int n = (lane >> 2) + 16 * j; const LAS float* s = scr + (16 * c) * 33 + n;
        v4u o; o.x = pack4_i8(s[0 * 33], s[1 * 33], s[2 * 33], s[3 * 33]); o.y = pack4_i8(s[4 * 33], s[5 * 33], s[6 * 33], s[7 * 33]);
        o.z = pack4_i8(s[8 * 33], s[9 * 33], s[10 * 33], s[11 * 33]); o.w = pack4_i8(s[12 * 33], s[13 * 33], s[14 * 33], s[15 * 33]);
        *(GLOBAL_AS v4u*)(WT + (size_t)(dst_row0 + n) * ldo + k0 + 16 * c) = o; }
    LDS_WAIT(); asm volatile("" ::: "memory");
}
__device__ __forceinline__ void cvt_job_i8(const float* W, int K, int N, unsigned char* WT, int ldo, int item, LAS float* scr, int lane, float inv, int rowmap = 0) {
    const int nblk = N / 32, kb = item / nblk, nb = item % nblk, n0 = 32 * nb;
    int dr = n0; if (rowmap) dr = (n0 >> 7) * 256 + (n0 & 127) + (rowmap == 2 ? 128 : 0);
    cvt_item_i8(W, N, WT, ldo, dr, 64 * kb, n0, scr, lane, inv);
}
__device__ __forceinline__ void cvt_job(const float* W, int K, int N, bf16* WT, int ldo, int rowmap, int item, LAS float* scr, int lane) {
    const int nblk = N / 32, kb = item / nblk, nb = item % nblk, n0 = 32 * nb;
    int dr = n0; if (rowmap) dr = (n0 >> 7) * 256 + (n0 & 127) + (rowmap == 2 ? 128 : 0);
    cvt_item(W, N, WT, ldo, dr, 64 * kb, n0, scr, lane);
}
__device__ const double ROPE_F[16] = {0.15915494309189535, 0.08949940160889101, 0.050329212104487035, 0.0283021958306234, 0.015915494309189534, 0.008949940160889102, 0.005032921210448704, 0.00283021958306234,
    0.0015915494309189536, 0.0008949940160889102, 0.0005032921210448703, 0.00028302195830623395, 0.00015915494309189535, 8.949940160889102e-05, 5.0329212104487035e-05, 2.8302195830623396e-05};

struct Ctx {
    float* out; unsigned char* ws; LAS unsigned char* lds; int tid, lane, wave, G, gw, NGW;
};

__device__ __forceinline__ void cvt_strip_i8(const float* W, int K, int N, unsigned char* WT, int ldo, float* sb, int rowmap, int strip, LAS float* scr, int lane) {
    const int n0 = 32 * strip; int dr = n0; if (rowmap) dr = (n0 >> 7) * 256 + (n0 & 127) + (rowmap == 2 ? 128 : 0);
    const float* col = W + n0 + (lane & 31) + (size_t)(lane >> 5) * N;
    float mx = 0.f;
    for (int k0 = 0; k0 < K; k0 += 64) { float wv[32];
#pragma unroll
        for (int i = 0; i < 32; ++i) wv[i] = col[(size_t)(k0 + 2 * i) * N];
#pragma unroll
        for (int i = 0; i < 32; ++i) mx = fmaxf(mx, fabsf(wv[i])); }
    mx = fmaxf(mx, __builtin_bit_cast(float, __builtin_amdgcn_ds_bpermute((lane ^ 32) << 2, __builtin_bit_cast(int, mx))));
    mx = fmaxf(mx, 1e-30f); const float inv = 127.0f / mx;
    if (lane < 32) sb[dr + lane] = mx * (1.0f / 127.0f);
    for (int k0 = 0; k0 < K; k0 += 64) { float wv[32];
#pragma unroll
        for (int i = 0; i < 32; ++i) wv[i] = col[(size_t)(k0 + 2 * i) * N];
#pragma unroll
        for (int i = 0; i < 32; ++i) scr[(2 * i + (lane >> 5)) * 33 + (lane & 31)] = wv[i] * inv;
        LDS_WAIT(); asm volatile("" ::: "memory");
        const int c = lane & 3;
#pragma unroll
        for (int j = 0; j < 2; ++j) { const int n = (lane >> 2) + 16 * j; const LAS float* s = scr + (16 * c) * 33 + n;
            v4u o; o.x = pack4_i8(s[0 * 33], s[1 * 33], s[2 * 33], s[3 * 33]); o.y = pack4_i8(s[4 * 33], s[5 * 33], s[6 * 33], s[7 * 33]);
            o.z = pack4_i8(s[8 * 33], s[9 * 33], s[10 * 33], s[11 * 33]); o.w = pack4_i8(s[12 * 33], s[13 * 33], s[14 * 33], s[15 * 33]);
            *(GLOBAL_AS v4u*)(WT + (size_t)(dr + n) * ldo + k0 + 16 * c) = o; }
        LDS_WAIT(); asm volatile("" ::: "memory"); }
}
__device__ __forceinline__ void cvt_strip_i8_wg(const float* W, int N, unsigned char* WT, int ldo, float* sb, int rowmap, int strip, LAS unsigned char* lds, int wave, int lane) {
    const int n0 = 32 * strip; int dr = n0; if (rowmap) dr = (n0 >> 7) * 256 + (n0 & 127) + (rowmap == 2 ? 128 : 0);
    const float* col = W + n0 + (lane & 31) + (size_t)(lane >> 5) * N;
    LAS float* scr = (LAS float*)(lds + wave * 16384); LAS float* pm = (LAS float*)(lds + 12288);
    float wv[2][32]; float mx = 0.f;
#pragma unroll
    for (int c = 0; c < 2; ++c)
#pragma unroll
        for (int i = 0; i < 32; ++i) wv[c][i] = col[(size_t)(64 * (2 * wave + c) + 2 * i) * N];
#pragma unroll
    for (int c = 0; c < 2; ++c)
#pragma unroll
        for (int i = 0; i < 32; ++i) mx = fmaxf(mx, fabsf(wv[c][i]));
    mx = fmaxf(mx, __builtin_bit_cast(float, __builtin_amdgcn_ds_bpermute((lane ^ 32) << 2, __builtin_bit_cast(int, mx))));
    if (lane < 32) pm[wave * 32 + lane] = mx;
    __syncthreads();
    float g = 0.f;
#pragma unroll
    for (int w = 0; w < 8; ++w) g = fmaxf(g, pm[w * 32 + (lane & 31)]);
    g = fmaxf(g, 1e-30f); const float inv = 127.0f / g;
    if (wave == 0 && lane < 32) sb[dr + lane] = g * (1.0f / 127.0f);
#pragma unroll
    for (int c = 0; c < 2; ++c) { const int k0 = 64 * (2 * wave + c);
#pragma unroll
        for (int i = 0; i < 32; ++i) scr[(2 * i + (lane >> 5)) * 33 + (lane & 31)] = wv[c][i] * inv;
        LDS_WAIT(); asm volatile("" ::: "memory");
        const int cc = lane & 3;
#pragma unroll
        for (int j = 0; j < 2; ++j) { const int n = (lane >> 2) + 16 * j; const LAS float* s = scr + (16 * cc) * 33 + n;
            v4u o; o.x = pack4_i8(s[0 * 33], s[1 * 33], s[2 * 33], s[3 * 33]); o.y = pack4_i8(s[4 * 33], s[5 * 33], s[6 * 33], s[7 * 33]);
            o.z = pack4_i8(s[8 * 33], s[9 * 33], s[10 * 33], s[11 * 33]); o.w = pack4_i8(s[12 * 33], s[13 * 33], s[14 * 33], s[15 * 33]);
            *(GLOBAL_AS v4u*)(WT + (size_t)(dr + n) * ldo + k0 + 16 * cc) = o; }
        LDS_WAIT(); asm volatile("" ::: "memory"); }
    __syncthreads();
}
template <class A> __device__ __forceinline__ void p0_prologue(const Ctx& C, const A& IN) {
    LAS float* scr = (LAS float*)(C.lds + C.wave * 16384);
    GLOBAL_AS float* sball = (GLOBAL_AS float*)(C.ws + WS_SB);
    constexpr int S0 = IN_E / 32, S4 = DFF / 32, S7 = 3072 / 32, NSTRIPS = 2 * (S0 + 2 * S4 + S7);
    constexpr int I1 = 4 * 24, I2 = 2 * 32, I3 = 16 * 32, I6 = 44 * 32, I8 = 16 * 32;
    constexpr int NITEMS = 2 * (I1 + I2 + I3 + I6 + I8);
    for (int st = blockIdx.x; st < NSTRIPS; st += C.G) {
        int r = st;
        if (r < 2 * S0) { const int ly = r / S0, q = r % S0; cvt_strip_i8_wg(IN.in[2] + (size_t)ly * DM * IN_E, IN_E, C.ws + WS_WEV + ly * EV_STRIDE + EV_WIN, DM, sball + ly * 8192, 0, q, C.lds, C.wave, C.lane); continue; } r -= 2 * S0;
        if (r < 2 * S4) { const int ly = r / S4, q = r % S4; cvt_strip_i8_wg(IN.in[9] + (size_t)ly * DM * DFF, DFF, C.ws + WS_WEV + ly * EV_STRIDE + EV_WGU, DM, sball + ly * 8192 + 2048, 1, q, C.lds, C.wave, C.lane); continue; } r -= 2 * S4;
        if (r < 2 * S4) { const int ly = r / S4, q = r % S4; cvt_strip_i8_wg(IN.in[10] + (size_t)ly * DM * DFF, DFF, C.ws + WS_WEV + ly * EV_STRIDE + EV_WGU, DM, sball + ly * 8192 + 2048, 2, q, C.lds, C.wave, C.lane); continue; } r -= 2 * S4;
        { const int ly = r / S7, q = r % S7; cvt_strip_i8_wg(IN.in[13] + (size_t)ly * DM * 3072, 3072, C.ws + WS_WOD + ly * OD_STRIDE + OD_WQKV, DM, sball + 16384 + ly * 4096, 0, q, C.lds, C.wave, C.lane); }
    }
    for (int it = C.gw; it < NITEMS; it += C.NGW) {
        int r = it;
        if (r < 2 * I1) { const int ly = r / I1, q = r % I1; cvt_job(IN.in[4] + (size_t)ly * 256 * 768, 256, 768, (bf16*)(C.ws + WS_WEV + ly * EV_STRIDE + EV_WUQ), 256, 0, q, scr, C.lane); continue; } r -= 2 * I1;
        if (r < 2 * I2) { const int ly = r / I2, q = r % I2; cvt_job(IN.in[6] + (size_t)ly * 128 * 1024, 128, 1024, (bf16*)(C.ws + WS_WEV + ly * EV_STRIDE + EV_WUKV), 256, 0, q, scr, C.lane); continue; } r -= 2 * I2;
        if (r < 2 * I3) { const int ly = r / I3, q = r % I3; cvt_job(IN.in[7] + (size_t)ly * DM * DM, DM, DM, (bf16*)(C.ws + WS_WEV + ly * EV_STRIDE + EV_WOUT), DM, 0, q, scr, C.lane); continue; } r -= 2 * I3;
        if (r < 2 * I6) { const int ly = r / I6, q = r % I6; cvt_job(IN.in[11] + (size_t)ly * DFF * DM, DFF, DM, (bf16*)(C.ws + WS_WEV + ly * EV_STRIDE + EV_WD), DFF, 0, q, scr, C.lane); continue; } r -= 2 * I6;
        { const int ly = r / I8, q = r % I8; cvt_job(IN.in[15] + (size_t)ly * DM * DM, DM, DM, (bf16*)(C.ws + WS_WOD + ly * OD_STRIDE + OD_WO), DM, 0, q, scr, C.lane); }
    }
    const int gt = blockIdx.x * (NWAVES * 64) + C.tid, NGT = C.G * NWAVES * 64;
    for (int i = gt; i < 2 * 6144; i += NGT) { const int ly = i / 6144, q = i % 6144; ((GLOBAL_AS v4u*)(C.ws + WS_WEV + ly * EV_STRIDE + EV_WIN + (size_t)IN_E * DM))[q] = (v4u){0u, 0u, 0u, 0u}; }
    for (int i = gt; i < 2 * 96; i += NGT) ((GLOBAL_AS float*)(C.ws + WS_SB))[(i / 96) * 8192 + IN_E + (i % 96)] = 0.f;
    for (int i = gt; i < 2 * 16384; i += NGT) { const int ly = i / 16384, q = i % 16384, row = q >> 4, cc = q & 15; ((GLOBAL_AS v4u*)(C.ws + WS_WEV + ly * EV_STRIDE + EV_WUKV + (size_t)row * 512 + 256))[cc] = (v4u){0u, 0u, 0u, 0u}; }
    GLOBAL_AS float* rope = (GLOBAL_AS float*)(C.ws + WS_ROPE);
    for (int i = gt; i < SEQ * 16; i += NGT) { const int t = i >> 4, k = i & 15; double fr = (double)t * ROPE_F[k]; fr -= floor(fr); const float f = (float)fr;
        rope[2 * i] = __builtin_amdgcn_cosf(f); rope[2 * i + 1] = __builtin_amdgcn_sinf(f); }
}
template <class A> __device__ __forceinline__ void moe_weights(const Ctx& C, const A& IN, int j) {
    LAS float* scr = (LAS float*)(C.lds + C.wave * 16384);
    constexpr int IG = 16 * 112, ID = 56 * 32;
    constexpr int NITEMS = NEXP * (2 * IG + ID);
    for (int it = C.gw; it < NITEMS; it += C.NGW) {
        const int e = it / (2 * IG + ID); int r = it % (2 * IG + ID);
        const size_t eo = ((size_t)j * NEXP + e) * (size_t)DM * DFFX;
        if (r < IG) { cvt_job8(IN.in[18] + eo, DM, DFFX, C.ws + WS_MWGU + (size_t)e * 7168 * DM, DM, 1, r, scr, C.lane, 32.0f); continue; } r -= IG;
        if (r < IG) { cvt_job8(IN.in[19] + eo, DM, DFFX, C.ws + WS_MWGU + (size_t)e * 7168 * DM, DM, 2, r, scr, C.lane, 32.0f); continue; } r -= IG;
        cvt_job8(IN.in[20] + eo, DFFX, DM, C.ws + WS_MWD + (size_t)e * DM * DFFX, DFFX, 0, r, scr, C.lane, 32.0f);
    }
}
template <int OUT = 0, bool XF32 = false>
__device__ __forceinline__ void norm_phase(const Ctx& C, const void* x, const float* g, bf16* H, bf16* xb = nullptr) {
    constexpr int NR = 4;
    f32x4 gg[4];
#pragma unroll
    for (int j = 0; j < 4; ++j) gg[j] = ((const GLOBAL_AS f32x4*)g)[64 * j + C.lane];
    for (int m0 = C.gw; m0 < NTOK; m0 += NR * C.NGW) {
        f32x4 v[NR][4]; float s[NR];
#pragma unroll
        for (int r = 0; r < NR; ++r) { const int m = min(m0 + r * C.NGW, NTOK - 1);
            if (XF32) { const GLOBAL_AS f32x4* xr = (const GLOBAL_AS f32x4*)((const GLOBAL_AS float*)x + (size_t)m * DM) + C.lane;
#pragma unroll
                for (int j = 0; j < 4; ++j) v[r][j] = xr[64 * j]; }
            else { const bf16* xr = (const bf16*)x + (size_t)m * LDX;
#pragma unroll
                for (int j = 0; j < 4; ++j) v[r][j] = ldx4(xr, 64 * j + C.lane); } }
#pragma unroll
        for (int r = 0; r < NR; ++r) { float a = 0.f;
#pragma unroll
            for (int j = 0; j < 4; ++j) a += (v[r][j].x * v[r][j].x + v[r][j].y * v[r][j].y) + (v[r][j].z * v[r][j].z + v[r][j].w * v[r][j].w);
            s[r] = a; }
#pragma unroll
        for (int r = 0; r < NR; ++r) s[r] = wsum_all(s[r]);
#pragma unroll
        for (int r = 0; r < NR; ++r) { const int m = m0 + r * C.NGW; if (m < NTOK) { const float rstd = 1.0f / sqrtf(s[r] * (1.0f / DM) + NORM_EPS);
            if (XF32) {
#pragma unroll
                for (int j = 0; j < 4; ++j) stx4(xb + (size_t)m * LDX, 64 * j + C.lane, v[r][j]); }
            if (OUT == 2) { f32x4 y[4]; float am = 0.f;
#pragma unroll
                for (int j = 0; j < 4; ++j) { y[j] = v[r][j] * rstd * gg[j]; am = fmaxf(fmaxf(am, fmaxf(fabsf(y[j].x), fabsf(y[j].y))), fmaxf(fabsf(y[j].z), fabsf(y[j].w))); }
                am = fmaxf(wmax_all(am), 1e-20f); const float inv = 127.0f / am; GLOBAL_AS unsigned* o4 = (GLOBAL_AS unsigned*)((unsigned char*)H + (size_t)m * DM) + C.lane;
#pragma unroll
                for (int j = 0; j < 4; ++j) o4[64 * j] = pack4_i8(y[j].x * inv, y[j].y * inv, y[j].z * inv, y[j].w * inv);
                if (C.lane == 0) ((GLOBAL_AS float*)(C.ws + WS_SA))[m] = am * (1.0f / 127.0f); }
            else if (OUT == 1) { GLOBAL_AS unsigned* o4 = (GLOBAL_AS unsigned*)((unsigned char*)H + (size_t)m * DM) + C.lane;
#pragma unroll
                for (int j = 0; j < 4; ++j) { const f32x4 y = v[r][j] * rstd * gg[j]; o4[64 * j] = pg8::cvt4_fp8(y.x, y.y, y.z, y.w); } }
            else { GLOBAL_AS unsigned long long* o8 = (GLOBAL_AS unsigned long long*)(H + (size_t)m * DM) + C.lane;
#pragma unroll
                for (int j = 0; j < 4; ++j) { const f32x4 y = v[r][j] * rstd * gg[j]; o8[64 * j] = (unsigned long long)pk2(y.x, y.y) | ((unsigned long long)pk2(y.z, y.w) << 32); } } } }
    }
}
__device__ __forceinline__ void norm_phase_b(const Ctx& C, const bf16* x, const float* g, bf16* H) {
    f32x4 gg[4];
#pragma unroll
    for (int j = 0; j < 4; ++j) gg[j] = ((const GLOBAL_AS f32x4*)g)[64 * j + C.lane];
    for (int m0 = C.gw; m0 < NTOK; m0 += 8 * C.NGW) {
        v2u w[8][4]; float s[8];
#pragma unroll
        for (int r = 0; r < 8; ++r) { const int m = min(m0 + r * C.NGW, NTOK - 1); const GLOBAL_AS v2u* xr = (const GLOBAL_AS v2u*)(x + (size_t)m * LDX) + C.lane;
#pragma unroll
            for (int j = 0; j < 4; ++j) w[r][j] = xr[64 * j]; }
#pragma unroll
        for (int r = 0; r < 8; ++r) { float a = 0.f;
#pragma unroll
            for (int j = 0; j < 4; ++j) { const float e0 = bflo(w[r][j].x), e1 = bfhi(w[r][j].x), e2 = bflo(w[r][j].y), e3 = bfhi(w[r][j].y); a += (e0 * e0 + e1 * e1) + (e2 * e2 + e3 * e3); }
            s[r] = a; }
#pragma unroll
        for (int r = 0; r < 8; ++r) s[r] = wsum_all(s[r]);
#pragma unroll
        for (int r = 0; r < 8; ++r) { const int m = m0 + r * C.NGW; if (m < NTOK) { const float rstd = 1.0f / sqrtf(s[r] * (1.0f / DM) + NORM_EPS);
            f32x4 y[4]; float am = 0.f;
#pragma unroll
            for (int j = 0; j < 4; ++j) { const f32x4 v = (f32x4){bflo(w[r][j].x), bfhi(w[r][j].x), bflo(w[r][j].y), bfhi(w[r][j].y)}; y[j] = v * rstd * gg[j];
                am = fmaxf(fmaxf(am, fmaxf(fabsf(y[j].x), fabsf(y[j].y))), fmaxf(fabsf(y[j].z), fabsf(y[j].w))); }
            am = fmaxf(wmax_all(am), 1e-20f); const float inv = 127.0f / am; GLOBAL_AS unsigned* o4 = (GLOBAL_AS unsigned*)((unsigned char*)H + (size_t)m * DM) + C.lane;
#pragma unroll
            for (int j = 0; j < 4; ++j) o4[64 * j] = pack4_i8(y[j].x * inv, y[j].y * inv, y[j].z * inv, y[j].w * inv);
            if (C.lane == 0) ((GLOBAL_AS float*)(C.ws + WS_SA))[m] = am * (1.0f / 127.0f); } }
    }
}
__device__ __forceinline__ void final_norm_phase(const Ctx& C, float* x, const float* g) {
    f32x4 gg[4];
#pragma unroll
    for (int j = 0; j < 4; ++j) gg[j] = ((const GLOBAL_AS f32x4*)g)[64 * j + C.lane];
    for (int m = C.gw; m < NTOK; m += C.NGW) {
        GLOBAL_AS f32x4* xr = (GLOBAL_AS f32x4*)(x + (size_t)m * DM) + C.lane; f32x4 v[4]; float s = 0.f;
#pragma unroll
        for (int j = 0; j < 4; ++j) { v[j] = xr[64 * j]; s += (v[j].x * v[j].x + v[j].y * v[j].y) + (v[j].z * v[j].z + v[j].w * v[j].w); }
        const float rstd = 1.0f / sqrtf(wave_sum(s, C.lane) * (1.0f / DM) + NORM_EPS);
#pragma unroll
        for (int j = 0; j < 4; ++j) xr[64 * j] = v[j] * rstd * gg[j];
    }
}
__device__ __forceinline__ void mla_prep_phase(const Ctx& C, bf16* PROJ, const float* qn, const float* kvn, bf16* KPE) {
    const GLOBAL_AS float* rope = (const GLOBAL_AS float*)(C.ws + WS_ROPE);
    const f32x4 gq = ((const GLOBAL_AS f32x4*)qn)[C.lane]; const f32x2 gk = ((const GLOBAL_AS f32x2*)kvn)[C.lane];
    for (int m0 = C.gw; m0 < NTOK; m0 += 8 * C.NGW) {
        v2u w[8]; unsigned w2[8]; unsigned r1[8], r2[8]; float sq[8], sk[8];
#pragma unroll
        for (int r = 0; r < 8; ++r) { const int m = min(m0 + r * C.NGW, NTOK - 1); const bf16* row = PROJ + (size_t)m * IN_E_PAD;
            w[r] = ((const GLOBAL_AS v2u*)(row + 1536))[C.lane]; w2[r] = ((const GLOBAL_AS unsigned*)(row + 1792))[C.lane]; r1[r] = row[1920 + (C.lane & 15)]; r2[r] = row[1936 + (C.lane & 15)]; }
#pragma unroll
        for (int r = 0; r < 8; ++r) { const float a0 = bflo(w[r].x), a1 = bfhi(w[r].x), a2 = bflo(w[r].y), a3 = bfhi(w[r].y), b0 = bflo(w2[r]), b1 = bfhi(w2[r]);
            sq[r] = wsum_all((a0 * a0 + a1 * a1) + (a2 * a2 + a3 * a3)); sk[r] = wsum_all(b0 * b0 + b1 * b1); }
#pragma unroll
        for (int r = 0; r < 8; ++r) { const int m = m0 + r * C.NGW; if (m < NTOK) { bf16* row = PROJ + (size_t)m * IN_E_PAD;
            const float rq = 1.0f / sqrtf(sq[r] * (1.0f / 256) + NORM_EPS), rk = 1.0f / sqrtf(sk[r] * (1.0f / 128) + NORM_EPS);
            v2u o; o.x = pk2(bflo(w[r].x) * rq * gq.x, bfhi(w[r].x) * rq * gq.y); o.y = pk2(bflo(w[r].y) * rq * gq.z, bfhi(w[r].y) * rq * gq.w); ((GLOBAL_AS v2u*)(row + 1536))[C.lane] = o;
            ((GLOBAL_AS unsigned*)(row + 1792))[C.lane] = pk2(bflo(w2[r]) * rk * gk.x, bfhi(w2[r]) * rk * gk.y);
            if (C.lane < 16) { const int t = m & (SEQ - 1); const float x1 = bflo(r1[r]), x2 = bflo(r2[r]);
                const float cs = rope[(t * 16 + C.lane) * 2], sn = rope[(t * 16 + C.lane) * 2 + 1];
                KPE[(size_t)m * 32 + C.lane] = (bf16)f2bf(x1 * cs - x2 * sn); KPE[(size_t)m * 32 + 16 + C.lane] = (bf16)f2bf(x1 * sn + x2 * cs); } } }
    }
}
#define LD8(dst, off, p) do { const v4u w_ = *(const GLOBAL_AS v4u*)(p); dst[(off) + 0] = bflo(w_.x); dst[(off) + 1] = bfhi(w_.x); dst[(off) + 2] = bflo(w_.y); dst[(off) + 3] = bfhi(w_.y); \
    dst[(off) + 4] = bflo(w_.z); dst[(off) + 5] = bfhi(w_.z); dst[(off) + 6] = bflo(w_.w); dst[(off) + 7] = bfhi(w_.w); } while (0)
__device__ __forceinline__ float dot8(const float* q, const v4u w) {
    return ((q[0] * bflo(w.x) + q[1] * bfhi(w.x)) + (q[2] * bflo(w.y) + q[3] * bfhi(w.y))) + ((q[4] * bflo(w.z) + q[5] * bfhi(w.z)) + (q[6] * bflo(w.w) + q[7] * bfhi(w.w)));
}
__device__ __forceinline__ void fma8(float* o, float p, const v4u w) {
    o[0] += p * bflo(w.x); o[1] += p * bfhi(w.x); o[2] += p * bflo(w.y); o[3] += p * bfhi(w.y); o[4] += p * bflo(w.z); o[5] += p * bfhi(w.z); o[6] += p * bflo(w.w); o[7] += p * bfhi(w.w);
}
__device__ __forceinline__ void store_o64(bf16* dst, const float* o, float inv) {
#pragma unroll
    for (int c = 0; c < 8; ++c) { v4u w; w.x = pk2(o[8 * c] * inv, o[8 * c + 1] * inv); w.y = pk2(o[8 * c + 2] * inv, o[8 * c + 3] * inv); w.z = pk2(o[8 * c + 4] * inv, o[8 * c + 5] * inv); w.w = pk2(o[8 * c + 6] * inv, o[8 * c + 7] * inv);
        ((GLOBAL_AS v4u*)dst)[c] = w; }
}
__device__ __forceinline__ void dil_naive_item(const bf16* PROJ, bf16* OC, int item, int tid) {
    const int b = item >> 5, h = (item >> 2) & 7, t = (item & 3) * 512 + tid;
    const bf16* base = PROJ + (size_t)b * SEQ * IN_E_PAD;
    float q[64], o[64];
#pragma unroll
    for (int c = 0; c < 8; ++c) LD8(q, 8 * c, base + (size_t)t * IN_E_PAD + h * 64 + 8 * c);
#pragma unroll
    for (int d = 0; d < 64; ++d) { q[d] *= 0.125f * LOG2E; o[d] = 0.f; }
    const float slope = ex2(-(float)(h + 1)) * LOG2E;
    float m = -INFINITY, l = 0.f;
    for (int g = 0; g < 3; ++g) { const int dl = 1 << (2 * g);
        for (int j = -64; j <= 64; ++j) { const int s = t + j * dl; if (s < 0 || s >= SEQ) continue;
            const bf16* kr = base + (size_t)s * IN_E_PAD + 512 + h * 64;
            float sc = 0.f;
#pragma unroll
            for (int c = 0; c < 8; ++c) sc += dot8(q + 8 * c, ((const GLOBAL_AS v4u*)kr)[c]);
            sc -= slope * (float)((j < 0 ? -j : j) * dl);
            const float mn = fmaxf(m, sc), al = ex2(m - mn), p = ex2(sc - mn); m = mn; l = l * al + p;
#pragma unroll
            for (int d = 0; d < 64; ++d) o[d] *= al;
#pragma unroll
            for (int c = 0; c < 8; ++c) fma8(o + 8 * c, p, ((const GLOBAL_AS v4u*)(kr + 512))[c]);
        } }
    store_o64(OC + ((size_t)b * SEQ + t) * DM + h * 64, o, 1.0f / l);
}
__device__ __forceinline__ void mla_naive_item(const bf16* QM, const bf16* KVM, const bf16* KPE, const float* rope, bf16* OC, int item, int tid) {
    const int b = item >> 6, h = (item >> 3) & 7, vh = (item >> 2) & 1, t = (item & 3) * 512 + tid;
    const size_t row = (size_t)b * SEQ + t;
    float q[96], o[32];
#pragma unroll
    for (int c = 0; c < 12; ++c) LD8(q, 8 * c, QM + row * 768 + h * 96 + 8 * c);
#pragma unroll
    for (int i = 0; i < 16; ++i) { const float cs = rope[(t * 16 + i) * 2], sn = rope[(t * 16 + i) * 2 + 1], x1 = q[64 + i], x2 = q[80 + i]; q[64 + i] = x1 * cs - x2 * sn; q[80 + i] = x1 * sn + x2 * cs; }
    const float scl = 0.10206207261596575f * LOG2E;
#pragma unroll
    for (int d = 0; d < 96; ++d) q[d] *= scl;
#pragma unroll
    for (int d = 0; d < 32; ++d) o[d] = 0.f;
    float m = -INFINITY, l = 0.f;
    const bf16* kvb = KVM + (size_t)b * SEQ * 1024 + h * 128; const bf16* kpb = KPE + (size_t)b * SEQ * 32;
    for (int s = 0; s < SEQ; s += 2) {
        float sc[2];
#pragma unroll
        for (int kk = 0; kk < 2; ++kk) { const GLOBAL_AS v4u* kr = (const GLOBAL_AS v4u*)(kvb + (size_t)(s + kk) * 1024); const GLOBAL_AS v4u* pr = (const GLOBAL_AS v4u*)(kpb + (size_t)(s + kk) * 32); float a = 0.f;
#pragma unroll
            for (int c = 0; c < 8; ++c) a += dot8(q + 8 * c, kr[c]);
#pragma unroll
            for (int c = 0; c < 4; ++c) a += dot8(q + 64 + 8 * c, pr[c]);
            sc[kk] = a; }
        const float mn = fmaxf(m, fmaxf(sc[0], sc[1])), al = ex2(m - mn); m = mn; l *= al;
#pragma unroll
        for (int d = 0; d < 32; ++d) o[d] *= al;
#pragma unroll
        for (int kk = 0; kk < 2; ++kk) { const float p = ex2(sc[kk] - mn); l += p; const GLOBAL_AS v4u* vr = (const GLOBAL_AS v4u*)(kvb + (size_t)(s + kk) * 1024 + 64 + vh * 32);
#pragma unroll
            for (int c = 0; c < 4; ++c) fma8(o + 8 * c, p, vr[c]); }
    }
    const float inv = 1.0f / l; bf16* dst = OC + row * DM + 512 + h * 64 + vh * 32;
#pragma unroll
    for (int c = 0; c < 4; ++c) { v4u w; w.x = pk2(o[8 * c] * inv, o[8 * c + 1] * inv); w.y = pk2(o[8 * c + 2] * inv, o[8 * c + 3] * inv); w.z = pk2(o[8 * c + 4] * inv, o[8 * c + 5] * inv); w.w = pk2(o[8 * c + 6] * inv, o[8 * c + 7] * inv);
        ((GLOBAL_AS v4u*)dst)[c] = w; }
}
__device__ __forceinline__ void na_naive_item(const bf16* QKV, const float* rpb, bf16* O, int item, int tid) {
    const int b = item >> 6, h = (item >> 2) & 15, t = (item & 3) * 512 + tid;
    const int i = t >> 6, c0 = t & 63; const int rs = min(max(i - 4, 0), 24), cs = min(max(c0 - 8, 0), 48);
    const bf16* base = QKV + (size_t)b * SEQ * 3072 + h * 64;
    float q[64], o[64];
#pragma unroll
    for (int c = 0; c < 8; ++c) LD8(q, 8 * c, base + (size_t)t * 3072 + 8 * c);
#pragma unroll
    for (int d = 0; d < 64; ++d) { q[d] *= 0.125f * LOG2E; o[d] = 0.f; }
    float m = -INFINITY, l = 0.f;
    for (int r = 0; r < 8; ++r)
        for (int k = 0; k < 16; ++k) { const int kt = (rs + r) * 64 + cs + k;
            const bf16* kr = base + (size_t)kt * 3072 + 1024;
            float sc = rpb[(h * 15 + (rs + r - i + 7)) * 31 + (cs + k - c0 + 15)] * LOG2E;
#pragma unroll
            for (int c = 0; c < 8; ++c) sc += dot8(q + 8 * c, ((const GLOBAL_AS v4u*)kr)[c]);
            const float mn = fmaxf(m, sc), al = ex2(m - mn), p = ex2(sc - mn); m = mn; l = l * al + p;
#pragma unroll
            for (int d = 0; d < 64; ++d) o[d] *= al;
#pragma unroll
            for (int c = 0; c < 8; ++c) fma8(o + 8 * c, p, ((const GLOBAL_AS v4u*)(kr + 1024))[c]);
        }
    store_o64(O + ((size_t)b * SEQ + t) * DM + h * 64, o, 1.0f / l);
}
__device__ __forceinline__ void route_phase(const Ctx& C, const bf16* x, const float* g, const float* wr, unsigned char* H8, unsigned* cnt  ) {
    LAS float* wl = (LAS float*)C.lds;
    for (int i = C.tid; i < 8192; i += NWAVES * 64) wl[(i & 7) * 1024 + (i >> 3)] = wr[i];
    __syncthreads();
    GLOBAL_AS v4i* route_i = (GLOBAL_AS v4i*)(C.ws + WS_ROUTE_I); GLOBAL_AS f32x2* route_w = (GLOBAL_AS f32x2*)(C.ws + WS_ROUTE_W);
    f32x4 gg[4];
#pragma unroll
    for (int j = 0; j < 4; ++j) gg[j] = ((const GLOBAL_AS f32x4*)g)[64 * j + C.lane];
    for (int base = C.gw * 32; base < NTOK; base += C.NGW * 32) {
        int my_e0 = 0, my_e1 = 0; float my_w0 = 0.f, my_w1 = 0.f;
        for (int i = 0; i < 32; i += 4) {
            v2u xw[4][4]; float s[4]; float lg[4][8]; f32x4 y[4][4];
#pragma unroll
            for (int r = 0; r < 4; ++r) { const GLOBAL_AS v2u* xr = (const GLOBAL_AS v2u*)(x + (size_t)(base + i + r) * LDX) + C.lane;
#pragma unroll
                for (int j = 0; j < 4; ++j) xw[r][j] = xr[64 * j]; }
#pragma unroll
            for (int r = 0; r < 4; ++r) { float a = 0.f;
#pragma unroll
                for (int j = 0; j < 4; ++j) { const v2u c = xw[r][j]; y[r][j] = (f32x4){bflo(c.x), bfhi(c.x), bflo(c.y), bfhi(c.y)}; a += (y[r][j].x * y[r][j].x + y[r][j].y * y[r][j].y) + (y[r][j].z * y[r][j].z + y[r][j].w * y[r][j].w); }
                s[r] = a; }
#pragma unroll
            for (int r = 0; r < 4; ++r) s[r] = wsum_all(s[r]);
#pragma unroll
            for (int r = 0; r < 4; ++r) { const float rstd = 1.0f / sqrtf(s[r] * (1.0f / DM) + NORM_EPS);
                GLOBAL_AS unsigned* o4 = (GLOBAL_AS unsigned*)(H8 + (size_t)(base + i + r) * DM) + C.lane;
#pragma unroll
                for (int e = 0; e < 8; ++e) lg[r][e] = 0.f;
#pragma unroll
                for (int j = 0; j < 4; ++j) { y[r][j] = y[r][j] * rstd * gg[j]; o4[64 * j] = pg8::cvt4_fp8(y[r][j].x, y[r][j].y, y[r][j].z, y[r][j].w); } }
#pragma unroll
            for (int j = 0; j < 4; ++j)
#pragma unroll
                for (int e = 0; e < 8; ++e) { const f32x4 w = *(const LAS f32x4*)(wl + e * 1024 + 4 * (64 * j + C.lane));
#pragma unroll
                    for (int r = 0; r < 4; ++r) lg[r][e] += (y[r][j].x * w.x + y[r][j].y * w.y) + (y[r][j].z * w.z + y[r][j].w * w.w); }
#pragma unroll
            for (int r = 0; r < 4; ++r)
#pragma unroll
                for (int e = 0; e < 8; ++e) lg[r][e] = wsum_all(lg[r][e]);
#pragma unroll
            for (int r = 0; r < 4; ++r) {
                int e0 = 0; float v0 = lg[r][0];
#pragma unroll
                for (int e = 1; e < 8; ++e) if (lg[r][e] > v0) { v0 = lg[r][e]; e0 = e; }
                int e1 = -1; float v1 = -INFINITY;
#pragma unroll
                for (int e = 0; e < 8; ++e) if (e != e0 && (e1 < 0 || lg[r][e] > v1)) { v1 = lg[r][e]; e1 = e; }
                const float ex = __expf(v1 - v0), w0 = 1.0f / (1.0f + ex), w1 = ex * w0;
                if (C.lane == i + r) { my_e0 = e0; my_e1 = e1; my_w0 = w0; my_w1 = w1; } }
        }
        const int chunk = base / MOE_CHUNK; const bool act = C.lane < 32; int pos0 = 0, pos1 = 0;
        const unsigned long long lt = (1ull << C.lane) - 1ull;
#pragma unroll
        for (int e = 0; e < 8; ++e) {
            const unsigned long long m0 = __ballot(act && my_e0 == e), m1 = __ballot(act && my_e1 == e);
            const int n0 = __popcll(m0), n1 = __popcll(m1);
            unsigned bs = 0; if (C.lane == 0 && (n0 + n1) > 0) bs = atomicAdd(cnt + (chunk * 8 + e) * 64, (unsigned)(n0 + n1));
            bs = (unsigned)__builtin_amdgcn_readfirstlane((int)bs);
            if (act && my_e0 == e) pos0 = (int)bs + __popcll(m0 & lt);
            if (act && my_e1 == e) pos1 = (int)bs + n0 + __popcll(m1 & lt);
        }
        if (act) { route_i[base + C.lane] = (v4i){my_e0, my_e1, pos0, pos1}; route_w[base + C.lane] = (f32x2){my_w0, my_w1}; }
    }
}
__device__ __forceinline__ int seg_base(const unsigned* cnt, int chunk, int e) {
    int acc = 0;
#pragma unroll
    for (int k = 0; k < 8; ++k) { const int n = (int)__hip_atomic_load(cnt + (chunk * 8 + k) * 64, __ATOMIC_RELAXED, __HIP_MEMORY_SCOPE_AGENT); if (k < e) acc += (n + 255) >> 8; }
    return acc * 256;
}
__device__ __forceinline__ void gather_all_phase(const Ctx& C, const unsigned char* H8, unsigned char* HG8, const unsigned* cnt) {
    GLOBAL_AS v4i* route_i = (GLOBAL_AS v4i*)(C.ws + WS_ROUTE_I);
    LAS int* segt = (LAS int*)C.lds;
    if (C.tid < N_CHUNK * 8) segt[C.tid] = seg_base(cnt, C.tid >> 3, C.tid & 7);
    __syncthreads();
    for (int m0 = C.gw; m0 < NTOK; m0 += 8 * C.NGW) {
        v4i ri[8]; v4u a[8];
#pragma unroll
        for (int r = 0; r < 8; ++r) { const int m = min(m0 + r * C.NGW, NTOK - 1); ri[r] = route_i[m]; a[r] = ((const GLOBAL_AS v4u*)(H8 + (size_t)m * DM))[C.lane]; }
#pragma unroll
        for (int r = 0; r < 8; ++r) { const int m = m0 + r * C.NGW; if (m < NTOK) { const int ch = m / MOE_CHUNK;
            const int s0 = segt[ch * 8 + ri[r].x] + ri[r].z, s1 = segt[ch * 8 + ri[r].y] + ri[r].w;
            unsigned char* base = HG8 + (size_t)ch * 2 * CHUNK_SLOTS * DM;
            ((GLOBAL_AS v4u*)(base + (size_t)s0 * DM))[C.lane] = a[r]; ((GLOBAL_AS v4u*)(base + (size_t)s1 * DM))[C.lane] = a[r];
            if (C.lane == 0) { v4i o = ri[r]; o.z = s0; o.w = s1; route_i[m] = o; } } }
    }
}
template <bool LAST>
__device__ __forceinline__ void combine_all_phase(const Ctx& C, bf16* x, float* out, const bf16* Y, const float* g, bf16* Hn) {
    const GLOBAL_AS v4i* route_i = (const GLOBAL_AS v4i*)(C.ws + WS_ROUTE_I); const GLOBAL_AS f32x2* route_w = (const GLOBAL_AS f32x2*)(C.ws + WS_ROUTE_W);
    f32x4 gg[4];
#pragma unroll
    for (int j = 0; j < 4; ++j) gg[j] = ((const GLOBAL_AS f32x4*)g)[64 * j + C.lane];
    for (int m0 = C.gw; m0 < NTOK; m0 += 4 * C.NGW) {
        v4i ri[4]; f32x2 rw[4]; v2u ya[4][4], yb[4][4], xw[4][4]; float s[4];
#pragma unroll
        for (int r = 0; r < 4; ++r) { const int m = min(m0 + r * C.NGW, NTOK - 1); ri[r] = route_i[m]; rw[r] = route_w[m];
            const GLOBAL_AS v2u* xr = (const GLOBAL_AS v2u*)(x + (size_t)m * LDX) + C.lane;
#pragma unroll
            for (int j = 0; j < 4; ++j) xw[r][j] = xr[64 * j]; }
#pragma unroll
        for (int r = 0; r < 4; ++r) { const int m = min(m0 + r * C.NGW, NTOK - 1); const bf16* base = Y + (size_t)(m / MOE_CHUNK) * CHUNK_SLOTS * DM;
            const GLOBAL_AS v2u* y0 = (const GLOBAL_AS v2u*)(base + (size_t)ri[r].z * DM) + C.lane; const GLOBAL_AS v2u* y1 = (const GLOBAL_AS v2u*)(base + (size_t)ri[r].w * DM) + C.lane;
#pragma unroll
            for (int j = 0; j < 4; ++j) { ya[r][j] = y0[64 * j]; yb[r][j] = y1[64 * j]; } }
#pragma unroll
        for (int r = 0; r < 4; ++r) { const int m = m0 + r * C.NGW; f32x4 v[4]; float acc = 0.f;
#pragma unroll
            for (int j = 0; j < 4; ++j) { const v2u a = ya[r][j], b = yb[r][j], c = xw[r][j]; f32x4 t = (f32x4){bflo(c.x), bfhi(c.x), bflo(c.y), bfhi(c.y)};
                t.x += rw[r].x * bflo(a.x) + rw[r].y * bflo(b.x); t.y += rw[r].x * bfhi(a.x) + rw[r].y * bfhi(b.x); t.z += rw[r].x * bflo(a.y) + rw[r].y * bflo(b.y); t.w += rw[r].x * bfhi(a.y) + rw[r].y * bfhi(b.y);
                v[j] = t; acc += (t.x * t.x + t.y * t.y) + (t.z * t.z + t.w * t.w); }
            const float rstd = 1.0f / sqrtf(wsum_all(acc) * (1.0f / DM) + NORM_EPS);
            if (m < NTOK) {
                if (LAST) { GLOBAL_AS f32x4* xr = (GLOBAL_AS f32x4*)(out + (size_t)m * DM) + C.lane;
#pragma unroll
                    for (int j = 0; j < 4; ++j) xr[64 * j] = v[j] * rstd * gg[j];
                } else { f32x4 y[4]; float am = 0.f;
#pragma unroll
                    for (int j = 0; j < 4; ++j) { stx4(x + (size_t)m * LDX, 64 * j + C.lane, v[j]); y[j] = v[j] * rstd * gg[j]; am = fmaxf(fmaxf(am, fmaxf(fabsf(y[j].x), fabsf(y[j].y))), fmaxf(fabsf(y[j].z), fabsf(y[j].w))); }
                    am = fmaxf(wmax_all(am), 1e-20f); const float inv = 127.0f / am; GLOBAL_AS unsigned* o4 = (GLOBAL_AS unsigned*)((unsigned char*)Hn + (size_t)m * DM) + C.lane;
#pragma unroll
                    for (int j = 0; j < 4; ++j) o4[64 * j] = pack4_i8(y[j].x * inv, y[j].y * inv, y[j].z * inv, y[j].w * inv);
                    if (C.lane == 0) ((GLOBAL_AS float*)(C.ws + WS_SA))[m] = am * (1.0f / 127.0f);
                } } }
    }
}
__device__ __forceinline__ void grouped_order(pg8::GroupedOrder& S, const unsigned* cnt, int chunk, int nN, int G, int c) {
    int te[8]; int acc = 0;
#pragma unroll
    for (int k = 0; k < 8; ++k) { const int n = __builtin_amdgcn_readfirstlane((int)__hip_atomic_load(cnt + (chunk * 8 + k) * 64, __ATOMIC_RELAXED, __HIP_MEMORY_SCOPE_AGENT)); acc += (n + 255) >> 8; te[k] = acc; }
    S.t0 = te[0]; S.t1 = te[1]; S.t2 = te[2]; S.t3 = te[3]; S.t4 = te[4]; S.t5 = te[5]; S.t6 = te[6]; S.RT = te[7]; S.nN = nN; S.G = G; S.c = c;
}
namespace att {
typedef short bf16x8 __attribute__((ext_vector_type(8)));
typedef short s16x4 __attribute__((ext_vector_type(4)));
typedef short v4i16_t __attribute__((ext_vector_type(4)));
typedef float f32x16 __attribute__((ext_vector_type(16)));
typedef float f32x2_t __attribute__((ext_vector_type(2)));
typedef __bf16 bf16x2_t __attribute__((ext_vector_type(2)));
typedef unsigned u32x4 __attribute__((ext_vector_type(4)));
__device__ __forceinline__ unsigned cvtpk(float lo, float hi) { f32x2_t v = {lo, hi}; bf16x2_t b = __builtin_convertvector(v, bf16x2_t); return __builtin_bit_cast(unsigned, b); }
__device__ __forceinline__ s16x4 vtr(const LAS unsigned char* p) { return __builtin_bit_cast(s16x4, __builtin_amdgcn_ds_read_tr16_b64_v4i16((LAS v4i16_t*)p)); }
#define VTR_ISSUE(dst, addr, OFF) asm volatile("ds_read_b64_tr_b16 %0, %1 offset:%2" : "=&v"(dst) : "v"(addr), "i"(OFF))
__device__ __forceinline__ void vtr_wait8(s16x4& a, s16x4& b, s16x4& c, s16x4& d, s16x4& e, s16x4& f, s16x4& g, s16x4& h) {
    asm volatile("s_waitcnt lgkmcnt(0)" : "+v"(a), "+v"(b), "+v"(c), "+v"(d), "+v"(e), "+v"(f), "+v"(g), "+v"(h)); }
#define VTR_PACK(lo, hi) ((bf16x8){lo[0], lo[1], lo[2], lo[3], hi[0], hi[1], hi[2], hi[3]})
__device__ __forceinline__ void xhalf_swap(unsigned& a, unsigned& b) { asm volatile("s_nop 1\n\tv_permlane32_swap_b32 %0, %1\n\ts_nop 1" : "+v"(a), "+v"(b)); }
__device__ __forceinline__ float xhalf_max(float v) { unsigned a = __builtin_bit_cast(unsigned, v), b = a; xhalf_swap(a, b); return fmaxf(__builtin_bit_cast(float, a), __builtin_bit_cast(float, b)); }
__device__ __forceinline__ float xhalf_sum(float v) { unsigned a = __builtin_bit_cast(unsigned, v), b = a; xhalf_swap(a, b); return __builtin_bit_cast(float, a) + __builtin_bit_cast(float, b); }
#define ATT_MFMA(a, b, c) __builtin_amdgcn_mfma_f32_32x32x16_bf16((a), (b), (c), 0, 0, 0)
__device__ __forceinline__ void sm_step(const f32x16& s, float c, float& m, float& l, f32x16& o0, f32x16& o1, bf16x8& p0, bf16x8& p1) {
    float mx = fmaxf(fmaxf(fmaxf(s[0], s[1]), fmaxf(s[2], s[3])), fmaxf(fmaxf(s[4], s[5]), fmaxf(s[6], s[7])));
    mx = fmaxf(mx, fmaxf(fmaxf(fmaxf(s[8], s[9]), fmaxf(s[10], s[11])), fmaxf(fmaxf(s[12], s[13]), fmaxf(s[14], s[15]))));
    mx = xhalf_max(mx);
    const float mn = fmaxf(m, mx * c), al = ex2(m - mn); m = mn;
    float pe[16]; float ls = 0.f;
#pragma unroll
    for (int i = 0; i < 16; ++i) { pe[i] = ex2(__builtin_fmaf(s[i], c, -mn)); ls += pe[i]; }
    l = l * al + ls;
#pragma unroll
    for (int i = 0; i < 16; ++i) { o0[i] *= al; o1[i] *= al; }
    u32x4 a, b; a.x = cvtpk(pe[0], pe[1]); a.y = cvtpk(pe[2], pe[3]); a.z = cvtpk(pe[4], pe[5]); a.w = cvtpk(pe[6], pe[7]);
    b.x = cvtpk(pe[8], pe[9]); b.y = cvtpk(pe[10], pe[11]); b.z = cvtpk(pe[12], pe[13]); b.w = cvtpk(pe[14], pe[15]);
    p0 = __builtin_bit_cast(bf16x8, a); p1 = __builtin_bit_cast(bf16x8, b);
}
constexpr int MLA_KB = 12 * 64 * 16, MLA_BUF = MLA_KB + 64 * 128;
__device__ __forceinline__ void mla_unit(const bf16* QM, const bf16* KVM, const bf16* KPE, const float* rope, bf16* OC, int unit, LAS unsigned char* lds, int tid) {
    const int lane = tid & 63, wave = __builtin_amdgcn_readfirstlane(tid >> 6), r32 = lane & 31, hh = lane >> 5;
    const int b = unit >> 5, h = (unit >> 2) & 7, qt = unit & 3, q0 = qt * 512 + wave * 64;
    const float c = 0.10206207261596575f * LOG2E;
    bf16x8 qf[2][6];
#pragma unroll
    for (int qb = 0; qb < 2; ++qb) { const int t = q0 + qb * 32 + r32; const bf16* src = QM + ((size_t)b * SEQ + t) * 768 + h * 96 + hh * 8;
#pragma unroll
        for (int ks = 0; ks < 6; ++ks) qf[qb][ks] = *(const bf16x8*)(src + 16 * ks);
        const f32x4* rp = (const f32x4*)(rope + (t * 16 + 8 * hh) * 2);
        bf16x8 a4 = qf[qb][4], a5 = qf[qb][5];
#pragma unroll
        for (int jj = 0; jj < 4; ++jj) { const f32x4 cs = rp[jj];
            const float x1a = bflo((unsigned)(unsigned short)a4[2 * jj]), x2a = bflo((unsigned)(unsigned short)a5[2 * jj]), x1b = bflo((unsigned)(unsigned short)a4[2 * jj + 1]), x2b = bflo((unsigned)(unsigned short)a5[2 * jj + 1]);
            a4[2 * jj] = (short)f2bf(x1a * cs.x - x2a * cs.y); a5[2 * jj] = (short)f2bf(x1a * cs.y + x2a * cs.x);
            a4[2 * jj + 1] = (short)f2bf(x1b * cs.z - x2b * cs.w); a5[2 * jj + 1] = (short)f2bf(x1b * cs.w + x2b * cs.z); }
        qf[qb][4] = a4; qf[qb][5] = a5; }
    f32x16 o[2][2];
#pragma unroll
    for (int i = 0; i < 16; ++i) { o[0][0][i] = 0.f; o[0][1][i] = 0.f; o[1][0][i] = 0.f; o[1][1][i] = 0.f; }
    float m0 = -INFINITY, m1 = -INFINITY, l0 = 0.f, l1 = 0.f;
    const bf16* kvb = KVM + (size_t)b * SEQ * 1024 + h * 128;
    const bf16* gk0 = kvb + (size_t)lane * 1024 + wave * 8;
    const bf16* gk1 = KPE + ((size_t)b * SEQ + lane) * 32 + (wave & 3) * 8;
    const int vkey = wave * 8 + (lane >> 3), vcc = (lane & 7) ^ (((vkey >> 1) & 1) << 2);
    const bf16* gv = kvb + (size_t)vkey * 1024 + 64 + vcc * 8;
    const bool two = wave < 4;
    const int lk0 = wave * 1024, lk1 = (8 + wave) * 1024, lv = MLA_KB + wave * 1024;
#define MLA_STAGE(bufp, jt) do { const size_t go_ = (size_t)(jt) * 64; \
        __builtin_amdgcn_global_load_lds((const unsigned*)(gk0 + go_ * 1024), (LAS unsigned*)((bufp) + lk0), 16, 0, 0); \
        if (two) __builtin_amdgcn_global_load_lds((const unsigned*)(gk1 + go_ * 32), (LAS unsigned*)((bufp) + lk1), 16, 0, 0); \
        __builtin_amdgcn_global_load_lds((const unsigned*)(gv + go_ * 1024), (LAS unsigned*)((bufp) + lv), 16, 0, 0); } while (0)
    const int ka = (hh * 64 + r32) * 16;
    const int i16 = lane & 15, q4 = i16 >> 2, p4 = i16 & 3, cb = (lane >> 4) & 1;
    const int vrow = (4 * hh + q4) * 128 + (p4 & 1) * 8;
    const int va0 = MLA_KB + vrow + (((0 ^ (q4 >> 1)) * 4 + cb * 2 + (p4 >> 1)) * 16), va1 = MLA_KB + vrow + (((1 ^ (q4 >> 1)) * 4 + cb * 2 + (p4 >> 1)) * 16);
    MLA_STAGE(lds, 0);
    asm volatile("s_waitcnt vmcnt(0)" ::: "memory");
    __syncthreads();
    for (int j = 0; j < SEQ / 64; ++j) {
        const LAS unsigned char* buf = lds + (j & 1) * MLA_BUF; LAS unsigned char* nbuf = lds + ((j + 1) & 1) * MLA_BUF;
        if ((j + 1) < SEQ / 64) MLA_STAGE(nbuf, j + 1);
#pragma unroll
        for (int kb = 0; kb < 2; ++kb) {
            bf16x8 p00, p01, p10, p11;
            { f32x16 s0, s1; bf16x8 kf[6];
#pragma unroll
              for (int ks = 0; ks < 6; ++ks) kf[ks] = *(const LAS bf16x8*)(buf + ka + ks * 2048 + kb * 512);
#pragma unroll
              for (int i = 0; i < 16; ++i) { s0[i] = 0.f; s1[i] = 0.f; }
#pragma unroll
              for (int ks = 0; ks < 6; ++ks) { s0 = ATT_MFMA(kf[ks], qf[0][ks], s0); s1 = ATT_MFMA(kf[ks], qf[1][ks], s1); }
              sm_step(s0, c, m0, l0, o[0][0], o[0][1], p00, p01);
              sm_step(s1, c, m1, l1, o[1][0], o[1][1], p10, p11); }
            { const unsigned a0 = (unsigned)(size_t)(buf + va0), a1 = (unsigned)(size_t)(buf + va1);
              s16x4 l00, h00, l01, h01, l10, h10, l11, h11;
              if (kb == 0) { VTR_ISSUE(l00, a0, 0); VTR_ISSUE(h00, a0, 1024); VTR_ISSUE(l01, a0, 2048); VTR_ISSUE(h01, a0, 3072); VTR_ISSUE(l10, a1, 0); VTR_ISSUE(h10, a1, 1024); VTR_ISSUE(l11, a1, 2048); VTR_ISSUE(h11, a1, 3072); }
              else         { VTR_ISSUE(l00, a0, 4096); VTR_ISSUE(h00, a0, 5120); VTR_ISSUE(l01, a0, 6144); VTR_ISSUE(h01, a0, 7168); VTR_ISSUE(l10, a1, 4096); VTR_ISSUE(h10, a1, 5120); VTR_ISSUE(l11, a1, 6144); VTR_ISSUE(h11, a1, 7168); }
              vtr_wait8(l00, h00, l01, h01, l10, h10, l11, h11);
              const bf16x8 v00 = VTR_PACK(l00, h00), v01 = VTR_PACK(l01, h01), v10 = VTR_PACK(l10, h10), v11 = VTR_PACK(l11, h11);
              o[0][0] = ATT_MFMA(v00, p00, o[0][0]); o[1][0] = ATT_MFMA(v00, p10, o[1][0]); o[0][1] = ATT_MFMA(v10, p00, o[0][1]); o[1][1] = ATT_MFMA(v10, p10, o[1][1]);
              o[0][0] = ATT_MFMA(v01, p01, o[0][0]); o[1][0] = ATT_MFMA(v01, p11, o[1][0]); o[0][1] = ATT_MFMA(v11, p01, o[0][1]); o[1][1] = ATT_MFMA(v11, p11, o[1][1]); }
        }
        asm volatile("s_waitcnt vmcnt(0)" ::: "memory");
        __syncthreads();
    }
#undef MLA_STAGE
    const float i0 = 1.0f / xhalf_sum(l0), i1 = 1.0f / xhalf_sum(l1);
#pragma unroll
    for (int qb = 0; qb < 2; ++qb) { const float inv = qb == 0 ? i0 : i1; bf16* dst = OC + ((size_t)b * SEQ + q0 + qb * 32 + r32) * DM + 512 + h * 64 + 4 * hh;
#pragma unroll
        for (int db = 0; db < 2; ++db)
#pragma unroll
            for (int g = 0; g < 4; ++g) { v2u w; w.x = cvtpk(o[qb][db][4 * g] * inv, o[qb][db][4 * g + 1] * inv); w.y = cvtpk(o[qb][db][4 * g + 2] * inv, o[qb][db][4 * g + 3] * inv);
                *(v2u*)(dst + db * 32 + 8 * g) = w; } }
}
__device__ __forceinline__ void stage32(LAS unsigned char* buf, const bf16* kp, const bf16* vp, size_t rs, int lane) {
    const bf16* v0 = vp + (size_t)(lane >> 3) * rs + ((lane & 7) ^ (((lane >> 4) & 1) << 2)) * 8;
#pragma unroll
    for (int i = 0; i < 4; ++i) { const int key = 8 * i + (lane >> 3); __builtin_amdgcn_global_load_lds((const unsigned*)(kp + (size_t)key * rs + ((lane & 7) ^ ((key >> 1) & 7)) * 8), (LAS unsigned*)(buf + i * 1024), 16, 0, 0); }
#pragma unroll
    for (int i = 0; i < 4; ++i) __builtin_amdgcn_global_load_lds((const unsigned*)(v0 + (size_t)(8 * i) * rs), (LAS unsigned*)(buf + 4096 + i * 1024), 16, 0, 0);
}
__device__ __forceinline__ void stageK(LAS unsigned char* kb, const bf16* kp, size_t rs, int lane) {
#pragma unroll
    for (int i = 0; i < 4; ++i) { const int key = 8 * i + (lane >> 3); __builtin_amdgcn_global_load_lds((const unsigned*)(kp + (size_t)key * rs + ((lane & 7) ^ ((key >> 1) & 7)) * 8), (LAS unsigned*)(kb + i * 1024), 16, 0, 0); }
}
__device__ __forceinline__ void stageV(LAS unsigned char* vb, const bf16* vp, size_t rs, int lane) {
    const bf16* v0 = vp + (size_t)(lane >> 3) * rs + ((lane & 7) ^ (((lane >> 4) & 1) << 2)) * 8;
#pragma unroll
    for (int i = 0; i < 4; ++i) __builtin_amdgcn_global_load_lds((const unsigned*)(v0 + (size_t)(8 * i) * rs), (LAS unsigned*)(vb + i * 1024), 16, 0, 0);
}
__device__ __forceinline__ f32x16 qk32(const LAS unsigned char* buf, const bf16x8 (&qf)[4], int r32, int hh) {
    f32x16 s; bf16x8 kf[4];
#pragma unroll
    for (int ks = 0; ks < 4; ++ks) kf[ks] = *(const LAS bf16x8*)(buf + r32 * 128 + (((2 * ks + hh) ^ ((r32 >> 1) & 7)) << 4));
#pragma unroll
    for (int i = 0; i < 16; ++i) s[i] = 0.f;
#pragma unroll
    for (int ks = 0; ks < 4; ++ks) s = ATT_MFMA(kf[ks], qf[ks], s);
    return s;
}
__device__ __forceinline__ void qk32x2(const LAS unsigned char* buf, const bf16x8 (&q0)[4], const bf16x8 (&q1)[4], f32x16& s0, f32x16& s1, int r32, int hh) {
    bf16x8 kf[4];
#pragma unroll
    for (int ks = 0; ks < 4; ++ks) kf[ks] = *(const LAS bf16x8*)(buf + r32 * 128 + (((2 * ks + hh) ^ ((r32 >> 1) & 7)) << 4));
#pragma unroll
    for (int i = 0; i < 16; ++i) { s0[i] = 0.f; s1[i] = 0.f; }
#pragma unroll
    for (int ks = 0; ks < 4; ++ks) { s0 = ATT_MFMA(kf[ks], q0[ks], s0); s1 = ATT_MFMA(kf[ks], q1[ks], s1); }
}
__device__ __forceinline__ void sm_step2(const float (&t)[16], float& m, float& l, f32x16& o0, f32x16& o1, bf16x8& p0, bf16x8& p1) {
    float mx = fmaxf(fmaxf(fmaxf(t[0], t[1]), fmaxf(t[2], t[3])), fmaxf(fmaxf(t[4], t[5]), fmaxf(t[6], t[7])));
    mx = fmaxf(mx, fmaxf(fmaxf(fmaxf(t[8], t[9]), fmaxf(t[10], t[11])), fmaxf(fmaxf(t[12], t[13]), fmaxf(t[14], t[15]))));
    mx = xhalf_max(mx);
    const float mn = fmaxf(m, mx), ms = (mn == -INFINITY) ? 0.f : mn, al = ex2(m - ms); m = mn;
    float pe[16]; float ls = 0.f;
#pragma unroll
    for (int i = 0; i < 16; ++i) { pe[i] = ex2(t[i] - ms); ls += pe[i]; }
    l = l * al + ls;
#pragma unroll
    for (int i = 0; i < 16; ++i) { o0[i] *= al; o1[i] *= al; }
    u32x4 a, b; a.x = cvtpk(pe[0], pe[1]); a.y = cvtpk(pe[2], pe[3]); a.z = cvtpk(pe[4], pe[5]); a.w = cvtpk(pe[6], pe[7]);
    b.x = cvtpk(pe[8], pe[9]); b.y = cvtpk(pe[10], pe[11]); b.z = cvtpk(pe[12], pe[13]); b.w = cvtpk(pe[14], pe[15]);
    p0 = __builtin_bit_cast(bf16x8, a); p1 = __builtin_bit_cast(bf16x8, b);
}
__device__ __forceinline__ void vfrag4(const LAS unsigned char* buf, int va0, int va1, bf16x8& v00, bf16x8& v01, bf16x8& v10, bf16x8& v11) {
    const unsigned a0 = (unsigned)(size_t)(buf + va0), a1 = (unsigned)(size_t)(buf + va1);
    s16x4 l00, h00, l01, h01, l10, h10, l11, h11;
    VTR_ISSUE(l00, a0, 0); VTR_ISSUE(h00, a0, 1024); VTR_ISSUE(l01, a0, 2048); VTR_ISSUE(h01, a0, 3072); VTR_ISSUE(l10, a1, 0); VTR_ISSUE(h10, a1, 1024); VTR_ISSUE(l11, a1, 2048); VTR_ISSUE(h11, a1, 3072);
    vtr_wait8(l00, h00, l01, h01, l10, h10, l11, h11);
    v00 = VTR_PACK(l00, h00); v01 = VTR_PACK(l01, h01); v10 = VTR_PACK(l10, h10); v11 = VTR_PACK(l11, h11);
}
#define ATT_VADDR() const int i16 = lane & 15, q4 = i16 >> 2, p4 = i16 & 3, cb = (lane >> 4) & 1; const int vrow = 4096 + (4 * hh + q4) * 128 + (p4 & 1) * 8; \
    const int va0 = vrow + (((0 ^ (q4 >> 1)) * 4 + cb * 2 + (p4 >> 1)) * 16), va1 = vrow + (((1 ^ (q4 >> 1)) * 4 + cb * 2 + (p4 >> 1)) * 16)
#define ATT_WAIT_V(n) asm volatile("s_waitcnt vmcnt(" #n ")" ::: "memory")

__device__ __forceinline__ void qrow_put(LAS unsigned char* tb, const v4u (&q)[4], int lane) {
#pragma unroll
    for (int i = 0; i < 4; ++i) { const int row = 8 * i + (lane >> 3); *(LAS v4u*)(tb + row * 128 + (((lane & 7) ^ ((row >> 1) & 7)) << 4)) = q[i]; }
}
__device__ __forceinline__ void qfrag_get(const LAS unsigned char* tb, bf16x8 (&qf)[4], int r32, int hh) {
#pragma unroll
    for (int ks = 0; ks < 4; ++ks) qf[ks] = *(const LAS bf16x8*)(tb + r32 * 128 + (((2 * ks + hh) ^ ((r32 >> 1) & 7)) << 4));
    asm volatile("s_waitcnt lgkmcnt(0)" : "+v"(qf[0]), "+v"(qf[1]), "+v"(qf[2]), "+v"(qf[3]) :: "memory");
}
__device__ __forceinline__ void ostage(LAS unsigned char* tb, const f32x16& o0, const f32x16& o1, float inv, int r32, int hh) {
#pragma unroll
    for (int db = 0; db < 2; ++db)
#pragma unroll
        for (int g = 0; g < 4; ++g) { const f32x16& o = db == 0 ? o0 : o1; v2u w; w.x = cvtpk(o[4 * g] * inv, o[4 * g + 1] * inv); w.y = cvtpk(o[4 * g + 2] * inv, o[4 * g + 3] * inv);
            *(LAS v2u*)(tb + r32 * 128 + (((db * 4 + g) ^ (r32 & 7)) << 4) + hh * 8) = w; }
}
__device__ __forceinline__ v4u orow(const LAS unsigned char* tb, int lane, int i) { return *(const LAS v4u*)(tb + i * 1024 + lane * 16); }
__device__ __forceinline__ int orow_chunk(int lane, int i) { return (lane & 7) ^ ((8 * i + (lane >> 3)) & 7); }
template <bool FINAL>
__device__ __forceinline__ void dil_tile(const bf16* PROJ, int dl, int idx, bf16* DPo, float* DLo, const bf16* DP1, const float* DL1, const bf16* DP2, const float* DL2, bf16* OC, LAS unsigned char* wl, int lane) {
    const int r32 = lane & 31, hh = lane >> 5;
    const int L = SEQ / dl, nch = L >> 6, ich = idx % nch, rho = (idx / nch) % dl, bh = idx >> 5, h = bh & 7, b = bh >> 3, i0 = ich << 6;
    const bf16* base = PROJ + ((size_t)b * SEQ + rho) * IN_E_PAD + h * 64;
    const size_t rs = (size_t)dl * IN_E_PAD;
    bf16x8 qf[2][4]; v4u qraw[2][4];
#pragma unroll
    for (int qb = 0; qb < 2; ++qb)
#pragma unroll
        for (int i = 0; i < 4; ++i) qraw[qb][i] = *(const v4u*)(base + (size_t)(i0 + qb * 32 + 8 * i + (lane >> 3)) * rs + (lane & 7) * 8);
    ATT_VADDR();
    const float c = 0.125f * LOG2E, sl = ex2(-(float)(h + 1)) * LOG2E * (float)dl;
    f32x16 o[2][2];
#pragma unroll
    for (int i = 0; i < 16; ++i) { o[0][0][i] = 0.f; o[0][1][i] = 0.f; o[1][0][i] = 0.f; o[1][1][i] = 0.f; }
    float m0 = -INFINITY, m1 = -INFINITY, l0 = 0.f, l1 = 0.f;
    const int klo = (i0 >= 64) ? 0 : 2, khi = (i0 + 128 <= L) ? 6 : 4;
    { const int ik0 = i0 - 64 + 32 * klo; stage32(wl, base + 512 + (size_t)ik0 * rs, base + 1024 + (size_t)ik0 * rs, rs, lane); }
    qrow_put(wl + 8192, qraw[0], lane); qrow_put(wl + 12288, qraw[1], lane); qfrag_get(wl + 8192, qf[0], r32, hh); qfrag_get(wl + 12288, qf[1], r32, hh);
    for (int kbi = klo; kbi < khi; ++kbi) {
        const LAS unsigned char* buf = wl + ((kbi - klo) & 1) * 8192;
        if (kbi + 1 < khi) { const int ik0 = i0 - 64 + 32 * (kbi + 1); stage32(wl + ((kbi + 1 - klo) & 1) * 8192, base + 512 + (size_t)ik0 * rs, base + 1024 + (size_t)ik0 * rs, rs, lane); ATT_WAIT_V(8); }
        else ATT_WAIT_V(0);
        const bool use0 = kbi <= 4, use1 = kbi >= 1;
        bf16x8 p00, p01, p10, p11;
        f32x16 sa, sb; qk32x2(buf, qf[0], qf[1], sa, sb, r32, hh);
        if (use0) { float t[16]; const float e0 = (float)((32 * kbi - 64) + 4 * hh - r32);
#pragma unroll
            for (int i = 0; i < 16; ++i) { const float ad = __builtin_fabsf(e0 + (float)((i & 3) + 8 * (i >> 2))); t[i] = ad <= 64.0f ? __builtin_fmaf(sa[i], c, -sl * ad) : -INFINITY; }
            sm_step2(t, m0, l0, o[0][0], o[0][1], p00, p01); }
        if (use1) { float t[16]; const float e0 = (float)((32 * kbi - 96) + 4 * hh - r32);
#pragma unroll
            for (int i = 0; i < 16; ++i) { const float ad = __builtin_fabsf(e0 + (float)((i & 3) + 8 * (i >> 2))); t[i] = ad <= 64.0f ? __builtin_fmaf(sb[i], c, -sl * ad) : -INFINITY; }
            sm_step2(t, m1, l1, o[1][0], o[1][1], p10, p11); }
        { bf16x8 v00, v01, v10, v11; vfrag4(buf, va0, va1, v00, v01, v10, v11);
          if (use0) { o[0][0] = ATT_MFMA(v00, p00, o[0][0]); o[0][1] = ATT_MFMA(v10, p00, o[0][1]); }
          if (use1) { o[1][0] = ATT_MFMA(v00, p10, o[1][0]); o[1][1] = ATT_MFMA(v10, p10, o[1][1]); }
          if (use0) { o[0][0] = ATT_MFMA(v01, p01, o[0][0]); o[0][1] = ATT_MFMA(v11, p01, o[0][1]); }
          if (use1) { o[1][0] = ATT_MFMA(v01, p11, o[1][0]); o[1][1] = ATT_MFMA(v11, p11, o[1][1]); } }
    }
    const float lt0 = xhalf_sum(l0), lt1 = xhalf_sum(l1);
#pragma unroll
    for (int qb = 0; qb < 2; ++qb) { const float lt = qb == 0 ? lt0 : lt1, mm = qb == 0 ? m0 : m1;
        const size_t tok = (size_t)b * SEQ + rho + (size_t)dl * (i0 + qb * 32 + r32);
        const float lse = mm + __builtin_amdgcn_logf(lt);
        if (!FINAL) {
            ostage(wl + qb * 4096, o[qb][0], o[qb][1], 1.0f / lt, r32, hh);
            if (hh == 0) DLo[(size_t)h * NTOK + tok] = lse;
        } else {
            const float a1 = DL1[(size_t)h * NTOK + tok], a2 = DL2[(size_t)h * NTOK + tok], mx = fmaxf(lse, fmaxf(a1, a2));
            const float e0 = ex2(lse - mx), e1 = ex2(a1 - mx), e2 = ex2(a2 - mx), es = 1.0f / (e0 + e1 + e2);
            ostage(wl + qb * 4096, o[qb][0], o[qb][1], e0 * es / lt, r32, hh);
            if (hh == 0) *(LAS f32x2*)(wl + 8192 + (qb * 32 + r32) * 8) = (f32x2){e1 * es, e2 * es};
        }
    }
    asm volatile("s_waitcnt lgkmcnt(0)" ::: "memory");
#pragma unroll
    for (int qb = 0; qb < 2; ++qb)
#pragma unroll
        for (int i = 0; i < 4; ++i) { const int r = 8 * i + (lane >> 3), ch = orow_chunk(lane, i);
            const size_t tok = (size_t)b * SEQ + rho + (size_t)dl * (i0 + qb * 32 + r);
            const v4u w = orow(wl + qb * 4096, lane, i);
            if (!FINAL) *(v4u*)(DPo + tok * 512 + h * 64 + ch * 8) = w;
            else { const f32x2 ww = *(const LAS f32x2*)(wl + 8192 + (qb * 32 + r) * 8);
                const v4u x1 = *(const v4u*)(DP1 + tok * 512 + h * 64 + ch * 8), x2 = *(const v4u*)(DP2 + tok * 512 + h * 64 + ch * 8);
                v4u y;
                y.x = cvtpk(bflo(w.x) + bflo(x1.x) * ww.x + bflo(x2.x) * ww.y, bfhi(w.x) + bfhi(x1.x) * ww.x + bfhi(x2.x) * ww.y);
                y.y = cvtpk(bflo(w.y) + bflo(x1.y) * ww.x + bflo(x2.y) * ww.y, bfhi(w.y) + bfhi(x1.y) * ww.x + bfhi(x2.y) * ww.y);
                y.z = cvtpk(bflo(w.z) + bflo(x1.z) * ww.x + bflo(x2.z) * ww.y, bfhi(w.z) + bfhi(x1.z) * ww.x + bfhi(x2.z) * ww.y);
                y.w = cvtpk(bflo(w.w) + bflo(x1.w) * ww.x + bflo(x2.w) * ww.y, bfhi(w.w) + bfhi(x1.w) * ww.x + bfhi(x2.w) * ww.y);
                *(v4u*)(OC + tok * DM + h * 64 + ch * 8) = y; } }
    asm volatile("s_waitcnt lgkmcnt(0)" ::: "memory");
}
__device__ __forceinline__ void na_tile(const bf16* QKV, const LAS float* rpb  , bf16* O, int idx, LAS unsigned char* wl, int lane) {
    asm volatile("" : "+v"(lane));
    const int r32 = lane & 31, hh = lane >> 5;
    const int cbk = idx & 3, iq = (idx >> 2) & 7, h = (idx >> 5) & 15, b = idx >> 9;
    const int qc = 16 * cbk + (r32 & 15), qr0 = 4 * iq + (r32 >> 4), qr1 = qr0 + 2;
    const bf16* qbase = QKV + ((size_t)h * NTOK + (size_t)b * SEQ) * 64; const bf16* kbase = qbase + (size_t)16 * NTOK * 64; const bf16* vbase = kbase + (size_t)16 * NTOK * 64;
    bf16x8 qf[2][4]; v4u qraw[2][4];
#pragma unroll
    for (int qb = 0; qb < 2; ++qb)
#pragma unroll
        for (int i = 0; i < 4; ++i) { const int r = 8 * i + (lane >> 3); qraw[qb][i] = *(const v4u*)(qbase + (size_t)((4 * iq + 2 * qb + (r >> 4)) * 64 + 16 * cbk + (r & 15)) * 64 + (lane & 7) * 8); }
    ATT_VADDR();
    const float c = 0.125f * LOG2E;
    const int csq = min(max(qc - 8, 0), 48), rs0 = min(max(qr0 - 4, 0), 24), rs1 = min(max(qr1 - 4, 0), 24);
    const int rA0 = min(max(4 * iq - 4, 0), 24), rB0 = min(max(4 * iq - 3, 0), 24) + 8, rA1 = min(max(4 * iq - 2, 0), 24), rB1 = min(max(4 * iq - 1, 0), 24) + 8;
    const int kc0 = min(max(16 * cbk - 8, 0), 32);
    const LAS float* rp = rpb + h * (15 * 31);
    f32x16 o[2][2];
#pragma unroll
    for (int i = 0; i < 16; ++i) { o[0][0][i] = 0.f; o[0][1][i] = 0.f; o[1][0][i] = 0.f; o[1][1][i] = 0.f; }
    float m0 = -INFINITY, m1 = -INFINITY, l0 = 0.f, l1 = 0.f;
    const int cd0 = kc0 + 4 * hh - csq, bc0 = kc0 + 4 * hh - qc + 15;
#define NA_ROW(kr_) ((size_t)((kr_) * 64 + kc0) * 64)
    stageK(wl, kbase + NA_ROW(rA0), 64, lane); stageV(wl + 8192, vbase + NA_ROW(rA0), 64, lane); stageK(wl + 4096, kbase + NA_ROW(rA0 + 1), 64, lane);
    qrow_put(wl + 12288, qraw[0], lane); qfrag_get(wl + 12288, qf[0], r32, hh); qrow_put(wl + 12288, qraw[1], lane); qfrag_get(wl + 12288, qf[1], r32, hh);
    ATT_WAIT_V(4);
    f32x16 sa, sb; qk32x2(wl, qf[0], qf[1], sa, sb, r32, hh);
    for (int kr = rA0; kr < rB1; ++kr) {
        const int j = kr - rA0; const bool n1 = kr + 1 < rB1, n2 = kr + 2 < rB1;
        if (n2) stageK(wl + (j & 1) * 4096, kbase + NA_ROW(kr + 2), 64, lane);
        if (n1) stageV(wl + 8192 + ((j + 1) & 1) * 4096, vbase + NA_ROW(kr + 1), 64, lane);
        if (n2) ATT_WAIT_V(8); else if (n1) ATT_WAIT_V(4); else ATT_WAIT_V(0);
        f32x16 na, nb;
        if (n1) qk32x2(wl + ((j + 1) & 1) * 4096, qf[0], qf[1], na, nb, r32, hh);
        const LAS unsigned char* buf = wl + 4096 + (j & 1) * 4096;
        const bool use0 = kr < rB0, use1 = kr >= rA1;
        bf16x8 p00, p01, p10, p11;
        if (use0) { float t[16]; const bool rok = (kr >= rs0) && (kr < rs0 + 8); const LAS float* bp = rp + (rok ? (kr - qr0 + 7) * 31 + bc0 : 0);
#pragma unroll
            for (int i = 0; i < 16; ++i) { const int dd = (i & 3) + 8 * (i >> 2); t[i] = bp[dd]; }
#pragma unroll
            for (int i = 0; i < 16; ++i) { const int dd = (i & 3) + 8 * (i >> 2); const bool ok = rok && ((unsigned)(cd0 + dd) < 16u); t[i] = ok ? __builtin_fmaf(sa[i], c, t[i]) : -INFINITY; }
            sm_step2(t, m0, l0, o[0][0], o[0][1], p00, p01); }
        if (use1) { float t[16]; const bool rok = (kr >= rs1) && (kr < rs1 + 8); const LAS float* bp = rp + (rok ? (kr - qr1 + 7) * 31 + bc0 : 0);
#pragma unroll
            for (int i = 0; i < 16; ++i) { const int dd = (i & 3) + 8 * (i >> 2); t[i] = bp[dd]; }
#pragma unroll
            for (int i = 0; i < 16; ++i) { const int dd = (i & 3) + 8 * (i >> 2); const bool ok = rok && ((unsigned)(cd0 + dd) < 16u); t[i] = ok ? __builtin_fmaf(sb[i], c, t[i]) : -INFINITY; }
            sm_step2(t, m1, l1, o[1][0], o[1][1], p10, p11); }
        { bf16x8 v00, v01, v10, v11; vfrag4(buf, va0, va1, v00, v01, v10, v11);
          if (use0) { o[0][0] = ATT_MFMA(v00, p00, o[0][0]); o[0][1] = ATT_MFMA(v10, p00, o[0][1]); }
          if (use1) { o[1][0] = ATT_MFMA(v00, p10, o[1][0]); o[1][1] = ATT_MFMA(v10, p10, o[1][1]); }
          if (use0) { o[0][0] = ATT_MFMA(v01, p01, o[0][0]); o[0][1] = ATT_MFMA(v11, p01, o[0][1]); }
          if (use1) { o[1][0] = ATT_MFMA(v01, p11, o[1][0]); o[1][1] = ATT_MFMA(v11, p11, o[1][1]); } }
        if (n1) { sa = na; sb = nb; }
    }
#undef NA_ROW
    const float i0 = 1.0f / xhalf_sum(l0), i1 = 1.0f / xhalf_sum(l1);
    ostage(wl, o[0][0], o[0][1], i0, r32, hh); ostage(wl + 4096, o[1][0], o[1][1], i1, r32, hh);
    asm volatile("s_waitcnt lgkmcnt(0)" ::: "memory");
#pragma unroll
    for (int qb = 0; qb < 2; ++qb)
#pragma unroll
        for (int i = 0; i < 4; ++i) { const int r = 8 * i + (lane >> 3);
            const v4u w = orow(wl + qb * 4096, lane, i);
            *(v4u*)(O + ((size_t)b * SEQ + (4 * iq + 2 * qb + (r >> 4)) * 64 + 16 * cbk + (r & 15)) * DM + h * 64 + orow_chunk(lane, i) * 8) = w; }
    asm volatile("s_waitcnt lgkmcnt(0)" ::: "memory");
}
}
#ifndef MK_MULTI
#define MK_MULTI 0
#endif
constexpr int NPH = 45;
struct Args { const float* in[22]; float* out; unsigned char* ws; int ph_lo, ph_hi; };
__global__ void __launch_bounds__(NWAVES * 64, 2) fwd(Args args) {
    extern __shared__ __attribute__((aligned(16))) unsigned char lds_raw[];
    Ctx C;
    C.out = args.out; C.ws = args.ws; C.lds = (LAS unsigned char*)lds_raw;
    C.tid = threadIdx.x; C.lane = C.tid & 63; C.wave = __builtin_amdgcn_readfirstlane(C.tid >> 6); C.G = gridDim.x; C.gw = blockIdx.x * NWAVES + C.wave; C.NGW = C.G * NWAVES;
    volatile LAS unsigned* MISC = (volatile LAS unsigned*)(C.lds + MISC_OFF);
    for (int u = C.tid; u < (LDS_BYTES - LDSCTL_OFF) / 4; u += NWAVES * 64) ((LAS unsigned*)(C.lds + LDSCTL_OFF))[u] = 0u;
    __syncthreads();
    XcdBarrier bar = xcd_barrier_post((unsigned*)(args.ws + WS_CTL) + CW_BAR, MISC + 8);
    const int lo = args.ph_lo, hi = args.ph_hi; int ph = 0; const int wave_s = C.wave;
#define PH_BEGIN { asm volatile("" : "+s"(ph)); const bool run_ = (ph >= lo && ph < hi); if (run_) { unsigned char* ws = args.ws; float* xo = args.out; int l_; asm volatile("v_mbcnt_lo_u32_b32 %0, -1, 0\n\tv_mbcnt_hi_u32_b32 %0, -1, %0" : "=v"(l_)); asm volatile("" : "+s"(ws), "+s"(xo)); \
        C.ws = ws; C.out = xo; C.lane = l_; C.wave = wave_s; C.tid = wave_s * 64 + l_; { int gw_ = blockIdx.x * NWAVES + wave_s, g_ = gridDim.x; asm volatile("" : "+s"(gw_), "+s"(g_)); C.gw = gw_; C.G = g_; C.NGW = g_ * NWAVES; } unsigned* ctl = (unsigned*)(ws + WS_CTL); (void)ctl;
#define PH_END } if (run_ && ph + 1 < hi) { XcdBarrier b2_ = bar; asm volatile("" : "+s"(b2_.bar)); int l2_; asm volatile("v_mbcnt_lo_u32_b32 %0, -1, 0\n\tv_mbcnt_hi_u32_b32 %0, -1, %0" : "=v"(l2_)); xcd_barrier(b2_, wave_s * 64 + l2_); } ++ph; }
#define H ((bf16*)(ws + WS_H))
#define XB ((bf16*)xo)
#define PROJ ((bf16*)(ws + WS_PROJ))
#define QM ((bf16*)(ws + WS_QM))
#define KVM ((bf16*)(ws + WS_KVM))
#define KPE ((bf16*)(ws + WS_KPE))
#define ACT ((bf16*)(ws + WS_ACT))
#define QKV ((bf16*)(ws + WS_QKV))
#define HG8 (ws + WS_HG8)
#define YALL ((bf16*)(ws + WS_YALL))
#define MACT (ws + WS_MACT)
#define wev (ws + WS_WEV + lp * EV_STRIDE)
#define wod (ws + WS_WOD + lp * OD_STRIDE)
#define cnt (ctl + CW_CNT + lp * N_CHUNK * 8 * 64)
#define xin (lp == 0 ? args.in[0] : (const float*)xo)
#define GEMM(EPI, ORD, g, S, E) pg8::gemm_phase<EPI, ORD, true, true, 0>(C.lds, g, S, E, C.tid)
#define GEMM8(EPI, ORD, g, S, E) pg8::gemm_phase<EPI, ORD, true, false, 1>(C.lds, g, S, E, C.tid)
#define GEMMI8(EPI, ORD, g, S, E) pg8::gemm_phase<EPI, ORD, true, false, 2>(C.lds, g, S, E, C.tid)

    PH_BEGIN p0_prologue(C, args); norm_phase<2, true>(C, args.in[0], args.in[1], H, XB); PH_END

    for (int lp = 0; lp < 2; ++lp) {
        PH_BEGIN { pg8::Gemm g{H, (const bf16*)(wev + EV_WIN), DM / 2, DM / 2, DM / 2}; pg8::StaticOrder S; S.init(NTOK, IN_E_PAD, C.G, (int)blockIdx.x); pg8::EpiBf16I8 E{PROJ, IN_E_PAD, (const float*)(ws + WS_SA), (const float*)(ws + WS_SB) + lp * 8192}; GEMMI8(pg8::EpiBf16I8, pg8::StaticOrder, g, S, E); } PH_END
        PH_BEGIN mla_prep_phase(C, PROJ, args.in[3] + lp * 256, args.in[5] + lp * 128, KPE); PH_END
        PH_BEGIN { { pg8::Gemm g{PROJ + 1536, (const bf16*)(wev + EV_WUQ), IN_E_PAD, 256, 256}; pg8::StaticOrder S; S.init(NTOK, 768, C.G, (int)blockIdx.x); pg8::EpiBf16 E{QM, 768}; GEMM(pg8::EpiBf16, pg8::StaticOrder, g, S, E); }
                   { pg8::Gemm g{PROJ + 1792, (const bf16*)(wev + EV_WUKV), IN_E_PAD, 256, 256}; pg8::StaticOrder S; S.init(NTOK, 1024, C.G, (int)blockIdx.x); pg8::EpiBf16 E{KVM, 1024}; GEMM(pg8::EpiBf16, pg8::StaticOrder, g, S, E); } } PH_END
        PH_BEGIN { const float* rope = (const float*)(ws + WS_ROPE);
                   for (int it = blockIdx.x; it < 1024; it += C.G) att::mla_unit(QM, KVM, KPE, rope, H, it, C.lds, C.tid);
                   LAS unsigned char* wl = C.lds + C.wave * 16384;
                   for (int it = C.gw; it < 8192; it += C.NGW) att::dil_tile<false>(PROJ, 1, it, (bf16*)(ws + WS_DP1), (float*)(ws + WS_DL1), nullptr, nullptr, nullptr, nullptr, nullptr, wl, C.lane);
                   for (int it = C.gw; it < 8192; it += C.NGW) att::dil_tile<false>(PROJ, 4, it, (bf16*)(ws + WS_DP2), (float*)(ws + WS_DL2), nullptr, nullptr, nullptr, nullptr, nullptr, wl, C.lane); } PH_END
        PH_BEGIN { LAS unsigned char* wl = C.lds + C.wave * 16384;
                   for (int it = C.gw; it < 8192; it += C.NGW) att::dil_tile<true>(PROJ, 16, it, nullptr, nullptr, (const bf16*)(ws + WS_DP1), (const float*)(ws + WS_DL1), (const bf16*)(ws + WS_DP2), (const float*)(ws + WS_DL2), H, wl, C.lane); } PH_END
        PH_BEGIN { pg8::Gemm g{H, (const bf16*)(wev + EV_WOUT), DM, DM, DM}; pg8::StaticOrder S; S.init(NTOK, DM, C.G, (int)blockIdx.x); pg8::EpiResidB E{(const pg8::bf16_t*)XB, (pg8::bf16_t*)XB, LDX}; GEMM(pg8::EpiResidB, pg8::StaticOrder, g, S, E); } PH_END
        PH_BEGIN norm_phase_b(C, XB, args.in[8] + lp * DM, H); PH_END
        PH_BEGIN { pg8::Gemm g{H, (const bf16*)(wev + EV_WGU), DM / 2, DM / 2, DM / 2}; pg8::StaticOrder S; S.init(NTOK, 2 * DFF, C.G, (int)blockIdx.x); pg8::EpiSwigluI8 E{ACT, DFF, (const float*)(ws + WS_SA), (const float*)(ws + WS_SB) + lp * 8192 + 2048}; GEMMI8(pg8::EpiSwigluI8, pg8::StaticOrder, g, S, E); } PH_END
        PH_BEGIN { pg8::Gemm g{ACT, (const bf16*)(wev + EV_WD), DFF, DFF, DFF}; pg8::StaticOrder S; S.init(NTOK, DM, C.G, (int)blockIdx.x); pg8::EpiResidB E{(const pg8::bf16_t*)XB, (pg8::bf16_t*)XB, LDX}; GEMM(pg8::EpiResidB, pg8::StaticOrder, g, S, E); } PH_END

        PH_BEGIN norm_phase_b(C, XB, args.in[12] + lp * DM, H); moe_weights(C, args, lp); PH_END
        PH_BEGIN { pg8::Gemm g{H, (const bf16*)(wod + OD_WQKV), DM / 2, DM / 2, DM / 2}; pg8::StaticOrder S; S.init(NTOK, 3072, C.G, (int)blockIdx.x); pg8::EpiBf16I8H E{QKV, NTOK, (const float*)(ws + WS_SA), (const float*)(ws + WS_SB) + 16384 + lp * 4096}; GEMMI8(pg8::EpiBf16I8H, pg8::StaticOrder, g, S, E); } PH_END
        PH_BEGIN { const float* rpb = args.in[14] + lp * 16 * 15 * 31; LAS float* rl = (LAS float*)(C.lds + RPB_OFF);
                   for (int i = C.tid; i < 16 * 15 * 31; i += NWAVES * 64) rl[i] = rpb[i] * 1.4426950408889634f;
                   __syncthreads();
                   LAS unsigned char* wl = C.lds + C.wave * 16384;
                   for (int it = C.gw; it < 16384; it += C.NGW) att::na_tile(QKV, rl, H, it, wl, C.lane); } PH_END
        PH_BEGIN { pg8::Gemm g{H, (const bf16*)(wod + OD_WO), DM, DM, DM}; pg8::StaticOrder S; S.init(NTOK, DM, C.G, (int)blockIdx.x); pg8::EpiResidB E{(const pg8::bf16_t*)XB, (pg8::bf16_t*)XB, LDX}; GEMM(pg8::EpiResidB, pg8::StaticOrder, g, S, E); } PH_END
        PH_BEGIN route_phase(C, XB, args.in[16] + lp * DM, args.in[17] + lp * DM * NEXP, (unsigned char*)H, cnt); PH_END
        PH_BEGIN gather_all_phase(C, (const unsigned char*)H, HG8, cnt); PH_END
#define MOE_GU(ch_) { pg8::Gemm g{(const bf16*)(HG8 + (size_t)(ch_) * 2 * CHUNK_SLOTS * DM), (const bf16*)(ws + WS_MWGU), DM / 2, DM / 2, DM / 2}; pg8::GroupedOrder S; grouped_order(S, cnt, (ch_), 28, C.G, (int)blockIdx.x); \
            pg8::EpiSwigluF8 E{MACT + (size_t)((ch_) & 1) * CHUNK_SLOTS * DFFX, DFFX, 1.0f / 32.0f}; GEMM8(pg8::EpiSwigluF8, pg8::GroupedOrder, g, S, E); }
#define MOE_DOWN(ch_) { pg8::Gemm g{(const bf16*)(MACT + (size_t)((ch_) & 1) * CHUNK_SLOTS * DFFX), (const bf16*)(ws + WS_MWD), DFFX / 2, DFFX / 2, DFFX / 2}; pg8::GroupedOrder S; grouped_order(S, cnt, (ch_), 4, C.G, (int)blockIdx.x); \
            pg8::EpiBf16S E{YALL + (size_t)(ch_) * CHUNK_SLOTS * DM, DM, 1.0f / 32.0f}; GEMM8(pg8::EpiBf16S, pg8::GroupedOrder, g, S, E); }
        PH_BEGIN MOE_GU(0) PH_END
        for (int ch = 1; ch < N_CHUNK; ++ch) {
            PH_BEGIN MOE_DOWN(ch - 1) MOE_GU(ch) PH_END
        }
        PH_BEGIN MOE_DOWN(N_CHUNK - 1) PH_END
#undef MOE_GU
#undef MOE_DOWN
        PH_BEGIN { if (lp == 0) combine_all_phase<false>(C, XB, xo, YALL, args.in[1] + DM, H); else combine_all_phase<true>(C, XB, xo, YALL, args.in[21], H); } PH_END
    }
#undef PH_BEGIN
#undef PH_END
#undef GEMM
#undef XB
#undef H
#undef PROJ
#undef QM
#undef KVM
#undef KPE
#undef ACT
#undef QKV
#undef HG8
#undef YALL
#undef GEMM8
#undef GEMMI8
#undef MACT
#undef wev
#undef wod
#undef cnt
#undef xin
}

extern "C" void kernel_launch(void* const* d_in, const int* in_sizes, int n_in, void* d_out, int out_size, void* d_ws, size_t ws_size, hipStream_t stream) {
    static int grid = 0;
    if (grid == 0) {
        if (n_in != 22 || in_sizes[0] != NTOK * DM || out_size != NTOK * DM || ws_size < WS_END) { fprintf(stderr, "kernel_launch: unexpected shapes (n_in %d, in0 %d, out %d, ws %zu); nothing launched\n", n_in, n_in > 0 ? in_sizes[0] : -1, out_size, ws_size); grid = -1; return; }
        int dev = 0, cus = 0, per_cu = 0;
        if (hipGetDevice(&dev) != hipSuccess || hipDeviceGetAttribute(&cus, hipDeviceAttributeMultiprocessorCount, dev) != hipSuccess) { grid = -1; return; }
        if (hipFuncSetAttribute((const void*)fwd, hipFuncAttributeMaxDynamicSharedMemorySize, LDS_BYTES) != hipSuccess) { fprintf(stderr, "kernel_launch: hipFuncSetAttribute failed\n"); grid = -1; return; }
        if (hipOccupancyMaxActiveBlocksPerMultiprocessor(&per_cu, (const void*)fwd, NWAVES * 64, LDS_BYTES) != hipSuccess || per_cu < 1) { fprintf(stderr, "kernel_launch: occupancy query says %d blocks per CU\n", per_cu); }
        (void)hipGetLastError();
        grid = cus;
    }
    if (grid < 0) return;
    if (hipMemsetAsync((char*)d_ws + WS_CTL, 0, CTL_ZERO_BYTES, stream) != hipSuccess) return;
    Args a{};
    for (int i = 0; i < 22; ++i) a.in[i] = (const float*)d_in[i];
    a.out = (float*)d_out; a.ws = (unsigned char*)d_ws;
#if MK_MULTI
    for (int p = 0; p < NPH; ++p) { a.ph_lo = p; a.ph_hi = p + 1; hipLaunchKernelGGL(fwd, dim3(grid), dim3(NWAVES * 64), LDS_BYTES, stream, a); }
#else
    a.ph_lo = 0; a.ph_hi = NPH; hipLaunchKernelGGL(fwd, dim3(grid), dim3(NWAVES * 64), LDS_BYTES, stream, a);
#endif
}
```

```cpp
#include <hip/hip_runtime.h>
#include <cstdio>
#include <cstdint>
#define MK_MULTI 0
namespace pg8 {
#define PG8_LAS __attribute__((address_space(3)))
#define PG8_GAS __attribute__((address_space(1)))
typedef unsigned short bf16_t;
typedef short bf16x8 __attribute__((ext_vector_type(8)));
typedef float f32x4 __attribute__((ext_vector_type(4)));
typedef unsigned u32x4 __attribute__((ext_vector_type(4)));
typedef int v4i_t __attribute__((ext_vector_type(4)));
typedef int v8i_t __attribute__((ext_vector_type(8)));
constexpr int BM = 256, BK = 64, HALF = 128, HTB = HALF * BK * 2  , STAGE_BYTES = 8 * HTB, NXCD = 8, WGM = 8, EPI_SC_OFF = STAGE_BYTES + 1024  ;

__host__ __device__ __forceinline__ int lds_byte(int r, int c) { const int st = (r >> 4) * 2 + (c >> 5), rr = r & 15, cc = c & 31, ob = rr * 64 + cc * 2; return st * 1024 + (ob ^ (((ob >> 9) & 1) << 5)); }
__host__ __device__ __forceinline__ void stage_rc(int b, int& R, int& C) { const int st = b / 1024, sb = b % 1024, swz = sb ^ (((sb >> 9) & 1) << 5); R = (st >> 1) * 16 + swz / 64; C = (st & 1) * 32 + (swz % 64) / 2; }
__host__ __device__ __forceinline__ int perm32(int rho) { const int n = rho >> 4, i = rho & 15; return 8 * (i >> 2) + 4 * n + (i & 3); }

struct Unit { int pm, pn, pc; };
struct Gemm { const bf16_t* A; const bf16_t* Bt; int lda, ldb, K; };

struct StaticOrder {
    int nM, nN, nwg, G, c;
    __host__ __device__ void init(int M, int N, int G_, int c_) { nM = M / BM; nN = N / BM; nwg = nM * nN; G = G_; c = c_; }
    __host__ __device__ bool next(int i, Unit& u) const {
        const long L = (long)i * G + c; if (L >= nwg) return false;
        int wgid = (int)L; { const int q = nwg / NXCD, r = nwg % NXCD, xcd = wgid % NXCD, off = wgid / NXCD; wgid = (xcd < r ? xcd * (q + 1) : r * (q + 1) + (xcd - r) * q) + off; }
        const int nig = WGM * nN, gid = wgid / nig, fm = gid * WGM, gsz = (nM - fm) < WGM ? (nM - fm) : WGM;
        u.pm = fm + ((wgid % nig) % gsz); u.pn = (wgid % nig) / gsz; u.pc = u.pn; return true;
    }
    __device__ __forceinline__ void a_ready(const Unit&) const {}
    __device__ __forceinline__ void done(const Unit&) const {}
};
struct GroupedOrder {
    int t0, t1, t2, t3, t4, t5, t6, RT, nN, G, c;
    __device__ bool next(int i, Unit& u) const {
        const int nwg = RT * nN; const long L = (long)i * G + c; if (L >= nwg) return false;
        int wgid = (int)L; { const int q = nwg / NXCD, r = nwg % NXCD, xcd = wgid % NXCD, off = wgid / NXCD; wgid = (xcd < r ? xcd * (q + 1) : r * (q + 1) + (xcd - r) * q) + off; }
        const int nig = WGM * nN, gid = wgid / nig, fm = gid * WGM, gsz = (RT - fm) < WGM ? (RT - fm) : WGM, w = wgid - gid * nig;
        const int rt = fm + (w % gsz), j = w / gsz;
        const int e = (rt >= t0) + (rt >= t1) + (rt >= t2) + (rt >= t3) + (rt >= t4) + (rt >= t5) + (rt >= t6);
        u.pm = rt; u.pn = e * nN + j; u.pc = j; return true;
    }
    __device__ __forceinline__ void a_ready(const Unit&) const {}
    __device__ __forceinline__ void done(const Unit&) const {}
};

__device__ __forceinline__ unsigned cvt_pk_bf16(float lo, float hi) { unsigned r; asm volatile("v_cvt_pk_bf16_f32 %0, %1, %2" : "=v"(r) : "v"(lo), "v"(hi)); return r; }

struct EpiBf16 {
    static constexpr bool PERM = true, AFTER_DRAIN = false, PREFETCH = false;
    bf16_t* O; int ldc;
    __device__ __forceinline__ void operator()(const f32x4 (&acc)[2][2][4][2], const Unit& u, int wr, int wc, int fr, int fq) const {
        const int row0 = u.pm * BM + wr * 64 + fr, col0 = u.pc * BM + wc * 32 + 8 * fq;
#pragma unroll
        for (int ai = 0; ai < 2; ++ai)
#pragma unroll
            for (int m = 0; m < 4; ++m) { bf16_t* rowp = O + (size_t)(row0 + ai * HALF + m * 16) * ldc + col0;
#pragma unroll
                for (int bj = 0; bj < 2; ++bj) { const f32x4 v0 = acc[ai][bj][m][0], v1 = acc[ai][bj][m][1];
                    u32x4 w; w.x = cvt_pk_bf16(v0[0], v0[1]); w.y = cvt_pk_bf16(v0[2], v0[3]); w.z = cvt_pk_bf16(v1[0], v1[1]); w.w = cvt_pk_bf16(v1[2], v1[3]);
                    *(PG8_GAS u32x4*)(rowp + bj * HALF) = w; } }
    }
};
struct EpiSwiglu {
    static constexpr bool PERM = true, AFTER_DRAIN = false, PREFETCH = false;
    bf16_t* O; int ldc;
    __device__ __forceinline__ void operator()(const f32x4 (&acc)[2][2][4][2], const Unit& u, int wr, int wc, int fr, int fq) const {
        const int row0 = u.pm * BM + wr * 64 + fr, col0 = u.pc * HALF + wc * 32 + 8 * fq;
#pragma unroll
        for (int ai = 0; ai < 2; ++ai)
#pragma unroll
            for (int m = 0; m < 4; ++m) { bf16_t* rowp = O + (size_t)(row0 + ai * HALF + m * 16) * ldc + col0;
                float r[8];
#pragma unroll
                for (int n = 0; n < 2; ++n)
#pragma unroll
                    for (int k = 0; k < 4; ++k) { const float g = acc[ai][0][m][n][k], up = acc[ai][1][m][n][k];
                        r[n * 4 + k] = g * __builtin_amdgcn_rcpf(1.0f + __expf(-g)) * up; }
                u32x4 w; w.x = cvt_pk_bf16(r[0], r[1]); w.y = cvt_pk_bf16(r[2], r[3]); w.z = cvt_pk_bf16(r[4], r[5]); w.w = cvt_pk_bf16(r[6], r[7]);
                *(PG8_GAS u32x4*)rowp = w; }
    }
};
__device__ __forceinline__ unsigned cvt4_fp8(float a, float b, float c, float d) { int r = 0; r = __builtin_amdgcn_cvt_pk_fp8_f32(a, b, r, false); r = __builtin_amdgcn_cvt_pk_fp8_f32(c, d, r, true); return (unsigned)r; }
struct EpiSwigluF8 {
    static constexpr bool PERM = true, AFTER_DRAIN = false, PREFETCH = false;
    unsigned char* O; int ldc; float sc;
    __device__ __forceinline__ void operator()(const f32x4 (&acc)[2][2][4][2], const Unit& u, int wr, int wc, int fr, int fq) const {
        const int row0 = u.pm * BM + wr * 64 + fr, col0 = u.pc * HALF + wc * 32 + 8 * fq;
        const float c1 = -1.4426950408889634f * sc, k2 = 1.0f / (sc * sc);
#pragma unroll
        for (int ai = 0; ai < 2; ++ai)
#pragma unroll
            for (int m = 0; m < 4; ++m) { unsigned char* rowp = O + (size_t)(row0 + ai * HALF + m * 16) * ldc + col0;
                typedef unsigned u32x2_t __attribute__((ext_vector_type(2)));
                u32x2_t w;
#pragma unroll
                for (int n = 0; n < 2; ++n) { const f32x4 ag = acc[ai][0][m][n], au = acc[ai][1][m][n];
                    const f32x4 x = ag * c1; f32x4 tt;
#pragma unroll
                    for (int k = 0; k < 4; ++k) tt[k] = __builtin_amdgcn_exp2f(x[k]);
                    const f32x4 d = tt * k2 + k2; f32x4 r;
#pragma unroll
                    for (int k = 0; k < 4; ++k) r[k] = __builtin_amdgcn_rcpf(d[k]);
                    const f32x4 o = (ag * au) * r;
                    w[n] = cvt4_fp8(o[0], o[1], o[2], o[3]); }
                *(PG8_GAS u32x2_t*)rowp = w; }
    }
};
struct EpiBf16S {
    static constexpr bool PERM = true, AFTER_DRAIN = false, PREFETCH = false;
    bf16_t* O; int ldc; float sc;
    __device__ __forceinline__ void operator()(const f32x4 (&acc)[2][2][4][2], const Unit& u, int wr, int wc, int fr, int fq) const {
        const int row0 = u.pm * BM + wr * 64 + fr, col0 = u.pc * BM + wc * 32 + 8 * fq;
#pragma unroll
        for (int ai = 0; ai < 2; ++ai)
#pragma unroll
            for (int m = 0; m < 4; ++m) { bf16_t* rowp = O + (size_t)(row0 + ai * HALF + m * 16) * ldc + col0;
#pragma unroll
                for (int bj = 0; bj < 2; ++bj) { const f32x4 v0 = acc[ai][bj][m][0] * sc, v1 = acc[ai][bj][m][1] * sc;
                    u32x4 w; w.x = cvt_pk_bf16(v0[0], v0[1]); w.y = cvt_pk_bf16(v0[2], v0[3]); w.z = cvt_pk_bf16(v1[0], v1[1]); w.w = cvt_pk_bf16(v1[2], v1[3]);
                    *(PG8_GAS u32x4*)(rowp + bj * HALF) = w; } }
    }
};
struct EpiBf16I8 {
    static constexpr bool PERM = true, AFTER_DRAIN = false, PREFETCH = true;
    bf16_t* O; int ldc; const float* sa; const float* sb;
    __device__ __forceinline__ void prefetch(const Unit& u, PG8_LAS unsigned char* blk, int wid, int lane) const {
        const float* src = (wid < 4) ? sa + u.pm * BM + wid * 64 + lane : sb + u.pn * BM + (wid - 4) * 64 + lane;
        __builtin_amdgcn_global_load_lds((const unsigned*)src, (PG8_LAS unsigned*)(blk + wid * 256), 4, 0, 0);
    }
    __device__ __forceinline__ void run(const f32x4 (&acc)[2][2][4][2], const Unit& u, int wr, int wc, int fr, int fq, const PG8_LAS float* scl) const {
        const int row0 = u.pm * BM + wr * 64 + fr, col0 = u.pc * BM + wc * 32 + 8 * fq, lrow0 = wr * 64 + fr, bcol0 = 256 + wc * 32 + 8 * fq;
        f32x4 sc[2][2];
#pragma unroll
        for (int bj = 0; bj < 2; ++bj)
#pragma unroll
            for (int n = 0; n < 2; ++n) sc[bj][n] = *(const PG8_LAS f32x4*)(scl + bcol0 + bj * HALF + 4 * n);
#pragma unroll
        for (int ai = 0; ai < 2; ++ai)
#pragma unroll
            for (int m = 0; m < 4; ++m) { const int row = row0 + ai * HALF + m * 16; bf16_t* rowp = O + (size_t)row * ldc + col0; const float s = scl[lrow0 + ai * HALF + m * 16];
#pragma unroll
                for (int bj = 0; bj < 2; ++bj) { f32x4 v[2];
#pragma unroll
                    for (int n = 0; n < 2; ++n) { f32x4 fa;
#pragma unroll
                        for (int k = 0; k < 4; ++k) { const float f = acc[ai][bj][m][n][k]; fa[k] = (float)__builtin_bit_cast(int, f); }
                        v[n] = fa * (sc[bj][n] * s); }
                    u32x4 w; w.x = cvt_pk_bf16(v[0][0], v[0][1]); w.y = cvt_pk_bf16(v[0][2], v[0][3]); w.z = cvt_pk_bf16(v[1][0], v[1][1]); w.w = cvt_pk_bf16(v[1][2], v[1][3]);
                    *(PG8_GAS u32x4*)(rowp + bj * HALF) = w; } }
    }
};
struct EpiBf16I8H {
    static constexpr bool PERM = true, AFTER_DRAIN = false, PREFETCH = true;
    bf16_t* O; int nrows; const float* sa; const float* sb;
    __device__ __forceinline__ void prefetch(const Unit& u, PG8_LAS unsigned char* blk, int wid, int lane) const {
        const float* src = (wid < 4) ? sa + u.pm * BM + wid * 64 + lane : sb + u.pn * BM + (wid - 4) * 64 + lane;
        __builtin_amdgcn_global_load_lds((const unsigned*)src, (PG8_LAS unsigned*)(blk + wid * 256), 4, 0, 0);
    }
    __device__ __forceinline__ void run(const f32x4 (&acc)[2][2][4][2], const Unit& u, int wr, int wc, int fr, int fq, const PG8_LAS float* scl) const {
        const int row0 = u.pm * BM + wr * 64 + fr, col0 = u.pc * BM + wc * 32 + 8 * fq, lrow0 = wr * 64 + fr, bcol0 = 256 + wc * 32 + 8 * fq;
        f32x4 sc[2][2];
#pragma unroll
        for (int bj = 0; bj < 2; ++bj)
#pragma unroll
            for (int n = 0; n < 2; ++n) sc[bj][n] = *(const PG8_LAS f32x4*)(scl + bcol0 + bj * HALF + 4 * n);
#pragma unroll
        for (int ai = 0; ai < 2; ++ai)
#pragma unroll
            for (int m = 0; m < 4; ++m) { const int row = row0 + ai * HALF + m * 16; const float s = scl[lrow0 + ai * HALF + m * 16];
#pragma unroll
                for (int bj = 0; bj < 2; ++bj) { f32x4 v[2];
#pragma unroll
                    for (int n = 0; n < 2; ++n) { f32x4 fa;
#pragma unroll
                        for (int k = 0; k < 4; ++k) { const float f = acc[ai][bj][m][n][k]; fa[k] = (float)__builtin_bit_cast(int, f); }
                        v[n] = fa * (sc[bj][n] * s); }
                    u32x4 w; w.x = cvt_pk_bf16(v[0][0], v[0][1]); w.y = cvt_pk_bf16(v[0][2], v[0][3]); w.z = cvt_pk_bf16(v[1][0], v[1][1]); w.w = cvt_pk_bf16(v[1][2], v[1][3]);
                    const int cc = col0 + bj * HALF; *(PG8_GAS u32x4*)(O + ((size_t)(cc >> 6) * nrows + row) * 64 + (cc & 63)) = w; } }
    }
};
struct EpiSwigluI8 {
    static constexpr bool PERM = true, AFTER_DRAIN = false, PREFETCH = true;
    bf16_t* O; int ldc; const float* sa; const float* sb;
    __device__ __forceinline__ void prefetch(const Unit& u, PG8_LAS unsigned char* blk, int wid, int lane) const {
        const float* src = (wid < 4) ? sa + u.pm * BM + wid * 64 + lane : sb + u.pn * BM + (wid - 4) * 64 + lane;
        __builtin_amdgcn_global_load_lds((const unsigned*)src, (PG8_LAS unsigned*)(blk + wid * 256), 4, 0, 0);
    }
    __device__ __forceinline__ void run(const f32x4 (&acc)[2][2][4][2], const Unit& u, int wr, int wc, int fr, int fq, const PG8_LAS float* scl) const {
        const int row0 = u.pm * BM + wr * 64 + fr, col0 = u.pc * HALF + wc * 32 + 8 * fq, lrow0 = wr * 64 + fr, bcol0 = 256 + wc * 32 + 8 * fq;
        f32x4 c1[2], c2[2]; float one = 1.0f; asm volatile("" : "+v"(one));
#pragma unroll
        for (int n = 0; n < 2; ++n) { const f32x4 sg = *(const PG8_LAS f32x4*)(scl + bcol0 + 4 * n), su = *(const PG8_LAS f32x4*)(scl + bcol0 + HALF + 4 * n); c1[n] = sg * -1.4426950408889634f; c2[n] = sg * su; }
#pragma unroll
        for (int ai = 0; ai < 2; ++ai)
#pragma unroll
            for (int m = 0; m < 4; ++m) { const int row = row0 + ai * HALF + m * 16; bf16_t* rowp = O + (size_t)row * ldc + col0; const float s = scl[lrow0 + ai * HALF + m * 16], s2 = s * s;
                u32x4 w;
#pragma unroll
                for (int n = 0; n < 2; ++n) { f32x4 fa, fu;
#pragma unroll
                    for (int k = 0; k < 4; ++k) { const float fg = acc[ai][0][m][n][k], fv = acc[ai][1][m][n][k]; fa[k] = (float)__builtin_bit_cast(int, fg); fu[k] = (float)__builtin_bit_cast(int, fv); }
                    const f32x4 x = fa * (c1[n] * s); f32x4 tt, r;
#pragma unroll
                    for (int k = 0; k < 4; ++k) tt[k] = __builtin_amdgcn_exp2f(x[k]);
                    const f32x4 d = tt * one + one;
#pragma unroll
                    for (int k = 0; k < 4; ++k) r[k] = __builtin_amdgcn_rcpf(d[k]);
                    const f32x4 o = ((fa * fu) * (c2[n] * s2)) * r;
                    if (n == 0) { w.x = cvt_pk_bf16(o[0], o[1]); w.y = cvt_pk_bf16(o[2], o[3]); } else { w.z = cvt_pk_bf16(o[0], o[1]); w.w = cvt_pk_bf16(o[2], o[3]); } }
                *(PG8_GAS u32x4*)rowp = w; }
    }
};
struct EpiNull { static constexpr bool PERM = true, AFTER_DRAIN = false, PREFETCH = false; int dummy;
    __device__ __forceinline__ void operator()(const f32x4 (&acc)[2][2][4][2], const Unit& u, int wr, int wc, int fr, int fq) const { float s = 0.f;
#pragma unroll
        for (int a = 0; a < 2; ++a)
#pragma unroll
            for (int b = 0; b < 2; ++b)
#pragma unroll
                for (int m = 0; m < 4; ++m)
#pragma unroll
                    for (int n = 0; n < 2; ++n) s += acc[a][b][m][n][0] + acc[a][b][m][n][1] + acc[a][b][m][n][2] + acc[a][b][m][n][3];
        asm volatile("" :: "v"(s)); }
};
struct EpiResidB {
    static constexpr bool PERM = true, AFTER_DRAIN = false, PREFETCH = false;
    const bf16_t* base; bf16_t* out; int ldc;
    __device__ __forceinline__ void operator()(const f32x4 (&acc)[2][2][4][2], const Unit& u, int wr, int wc, int fr, int fq) const {
        const int row0 = u.pm * BM + wr * 64 + fr, col0 = u.pc * BM + wc * 32 + 8 * fq;
#pragma unroll
        for (int ai = 0; ai < 2; ++ai)
#pragma unroll
            for (int m = 0; m < 4; ++m) { const size_t ro = (size_t)(row0 + ai * HALF + m * 16) * ldc + col0;
#pragma unroll
                for (int bj = 0; bj < 2; ++bj) { const u32x4 b = *(const PG8_GAS u32x4*)(base + ro + bj * HALF); const f32x4 v0 = acc[ai][bj][m][0], v1 = acc[ai][bj][m][1];
                    u32x4 w; w.x = cvt_pk_bf16(v0[0] + __builtin_bit_cast(float, b.x << 16), v0[1] + __builtin_bit_cast(float, b.x & 0xffff0000u)); w.y = cvt_pk_bf16(v0[2] + __builtin_bit_cast(float, b.y << 16), v0[3] + __builtin_bit_cast(float, b.y & 0xffff0000u));
                    w.z = cvt_pk_bf16(v1[0] + __builtin_bit_cast(float, b.z << 16), v1[1] + __builtin_bit_cast(float, b.z & 0xffff0000u)); w.w = cvt_pk_bf16(v1[2] + __builtin_bit_cast(float, b.w << 16), v1[3] + __builtin_bit_cast(float, b.w & 0xffff0000u));
                    *(PG8_GAS u32x4*)(out + ro + bj * HALF) = w; } }
    }
};
struct EpiResid {
    static constexpr bool PERM = false, AFTER_DRAIN = false, PREFETCH = false;
    const float* base; float* out; int ldc;
    __device__ __forceinline__ void operator()(const f32x4 (&acc)[2][2][4][2], const Unit& u, int wr, int wc, int fr, int fq) const {
        const int row0 = u.pm * BM + wr * 64 + fr, col0 = u.pc * BM + wc * 32 + 4 * fq;
#pragma unroll
        for (int ai = 0; ai < 2; ++ai)
#pragma unroll
            for (int m = 0; m < 4; ++m) { const size_t ro = (size_t)(row0 + ai * HALF + m * 16) * ldc + col0;
#pragma unroll
                for (int bj = 0; bj < 2; ++bj)
#pragma unroll
                    for (int n = 0; n < 2; ++n) { const size_t o = ro + bj * HALF + n * 16;
                        const f32x4 b = *(const PG8_GAS f32x4*)(base + o); *(PG8_GAS f32x4*)(out + o) = b + acc[ai][bj][m][n]; } }
    }
};
template <class Epi, class Sched, bool ALIGN_EPI = false, bool SP2 = false, int DT = 0>
__device__ __forceinline__ void gemm_phase(PG8_LAS unsigned char* lds, const Gemm g, const Sched& S, const Epi& E, int tid_in) {
    int tid_ = tid_in; asm volatile("" : "+v"(tid_));
    const int tid = tid_, wid = __builtin_amdgcn_readfirstlane(tid >> 6), lane = tid & 63, wr = wid >> 2, wc = wid & 3, fr = lane & 15, fq = lane >> 4;
    const int K = g.K, nt = K / BK;
    unsigned voffA[2], voffB[2];
#pragma unroll
    for (int i = 0; i < 2; ++i) { int R, C; stage_rc(tid * 16 + i * 8192, R, C); const int Rb = Epi::PERM ? ((R & ~31) + perm32(R & 31)) : R;
        voffA[i] = (unsigned)(R * g.lda + C) * 2u; voffB[i] = (unsigned)(Rb * g.ldb + C) * 2u; }
    const size_t kstep = (size_t)(BK * 2);
    const size_t hstepA = (size_t)HALF * g.lda * 2, hstepB = (size_t)HALF * g.ldb * 2;
    const size_t tstepA = 2 * hstepA, tstepB = 2 * hstepB;
    const unsigned ldsw = (unsigned)wid * 1024u;
    const int aoff = lds_byte(wr * 64 + fr, fq * 8), boff = lds_byte(wc * 32 + fr, fq * 8);
#define PG8_SA(b, h) (((b) * 2 + (h)) * HTB)
#define PG8_SB(b, h) ((4 + (b) * 2 + (h)) * HTB)
#define PG8_STAGE(bufoff, gbase, voff) do { _Pragma("unroll") for (int _i = 0; _i < 2; ++_i) \
        __builtin_amdgcn_global_load_lds((const unsigned*)((const char*)(gbase) + (voff)[_i]), (PG8_LAS unsigned*)(lds + (bufoff) + ldsw + _i * 8192), 16, 0, 0); } while (0)
#define PG8_LD16(base, off) (*(const PG8_LAS v4i_t*)((base) + (off)))
#define PG8_LDA(dst, b, h) do { if constexpr (DT == 1) { _Pragma("unroll") for (int m = 0; m < 4; ++m) A8[m] = __builtin_shufflevector(PG8_LD16(abase8, ((b) * 2 + (h)) * HTB + m * 2048), PG8_LD16(abase8, ((b) * 2 + (h)) * HTB + m * 2048 + 1024), 0, 1, 2, 3, 4, 5, 6, 7); } \
        else { _Pragma("unroll") for (int m = 0; m < 4; ++m) _Pragma("unroll") for (int k = 0; k < 2; ++k) dst[m][k] = *(const PG8_LAS bf16x8*)(lds + PG8_SA(b, h) + aoff + m * 2048 + k * 1024); } } while (0)
#define PG8_LDB(dst, b, h) do { if constexpr (DT == 1) { _Pragma("unroll") for (int n = 0; n < 2; ++n) dst##8[n] = __builtin_shufflevector(PG8_LD16(bbase8, ((b) * 2 + (h)) * HTB + n * 2048), PG8_LD16(bbase8, ((b) * 2 + (h)) * HTB + n * 2048 + 1024), 0, 1, 2, 3, 4, 5, 6, 7); } \
        else { _Pragma("unroll") for (int n = 0; n < 2; ++n) _Pragma("unroll") for (int k = 0; k < 2; ++k) dst[n][k] = *(const PG8_LAS bf16x8*)(lds + PG8_SB(b, h) + boff + n * 2048 + k * 1024); } } while (0)
#define PG8_MMA(ai, bj, At, Bt, first) do { __builtin_amdgcn_s_setprio(1); \
        if constexpr (DT == 1) { if (first) { _Pragma("unroll") for (int m = 0; m < 4; ++m) _Pragma("unroll") for (int n = 0; n < 2; ++n) \
            asm volatile("v_mfma_f32_16x16x128_f8f6f4 %0, %1, %2, 0" : "=v"(acc[ai][bj][m][n]) : "v"(Bt##8[n]), "v"(A8[m])); } \
          else { _Pragma("unroll") for (int m = 0; m < 4; ++m) _Pragma("unroll") for (int n = 0; n < 2; ++n) \
            asm volatile("v_mfma_f32_16x16x128_f8f6f4 %0, %1, %2, %0" : "+v"(acc[ai][bj][m][n]) : "v"(Bt##8[n]), "v"(A8[m])); } } \
        else if constexpr (DT == 2) {   \
          if (first) { _Pragma("unroll") for (int m = 0; m < 4; ++m) _Pragma("unroll") for (int n = 0; n < 2; ++n) \
            asm volatile("v_mfma_i32_16x16x64_i8 %0, %1, %2, 0" : "=v"(acc[ai][bj][m][n]) : "v"(Bt[n][0]), "v"(At[m][0])); } \
          else { _Pragma("unroll") for (int m = 0; m < 4; ++m) _Pragma("unroll") for (int n = 0; n < 2; ++n) \
            asm volatile("v_mfma_i32_16x16x64_i8 %0, %1, %2, %0" : "+v"(acc[ai][bj][m][n]) : "v"(Bt[n][0]), "v"(At[m][0])); } \
          _Pragma("unroll") for (int m = 0; m < 4; ++m) _Pragma("unroll") for (int n = 0; n < 2; ++n) \
            asm volatile("v_mfma_i32_16x16x64_i8 %0, %1, %2, %0" : "+v"(acc[ai][bj][m][n]) : "v"(Bt[n][1]), "v"(At[m][1])); } \
        else { _Pragma("unroll") for (int m = 0; m < 4; ++m) _Pragma("unroll") for (int n = 0; n < 2; ++n) _Pragma("unroll") for (int k = 0; k < 2; ++k) \
            acc[ai][bj][m][n] = __builtin_amdgcn_mfma_f32_16x16x32_bf16(Bt[n][k], At[m][k], acc[ai][bj][m][n], 0, 0, 0); } \
        __builtin_amdgcn_s_setprio(0); } while (0)
#define PG8_WAIT_V(n) asm volatile("s_waitcnt vmcnt(" #n ")" ::: "memory")
#define PG8_WAIT_L(n) asm volatile("s_waitcnt lgkmcnt(" #n ")" ::: "memory")
#define PG8_BAR __builtin_amdgcn_s_barrier()
#define PG8_SCHED __builtin_amdgcn_sched_barrier(0)
    Unit cur, nxt; int ui = 0;
    if (!S.next(0, cur)) return;
    f32x4 acc[2][2][4][2];
    if constexpr (DT == 0) {
#pragma unroll
        for (int a = 0; a < 2; ++a)
#pragma unroll
            for (int b = 0; b < 2; ++b)
#pragma unroll
                for (int m = 0; m < 4; ++m)
#pragma unroll
                    for (int n = 0; n < 2; ++n) acc[a][b][m][n] = (f32x4){0.f, 0.f, 0.f, 0.f};
    }
    PG8_LAS unsigned char* abase8 = lds + aoff; PG8_LAS unsigned char* bbase8 = lds + 4 * HTB + boff; asm volatile("" : "+v"(abase8), "+v"(bbase8));
    bf16x8 At[4][2], B0[2][2], B1[2][2]; v8i_t A8[4], B08[2], B18[2];
    const char* cA = (const char*)g.A + (size_t)cur.pm * tstepA; const char* cB = (const char*)g.Bt + (size_t)cur.pn * tstepB;
    S.a_ready(cur);
    if constexpr (Epi::PREFETCH) E.prefetch(cur, lds + EPI_SC_OFF, wid, lane);
    if constexpr (SP2) {
        PG8_STAGE(PG8_SB(0, 0), cB, voffB); PG8_STAGE(PG8_SB(0, 1), cB + hstepB, voffB); PG8_STAGE(PG8_SA(0, 0), cA, voffA); PG8_STAGE(PG8_SA(0, 1), cA + hstepA, voffA);
        if (wr == 1) PG8_BAR;
        PG8_WAIT_V(2); PG8_BAR;
        PG8_STAGE(PG8_SB(1, 0), cB + kstep, voffB); PG8_STAGE(PG8_SA(1, 0), cA + kstep, voffA); PG8_STAGE(PG8_SB(1, 1), cB + hstepB + kstep, voffB);
        PG8_WAIT_V(6); PG8_BAR;
    } else {
        PG8_STAGE(PG8_SB(0, 0), cB, voffB); PG8_STAGE(PG8_SA(0, 0), cA, voffA); PG8_STAGE(PG8_SB(0, 1), cB + hstepB, voffB); PG8_STAGE(PG8_SA(0, 1), cA + hstepA, voffA);
        if (wr == 1) PG8_BAR;
        PG8_WAIT_V(4); PG8_BAR;
        PG8_STAGE(PG8_SB(1, 0), cB + kstep, voffB); PG8_STAGE(PG8_SA(1, 0), cA + kstep, voffA); PG8_STAGE(PG8_SB(1, 1), cB + hstepB + kstep, voffB);
        PG8_WAIT_V(6); PG8_BAR;
    }
    for (;;) {
        const bool has_next = S.next(ui + 1, nxt);
        const char* nA = has_next ? (const char*)g.A + (size_t)nxt.pm * tstepA : cA; const char* nB = has_next ? (const char*)g.Bt + (size_t)nxt.pn * tstepB : cB;
#define PG8_ITER(FIRST) \
            const bool last = (t == nt - 2); \
            const char* a1 = cA + (size_t)(t + 1) * kstep; \
            const char* a2 = last ? nA : cA + (size_t)(t + 2) * kstep; const char* b2 = last ? nB : cB + (size_t)(t + 2) * kstep; \
            const char* a3 = a2 + kstep; const char* b3 = b2 + kstep; \
            if (last && has_next) S.a_ready(nxt); \
            if constexpr (SP2) { \
            PG8_LDB(B0, 0, 0); PG8_LDB(B1, 0, 1); PG8_SCHED; PG8_LDA(At, 0, 0); PG8_STAGE(PG8_SA(1, 1), a1 + hstepA, voffA); \
            PG8_WAIT_V(8); PG8_WAIT_L(0); PG8_BAR; PG8_MMA(0, 0, At, B0, FIRST); PG8_MMA(0, 1, At, B1, FIRST); PG8_BAR; PG8_SCHED; \
            PG8_LDA(At, 0, 1); PG8_STAGE(PG8_SB(0, 0), b2, voffB); PG8_STAGE(PG8_SB(0, 1), b2 + hstepB, voffB); PG8_STAGE(PG8_SA(0, 0), a2, voffA); \
            PG8_WAIT_V(8); PG8_WAIT_L(0); PG8_BAR; PG8_MMA(1, 0, At, B0, FIRST); PG8_MMA(1, 1, At, B1, FIRST); PG8_BAR; PG8_SCHED; \
            PG8_LDB(B0, 1, 0); PG8_LDB(B1, 1, 1); PG8_SCHED; PG8_LDA(At, 1, 0); PG8_STAGE(PG8_SA(0, 1), a2 + hstepA, voffA); \
            PG8_WAIT_V(8); PG8_WAIT_L(0); PG8_BAR; PG8_MMA(0, 0, At, B0, false); PG8_MMA(0, 1, At, B1, false); PG8_BAR; PG8_SCHED; \
            PG8_LDA(At, 1, 1); PG8_STAGE(PG8_SB(1, 0), b3, voffB); PG8_STAGE(PG8_SB(1, 1), b3 + hstepB, voffB); PG8_STAGE(PG8_SA(1, 0), a3, voffA); \
            PG8_WAIT_V(8); PG8_WAIT_L(0); PG8_BAR; PG8_MMA(1, 0, At, B0, false); PG8_MMA(1, 1, At, B1, false); PG8_BAR; PG8_SCHED; \
            } else { \
            PG8_LDB(B0, 0, 0); PG8_SCHED; PG8_LDA(At, 0, 0); PG8_STAGE(PG8_SA(1, 1), a1 + hstepA, voffA); \
            PG8_WAIT_L(8); PG8_BAR; PG8_WAIT_L(0); PG8_MMA(0, 0, At, B0, FIRST); PG8_BAR; PG8_SCHED; \
            PG8_LDB(B1, 0, 1); PG8_STAGE(PG8_SB(0, 0), b2, voffB); \
            PG8_BAR; PG8_WAIT_L(0); PG8_MMA(0, 1, At, B1, FIRST); PG8_BAR; \
            PG8_LDA(At, 0, 1); PG8_STAGE(PG8_SA(0, 0), a2, voffA); \
            PG8_BAR; PG8_WAIT_L(0); PG8_MMA(1, 0, At, B0, FIRST); PG8_BAR; PG8_SCHED; \
            PG8_STAGE(PG8_SB(0, 1), b2 + hstepB, voffB); \
            PG8_WAIT_V(6); PG8_BAR; PG8_MMA(1, 1, At, B1, FIRST); PG8_BAR; \
            PG8_LDB(B0, 1, 0); PG8_SCHED; PG8_LDA(At, 1, 0); PG8_STAGE(PG8_SA(0, 1), a2 + hstepA, voffA); \
            PG8_WAIT_L(8); PG8_BAR; PG8_WAIT_L(0); PG8_MMA(0, 0, At, B0, false); PG8_BAR; PG8_SCHED; \
            PG8_LDB(B1, 1, 1); PG8_STAGE(PG8_SB(1, 0), b3, voffB); \
            PG8_BAR; PG8_WAIT_L(0); PG8_MMA(0, 1, At, B1, false); PG8_BAR; \
            PG8_LDA(At, 1, 1); PG8_STAGE(PG8_SA(1, 0), a3, voffA); \
            PG8_BAR; PG8_WAIT_L(0); PG8_MMA(1, 0, At, B0, false); PG8_BAR; PG8_SCHED; \
            PG8_STAGE(PG8_SB(1, 1), b3 + hstepB, voffB); \
            PG8_WAIT_V(6); PG8_BAR; PG8_MMA(1, 1, At, B1, false); PG8_BAR; \
            }
        int t = 0;
        if constexpr (DT != 0) { PG8_ITER(true) t = 2; }
#pragma clang loop unroll(disable)
        for (; t < nt; t += 2) {
            PG8_ITER(false)
        }
#undef PG8_ITER
        if constexpr (DT != 0) asm volatile("s_nop 15\n\ts_nop 15" ::: "memory");
        if constexpr (ALIGN_EPI) { if (wr == 0) PG8_BAR; }
        if constexpr (Epi::PREFETCH) { E.run(acc, cur, wr, wc, fr, fq, (const PG8_LAS float*)(lds + EPI_SC_OFF + (ui & 1) * 2048)); S.done(cur);
            if (has_next) E.prefetch(nxt, lds + EPI_SC_OFF + ((ui + 1) & 1) * 2048, wid, lane); }
        else if constexpr (!Epi::AFTER_DRAIN) { E(acc, cur, wr, wc, fr, fq); S.done(cur); }
        if (!has_next) break;
        if constexpr (DT == 0) {
#pragma unroll
        for (int a = 0; a < 2; ++a)
#pragma unroll
            for (int b = 0; b < 2; ++b)
#pragma unroll
                for (int m = 0; m < 4; ++m)
#pragma unroll
                    for (int n = 0; n < 2; ++n) acc[a][b][m][n] = (f32x4){0.f, 0.f, 0.f, 0.f};
        }
        cur = nxt; cA = nA; cB = nB; ++ui;
        if constexpr (ALIGN_EPI) { if (wr == 1) PG8_BAR; }
    }
    PG8_WAIT_V(0);
    if constexpr (!ALIGN_EPI) { if (wr == 0) PG8_BAR; }
    PG8_BAR;
    if constexpr (Epi::AFTER_DRAIN) { E.fused(acc, cur, wr, wc, fr, fq, lds, wid, lane); S.done(cur); }
#undef PG8_SA
#undef PG8_SB
#undef PG8_STAGE
#undef PG8_LD16
#undef PG8_LDA
#undef PG8_LDB
#undef PG8_MMA
#undef PG8_WAIT_V
#undef PG8_WAIT_L
#undef PG8_BAR
#undef PG8_SCHED
}
}
constexpr int NWAVES = 8;
constexpr int NB = 32, SEQ = 2048, DM = 1024, NTOK = NB * SEQ;
constexpr int IN_E = 1952, IN_E_PAD = 2048, DFF = 2816, DFFX = 3584, NEXP = 8;
constexpr int MOE_CHUNK = 15360, N_CHUNK = (NTOK + MOE_CHUNK - 1) / MOE_CHUNK, CHUNK_SLOTS = 2 * MOE_CHUNK + NEXP * 256;
constexpr float NORM_EPS = 1e-6f, LOG2E = 1.4426950408889634f;

constexpr size_t MiB = 1u << 20;
constexpr size_t WS_CTL = 0, CTL_ZERO_BYTES = 1 * MiB;
constexpr size_t WS_ROPE = 1 * MiB;
constexpr size_t WS_ROUTE_I = 2 * MiB;
constexpr size_t WS_ROUTE_W = 3 * MiB;
constexpr size_t WS_WEV = 4 * MiB, EV_STRIDE = 24 * MiB;
constexpr size_t EV_WIN = 0, EV_WUQ = 4 * MiB, EV_WUKV = 4 * MiB + 512 * 1024, EV_WOUT = 5 * MiB, EV_WGU = 7 * MiB, EV_WD = 18 * MiB;
constexpr size_t WS_WOD = 52 * MiB, OD_STRIDE = 8 * MiB;
constexpr size_t OD_WQKV = 0, OD_WO = 6 * MiB;
constexpr size_t WS_MWGU = 68 * MiB;
constexpr size_t WS_MWD = 180 * MiB;
constexpr size_t WS_H = 236 * MiB;
constexpr size_t WS_BIG = 364 * MiB;
constexpr size_t WS_PROJ = WS_BIG, WS_QM = WS_BIG + 256 * MiB, WS_KVM = WS_BIG + 352 * MiB, WS_KPE = WS_BIG + 480 * MiB;
constexpr size_t WS_ACT = WS_BIG;
constexpr size_t WS_QKV = WS_BIG;
constexpr size_t WS_YALL = WS_BIG, WS_HG8 = WS_BIG + 32 * MiB, WS_MACT = WS_BIG + 320 * MiB;
constexpr size_t WS_DP1 = 848 * MiB, WS_DP2 = 912 * MiB, WS_DL1 = 976 * MiB, WS_DL2 = 978 * MiB;
constexpr size_t WS_SA = 980 * MiB;
constexpr size_t WS_SB = 981 * MiB;
constexpr size_t WS_END = 982 * MiB;
static_assert(WS_MACT + 2 * (size_t)CHUNK_SLOTS * DFFX <= WS_DP1 + 132 * MiB && WS_KPE + (size_t)NTOK * 64 <= WS_DP1 && WS_YALL + (size_t)N_CHUNK * CHUNK_SLOTS * DM * 2 <= WS_MACT && (size_t)CHUNK_SLOTS * DM == 32 * MiB, "ws map");
constexpr int CW_BAR = 4096;
constexpr int CW_WMAX = 12288;
constexpr int CW_CNT = 16384;

constexpr int RING_BYTES = 131072, LDSCTL_OFF = RING_BYTES, MISC_OFF = LDSCTL_OFF + 320, LDS_BYTES = 163840, RPB_OFF = 132096;

#define GAS __attribute__((address_space(1)))
#define LAS __attribute__((address_space(3)))
typedef unsigned short bf16;
typedef unsigned v4u __attribute__((ext_vector_type(4)));
typedef unsigned v2u __attribute__((ext_vector_type(2)));
typedef int v4i __attribute__((ext_vector_type(4)));
typedef float f32x4 __attribute__((ext_vector_type(4)));
typedef float f32x2 __attribute__((ext_vector_type(2)));
#define LDS_WAIT() asm volatile("s_waitcnt lgkmcnt(0)" ::: "memory")
#define VM_WAIT() asm volatile("s_waitcnt vmcnt(0)" ::: "memory")
__device__ __forceinline__ unsigned f2bf(float f) { unsigned u = __builtin_bit_cast(unsigned, f); return (u + 0x7fffu + ((u >> 16) & 1u)) >> 16; }
#if defined(__HIP_DEVICE_COMPILE__)
#define GLOBAL_AS __attribute__((address_space(1)))
#else
#define GLOBAL_AS
#endif
__device__ __forceinline__ unsigned pk2(float lo, float hi) { return f2bf(lo) | (f2bf(hi) << 16); }
__device__ __forceinline__ float bflo(unsigned w) { return __builtin_bit_cast(float, w << 16); }
__device__ __forceinline__ float bfhi(unsigned w) { return __builtin_bit_cast(float, w & 0xffff0000u); }
template <int CTRL> __device__ __forceinline__ float dppf(float v) { return __builtin_bit_cast(float, __builtin_amdgcn_mov_dpp(__builtin_bit_cast(int, v), CTRL, 0xF, 0xF, true)); }
__device__ __forceinline__ void swap16(unsigned& a, unsigned& b) { asm("s_nop 1\n\tv_permlane16_swap_b32 %0, %1\n\ts_nop 1" : "+v"(a), "+v"(b)); }
__device__ __forceinline__ void swap32(unsigned& a, unsigned& b) { asm("s_nop 1\n\tv_permlane32_swap_b32 %0, %1\n\ts_nop 1" : "+v"(a), "+v"(b)); }
__device__ __forceinline__ float wsum_all(float v) {
    v += dppf<0xB1>(v); v += dppf<0x4E>(v); v += dppf<0x141>(v); v += dppf<0x140>(v);
    unsigned a = __builtin_bit_cast(unsigned, v), b = a; swap16(a, b); v = __builtin_bit_cast(float, a) + __builtin_bit_cast(float, b);
    a = __builtin_bit_cast(unsigned, v); b = a; swap32(a, b); return __builtin_bit_cast(float, a) + __builtin_bit_cast(float, b);
}
__device__ __forceinline__ float wmax_all(float v) {
    v = fmaxf(v, dppf<0xB1>(v)); v = fmaxf(v, dppf<0x4E>(v)); v = fmaxf(v, dppf<0x141>(v)); v = fmaxf(v, dppf<0x140>(v));
    unsigned a = __builtin_bit_cast(unsigned, v), b = a; swap16(a, b); v = fmaxf(__builtin_bit_cast(float, a), __builtin_bit_cast(float, b));
    a = __builtin_bit_cast(unsigned, v); b = a; swap32(a, b); return fmaxf(__builtin_bit_cast(float, a), __builtin_bit_cast(float, b));
}
constexpr int LDX = 2048;
__device__ __forceinline__ f32x4 ldx4(const bf16* row, int idx) { const v2u w = ((const GLOBAL_AS v2u*)row)[idx]; return (f32x4){bflo(w.x), bfhi(w.x), bflo(w.y), bfhi(w.y)}; }
__device__ __forceinline__ void stx4(bf16* row, int idx, f32x4 v) { v2u w; w.x = pk2(v.x, v.y); w.y = pk2(v.z, v.w); ((GLOBAL_AS v2u*)row)[idx] = w; }
__device__ __forceinline__ float ex2(float x) { return __builtin_amdgcn_exp2f(x); }

#define XB_TMO      128
#define XB_XCNT(j)  (256  + 64 * (j))
#define XB_XSUB(j)  (1280 + 64 * (j))
#define XB_XGEN(j)  (2304 + 64 * (j))
#define XB_TOP      3328
#define XB_TOPGEN   3392
#define XCD_BAR_WORDS 3456
#define XB_SPIN_CAP (1u << 22)

__device__ __forceinline__ unsigned xb_ld(unsigned* p)              { return __hip_atomic_load(p, __ATOMIC_RELAXED, __HIP_MEMORY_SCOPE_AGENT); }
__device__ __forceinline__ unsigned xb_add(unsigned* p, unsigned v) { return __hip_atomic_fetch_add(p, v, __ATOMIC_RELAXED, __HIP_MEMORY_SCOPE_AGENT); }
__device__ __forceinline__ unsigned xb_xcc_id() { return (unsigned)__builtin_amdgcn_s_getreg((3 << 11) | 20) & 0xFu; }
#define XB_SPIN(cond, bar) do { unsigned _sp = 0; while (cond) { __builtin_amdgcn_s_sleep(1); \
    if ((++_sp & 255u) == 0u) { if (xb_ld(&(bar)[XB_TMO])) break; if (_sp > XB_SPIN_CAP) { atomicAdd(&(bar)[XB_TMO], 1u); break; } } } } while (0)

struct XcdBarrier {
    unsigned* bar; unsigned x;
    volatile LAS unsigned* st;
};

__device__ __forceinline__ XcdBarrier xcd_barrier_post(unsigned* bar, volatile LAS unsigned* st) {
    XcdBarrier b; b.bar = bar; b.x = xb_xcc_id(); b.st = st;
    if (threadIdx.x == 0) (void)xb_add(&bar[XB_XCNT(b.x)], 1u);
    return b;
}
__device__ __forceinline__ void xcd_barrier_complete(unsigned* bar, unsigned x, unsigned& nloc, unsigned& nx) {
    const unsigned G = gridDim.x * gridDim.y * gridDim.z;
    unsigned sum, cnt, mine, sp = 0u;
    for (;;) {
        sum = 0u; cnt = 0u; mine = 0u;
#pragma unroll
        for (unsigned j = 0; j < 16; ++j) { const unsigned c = xb_ld(&bar[XB_XCNT(j)]); sum += c; cnt += (c > 0u) ? 1u : 0u; mine = (j == x) ? c : mine; }
        if (sum == G) break;
        __builtin_amdgcn_s_sleep(1);
        if ((++sp & 255u) == 0u) { if (xb_ld(&bar[XB_TMO])) break; if (sp > XB_SPIN_CAP) { atomicAdd(&bar[XB_TMO], 1u); break; } }
    }
    nloc = mine > 0u ? mine : 1u; nx = cnt > 0u ? cnt : 1u;
}

__device__ __forceinline__ void xcd_barrier(const XcdBarrier& b, int tid) {
    asm volatile("s_waitcnt vmcnt(0)" ::: "memory");
    __syncthreads();
    if (tid == 0) {
        unsigned* bar = b.bar;
        __builtin_amdgcn_s_waitcnt(0);
        unsigned nloc = b.st[0], nx = b.st[1];
        if (nloc == 0u) { xcd_barrier_complete(bar, b.x, nloc, nx); b.st[0] = nloc; b.st[1] = nx; }
        const unsigned old = xb_add(&bar[XB_XSUB(b.x)], 1u);
        const unsigned gen = old / nloc;
        if (old + 1u == (gen + 1u) * nloc) {
            __builtin_amdgcn_fence(__ATOMIC_RELEASE, "agent");
            asm volatile("s_waitcnt vmcnt(0)" ::: "memory");
            const unsigned og = xb_add(&bar[XB_TOP], 1u);
            const unsigned tg = og / nx;
            if (og + 1u == (tg + 1u) * nx) xb_add(&bar[XB_TOPGEN], 1u);
            else XB_SPIN(xb_ld(&bar[XB_TOPGEN]) == tg, bar);
            __builtin_amdgcn_fence(__ATOMIC_ACQUIRE, "agent");
            xb_add(&bar[XB_XGEN(b.x)], 1u);
            asm volatile("s_waitcnt vmcnt(0)" ::: "memory");
        } else {
            XB_SPIN(xb_ld(&bar[XB_XGEN(b.x)]) == gen, bar);
            __builtin_amdgcn_fence(__ATOMIC_ACQUIRE, "agent");
            asm volatile("s_waitcnt vmcnt(0)" ::: "memory");
        }
    }
    __syncthreads();
}
__device__ __forceinline__ float wave_sum(float v, int lane) {
#pragma unroll
    for (int o = 1; o < 64; o <<= 1) v += __builtin_bit_cast(float, __builtin_amdgcn_ds_bpermute((lane ^ o) << 2, __builtin_bit_cast(int, v)));
    return v;
}
__device__ __forceinline__ void cvt_item(const float* W, int N, bf16* WT, int ldo, int dst_row0, int k0, int n0, LAS float* scr, int lane) {
    float wv[32];
#pragma unroll
    for (int i = 0; i < 32; ++i) wv[i] = W[(size_t)(k0 + 2 * i + (lane >> 5)) * N + n0 + (lane & 31)];
#pragma unroll
    for (int i = 0; i < 32; ++i) scr[(2 * i + (lane >> 5)) * 33 + (lane & 31)] = wv[i];
    LDS_WAIT(); asm volatile("" ::: "memory");
    const int c = lane & 7;
#pragma unroll
    for (int j = 0; j < 4; ++j) { const int n = (lane >> 3) + 8 * j; const LAS float* s = scr + (8 * c) * 33 + n;
        v4u o; o.x = pk2(s[0 * 33], s[1 * 33]); o.y = pk2(s[2 * 33], s[3 * 33]); o.z = pk2(s[4 * 33], s[5 * 33]); o.w = pk2(s[6 * 33], s[7 * 33]);
        *(GLOBAL_AS v4u*)(WT + (size_t)(dst_row0 + n) * ldo + k0 + 8 * c) = o; }
    LDS_WAIT(); asm volatile("" ::: "memory");
}
__device__ __forceinline__ void cvt_item8(const float* W, int N, unsigned char* WT, int ldo, int dst_row0, int k0, int n0, LAS float* scr, int lane, float scale) {
    float wv[32];
#pragma unroll
    for (int i = 0; i < 32; ++i) wv[i] = W[(size_t)(k0 + 2 * i + (lane >> 5)) * N + n0 + (lane & 31)];
#pragma unroll
    for (int i = 0; i < 32; ++i) scr[(2 * i + (lane >> 5)) * 33 + (lane & 31)] = wv[i] * scale;
    LDS_WAIT(); asm volatile("" ::: "memory");
    const int c = lane & 3;
#pragma unroll
    for (int j = 0; j < 2; ++j) { const int n = (lane >> 2) + 16 * j; const LAS float* s = scr + (16 * c) * 33 + n;
        v4u o; o.x = pg8::cvt4_fp8(s[0 * 33], s[1 * 33], s[2 * 33], s[3 * 33]); o.y = pg8::cvt4_fp8(s[4 * 33], s[5 * 33], s[6 * 33], s[7 * 33]);
        o.z = pg8::cvt4_fp8(s[8 * 33], s[9 * 33], s[10 * 33], s[11 * 33]); o.w = pg8::cvt4_fp8(s[12 * 33], s[13 * 33], s[14 * 33], s[15 * 33]);
        *(GLOBAL_AS v4u*)(WT + (size_t)(dst_row0 + n) * ldo + k0 + 16 * c) = o; }
    LDS_WAIT(); asm volatile("" ::: "memory");
}
__device__ __forceinline__ void cvt_job8(const float* W, int K, int N, unsigned char* WT, int ldo, int rowmap, int item, LAS float* scr, int lane, float scale) {
    const int nblk = N / 32, kb = item / nblk, nb = item % nblk, n0 = 32 * nb;
    int dr = n0; if (rowmap) dr = (n0 >> 7) * 256 + (n0 & 127) + (rowmap == 2 ? 128 : 0);
    cvt_item8(W, N, WT, ldo, dr, 64 * kb, n0, scr, lane, scale);
}
__device__ __forceinline__ unsigned pack4_i8(float a, float b, float c, float d) {
    const int qa = (int)__builtin_rintf(a), qb = (int)__builtin_rintf(b), qc = (int)__builtin_rintf(c), qd = (int)__builtin_rintf(d);
    return (unsigned)(qa & 255) | ((unsigned)(qb & 255) << 8) | ((unsigned)(qc & 255) << 16) | ((unsigned)(qd & 255) << 24);
}
__device__ __forceinline__ void cvt_item_i8(const float* W, int N, unsigned char* WT, int ldo, int dst_row0, int k0, int n0, LAS float* scr, int lane, float inv) {
    float wv[32];
#pragma unroll
    for (int i = 0; i < 32; ++i) wv[i] = W[(size_t)(k0 + 2 * i + (lane >> 5)) * N + n0 + (lane & 31)];
#pragma unroll
    for (int i = 0; i < 32; ++i) scr[(2 * i + (lane >> 5)) * 33 + (lane & 31)] = __builtin_amdgcn_fmed3f(wv[i] * inv, -127.0f, 127.0f);
    LDS_WAIT(); asm volatile("" ::: "memory");
    const int c = lane & 3;
#pragma unroll
    for (int j = 0; j < 2; ++j) { const int n = (lane >> 2) + 16 * j; const LAS float* s = scr + (16 * c) * 33 + n;
        v4u o; o.x = pack4_i8(s[0 * 33], s[1 * 33], s[2 * 33], s[3 * 33]); o.y = pack4_i8(s[4 * 33], s[5 * 33], s[6 * 33], s[7 * 33]);
        o.z = pack4_i8(s[8 * 33], s[9 * 33], s[10 * 33], s[11 * 33]); o.w = pack4_i8(s[12 * 33], s[13 * 33], s[14 * 33], s[15 * 33]);
        *(GLOBAL_AS v4u*)(WT + (size_t)(dst_row0 + n) * ldo + k0 + 16 * c) = o; }
    LDS_WAIT(); asm volatile("" ::: "memory");
}
__device__ __forceinline__ void cvt_job_i8(const float* W, int K, int N, unsigned char* WT, int ldo, int item, LAS float* scr, int lane, float inv, int rowmap = 0) {
    const int nblk = N / 32, kb = item / nblk, nb = item % nblk, n0 = 32 * nb;
    int dr = n0; if (rowmap) dr = (n0 >> 7) * 256 + (n0 & 127) + (rowmap == 2 ? 128 : 0);
    cvt_item_i8(W, N, WT, ldo, dr, 64 * kb, n0, scr, lane, inv);
}
__device__ __forceinline__ void cvt_job(const float* W, int K, int N, bf16* WT, int ldo, int rowmap, int item, LAS float* scr, int lane) {
    const int nblk = N / 32, kb = item / nblk, nb = item % nblk, n0 = 32 * nb;
    int dr = n0; if (rowmap) dr = (n0 >> 7) * 256 + (n0 & 127) + (rowmap == 2 ? 128 : 0);
    cvt_item(W, N, WT, ldo, dr, 64 * kb, n0, scr, lane);
}
__device__ const double ROPE_F[16] = {0.15915494309189535, 0.08949940160889101, 0.050329212104487035, 0.0283021958306234, 0.015915494309189534, 0.008949940160889102, 0.005032921210448704, 0.00283021958306234,
    0.0015915494309189536, 0.0008949940160889102, 0.0005032921210448703, 0.00028302195830623395, 0.00015915494309189535, 8.949940160889102e-05, 5.0329212104487035e-05, 2.8302195830623396e-05};

struct Ctx {
    float* out; unsigned char* ws; LAS unsigned char* lds; int tid, lane, wave, G, gw, NGW;
};

__device__ __forceinline__ void cvt_strip_i8(const float* W, int K, int N, unsigned char* WT, int ldo, float* sb, int rowmap, int strip, LAS float* scr, int lane) {
    const int n0 = 32 * strip; int dr = n0; if (rowmap) dr = (n0 >> 7) * 256 + (n0 & 127) + (rowmap == 2 ? 128 : 0);
    const float* col = W + n0 + (lane & 31) + (size_t)(lane >> 5) * N;
    float mx = 0.f;
    for (int k0 = 0; k0 < K; k0 += 64) { float wv[32];
#pragma unroll
        for (int i = 0; i < 32; ++i) wv[i] = col[(size_t)(k0 + 2 * i) * N];
#pragma unroll
        for (int i = 0; i < 32; ++i) mx = fmaxf(mx, fabsf(wv[i])); }
    mx = fmaxf(mx, __builtin_bit_cast(float, __builtin_amdgcn_ds_bpermute((lane ^ 32) << 2, __builtin_bit_cast(int, mx))));
    mx = fmaxf(mx, 1e-30f); const float inv = 127.0f / mx;
    if (lane < 32) sb[dr + lane] = mx * (1.0f / 127.0f);
    for (int k0 = 0; k0 < K; k0 += 64) { float wv[32];
#pragma unroll
        for (int i = 0; i < 32; ++i) wv[i] = col[(size_t)(k0 + 2 * i) * N];
#pragma unroll
        for (int i = 0; i < 32; ++i) scr[(2 * i + (lane >> 5)) * 33 + (lane & 31)] = wv[i] * inv;
        LDS_WAIT(); asm volatile("" ::: "memory");
        const int c = lane & 3;
#pragma unroll
        for (int j = 0; j < 2; ++j) { const int n = (lane >> 2) + 16 * j; const LAS float* s = scr + (16 * c) * 33 + n;
            v4u o; o.x = pack4_i8(s[0 * 33], s[1 * 33], s[2 * 33], s[3 * 33]); o.y = pack4_i8(s[4 * 33], s[5 * 33], s[6 * 33], s[7 * 33]);
            o.z = pack4_i8(s[8 * 33], s[9 * 33], s[10 * 33], s[11 * 33]); o.w = pack4_i8(s[12 * 33], s[13 * 33], s[14 * 33], s[15 * 33]);
            *(GLOBAL_AS v4u*)(WT + (size_t)(dr + n) * ldo + k0 + 16 * c) = o; }
        LDS_WAIT(); asm volatile("" ::: "memory"); }
}
__device__ __forceinline__ void cvt_strip_i8_wg(const float* W, int N, unsigned char* WT, int ldo, float* sb, int rowmap, int strip, LAS unsigned char* lds, int wave, int lane) {
    const int n0 = 32 * strip; int dr = n0; if (rowmap) dr = (n0 >> 7) * 256 + (n0 & 127) + (rowmap == 2 ? 128 : 0);
    const float* col = W + n0 + (lane & 31) + (size_t)(lane >> 5) * N;
    LAS float* scr = (LAS float*)(lds + wave * 16384); LAS float* pm = (LAS float*)(lds + 12288);
    float wv[2][32]; float mx = 0.f;
#pragma unroll
    for (int c = 0; c < 2; ++c)
#pragma unroll
        for (int i = 0; i < 32; ++i) wv[c][i] = col[(size_t)(64 * (2 * wave + c) + 2 * i) * N];
#pragma unroll
    for (int c = 0; c < 2; ++c)
#pragma unroll
        for (int i = 0; i < 32; ++i) mx = fmaxf(mx, fabsf(wv[c][i]));
    mx = fmaxf(mx, __builtin_bit_cast(float, __builtin_amdgcn_ds_bpermute((lane ^ 32) << 2, __builtin_bit_cast(int, mx))));
    if (lane < 32) pm[wave * 32 + lane] = mx;
    __syncthreads();
    float g = 0.f;
#pragma unroll
    for (int w = 0; w < 8; ++w) g = fmaxf(g, pm[w * 32 + (lane & 31)]);
    g = fmaxf(g, 1e-30f); const float inv = 127.0f / g;
    if (wave == 0 && lane < 32) sb[dr + lane] = g * (1.0f / 127.0f);
#pragma unroll
    for (int c = 0; c < 2; ++c) { const int k0 = 64 * (2 * wave + c);
#pragma unroll
        for (int i = 0; i < 32; ++i) scr[(2 * i + (lane >> 5)) * 33 + (lane & 31)] = wv[c][i] * inv;
        LDS_WAIT(); asm volatile("" ::: "memory");
        const int cc = lane & 3;
#pragma unroll
        for (int j = 0; j < 2; ++j) { const int n = (lane >> 2) + 16 * j; const LAS float* s = scr + (16 * cc) * 33 + n;
            v4u o; o.x = pack4_i8(s[0 * 33], s[1 * 33], s[2 * 33], s[3 * 33]); o.y = pack4_i8(s[4 * 33], s[5 * 33], s[6 * 33], s[7 * 33]);
            o.z = pack4_i8(s[8 * 33], s[9 * 33], s[10 * 33], s[11 * 33]); o.w = pack4_i8(s[12 * 33], s[13 * 33], s[14 * 33], s[15 * 33]);
            *(GLOBAL_AS v4u*)(WT + (size_t)(dr + n) * ldo + k0 + 16 * cc) = o; }
        LDS_WAIT(); asm volatile("" ::: "memory"); }
    __syncthreads();
}
template <class A> __device__ __forceinline__ void p0_prologue(const Ctx& C, const A& IN) {
    LAS float* scr = (LAS float*)(C.lds + C.wave * 16384);
    GLOBAL_AS float* sball = (GLOBAL_AS float*)(C.ws + WS_SB);
    constexpr int S0 = IN_E / 32, S4 = DFF / 32, S7 = 3072 / 32, NSTRIPS = 2 * (S0 + 2 * S4 + S7);
    constexpr int I1 = 4 * 24, I2 = 2 * 32, I3 = 16 * 32, I6 = 44 * 32, I8 = 16 * 32;
    constexpr int NITEMS = 2 * (I1 + I2 + I3 + I6 + I8);
    for (int st = blockIdx.x; st < NSTRIPS; st += C.G) {
        int r = st;
        if (r < 2 * S0) { const int ly = r / S0, q = r % S0; cvt_strip_i8_wg(IN.in[2] + (size_t)ly * DM * IN_E, IN_E, C.ws + WS_WEV + ly * EV_STRIDE + EV_WIN, DM, sball + ly * 8192, 0, q, C.lds, C.wave, C.lane); continue; } r -= 2 * S0;
        if (r < 2 * S4) { const int ly = r / S4, q = r % S4; cvt_strip_i8_wg(IN.in[9] + (size_t)ly * DM * DFF, DFF, C.ws + WS_WEV + ly * EV_STRIDE + EV_WGU, DM, sball + ly * 8192 + 2048, 1, q, C.lds, C.wave, C.lane); continue; } r -= 2 * S4;
        if (r < 2 * S4) { const int ly = r / S4, q = r % S4; cvt_strip_i8_wg(IN.in[10] + (size_t)ly * DM * DFF, DFF, C.ws + WS_WEV + ly * EV_STRIDE + EV_WGU, DM, sball + ly * 8192 + 2048, 2, q, C.lds, C.wave, C.lane); continue; } r -= 2 * S4;
        { const int ly = r / S7, q = r % S7; cvt_strip_i8_wg(IN.in[13] + (size_t)ly * DM * 3072, 3072, C.ws + WS_WOD + ly * OD_STRIDE + OD_WQKV, DM, sball + 16384 + ly * 4096, 0, q, C.lds, C.wave, C.lane); }
    }
    for (int it = C.gw; it < NITEMS; it += C.NGW) {
        int r = it;
        if (r < 2 * I1) { const int ly = r / I1, q = r % I1; cvt_job(IN.in[4] + (size_t)ly * 256 * 768, 256, 768, (bf16*)(C.ws + WS_WEV + ly * EV_STRIDE + EV_WUQ), 256, 0, q, scr, C.lane); continue; } r -= 2 * I1;
        if (r < 2 * I2) { const int ly = r / I2, q = r % I2; cvt_job(IN.in[6] + (size_t)ly * 128 * 1024, 128, 1024, (bf16*)(C.ws + WS_WEV + ly * EV_STRIDE + EV_WUKV), 256, 0, q, scr, C.lane); continue; } r -= 2 * I2;
        if (r < 2 * I3) { const int ly = r / I3, q = r % I3; cvt_job(IN.in[7] + (size_t)ly * DM * DM, DM, DM, (bf16*)(C.ws + WS_WEV + ly * EV_STRIDE + EV_WOUT), DM, 0, q, scr, C.lane); continue; } r -= 2 * I3;
        if (r < 2 * I6) { const int ly = r / I6, q = r % I6; cvt_job(IN.in[11] + (size_t)ly * DFF * DM, DFF, DM, (bf16*)(C.ws + WS_WEV + ly * EV_STRIDE + EV_WD), DFF, 0, q, scr, C.lane); continue; } r -= 2 * I6;
        { const int ly = r / I8, q = r % I8; cvt_job(IN.in[15] + (size_t)ly * DM * DM, DM, DM, (bf16*)(C.ws + WS_WOD + ly * OD_STRIDE + OD_WO), DM, 0, q, scr, C.lane); }
    }
    const int gt = blockIdx.x * (NWAVES * 64) + C.tid, NGT = C.G * NWAVES * 64;
    for (int i = gt; i < 2 * 6144; i += NGT) { const int ly = i / 6144, q = i % 6144; ((GLOBAL_AS v4u*)(C.ws + WS_WEV + ly * EV_STRIDE + EV_WIN + (size_t)IN_E * DM))[q] = (v4u){0u, 0u, 0u, 0u}; }
    for (int i = gt; i < 2 * 96; i += NGT) ((GLOBAL_AS float*)(C.ws + WS_SB))[(i / 96) * 8192 + IN_E + (i % 96)] = 0.f;
    for (int i = gt; i < 2 * 16384; i += NGT) { const int ly = i / 16384, q = i % 16384, row = q >> 4, cc = q & 15; ((GLOBAL_AS v4u*)(C.ws + WS_WEV + ly * EV_STRIDE + EV_WUKV + (size_t)row * 512 + 256))[cc] = (v4u){0u, 0u, 0u, 0u}; }
    GLOBAL_AS float* rope = (GLOBAL_AS float*)(C.ws + WS_ROPE);
    for (int i = gt; i < SEQ * 16; i += NGT) { const int t = i >> 4, k = i & 15; double fr = (double)t * ROPE_F[k]; fr -= floor(fr); const float f = (float)fr;
        rope[2 * i] = __builtin_amdgcn_cosf(f); rope[2 * i + 1] = __builtin_amdgcn_sinf(f); }
}
template <class A> __device__ __forceinline__ void moe_weights(const Ctx& C, const A& IN, int j) {
    LAS float* scr = (LAS float*)(C.lds + C.wave * 16384);
    constexpr int IG = 16 * 112, ID = 56 * 32;
    constexpr int NITEMS = NEXP * (2 * IG + ID);
    for (int it = C.gw; it < NITEMS; it += C.NGW) {
        const int e = it / (2 * IG + ID); int r = it % (2 * IG + ID);
        const size_t eo = ((size_t)j * NEXP + e) * (size_t)DM * DFFX;
        if (r < IG) { cvt_job8(IN.in[18] + eo, DM, DFFX, C.ws + WS_MWGU + (size_t)e * 7168 * DM, DM, 1, r, scr, C.lane, 32.0f); continue; } r -= IG;
        if (r < IG) { cvt_job8(IN.in[19] + eo, DM, DFFX, C.ws + WS_MWGU + (size_t)e * 7168 * DM, DM, 2, r, scr, C.lane, 32.0f); continue; } r -= IG;
        cvt_job8(IN.in[20] + eo, DFFX, DM, C.ws + WS_MWD + (size_t)e * DM * DFFX, DFFX, 0, r, scr, C.lane, 32.0f);
    }
}
template <int OUT = 0, bool XF32 = false>
__device__ __forceinline__ void norm_phase(const Ctx& C, const void* x, const float* g, bf16* H, bf16* xb = nullptr) {
    constexpr int NR = 4;
    f32x4 gg[4];
#pragma unroll
    for (int j = 0; j < 4; ++j) gg[j] = ((const GLOBAL_AS f32x4*)g)[64 * j + C.lane];
    for (int m0 = C.gw; m0 < NTOK; m0 += NR * C.NGW) {
        f32x4 v[NR][4]; float s[NR];
#pragma unroll
        for (int r = 0; r < NR; ++r) { const int m = min(m0 + r * C.NGW, NTOK - 1);
            if (XF32) { const GLOBAL_AS f32x4* xr = (const GLOBAL_AS f32x4*)((const GLOBAL_AS float*)x + (size_t)m * DM) + C.lane;
#pragma unroll
                for (int j = 0; j < 4; ++j) v[r][j] = xr[64 * j]; }
            else { const bf16* xr = (const bf16*)x + (size_t)m * LDX;
#pragma unroll
                for (int j = 0; j < 4; ++j) v[r][j] = ldx4(xr, 64 * j + C.lane); } }
#pragma unroll
        for (int r = 0; r < NR; ++r) { float a = 0.f;
#pragma unroll
            for (int j = 0; j < 4; ++j) a += (v[r][j].x * v[r][j].x + v[r][j].y * v[r][j].y) + (v[r][j].z * v[r][j].z + v[r][j].w * v[r][j].w);
            s[r] = a; }
#pragma unroll
        for (int r = 0; r < NR; ++r) s[r] = wsum_all(s[r]);
#pragma unroll
        for (int r = 0; r < NR; ++r) { const int m = m0 + r * C.NGW; if (m < NTOK) { const float rstd = 1.0f / sqrtf(s[r] * (1.0f / DM) + NORM_EPS);
            if (XF32) {
#pragma unroll
                for (int j = 0; j < 4; ++j) stx4(xb + (size_t)m * LDX, 64 * j + C.lane, v[r][j]); }
            if (OUT == 2) { f32x4 y[4]; float am = 0.f;
#pragma unroll
                for (int j = 0; j < 4; ++j) { y[j] = v[r][j] * rstd * gg[j]; am = fmaxf(fmaxf(am, fmaxf(fabsf(y[j].x), fabsf(y[j].y))), fmaxf(fabsf(y[j].z), fabsf(y[j].w))); }
                am = fmaxf(wmax_all(am), 1e-20f); const float inv = 127.0f / am; GLOBAL_AS unsigned* o4 = (GLOBAL_AS unsigned*)((unsigned char*)H + (size_t)m * DM) + C.lane;
#pragma unroll
                for (int j = 0; j < 4; ++j) o4[64 * j] = pack4_i8(y[j].x * inv, y[j].y * inv, y[j].z * inv, y[j].w * inv);
                if (C.lane == 0) ((GLOBAL_AS float*)(C.ws + WS_SA))[m] = am * (1.0f / 127.0f); }
            else if (OUT == 1) { GLOBAL_AS unsigned* o4 = (GLOBAL_AS unsigned*)((unsigned char*)H + (size_t)m * DM) + C.lane;
#pragma unroll
                for (int j = 0; j < 4; ++j) { const f32x4 y = v[r][j] * rstd * gg[j]; o4[64 * j] = pg8::cvt4_fp8(y.x, y.y, y.z, y.w); } }
            else { GLOBAL_AS unsigned long long* o8 = (GLOBAL_AS unsigned long long*)(H + (size_t)m * DM) + C.lane;
#pragma unroll
                for (int j = 0; j < 4; ++j) { const f32x4 y = v[r][j] * rstd * gg[j]; o8[64 * j] = (unsigned long long)pk2(y.x, y.y) | ((unsigned long long)pk2(y.z, y.w) << 32); } } } }
    }
}
__device__ __forceinline__ void norm_phase_b(const Ctx& C, const bf16* x, const float* g, bf16* H) {
    f32x4 gg[4];
#pragma unroll
    for (int j = 0; j < 4; ++j) gg[j] = ((const GLOBAL_AS f32x4*)g)[64 * j + C.lane];
    for (int m0 = C.gw; m0 < NTOK; m0 += 8 * C.NGW) {
        v2u w[8][4]; float s[8];
#pragma unroll
        for (int r = 0; r < 8; ++r) { const int m = min(m0 + r * C.NGW, NTOK - 1); const GLOBAL_AS v2u* xr = (const GLOBAL_AS v2u*)(x + (size_t)m * LDX) + C.lane;
#pragma unroll
            for (int j = 0; j < 4; ++j) w[r][j] = xr[64 * j]; }
#pragma unroll
        for (int r = 0; r < 8; ++r) { float a = 0.f;
#pragma unroll
            for (int j = 0; j < 4; ++j) { const float e0 = bflo(w[r][j].x), e1 = bfhi(w[r][j].x), e2 = bflo(w[r][j].y), e3 = bfhi(w[r][j].y); a += (e0 * e0 + e1 * e1) + (e2 * e2 + e3 * e3); }
            s[r] = a; }
#pragma unroll
        for (int r = 0; r < 8; ++r) s[r] = wsum_all(s[r]);
#pragma unroll
        for (int r = 0; r < 8; ++r) { const int m = m0 + r * C.NGW; if (m < NTOK) { const float rstd = 1.0f / sqrtf(s[r] * (1.0f / DM) + NORM_EPS);
            f32x4 y[4]; float am = 0.f;
#pragma unroll
            for (int j = 0; j < 4; ++j) { const f32x4 v = (f32x4){bflo(w[r][j].x), bfhi(w[r][j].x), bflo(w[r][j].y), bfhi(w[r][j].y)}; y[j] = v * rstd * gg[j];
                am = fmaxf(fmaxf(am, fmaxf(fabsf(y[j].x), fabsf(y[j].y))), fmaxf(fabsf(y[j].z), fabsf(y[j].w))); }
            am = fmaxf(wmax_all(am), 1e-20f); const float inv = 127.0f / am; GLOBAL_AS unsigned* o4 = (GLOBAL_AS unsigned*)((unsigned char*)H + (size_t)m * DM) + C.lane;
#pragma unroll
            for (int j = 0; j < 4; ++j) o4[64 * j] = pack4_i8(y[j].x * inv, y[j].y * inv, y[j].z * inv, y[j].w * inv);
            if (C.lane == 0) ((GLOBAL_AS float*)(C.ws + WS_SA))[m] = am * (1.0f / 127.0f); } }
    }
}
__device__ __forceinline__ void final_norm_phase(const Ctx& C, float* x, const float* g) {
    f32x4 gg[4];
#pragma unroll
    for (int j = 0; j < 4; ++j) gg[j] = ((const GLOBAL_AS f32x4*)g)[64 * j + C.lane];
    for (int m = C.gw; m < NTOK; m += C.NGW) {
        GLOBAL_AS f32x4* xr = (GLOBAL_AS f32x4*)(x + (size_t)m * DM) + C.lane; f32x4 v[4]; float s = 0.f;
#pragma unroll
        for (int j = 0; j < 4; ++j) { v[j] = xr[64 * j]; s += (v[j].x * v[j].x + v[j].y * v[j].y) + (v[j].z * v[j].z + v[j].w * v[j].w); }
        const float rstd = 1.0f / sqrtf(wave_sum(s, C.lane) * (1.0f / DM) + NORM_EPS);
#pragma unroll
        for (int j = 0; j < 4; ++j) xr[64 * j] = v[j] * rstd * gg[j];
    }
}
__device__ __forceinline__ void mla_prep_phase(const Ctx& C, bf16* PROJ, const float* qn, const float* kvn, bf16* KPE) {
    const GLOBAL_AS float* rope = (const GLOBAL_AS float*)(C.ws + WS_ROPE);
    const f32x4 gq = ((const GLOBAL_AS f32x4*)qn)[C.lane]; const f32x2 gk = ((const GLOBAL_AS f32x2*)kvn)[C.lane];
    for (int m0 = C.gw; m0 < NTOK; m0 += 8 * C.NGW) {
        v2u w[8]; unsigned w2[8]; unsigned r1[8], r2[8]; float sq[8], sk[8];
#pragma unroll
        for (int r = 0; r < 8; ++r) { const int m = min(m0 + r * C.NGW, NTOK - 1); const bf16* row = PROJ + (size_t)m * IN_E_PAD;
            w[r] = ((const GLOBAL_AS v2u*)(row + 1536))[C.lane]; w2[r] = ((const GLOBAL_AS unsigned*)(row + 1792))[C.lane]; r1[r] = row[1920 + (C.lane & 15)]; r2[r] = row[1936 + (C.lane & 15)]; }
#pragma unroll
        for (int r = 0; r < 8; ++r) { const float a0 = bflo(w[r].x), a1 = bfhi(w[r].x), a2 = bflo(w[r].y), a3 = bfhi(w[r].y), b0 = bflo(w2[r]), b1 = bfhi(w2[r]);
            sq[r] = wsum_all((a0 * a0 + a1 * a1) + (a2 * a2 + a3 * a3)); sk[r] = wsum_all(b0 * b0 + b1 * b1); }
#pragma unroll
        for (int r = 0; r < 8; ++r) { const int m = m0 + r * C.NGW; if (m < NTOK) { bf16* row = PROJ + (size_t)m * IN_E_PAD;
            const float rq = 1.0f / sqrtf(sq[r] * (1.0f / 256) + NORM_EPS), rk = 1.0f / sqrtf(sk[r] * (1.0f / 128) + NORM_EPS);
            v2u o; o.x = pk2(bflo(w[r].x) * rq * gq.x, bfhi(w[r].x) * rq * gq.y); o.y = pk2(bflo(w[r].y) * rq * gq.z, bfhi(w[r].y) * rq * gq.w); ((GLOBAL_AS v2u*)(row + 1536))[C.lane] = o;
            ((GLOBAL_AS unsigned*)(row + 1792))[C.lane] = pk2(bflo(w2[r]) * rk * gk.x, bfhi(w2[r]) * rk * gk.y);
            if (C.lane < 16) { const int t = m & (SEQ - 1); const float x1 = bflo(r1[r]), x2 = bflo(r2[r]);
                const float cs = rope[(t * 16 + C.lane) * 2], sn = rope[(t * 16 + C.lane) * 2 + 1];
                KPE[(size_t)m * 32 + C.lane] = (bf16)f2bf(x1 * cs - x2 * sn); KPE[(size_t)m * 32 + 16 + C.lane] = (bf16)f2bf(x1 * sn + x2 * cs); } } }
    }
}
#define LD8(dst, off, p) do { const v4u w_ = *(const GLOBAL_AS v4u*)(p); dst[(off) + 0] = bflo(w_.x); dst[(off) + 1] = bfhi(w_.x); dst[(off) + 2] = bflo(w_.y); dst[(off) + 3] = bfhi(w_.y); \
    dst[(off) + 4] = bflo(w_.z); dst[(off) + 5] = bfhi(w_.z); dst[(off) + 6] = bflo(w_.w); dst[(off) + 7] = bfhi(w_.w); } while (0)
__device__ __forceinline__ float dot8(const float* q, const v4u w) {
    return ((q[0] * bflo(w.x) + q[1] * bfhi(w.x)) + (q[2] * bflo(w.y) + q[3] * bfhi(w.y))) + ((q[4] * bflo(w.z) + q[5] * bfhi(w.z)) + (q[6] * bflo(w.w) + q[7] * bfhi(w.w)));
}
__device__ __forceinline__ void fma8(float* o, float p, const v4u w) {
    o[0] += p * bflo(w.x); o[1] += p * bfhi(w.x); o[2] += p * bflo(w.y); o[3] += p * bfhi(w.y); o[4] += p * bflo(w.z); o[5] += p * bfhi(w.z); o[6] += p * bflo(w.w); o[7] += p * bfhi(w.w);
}
__device__ __forceinline__ void store_o64(bf16* dst, const float* o, float inv) {
#pragma unroll
    for (int c = 0; c < 8; ++c) { v4u w; w.x = pk2(o[8 * c] * inv, o[8 * c + 1] * inv); w.y = pk2(o[8 * c + 2] * inv, o[8 * c + 3] * inv); w.z = pk2(o[8 * c + 4] * inv, o[8 * c + 5] * inv); w.w = pk2(o[8 * c + 6] * inv, o[8 * c + 7] * inv);
        ((GLOBAL_AS v4u*)dst)[c] = w; }
}
__device__ __forceinline__ void dil_naive_item(const bf16* PROJ, bf16* OC, int item, int tid) {
    const int b = item >> 5, h = (item >> 2) & 7, t = (item & 3) * 512 + tid;
    const bf16* base = PROJ + (size_t)b * SEQ * IN_E_PAD;
    float q[64], o[64];
#pragma unroll
    for (int c = 0; c < 8; ++c) LD8(q, 8 * c, base + (size_t)t * IN_E_PAD + h * 64 + 8 * c);
#pragma unroll
    for (int d = 0; d < 64; ++d) { q[d] *= 0.125f * LOG2E; o[d] = 0.f; }
    const float slope = ex2(-(float)(h + 1)) * LOG2E;
    float m = -INFINITY, l = 0.f;
    for (int g = 0; g < 3; ++g) { const int dl = 1 << (2 * g);
        for (int j = -64; j <= 64; ++j) { const int s = t + j * dl; if (s < 0 || s >= SEQ) continue;
            const bf16* kr = base + (size_t)s * IN_E_PAD + 512 + h * 64;
            float sc = 0.f;
#pragma unroll
            for (int c = 0; c < 8; ++c) sc += dot8(q + 8 * c, ((const GLOBAL_AS v4u*)kr)[c]);
            sc -= slope * (float)((j < 0 ? -j : j) * dl);
            const float mn = fmaxf(m, sc), al = ex2(m - mn), p = ex2(sc - mn); m = mn; l = l * al + p;
#pragma unroll
            for (int d = 0; d < 64; ++d) o[d] *= al;
#pragma unroll
            for (int c = 0; c < 8; ++c) fma8(o + 8 * c, p, ((const GLOBAL_AS v4u*)(kr + 512))[c]);
        } }
    store_o64(OC + ((size_t)b * SEQ + t) * DM + h * 64, o, 1.0f / l);
}
__device__ __forceinline__ void mla_naive_item(const bf16* QM, const bf16* KVM, const bf16* KPE, const float* rope, bf16* OC, int item, int tid) {
    const int b = item >> 6, h = (item >> 3) & 7, vh = (item >> 2) & 1, t = (item & 3) * 512 + tid;
    const size_t row = (size_t)b * SEQ + t;
    float q[96], o[32];
#pragma unroll
    for (int c = 0; c < 12; ++c) LD8(q, 8 * c, QM + row * 768 + h * 96 + 8 * c);
#pragma unroll
    for (int i = 0; i < 16; ++i) { const float cs = rope[(t * 16 + i) * 2], sn = rope[(t * 16 + i) * 2 + 1], x1 = q[64 + i], x2 = q[80 + i]; q[64 + i] = x1 * cs - x2 * sn; q[80 + i] = x1 * sn + x2 * cs; }
    const float scl = 0.10206207261596575f * LOG2E;
#pragma unroll
    for (int d = 0; d < 96; ++d) q[d] *= scl;
#pragma unroll
    for (int d = 0; d < 32; ++d) o[d] = 0.f;
    float m = -INFINITY, l = 0.f;
    const bf16* kvb = KVM + (size_t)b * SEQ * 1024 + h * 128; const bf16* kpb = KPE + (size_t)b * SEQ * 32;
    for (int s = 0; s < SEQ; s += 2) {
        float sc[2];
#pragma unroll
        for (int kk = 0; kk < 2; ++kk) { const GLOBAL_AS v4u* kr = (const GLOBAL_AS v4u*)(kvb + (size_t)(s + kk) * 1024); const GLOBAL_AS v4u* pr = (const GLOBAL_AS v4u*)(kpb + (size_t)(s + kk) * 32); float a = 0.f;
#pragma unroll
            for (int c = 0; c < 8; ++c) a += dot8(q + 8 * c, kr[c]);
#pragma unroll
            for (int c = 0; c < 4; ++c) a += dot8(q + 64 + 8 * c, pr[c]);
            sc[kk] = a; }
        const float mn = fmaxf(m, fmaxf(sc[0], sc[1])), al = ex2(m - mn); m = mn; l *= al;
#pragma unroll
        for (int d = 0; d < 32; ++d) o[d] *= al;
#pragma unroll
        for (int kk = 0; kk < 2; ++kk) { const float p = ex2(sc[kk] - mn); l += p; const GLOBAL_AS v4u* vr = (const GLOBAL_AS v4u*)(kvb + (size_t)(s + kk) * 1024 + 64 + vh * 32);
#pragma unroll
            for (int c = 0; c < 4; ++c) fma8(o + 8 * c, p, vr[c]); }
    }
    const float inv = 1.0f / l; bf16* dst = OC + row * DM + 512 + h * 64 + vh * 32;
#pragma unroll
    for (int c = 0; c < 4; ++c) { v4u w; w.x = pk2(o[8 * c] * inv, o[8 * c + 1] * inv); w.y = pk2(o[8 * c + 2] * inv, o[8 * c + 3] * inv); w.z = pk2(o[8 * c + 4] * inv, o[8 * c + 5] * inv); w.w = pk2(o[8 * c + 6] * inv, o[8 * c + 7] * inv);
        ((GLOBAL_AS v4u*)dst)[c] = w; }
}
__device__ __forceinline__ void na_naive_item(const bf16* QKV, const float* rpb, bf16* O, int item, int tid) {
    const int b = item >> 6, h = (item >> 2) & 15, t = (item & 3) * 512 + tid;
    const int i = t >> 6, c0 = t & 63; const int rs = min(max(i - 4, 0), 24), cs = min(max(c0 - 8, 0), 48);
    const bf16* base = QKV + (size_t)b * SEQ * 3072 + h * 64;
    float q[64], o[64];
#pragma unroll
    for (int c = 0; c < 8; ++c) LD8(q, 8 * c, base + (size_t)t * 3072 + 8 * c);
#pragma unroll
    for (int d = 0; d < 64; ++d) { q[d] *= 0.125f * LOG2E; o[d] = 0.f; }
    float m = -INFINITY, l = 0.f;
    for (int r = 0; r < 8; ++r)
        for (int k = 0; k < 16; ++k) { const int kt = (rs + r) * 64 + cs + k;
            const bf16* kr = base + (size_t)kt * 3072 + 1024;
            float sc = rpb[(h * 15 + (rs + r - i + 7)) * 31 + (cs + k - c0 + 15)] * LOG2E;
#pragma unroll
            for (int c = 0; c < 8; ++c) sc += dot8(q + 8 * c, ((const GLOBAL_AS v4u*)kr)[c]);
            const float mn = fmaxf(m, sc), al = ex2(m - mn), p = ex2(sc - mn); m = mn; l = l * al + p;
#pragma unroll
            for (int d = 0; d < 64; ++d) o[d] *= al;
#pragma unroll
            for (int c = 0; c < 8; ++c) fma8(o + 8 * c, p, ((const GLOBAL_AS v4u*)(kr + 1024))[c]);
        }
    store_o64(O + ((size_t)b * SEQ + t) * DM + h * 64, o, 1.0f / l);
}
__device__ __forceinline__ void route_phase(const Ctx& C, const bf16* x, const float* g, const float* wr, unsigned char* H8, unsigned* cnt  ) {
    LAS float* wl = (LAS float*)C.lds;
    for (int i = C.tid; i < 8192; i += NWAVES * 64) wl[(i & 7) * 1024 + (i >> 3)] = wr[i];
    __syncthreads();
    GLOBAL_AS v4i* route_i = (GLOBAL_AS v4i*)(C.ws + WS_ROUTE_I); GLOBAL_AS f32x2* route_w = (GLOBAL_AS f32x2*)(C.ws + WS_ROUTE_W);
    f32x4 gg[4];
#pragma unroll
    for (int j = 0; j < 4; ++j) gg[j] = ((const GLOBAL_AS f32x4*)g)[64 * j + C.lane];
    for (int base = C.gw * 32; base < NTOK; base += C.NGW * 32) {
        int my_e0 = 0, my_e1 = 0; float my_w0 = 0.f, my_w1 = 0.f;
        for (int i = 0; i < 32; i += 4) {
            v2u xw[4][4]; float s[4]; float lg[4][8]; f32x4 y[4][4];
#pragma unroll
            for (int r = 0; r < 4; ++r) { const GLOBAL_AS v2u* xr = (const GLOBAL_AS v2u*)(x + (size_t)(base + i + r) * LDX) + C.lane;
#pragma unroll
                for (int j = 0; j < 4; ++j) xw[r][j] = xr[64 * j]; }
#pragma unroll
            for (int r = 0; r < 4; ++r) { float a = 0.f;
#pragma unroll
                for (int j = 0; j < 4; ++j) { const v2u c = xw[r][j]; y[r][j] = (f32x4){bflo(c.x), bfhi(c.x), bflo(c.y), bfhi(c.y)}; a += (y[r][j].x * y[r][j].x + y[r][j].y * y[r][j].y) + (y[r][j].z * y[r][j].z + y[r][j].w * y[r][j].w); }
                s[r] = a; }
#pragma unroll
            for (int r = 0; r < 4; ++r) s[r] = wsum_all(s[r]);
#pragma unroll
            for (int r = 0; r < 4; ++r) { const float rstd = 1.0f / sqrtf(s[r] * (1.0f / DM) + NORM_EPS);
                GLOBAL_AS unsigned* o4 = (GLOBAL_AS unsigned*)(H8 + (size_t)(base + i + r) * DM) + C.lane;
#pragma unroll
                for (int e = 0; e < 8; ++e) lg[r][e] = 0.f;
#pragma unroll
                for (int j = 0; j < 4; ++j) { y[r][j] = y[r][j] * rstd * gg[j]; o4[64 * j] = pg8::cvt4_fp8(y[r][j].x, y[r][j].y, y[r][j].z, y[r][j].w); } }
#pragma unroll
            for (int j = 0; j < 4; ++j)
#pragma unroll
                for (int e = 0; e < 8; ++e) { const f32x4 w = *(const LAS f32x4*)(wl + e * 1024 + 4 * (64 * j + C.lane));
#pragma unroll
                    for (int r = 0; r < 4; ++r) lg[r][e] += (y[r][j].x * w.x + y[r][j].y * w.y) + (y[r][j].z * w.z + y[r][j].w * w.w); }
#pragma unroll
            for (int r = 0; r < 4; ++r)
#pragma unroll
                for (int e = 0; e < 8; ++e) lg[r][e] = wsum_all(lg[r][e]);
#pragma unroll
            for (int r = 0; r < 4; ++r) {
                int e0 = 0; float v0 = lg[r][0];
#pragma unroll
                for (int e = 1; e < 8; ++e) if (lg[r][e] > v0) { v0 = lg[r][e]; e0 = e; }
                int e1 = -1; float v1 = -INFINITY;
#pragma unroll
                for (int e = 0; e < 8; ++e) if (e != e0 && (e1 < 0 || lg[r][e] > v1)) { v1 = lg[r][e]; e1 = e; }
                const float ex = __expf(v1 - v0), w0 = 1.0f / (1.0f + ex), w1 = ex * w0;
                if (C.lane == i + r) { my_e0 = e0; my_e1 = e1; my_w0 = w0; my_w1 = w1; } }
        }
        const int chunk = base / MOE_CHUNK; const bool act = C.lane < 32; int pos0 = 0, pos1 = 0;
        const unsigned long long lt = (1ull << C.lane) - 1ull;
#pragma unroll
        for (int e = 0; e < 8; ++e) {
            const unsigned long long m0 = __ballot(act && my_e0 == e), m1 = __ballot(act && my_e1 == e);
            const int n0 = __popcll(m0), n1 = __popcll(m1);
            unsigned bs = 0; if (C.lane == 0 && (n0 + n1) > 0) bs = atomicAdd(cnt + (chunk * 8 + e) * 64, (unsigned)(n0 + n1));
            bs = (unsigned)__builtin_amdgcn_readfirstlane((int)bs);
            if (act && my_e0 == e) pos0 = (int)bs + __popcll(m0 & lt);
            if (act && my_e1 == e) pos1 = (int)bs + n0 + __popcll(m1 & lt);
        }
        if (act) { route_i[base + C.lane] = (v4i){my_e0, my_e1, pos0, pos1}; route_w[base + C.lane] = (f32x2){my_w0, my_w1}; }
    }
}
__device__ __forceinline__ int seg_base(const unsigned* cnt, int chunk, int e) {
    int acc = 0;
#pragma unroll
    for (int k = 0; k < 8; ++k) { const int n = (int)__hip_atomic_load(cnt + (chunk * 8 + k) * 64, __ATOMIC_RELAXED, __HIP_MEMORY_SCOPE_AGENT); if (k < e) acc += (n + 255) >> 8; }
    return acc * 256;
}
__device__ __forceinline__ void gather_all_phase(const Ctx& C, const unsigned char* H8, unsigned char* HG8, const unsigned* cnt) {
    GLOBAL_AS v4i* route_i = (GLOBAL_AS v4i*)(C.ws + WS_ROUTE_I);
    LAS int* segt = (LAS int*)C.lds;
    if (C.tid < N_CHUNK * 8) segt[C.tid] = seg_base(cnt, C.tid >> 3, C.tid & 7);
    __syncthreads();
    for (int m0 = C.gw; m0 < NTOK; m0 += 8 * C.NGW) {
        v4i ri[8]; v4u a[8];
#pragma unroll
        for (int r = 0; r < 8; ++r) { const int m = min(m0 + r * C.NGW, NTOK - 1); ri[r] = route_i[m]; a[r] = ((const GLOBAL_AS v4u*)(H8 + (size_t)m * DM))[C.lane]; }
#pragma unroll
        for (int r = 0; r < 8; ++r) { const int m = m0 + r * C.NGW; if (m < NTOK) { const int ch = m / MOE_CHUNK;
            const int s0 = segt[ch * 8 + ri[r].x] + ri[r].z, s1 = segt[ch * 8 + ri[r].y] + ri[r].w;
            unsigned char* base = HG8 + (size_t)ch * 2 * CHUNK_SLOTS * DM;
            ((GLOBAL_AS v4u*)(base + (size_t)s0 * DM))[C.lane] = a[r]; ((GLOBAL_AS v4u*)(base + (size_t)s1 * DM))[C.lane] = a[r];
            if (C.lane == 0) { v4i o = ri[r]; o.z = s0; o.w = s1; route_i[m] = o; } } }
    }
}
template <bool LAST>
__device__ __forceinline__ void combine_all_phase(const Ctx& C, bf16* x, float* out, const bf16* Y, const float* g, bf16* Hn) {
    const GLOBAL_AS v4i* route_i = (const GLOBAL_AS v4i*)(C.ws + WS_ROUTE_I); const GLOBAL_AS f32x2* route_w = (const GLOBAL_AS f32x2*)(C.ws + WS_ROUTE_W);
    f32x4 gg[4];
#pragma unroll
    for (int j = 0; j < 4; ++j) gg[j] = ((const GLOBAL_AS f32x4*)g)[64 * j + C.lane];
    for (int m0 = C.gw; m0 < NTOK; m0 += 4 * C.NGW) {
        v4i ri[4]; f32x2 rw[4]; v2u ya[4][4], yb[4][4], xw[4][4]; float s[4];
#pragma unroll
        for (int r = 0; r < 4; ++r) { const int m = min(m0 + r * C.NGW, NTOK - 1); ri[r] = route_i[m]; rw[r] = route_w[m];
            const GLOBAL_AS v2u* xr = (const GLOBAL_AS v2u*)(x + (size_t)m * LDX) + C.lane;
#pragma unroll
            for (int j = 0; j < 4; ++j) xw[r][j] = xr[64 * j]; }
#pragma unroll
        for (int r = 0; r < 4; ++r) { const int m = min(m0 + r * C.NGW, NTOK - 1); const bf16* base = Y + (size_t)(m / MOE_CHUNK) * CHUNK_SLOTS * DM;
            const GLOBAL_AS v2u* y0 = (const GLOBAL_AS v2u*)(base + (size_t)ri[r].z * DM) + C.lane; const GLOBAL_AS v2u* y1 = (const GLOBAL_AS v2u*)(base + (size_t)ri[r].w * DM) + C.lane;
#pragma unroll
            for (int j = 0; j < 4; ++j) { ya[r][j] = y0[64 * j]; yb[r][j] = y1[64 * j]; } }
#pragma unroll
        for (int r = 0; r < 4; ++r) { const int m = m0 + r * C.NGW; f32x4 v[4]; float acc = 0.f;
#pragma unroll
            for (int j = 0; j < 4; ++j) { const v2u a = ya[r][j], b = yb[r][j], c = xw[r][j]; f32x4 t = (f32x4){bflo(c.x), bfhi(c.x), bflo(c.y), bfhi(c.y)};
                t.x += rw[r].x * bflo(a.x) + rw[r].y * bflo(b.x); t.y += rw[r].x * bfhi(a.x) + rw[r].y * bfhi(b.x); t.z += rw[r].x * bflo(a.y) + rw[r].y * bflo(b.y); t.w += rw[r].x * bfhi(a.y) + rw[r].y * bfhi(b.y);
                v[j] = t; acc += (t.x * t.x + t.y * t.y) + (t.z * t.z + t.w * t.w); }
            const float rstd = 1.0f / sqrtf(wsum_all(acc) * (1.0f / DM) + NORM_EPS);
            if (m < NTOK) {
                if (LAST) { GLOBAL_AS f32x4* xr = (GLOBAL_AS f32x4*)(out + (size_t)m * DM) + C.lane;
#pragma unroll
                    for (int j = 0; j < 4; ++j) xr[64 * j] = v[j] * rstd * gg[j];
                } else { f32x4 y[4]; float am = 0.f;
#pragma unroll
                    for (int j = 0; j < 4; ++j) { stx4(x + (size_t)m * LDX, 64 * j + C.lane, v[j]); y[j] = v[j] * rstd * gg[j]; am = fmaxf(fmaxf(am, fmaxf(fabsf(y[j].x), fabsf(y[j].y))), fmaxf(fabsf(y[j].z), fabsf(y[j].w))); }
                    am = fmaxf(wmax_all(am), 1e-20f); const float inv = 127.0f / am; GLOBAL_AS unsigned* o4 = (GLOBAL_AS unsigned*)((unsigned char*)Hn + (size_t)m * DM) + C.lane;
#pragma unroll
                    for (int j = 0; j < 4; ++j) o4[64 * j] = pack4_i8(y[j].x * inv, y[j].y * inv, y[j].z * inv, y[j].w * inv);
                    if (C.lane == 0) ((GLOBAL_AS float*)(C.ws + WS_SA))[m] = am * (1.0f / 127.0f);
                } } }
    }
}
__device__ __forceinline__ void grouped_order(pg8::GroupedOrder& S, const unsigned* cnt, int chunk, int nN, int G, int c) {
    int te[8]; int acc = 0;
#pragma unroll
    for (int k = 0; k < 8; ++k) { const int n = __builtin_amdgcn_readfirstlane((int)__hip_atomic_load(cnt + (chunk * 8 + k) * 64, __ATOMIC_RELAXED, __HIP_MEMORY_SCOPE_AGENT)); acc += (n + 255) >> 8; te[k] = acc; }
    S.t0 = te[0]; S.t1 = te[1]; S.t2 = te[2]; S.t3 = te[3]; S.t4 = te[4]; S.t5 = te[5]; S.t6 = te[6]; S.RT = te[7]; S.nN = nN; S.G = G; S.c = c;
}
namespace att {
typedef short bf16x8 __attribute__((ext_vector_type(8)));
typedef short s16x4 __attribute__((ext_vector_type(4)));
typedef short v4i16_t __attribute__((ext_vector_type(4)));
typedef float f32x16 __attribute__((ext_vector_type(16)));
typedef float f32x2_t __attribute__((ext_vector_type(2)));
typedef __bf16 bf16x2_t __attribute__((ext_vector_type(2)));
typedef unsigned u32x4 __attribute__((ext_vector_type(4)));
__device__ __forceinline__ unsigned cvtpk(float lo, float hi) { f32x2_t v = {lo, hi}; bf16x2_t b = __builtin_convertvector(v, bf16x2_t); return __builtin_bit_cast(unsigned, b); }
__device__ __forceinline__ s16x4 vtr(const LAS unsigned char* p) { return __builtin_bit_cast(s16x4, __builtin_amdgcn_ds_read_tr16_b64_v4i16((LAS v4i16_t*)p)); }
#define VTR_ISSUE(dst, addr, OFF) asm volatile("ds_read_b64_tr_b16 %0, %1 offset:%2" : "=&v"(dst) : "v"(addr), "i"(OFF))
__device__ __forceinline__ void vtr_wait8(s16x4& a, s16x4& b, s16x4& c, s16x4& d, s16x4& e, s16x4& f, s16x4& g, s16x4& h) {
    asm volatile("s_waitcnt lgkmcnt(0)" : "+v"(a), "+v"(b), "+v"(c), "+v"(d), "+v"(e), "+v"(f), "+v"(g), "+v"(h)); }
#define VTR_PACK(lo, hi) ((bf16x8){lo[0], lo[1], lo[2], lo[3], hi[0], hi[1], hi[2], hi[3]})
__device__ __forceinline__ void xhalf_swap(unsigned& a, unsigned& b) { asm volatile("s_nop 1\n\tv_permlane32_swap_b32 %0, %1\n\ts_nop 1" : "+v"(a), "+v"(b)); }
__device__ __forceinline__ float xhalf_max(float v) { unsigned a = __builtin_bit_cast(unsigned, v), b = a; xhalf_swap(a, b); return fmaxf(__builtin_bit_cast(float, a), __builtin_bit_cast(float, b)); }
__device__ __forceinline__ float xhalf_sum(float v) { unsigned a = __builtin_bit_cast(unsigned, v), b = a; xhalf_swap(a, b); return __builtin_bit_cast(float, a) + __builtin_bit_cast(float, b); }
#define ATT_MFMA(a, b, c) __builtin_amdgcn_mfma_f32_32x32x16_bf16((a), (b), (c), 0, 0, 0)
__device__ __forceinline__ void sm_step(const f32x16& s, float c, float& m, float& l, f32x16& o0, f32x16& o1, bf16x8& p0, bf16x8& p1) {
    float mx = fmaxf(fmaxf(fmaxf(s[0], s[1]), fmaxf(s[2], s[3])), fmaxf(fmaxf(s[4], s[5]), fmaxf(s[6], s[7])));
    mx = fmaxf(mx, fmaxf(fmaxf(fmaxf(s[8], s[9]), fmaxf(s[10], s[11])), fmaxf(fmaxf(s[12], s[13]), fmaxf(s[14], s[15]))));
    mx = xhalf_max(mx);
    const float mn = fmaxf(m, mx * c), al = ex2(m - mn); m = mn;
    float pe[16]; float ls = 0.f;
#pragma unroll
    for (int i = 0; i < 16; ++i) { pe[i] = ex2(__builtin_fmaf(s[i], c, -mn)); ls += pe[i]; }
    l = l * al + ls;
#pragma unroll
    for (int i = 0; i < 16; ++i) { o0[i] *= al; o1[i] *= al; }
    u32x4 a, b; a.x = cvtpk(pe[0], pe[1]); a.y = cvtpk(pe[2], pe[3]); a.z = cvtpk(pe[4], pe[5]); a.w = cvtpk(pe[6], pe[7]);
    b.x = cvtpk(pe[8], pe[9]); b.y = cvtpk(pe[10], pe[11]); b.z = cvtpk(pe[12], pe[13]); b.w = cvtpk(pe[14], pe[15]);
    p0 = __builtin_bit_cast(bf16x8, a); p1 = __builtin_bit_cast(bf16x8, b);
}
constexpr int MLA_KB = 12 * 64 * 16, MLA_BUF = MLA_KB + 64 * 128;
__device__ __forceinline__ void mla_unit(const bf16* QM, const bf16* KVM, const bf16* KPE, const float* rope, bf16* OC, int unit, LAS unsigned char* lds, int tid) {
    const int lane = tid & 63, wave = __builtin_amdgcn_readfirstlane(tid >> 6), r32 = lane & 31, hh = lane >> 5;
    const int b = unit >> 5, h = (unit >> 2) & 7, qt = unit & 3, q0 = qt * 512 + wave * 64;
    const float c = 0.10206207261596575f * LOG2E;
    bf16x8 qf[2][6];
#pragma unroll
    for (int qb = 0; qb < 2; ++qb) { const int t = q0 + qb * 32 + r32; const bf16* src = QM + ((size_t)b * SEQ + t) * 768 + h * 96 + hh * 8;
#pragma unroll
        for (int ks = 0; ks < 6; ++ks) qf[qb][ks] = *(const bf16x8*)(src + 16 * ks);
        const f32x4* rp = (const f32x4*)(rope + (t * 16 + 8 * hh) * 2);
        bf16x8 a4 = qf[qb][4], a5 = qf[qb][5];
#pragma unroll
        for (int jj = 0; jj < 4; ++jj) { const f32x4 cs = rp[jj];
            const float x1a = bflo((unsigned)(unsigned short)a4[2 * jj]), x2a = bflo((unsigned)(unsigned short)a5[2 * jj]), x1b = bflo((unsigned)(unsigned short)a4[2 * jj + 1]), x2b = bflo((unsigned)(unsigned short)a5[2 * jj + 1]);
            a4[2 * jj] = (short)f2bf(x1a * cs.x - x2a * cs.y); a5[2 * jj] = (short)f2bf(x1a * cs.y + x2a * cs.x);
            a4[2 * jj + 1] = (short)f2bf(x1b * cs.z - x2b * cs.w); a5[2 * jj + 1] = (short)f2bf(x1b * cs.w + x2b * cs.z); }
        qf[qb][4] = a4; qf[qb][5] = a5; }
    f32x16 o[2][2];
#pragma unroll
    for (int i = 0; i < 16; ++i) { o[0][0][i] = 0.f; o[0][1][i] = 0.f; o[1][0][i] = 0.f; o[1][1][i] = 0.f; }
    float m0 = -INFINITY, m1 = -INFINITY, l0 = 0.f, l1 = 0.f;
    const bf16* kvb = KVM + (size_t)b * SEQ * 1024 + h * 128;
    const bf16* gk0 = kvb + (size_t)lane * 1024 + wave * 8;
    const bf16* gk1 = KPE + ((size_t)b * SEQ + lane) * 32 + (wave & 3) * 8;
    const int vkey = wave * 8 + (lane >> 3), vcc = (lane & 7) ^ (((vkey >> 1) & 1) << 2);
    const bf16* gv = kvb + (size_t)vkey * 1024 + 64 + vcc * 8;
    const bool two = wave < 4;
    const int lk0 = wave * 1024, lk1 = (8 + wave) * 1024, lv = MLA_KB + wave * 1024;
#define MLA_STAGE(bufp, jt) do { const size_t go_ = (size_t)(jt) * 64; \
        __builtin_amdgcn_global_load_lds((const unsigned*)(gk0 + go_ * 1024), (LAS unsigned*)((bufp) + lk0), 16, 0, 0); \
        if (two) __builtin_amdgcn_global_load_lds((const unsigned*)(gk1 + go_ * 32), (LAS unsigned*)((bufp) + lk1), 16, 0, 0); \
        __builtin_amdgcn_global_load_lds((const unsigned*)(gv + go_ * 1024), (LAS unsigned*)((bufp) + lv), 16, 0, 0); } while (0)
    const int ka = (hh * 64 + r32) * 16;
    const int i16 = lane & 15, q4 = i16 >> 2, p4 = i16 & 3, cb = (lane >> 4) & 1;
    const int vrow = (4 * hh + q4) * 128 + (p4 & 1) * 8;
    const int va0 = MLA_KB + vrow + (((0 ^ (q4 >> 1)) * 4 + cb * 2 + (p4 >> 1)) * 16), va1 = MLA_KB + vrow + (((1 ^ (q4 >> 1)) * 4 + cb * 2 + (p4 >> 1)) * 16);
    MLA_STAGE(lds, 0);
    asm volatile("s_waitcnt vmcnt(0)" ::: "memory");
    __syncthreads();
    for (int j = 0; j < SEQ / 64; ++j) {
        const LAS unsigned char* buf = lds + (j & 1) * MLA_BUF; LAS unsigned char* nbuf = lds + ((j + 1) & 1) * MLA_BUF;
        if ((j + 1) < SEQ / 64) MLA_STAGE(nbuf, j + 1);
#pragma unroll
        for (int kb = 0; kb < 2; ++kb) {
            bf16x8 p00, p01, p10, p11;
            { f32x16 s0, s1; bf16x8 kf[6];
#pragma unroll
              for (int ks = 0; ks < 6; ++ks) kf[ks] = *(const LAS bf16x8*)(buf + ka + ks * 2048 + kb * 512);
#pragma unroll
              for (int i = 0; i < 16; ++i) { s0[i] = 0.f; s1[i] = 0.f; }
#pragma unroll
              for (int ks = 0; ks < 6; ++ks) { s0 = ATT_MFMA(kf[ks], qf[0][ks], s0); s1 = ATT_MFMA(kf[ks], qf[1][ks], s1); }
              sm_step(s0, c, m0, l0, o[0][0], o[0][1], p00, p01);
              sm_step(s1, c, m1, l1, o[1][0], o[1][1], p10, p11); }
            { const unsigned a0 = (unsigned)(size_t)(buf + va0), a1 = (unsigned)(size_t)(buf + va1);
              s16x4 l00, h00, l01, h01, l10, h10, l11, h11;
              if (kb == 0) { VTR_ISSUE(l00, a0, 0); VTR_ISSUE(h00, a0, 1024); VTR_ISSUE(l01, a0, 2048); VTR_ISSUE(h01, a0, 3072); VTR_ISSUE(l10, a1, 0); VTR_ISSUE(h10, a1, 1024); VTR_ISSUE(l11, a1, 2048); VTR_ISSUE(h11, a1, 3072); }
              else         { VTR_ISSUE(l00, a0, 4096); VTR_ISSUE(h00, a0, 5120); VTR_ISSUE(l01, a0, 6144); VTR_ISSUE(h01, a0, 7168); VTR_ISSUE(l10, a1, 4096); VTR_ISSUE(h10, a1, 5120); VTR_ISSUE(l11, a1, 6144); VTR_ISSUE(h11, a1, 7168); }
              vtr_wait8(l00, h00, l01, h01, l10, h10, l11, h11);
              const bf16x8 v00 = VTR_PACK(l00, h00), v01 = VTR_PACK(l01, h01), v10 = VTR_PACK(l10, h10), v11 = VTR_PACK(l11, h11);
              o[0][0] = ATT_MFMA(v00, p00, o[0][0]); o[1][0] = ATT_MFMA(v00, p10, o[1][0]); o[0][1] = ATT_MFMA(v10, p00, o[0][1]); o[1][1] = ATT_MFMA(v10, p10, o[1][1]);
              o[0][0] = ATT_MFMA(v01, p01, o[0][0]); o[1][0] = ATT_MFMA(v01, p11, o[1][0]); o[0][1] = ATT_MFMA(v11, p01, o[0][1]); o[1][1] = ATT_MFMA(v11, p11, o[1][1]); }
        }
        asm volatile("s_waitcnt vmcnt(0)" ::: "memory");
        __syncthreads();
    }
#undef MLA_STAGE
    const float i0 = 1.0f / xhalf_sum(l0), i1 = 1.0f / xhalf_sum(l1);
#pragma unroll
    for (int qb = 0; qb < 2; ++qb) { const float inv = qb == 0 ? i0 : i1; bf16* dst = OC + ((size_t)b * SEQ + q0 + qb * 32 + r32) * DM + 512 + h * 64 + 4 * hh;
#pragma unroll
        for (int db = 0; db < 2; ++db)
#pragma unroll
            for (int g = 0; g < 4; ++g) { v2u w; w.x = cvtpk(o[qb][db][4 * g] * inv, o[qb][db][4 * g + 1] * inv); w.y = cvtpk(o[qb][db][4 * g + 2] * inv, o[qb][db][4 * g + 3] * inv);
                *(v2u*)(dst + db * 32 + 8 * g) = w; } }
}
__device__ __forceinline__ void stage32(LAS unsigned char* buf, const bf16* kp, const bf16* vp, size_t rs, int lane) {
    const bf16* v0 = vp + (size_t)(lane >> 3) * rs + ((lane & 7) ^ (((lane >> 4) & 1) << 2)) * 8;
#pragma unroll
    for (int i = 0; i < 4; ++i) { const int key = 8 * i + (lane >> 3); __builtin_amdgcn_global_load_lds((const unsigned*)(kp + (size_t)key * rs + ((lane & 7) ^ ((key >> 1) & 7)) * 8), (LAS unsigned*)(buf + i * 1024), 16, 0, 0); }
#pragma unroll
    for (int i = 0; i < 4; ++i) __builtin_amdgcn_global_load_lds((const unsigned*)(v0 + (size_t)(8 * i) * rs), (LAS unsigned*)(buf + 4096 + i * 1024), 16, 0, 0);
}
__device__ __forceinline__ void stageK(LAS unsigned char* kb, const bf16* kp, size_t rs, int lane) {
#pragma unroll
    for (int i = 0; i < 4; ++i) { const int key = 8 * i + (lane >> 3); __builtin_amdgcn_global_load_lds((const unsigned*)(kp + (size_t)key * rs + ((lane & 7) ^ ((key >> 1) & 7)) * 8), (LAS unsigned*)(kb + i * 1024), 16, 0, 0); }
}
__device__ __forceinline__ void stageV(LAS unsigned char* vb, const bf16* vp, size_t rs, int lane) {
    const bf16* v0 = vp + (size_t)(lane >> 3) * rs + ((lane & 7) ^ (((lane >> 4) & 1) << 2)) * 8;
#pragma unroll
    for (int i = 0; i < 4; ++i) __builtin_amdgcn_global_load_lds((const unsigned*)(v0 + (size_t)(8 * i) * rs), (LAS unsigned*)(vb + i * 1024), 16, 0, 0);
}
__device__ __forceinline__ f32x16 qk32(const LAS unsigned char* buf, const bf16x8 (&qf)[4], int r32, int hh) {
    f32x16 s; bf16x8 kf[4];
#pragma unroll
    for (int ks = 0; ks < 4; ++ks) kf[ks] = *(const LAS bf16x8*)(buf + r32 * 128 + (((2 * ks + hh) ^ ((r32 >> 1) & 7)) << 4));
#pragma unroll
    for (int i = 0; i < 16; ++i) s[i] = 0.f;
#pragma unroll
    for (int ks = 0; ks < 4; ++ks) s = ATT_MFMA(kf[ks], qf[ks], s);
    return s;
}
__device__ __forceinline__ void qk32x2(const LAS unsigned char* buf, const bf16x8 (&q0)[4], const bf16x8 (&q1)[4], f32x16& s0, f32x16& s1, int r32, int hh) {
    bf16x8 kf[4];
#pragma unroll
    for (int ks = 0; ks < 4; ++ks) kf[ks] = *(const LAS bf16x8*)(buf + r32 * 128 + (((2 * ks + hh) ^ ((r32 >> 1) & 7)) << 4));
#pragma unroll
    for (int i = 0; i < 16; ++i) { s0[i] = 0.f; s1[i] = 0.f; }
#pragma unroll
    for (int ks = 0; ks < 4; ++ks) { s0 = ATT_MFMA(kf[ks], q0[ks], s0); s1 = ATT_MFMA(kf[ks], q1[ks], s1); }
}
__device__ __forceinline__ void sm_step2(const float (&t)[16], float& m, float& l, f32x16& o0, f32x16& o1, bf16x8& p0, bf16x8& p1) {
    float mx = fmaxf(fmaxf(fmaxf(t[0], t[1]), fmaxf(t[2], t[3])), fmaxf(fmaxf(t[4], t[5]), fmaxf(t[6], t[7])));
    mx = fmaxf(mx, fmaxf(fmaxf(fmaxf(t[8], t[9]), fmaxf(t[10], t[11])), fmaxf(fmaxf(t[12], t[13]), fmaxf(t[14], t[15]))));
    mx = xhalf_max(mx);
    const float mn = fmaxf(m, mx), ms = (mn == -INFINITY) ? 0.f : mn, al = ex2(m - ms); m = mn;
    float pe[16]; float ls = 0.f;
#pragma unroll
    for (int i = 0; i < 16; ++i) { pe[i] = ex2(t[i] - ms); ls += pe[i]; }
    l = l * al + ls;
#pragma unroll
    for (int i = 0; i < 16; ++i) { o0[i] *= al; o1[i] *= al; }
    u32x4 a, b; a.x = cvtpk(pe[0], pe[1]); a.y = cvtpk(pe[2], pe[3]); a.z = cvtpk(pe[4], pe[5]); a.w = cvtpk(pe[6], pe[7]);
    b.x = cvtpk(pe[8], pe[9]); b.y = cvtpk(pe[10], pe[11]); b.z = cvtpk(pe[12], pe[13]); b.w = cvtpk(pe[14], pe[15]);
    p0 = __builtin_bit_cast(bf16x8, a); p1 = __builtin_bit_cast(bf16x8, b);
}
__device__ __forceinline__ void vfrag4(const LAS unsigned char* buf, int va0, int va1, bf16x8& v00, bf16x8& v01, bf16x8& v10, bf16x8& v11) {
    const unsigned a0 = (unsigned)(size_t)(buf + va0), a1 = (unsigned)(size_t)(buf + va1);
    s16x4 l00, h00, l01, h01, l10, h10, l11, h11;
    VTR_ISSUE(l00, a0, 0); VTR_ISSUE(h00, a0, 1024); VTR_ISSUE(l01, a0, 2048); VTR_ISSUE(h01, a0, 3072); VTR_ISSUE(l10, a1, 0); VTR_ISSUE(h10, a1, 1024); VTR_ISSUE(l11, a1, 2048); VTR_ISSUE(h11, a1, 3072);
    vtr_wait8(l00, h00, l01, h01, l10, h10, l11, h11);
    v00 = VTR_PACK(l00, h00); v01 = VTR_PACK(l01, h01); v10 = VTR_PACK(l10, h10); v11 = VTR_PACK(l11, h11);
}
#define ATT_VADDR() const int i16 = lane & 15, q4 = i16 >> 2, p4 = i16 & 3, cb = (lane >> 4) & 1; const int vrow = 4096 + (4 * hh + q4) * 128 + (p4 & 1) * 8; \
    const int va0 = vrow + (((0 ^ (q4 >> 1)) * 4 + cb * 2 + (p4 >> 1)) * 16), va1 = vrow + (((1 ^ (q4 >> 1)) * 4 + cb * 2 + (p4 >> 1)) * 16)
#define ATT_WAIT_V(n) asm volatile("s_waitcnt vmcnt(" #n ")" ::: "memory")

__device__ __forceinline__ void qrow_put(LAS unsigned char* tb, const v4u (&q)[4], int lane) {
#pragma unroll
    for (int i = 0; i < 4; ++i) { const int row = 8 * i + (lane >> 3); *(LAS v4u*)(tb + row * 128 + (((lane & 7) ^ ((row >> 1) & 7)) << 4)) = q[i]; }
}
__device__ __forceinline__ void qfrag_get(const LAS unsigned char* tb, bf16x8 (&qf)[4], int r32, int hh) {
#pragma unroll
    for (int ks = 0; ks < 4; ++ks) qf[ks] = *(const LAS bf16x8*)(tb + r32 * 128 + (((2 * ks + hh) ^ ((r32 >> 1) & 7)) << 4));
    asm volatile("s_waitcnt lgkmcnt(0)" : "+v"(qf[0]), "+v"(qf[1]), "+v"(qf[2]), "+v"(qf[3]) :: "memory");
}
__device__ __forceinline__ void ostage(LAS unsigned char* tb, const f32x16& o0, const f32x16& o1, float inv, int r32, int hh) {
#pragma unroll
    for (int db = 0; db < 2; ++db)
#pragma unroll
        for (int g = 0; g < 4; ++g) { const f32x16& o = db == 0 ? o0 : o1; v2u w; w.x = cvtpk(o[4 * g] * inv, o[4 * g + 1] * inv); w.y = cvtpk(o[4 * g + 2] * inv, o[4 * g + 3] * inv);
            *(LAS v2u*)(tb + r32 * 128 + (((db * 4 + g) ^ (r32 & 7)) << 4) + hh * 8) = w; }
}
__device__ __forceinline__ v4u orow(const LAS unsigned char* tb, int lane, int i) { return *(const LAS v4u*)(tb + i * 1024 + lane * 16); }
__device__ __forceinline__ int orow_chunk(int lane, int i) { return (lane & 7) ^ ((8 * i + (lane >> 3)) & 7); }
template <bool FINAL>
__device__ __forceinline__ void dil_tile(const bf16* PROJ, int dl, int idx, bf16* DPo, float* DLo, const bf16* DP1, const float* DL1, const bf16* DP2, const float* DL2, bf16* OC, LAS unsigned char* wl, int lane) {
    const int r32 = lane & 31, hh = lane >> 5;
    const int L = SEQ / dl, nch = L >> 6, ich = idx % nch, rho = (idx / nch) % dl, bh = idx >> 5, h = bh & 7, b = bh >> 3, i0 = ich << 6;
    const bf16* base = PROJ + ((size_t)b * SEQ + rho) * IN_E_PAD + h * 64;
    const size_t rs = (size_t)dl * IN_E_PAD;
    bf16x8 qf[2][4]; v4u qraw[2][4];
#pragma unroll
    for (int qb = 0; qb < 2; ++qb)
#pragma unroll
        for (int i = 0; i < 4; ++i) qraw[qb][i] = *(const v4u*)(base + (size_t)(i0 + qb * 32 + 8 * i + (lane >> 3)) * rs + (lane & 7) * 8);
    ATT_VADDR();
    const float c = 0.125f * LOG2E, sl = ex2(-(float)(h + 1)) * LOG2E * (float)dl;
    f32x16 o[2][2];
#pragma unroll
    for (int i = 0; i < 16; ++i) { o[0][0][i] = 0.f; o[0][1][i] = 0.f; o[1][0][i] = 0.f; o[1][1][i] = 0.f; }
    float m0 = -INFINITY, m1 = -INFINITY, l0 = 0.f, l1 = 0.f;
    const int klo = (i0 >= 64) ? 0 : 2, khi = (i0 + 128 <= L) ? 6 : 4;
    { const int ik0 = i0 - 64 + 32 * klo; stage32(wl, base + 512 + (size_t)ik0 * rs, base + 1024 + (size_t)ik0 * rs, rs, lane); }
    qrow_put(wl + 8192, qraw[0], lane); qrow_put(wl + 12288, qraw[1], lane); qfrag_get(wl + 8192, qf[0], r32, hh); qfrag_get(wl + 12288, qf[1], r32, hh);
    for (int kbi = klo; kbi < khi; ++kbi) {
        const LAS unsigned char* buf = wl + ((kbi - klo) & 1) * 8192;
        if (kbi + 1 < khi) { const int ik0 = i0 - 64 + 32 * (kbi + 1); stage32(wl + ((kbi + 1 - klo) & 1) * 8192, base + 512 + (size_t)ik0 * rs, base + 1024 + (size_t)ik0 * rs, rs, lane); ATT_WAIT_V(8); }
        else ATT_WAIT_V(0);
        const bool use0 = kbi <= 4, use1 = kbi >= 1;
        bf16x8 p00, p01, p10, p11;
        f32x16 sa, sb; qk32x2(buf, qf[0], qf[1], sa, sb, r32, hh);
        if (use0) { float t[16]; const float e0 = (float)((32 * kbi - 64) + 4 * hh - r32);
#pragma unroll
            for (int i = 0; i < 16; ++i) { const float ad = __builtin_fabsf(e0 + (float)((i & 3) + 8 * (i >> 2))); t[i] = ad <= 64.0f ? __builtin_fmaf(sa[i], c, -sl * ad) : -INFINITY; }
            sm_step2(t, m0, l0, o[0][0], o[0][1], p00, p01); }
        if (use1) { float t[16]; const float e0 = (float)((32 * kbi - 96) + 4 * hh - r32);
#pragma unroll
            for (int i = 0; i < 16; ++i) { const float ad = __builtin_fabsf(e0 + (float)((i & 3) + 8 * (i >> 2))); t[i] = ad <= 64.0f ? __builtin_fmaf(sb[i], c, -sl * ad) : -INFINITY; }
            sm_step2(t, m1, l1, o[1][0], o[1][1], p10, p11); }
        { bf16x8 v00, v01, v10, v11; vfrag4(buf, va0, va1, v00, v01, v10, v11);
          if (use0) { o[0][0] = ATT_MFMA(v00, p00, o[0][0]); o[0][1] = ATT_MFMA(v10, p00, o[0][1]); }
          if (use1) { o[1][0] = ATT_MFMA(v00, p10, o[1][0]); o[1][1] = ATT_MFMA(v10, p10, o[1][1]); }
          if (use0) { o[0][0] = ATT_MFMA(v01, p01, o[0][0]); o[0][1] = ATT_MFMA(v11, p01, o[0][1]); }
          if (use1) { o[1][0] = ATT_MFMA(v01, p11, o[1][0]); o[1][1] = ATT_MFMA(v11, p11, o[1][1]); } }
    }
    const float lt0 = xhalf_sum(l0), lt1 = xhalf_sum(l1);
#pragma unroll
    for (int qb = 0; qb < 2; ++qb) { const float lt = qb == 0 ? lt0 : lt1, mm = qb == 0 ? m0 : m1;
        const size_t tok = (size_t)b * SEQ + rho + (size_t)dl * (i0 + qb * 32 + r32);
        const float lse = mm + __builtin_amdgcn_logf(lt);
        if (!FINAL) {
            ostage(wl + qb * 4096, o[qb][0], o[qb][1], 1.0f / lt, r32, hh);
            if (hh == 0) DLo[(size_t)h * NTOK + tok] = lse;
        } else {
            const float a1 = DL1[(size_t)h * NTOK + tok], a2 = DL2[(size_t)h * NTOK + tok], mx = fmaxf(lse, fmaxf(a1, a2));
            const float e0 = ex2(lse - mx), e1 = ex2(a1 - mx), e2 = ex2(a2 - mx), es = 1.0f / (e0 + e1 + e2);
            ostage(wl + qb * 4096, o[qb][0], o[qb][1], e0 * es / lt, r32, hh);
            if (hh == 0) *(LAS f32x2*)(wl + 8192 + (qb * 32 + r32) * 8) = (f32x2){e1 * es, e2 * es};
        }
    }
    asm volatile("s_waitcnt lgkmcnt(0)" ::: "memory");
#pragma unroll
    for (int qb = 0; qb < 2; ++qb)
#pragma unroll
        for (int i = 0; i < 4; ++i) { const int r = 8 * i + (lane >> 3), ch = orow_chunk(lane, i);
            const size_t tok = (size_t)b * SEQ + rho + (size_t)dl * (i0 + qb * 32 + r);
            const v4u w = orow(wl + qb * 4096, lane, i);
            if (!FINAL) *(v4u*)(DPo + tok * 512 + h * 64 + ch * 8) = w;
            else { const f32x2 ww = *(const LAS f32x2*)(wl + 8192 + (qb * 32 + r) * 8);
                const v4u x1 = *(const v4u*)(DP1 + tok * 512 + h * 64 + ch * 8), x2 = *(const v4u*)(DP2 + tok * 512 + h * 64 + ch * 8);
                v4u y;
                y.x = cvtpk(bflo(w.x) + bflo(x1.x) * ww.x + bflo(x2.x) * ww.y, bfhi(w.x) + bfhi(x1.x) * ww.x + bfhi(x2.x) * ww.y);
                y.y = cvtpk(bflo(w.y) + bflo(x1.y) * ww.x + bflo(x2.y) * ww.y, bfhi(w.y) + bfhi(x1.y) * ww.x + bfhi(x2.y) * ww.y);
                y.z = cvtpk(bflo(w.z) + bflo(x1.z) * ww.x + bflo(x2.z) * ww.y, bfhi(w.z) + bfhi(x1.z) * ww.x + bfhi(x2.z) * ww.y);
                y.w = cvtpk(bflo(w.w) + bflo(x1.w) * ww.x + bflo(x2.w) * ww.y, bfhi(w.w) + bfhi(x1.w) * ww.x + bfhi(x2.w) * ww.y);
                *(v4u*)(OC + tok * DM + h * 64 + ch * 8) = y; } }
    asm volatile("s_waitcnt lgkmcnt(0)" ::: "memory");
}
__device__ __forceinline__ void na_tile(const bf16* QKV, const LAS float* rpb  , bf16* O, int idx, LAS unsigned char* wl, int lane) {
    asm volatile("" : "+v"(lane));
    const int r32 = lane & 31, hh = lane >> 5;
    const int cbk = idx & 3, iq = (idx >> 2) & 7, h = (idx >> 5) & 15, b = idx >> 9;
    const int qc = 16 * cbk + (r32 & 15), qr0 = 4 * iq + (r32 >> 4), qr1 = qr0 + 2;
    const bf16* qbase = QKV + ((size_t)h * NTOK + (size_t)b * SEQ) * 64; const bf16* kbase = qbase + (size_t)16 * NTOK * 64; const bf16* vbase = kbase + (size_t)16 * NTOK * 64;
    bf16x8 qf[2][4]; v4u qraw[2][4];
#pragma unroll
    for (int qb = 0; qb < 2; ++qb)
#pragma unroll
        for (int i = 0; i < 4; ++i) { const int r = 8 * i + (lane >> 3); qraw[qb][i] = *(const v4u*)(qbase + (size_t)((4 * iq + 2 * qb + (r >> 4)) * 64 + 16 * cbk + (r & 15)) * 64 + (lane & 7) * 8); }
    ATT_VADDR();
    const float c = 0.125f * LOG2E;
    const int csq = min(max(qc - 8, 0), 48), rs0 = min(max(qr0 - 4, 0), 24), rs1 = min(max(qr1 - 4, 0), 24);
    const int rA0 = min(max(4 * iq - 4, 0), 24), rB0 = min(max(4 * iq - 3, 0), 24) + 8, rA1 = min(max(4 * iq - 2, 0), 24), rB1 = min(max(4 * iq - 1, 0), 24) + 8;
    const int kc0 = min(max(16 * cbk - 8, 0), 32);
    const LAS float* rp = rpb + h * (15 * 31);
    f32x16 o[2][2];
#pragma unroll
    for (int i = 0; i < 16; ++i) { o[0][0][i] = 0.f; o[0][1][i] = 0.f; o[1][0][i] = 0.f; o[1][1][i] = 0.f; }
    float m0 = -INFINITY, m1 = -INFINITY, l0 = 0.f, l1 = 0.f;
    const int cd0 = kc0 + 4 * hh - csq, bc0 = kc0 + 4 * hh - qc + 15;
#define NA_ROW(kr_) ((size_t)((kr_) * 64 + kc0) * 64)
    stageK(wl, kbase + NA_ROW(rA0), 64, lane); stageV(wl + 8192, vbase + NA_ROW(rA0), 64, lane); stageK(wl + 4096, kbase + NA_ROW(rA0 + 1), 64, lane);
    qrow_put(wl + 12288, qraw[0], lane); qfrag_get(wl + 12288, qf[0], r32, hh); qrow_put(wl + 12288, qraw[1], lane); qfrag_get(wl + 12288, qf[1], r32, hh);
    ATT_WAIT_V(4);
    f32x16 sa, sb; qk32x2(wl, qf[0], qf[1], sa, sb, r32, hh);
    for (int kr = rA0; kr < rB1; ++kr) {
        const int j = kr - rA0; const bool n1 = kr + 1 < rB1, n2 = kr + 2 < rB1;
        if (n2) stageK(wl + (j & 1) * 4096, kbase + NA_ROW(kr + 2), 64, lane);
        if (n1) stageV(wl + 8192 + ((j + 1) & 1) * 4096, vbase + NA_ROW(kr + 1), 64, lane);
        if (n2) ATT_WAIT_V(8); else if (n1) ATT_WAIT_V(4); else ATT_WAIT_V(0);
        f32x16 na, nb;
        if (n1) qk32x2(wl + ((j + 1) & 1) * 4096, qf[0], qf[1], na, nb, r32, hh);
        const LAS unsigned char* buf = wl + 4096 + (j & 1) * 4096;
        const bool use0 = kr < rB0, use1 = kr >= rA1;
        bf16x8 p00, p01, p10, p11;
        if (use0) { float t[16]; const bool rok = (kr >= rs0) && (kr < rs0 + 8); const LAS float* bp = rp + (rok ? (kr - qr0 + 7) * 31 + bc0 : 0);
#pragma unroll
            for (int i = 0; i < 16; ++i) { const int dd = (i & 3) + 8 * (i >> 2); t[i] = bp[dd]; }
#pragma unroll
            for (int i = 0; i < 16; ++i) { const int dd = (i & 3) + 8 * (i >> 2); const bool ok = rok && ((unsigned)(cd0 + dd) < 16u); t[i] = ok ? __builtin_fmaf(sa[i], c, t[i]) : -INFINITY; }
            sm_step2(t, m0, l0, o[0][0], o[0][1], p00, p01); }
        if (use1) { float t[16]; const bool rok = (kr >= rs1) && (kr < rs1 + 8); const LAS float* bp = rp + (rok ? (kr - qr1 + 7) * 31 + bc0 : 0);
#pragma unroll
            for (int i = 0; i < 16; ++i) { const int dd = (i & 3) + 8 * (i >> 2); t[i] = bp[dd]; }
#pragma unroll
            for (int i = 0; i < 16; ++i) { const int dd = (i & 3) + 8 * (i >> 2); const bool ok = rok && ((unsigned)(cd0 + dd) < 16u); t[i] = ok ? __builtin_fmaf(sb[i], c, t[i]) : -INFINITY; }
            sm_step2(t, m1, l1, o[1][0], o[1][1], p10, p11); }
        { bf16x8 v00, v01, v10, v11; vfrag4(buf, va0, va1, v00, v01, v10, v11);
          if (use0) { o[0][0] = ATT_MFMA(v00, p00, o[0][0]); o[0][1] = ATT_MFMA(v10, p00, o[0][1]); }
          if (use1) { o[1][0] = ATT_MFMA(v00, p10, o[1][0]); o[1][1] = ATT_MFMA(v10, p10, o[1][1]); }
          if (use0) { o[0][0] = ATT_MFMA(v01, p01, o[0][0]); o[0][1] = ATT_MFMA(v11, p01, o[0][1]); }
          if (use1) { o[1][0] = ATT_MFMA(v01, p11, o[1][0]); o[1][1] = ATT_MFMA(v11, p11, o[1][1]); } }
        if (n1) { sa = na; sb = nb; }
    }
#undef NA_ROW
    const float i0 = 1.0f / xhalf_sum(l0), i1 = 1.0f / xhalf_sum(l1);
    ostage(wl, o[0][0], o[0][1], i0, r32, hh); ostage(wl + 4096, o[1][0], o[1][1], i1, r32, hh);
    asm volatile("s_waitcnt lgkmcnt(0)" ::: "memory");
#pragma unroll
    for (int qb = 0; qb < 2; ++qb)
#pragma unroll
        for (int i = 0; i < 4; ++i) { const int r = 8 * i + (lane >> 3);
            const v4u w = orow(wl + qb * 4096, lane, i);
            *(v4u*)(O + ((size_t)b * SEQ + (4 * iq + 2 * qb + (r >> 4)) * 64 + 16 * cbk + (r & 15)) * DM + h * 64 + orow_chunk(lane, i) * 8) = w; }
    asm volatile("s_waitcnt lgkmcnt(0)" ::: "memory");
}
}
#ifndef MK_MULTI
#define MK_MULTI 0
#endif
constexpr int NPH = 45;
struct Args { const float* in[22]; float* out; unsigned char* ws; int ph_lo, ph_hi; };
__global__ void __launch_bounds__(NWAVES * 64, 2) fwd(Args args) {
    extern __shared__ __attribute__((aligned(16))) unsigned char lds_raw[];
    Ctx C;
    C.out = args.out; C.ws = args.ws; C.lds = (LAS unsigned char*)lds_raw;
    C.tid = threadIdx.x; C.lane = C.tid & 63; C.wave = __builtin_amdgcn_readfirstlane(C.tid >> 6); C.G = gridDim.x; C.gw = blockIdx.x * NWAVES + C.wave; C.NGW = C.G * NWAVES;
    volatile LAS unsigned* MISC = (volatile LAS unsigned*)(C.lds + MISC_OFF);
    for (int u = C.tid; u < (LDS_BYTES - LDSCTL_OFF) / 4; u += NWAVES * 64) ((LAS unsigned*)(C.lds + LDSCTL_OFF))[u] = 0u;
    __syncthreads();
    XcdBarrier bar = xcd_barrier_post((unsigned*)(args.ws + WS_CTL) + CW_BAR, MISC + 8);
    const int lo = args.ph_lo, hi = args.ph_hi; int ph = 0; const int wave_s = C.wave;
#define PH_BEGIN { asm volatile("" : "+s"(ph)); const bool run_ = (ph >= lo && ph < hi); if (run_) { unsigned char* ws = args.ws; float* xo = args.out; int l_; asm volatile("v_mbcnt_lo_u32_b32 %0, -1, 0\n\tv_mbcnt_hi_u32_b32 %0, -1, %0" : "=v"(l_)); asm volatile("" : "+s"(ws), "+s"(xo)); \
        C.ws = ws; C.out = xo; C.lane = l_; C.wave = wave_s; C.tid = wave_s * 64 + l_; { int gw_ = blockIdx.x * NWAVES + wave_s, g_ = gridDim.x; asm volatile("" : "+s"(gw_), "+s"(g_)); C.gw = gw_; C.G = g_; C.NGW = g_ * NWAVES; } unsigned* ctl = (unsigned*)(ws + WS_CTL); (void)ctl;
#define PH_END } if (run_ && ph + 1 < hi) { XcdBarrier b2_ = bar; asm volatile("" : "+s"(b2_.bar)); int l2_; asm volatile("v_mbcnt_lo_u32_b32 %0, -1, 0\n\tv_mbcnt_hi_u32_b32 %0, -1, %0" : "=v"(l2_)); xcd_barrier(b2_, wave_s * 64 + l2_); } ++ph; }
#define H ((bf16*)(ws + WS_H))
#define XB ((bf16*)xo)
#define PROJ ((bf16*)(ws + WS_PROJ))
#define QM ((bf16*)(ws + WS_QM))
#define KVM ((bf16*)(ws + WS_KVM))
#define KPE ((bf16*)(ws + WS_KPE))
#define ACT ((bf16*)(ws + WS_ACT))
#define QKV ((bf16*)(ws + WS_QKV))
#define HG8 (ws + WS_HG8)
#define YALL ((bf16*)(ws + WS_YALL))
#define MACT (ws + WS_MACT)
#define wev (ws + WS_WEV + lp * EV_STRIDE)
#define wod (ws + WS_WOD + lp * OD_STRIDE)
#define cnt (ctl + CW_CNT + lp * N_CHUNK * 8 * 64)
#define xin (lp == 0 ? args.in[0] : (const float*)xo)
#define GEMM(EPI, ORD, g, S, E) pg8::gemm_phase<EPI, ORD, true, true, 0>(C.lds, g, S, E, C.tid)
#define GEMM8(EPI, ORD, g, S, E) pg8::gemm_phase<EPI, ORD, true, true, 1>(C.lds, g, S, E, C.tid)
#define GEMMI8(EPI, ORD, g, S, E) pg8::gemm_phase<EPI, ORD, true, true, 2>(C.lds, g, S, E, C.tid)

    PH_BEGIN p0_prologue(C, args); norm_phase<2, true>(C, args.in[0], args.in[1], H, XB); PH_END

    for (int lp = 0; lp < 2; ++lp) {
        PH_BEGIN { pg8::Gemm g{H, (const bf16*)(wev + EV_WIN), DM / 2, DM / 2, DM / 2}; pg8::StaticOrder S; S.init(NTOK, IN_E_PAD, C.G, (int)blockIdx.x); pg8::EpiBf16I8 E{PROJ, IN_E_PAD, (const float*)(ws + WS_SA), (const float*)(ws + WS_SB) + lp * 8192}; GEMMI8(pg8::EpiBf16I8, pg8::StaticOrder, g, S, E); } PH_END
        PH_BEGIN mla_prep_phase(C, PROJ, args.in[3] + lp * 256, args.in[5] + lp * 128, KPE); PH_END
        PH_BEGIN { { pg8::Gemm g{PROJ + 1536, (const bf16*)(wev + EV_WUQ), IN_E_PAD, 256, 256}; pg8::StaticOrder S; S.init(NTOK, 768, C.G, (int)blockIdx.x); pg8::EpiBf16 E{QM, 768}; GEMM(pg8::EpiBf16, pg8::StaticOrder, g, S, E); }
                   { pg8::Gemm g{PROJ + 1792, (const bf16*)(wev + EV_WUKV), IN_E_PAD, 256, 256}; pg8::StaticOrder S; S.init(NTOK, 1024, C.G, (int)blockIdx.x); pg8::EpiBf16 E{KVM, 1024}; GEMM(pg8::EpiBf16, pg8::StaticOrder, g, S, E); } } PH_END
        PH_BEGIN { const float* rope = (const float*)(ws + WS_ROPE);
                   if (wave_s >= 4) __builtin_amdgcn_s_setprio(1);
                   for (int it = blockIdx.x; it < 1024; it += C.G) att::mla_unit(QM, KVM, KPE, rope, H, it, C.lds, C.tid);
                   LAS unsigned char* wl = C.lds + C.wave * 16384;
                   for (int it = C.gw; it < 8192; it += C.NGW) att::dil_tile<false>(PROJ, 1, it, (bf16*)(ws + WS_DP1), (float*)(ws + WS_DL1), nullptr, nullptr, nullptr, nullptr, nullptr, wl, C.lane);
                   for (int it = C.gw; it < 8192; it += C.NGW) att::dil_tile<false>(PROJ, 4, it, (bf16*)(ws + WS_DP2), (float*)(ws + WS_DL2), nullptr, nullptr, nullptr, nullptr, nullptr, wl, C.lane); __builtin_amdgcn_s_setprio(0); } PH_END
        PH_BEGIN { LAS unsigned char* wl = C.lds + C.wave * 16384;
                   if (wave_s >= 4) __builtin_amdgcn_s_setprio(1);
                   for (int it = C.gw; it < 8192; it += C.NGW) att::dil_tile<true>(PROJ, 16, it, nullptr, nullptr, (const bf16*)(ws + WS_DP1), (const float*)(ws + WS_DL1), (const bf16*)(ws + WS_DP2), (const float*)(ws + WS_DL2), H, wl, C.lane); __builtin_amdgcn_s_setprio(0); } PH_END
        PH_BEGIN { pg8::Gemm g{H, (const bf16*)(wev + EV_WOUT), DM, DM, DM}; pg8::StaticOrder S; S.init(NTOK, DM, C.G, (int)blockIdx.x); pg8::EpiResidB E{(const pg8::bf16_t*)XB, (pg8::bf16_t*)XB, LDX}; GEMM(pg8::EpiResidB, pg8::StaticOrder, g, S, E); } PH_END
        PH_BEGIN norm_phase_b(C, XB, args.in[8] + lp * DM, H); PH_END
        PH_BEGIN { pg8::Gemm g{H, (const bf16*)(wev + EV_WGU), DM / 2, DM / 2, DM / 2}; pg8::StaticOrder S; S.init(NTOK, 2 * DFF, C.G, (int)blockIdx.x); pg8::EpiSwigluI8 E{ACT, DFF, (const float*)(ws + WS_SA), (const float*)(ws + WS_SB) + lp * 8192 + 2048}; GEMMI8(pg8::EpiSwigluI8, pg8::StaticOrder, g, S, E); } PH_END
        PH_BEGIN { pg8::Gemm g{ACT, (const bf16*)(wev + EV_WD), DFF, DFF, DFF}; pg8::StaticOrder S; S.init(NTOK, DM, C.G, (int)blockIdx.x); pg8::EpiResidB E{(const pg8::bf16_t*)XB, (pg8::bf16_t*)XB, LDX}; GEMM(pg8::EpiResidB, pg8::StaticOrder, g, S, E); } PH_END

        PH_BEGIN norm_phase_b(C, XB, args.in[12] + lp * DM, H); moe_weights(C, args, lp); PH_END
        PH_BEGIN { pg8::Gemm g{H, (const bf16*)(wod + OD_WQKV), DM / 2, DM / 2, DM / 2}; pg8::StaticOrder S; S.init(NTOK, 3072, C.G, (int)blockIdx.x); pg8::EpiBf16I8H E{QKV, NTOK, (const float*)(ws + WS_SA), (const float*)(ws + WS_SB) + 16384 + lp * 4096}; GEMMI8(pg8::EpiBf16I8H, pg8::StaticOrder, g, S, E); } PH_END
        PH_BEGIN { const float* rpb = args.in[14] + lp * 16 * 15 * 31; LAS float* rl = (LAS float*)(C.lds + RPB_OFF);
                   for (int i = C.tid; i < 16 * 15 * 31; i += NWAVES * 64) rl[i] = rpb[i] * 1.4426950408889634f;
                   __syncthreads();
                   LAS unsigned char* wl = C.lds + C.wave * 16384;
                   if (wave_s >= 4) __builtin_amdgcn_s_setprio(1);
                   for (int it = C.gw; it < 16384; it += C.NGW) att::na_tile(QKV, rl, H, it, wl, C.lane);
                   __builtin_amdgcn_s_setprio(0); } PH_END
        PH_BEGIN { pg8::Gemm g{H, (const bf16*)(wod + OD_WO), DM, DM, DM}; pg8::StaticOrder S; S.init(NTOK, DM, C.G, (int)blockIdx.x); pg8::EpiResidB E{(const pg8::bf16_t*)XB, (pg8::bf16_t*)XB, LDX}; GEMM(pg8::EpiResidB, pg8::StaticOrder, g, S, E); } PH_END
        PH_BEGIN route_phase(C, XB, args.in[16] + lp * DM, args.in[17] + lp * DM * NEXP, (unsigned char*)H, cnt); PH_END
        PH_BEGIN gather_all_phase(C, (const unsigned char*)H, HG8, cnt); PH_END
#define MOE_GU(ch_) { pg8::Gemm g{(const bf16*)(HG8 + (size_t)(ch_) * 2 * CHUNK_SLOTS * DM), (const bf16*)(ws + WS_MWGU), DM / 2, DM / 2, DM / 2}; pg8::GroupedOrder S; grouped_order(S, cnt, (ch_), 28, C.G, (int)blockIdx.x); \
            pg8::EpiSwigluF8 E{MACT + (size_t)((ch_) & 1) * CHUNK_SLOTS * DFFX, DFFX, 1.0f / 32.0f}; GEMM8(pg8::EpiSwigluF8, pg8::GroupedOrder, g, S, E); }
#define MOE_DOWN(ch_) { pg8::Gemm g{(const bf16*)(MACT + (size_t)((ch_) & 1) * CHUNK_SLOTS * DFFX), (const bf16*)(ws + WS_MWD), DFFX / 2, DFFX / 2, DFFX / 2}; pg8::GroupedOrder S; grouped_order(S, cnt, (ch_), 4, C.G, (int)blockIdx.x); \
            pg8::EpiBf16S E{YALL + (size_t)(ch_) * CHUNK_SLOTS * DM, DM, 1.0f / 32.0f}; GEMM8(pg8::EpiBf16S, pg8::GroupedOrder, g, S, E); }
        PH_BEGIN MOE_GU(0) PH_END
        for (int ch = 1; ch < N_CHUNK; ++ch) {
            PH_BEGIN MOE_DOWN(ch - 1) MOE_GU(ch) PH_END
        }
        PH_BEGIN MOE_DOWN(N_CHUNK - 1) PH_END
#undef MOE_GU
#undef MOE_DOWN
        PH_BEGIN { if (lp == 0) combine_all_phase<false>(C, XB, xo, YALL, args.in[1] + DM, H); else combine_all_phase<true>(C, XB, xo, YALL, args.in[21], H); } PH_END
    }
#undef PH_BEGIN
#undef PH_END
#undef GEMM
#undef XB
#undef H
#undef PROJ
#undef QM
#undef KVM
#undef KPE
#undef ACT
#undef QKV
#undef HG8
#undef YALL
#undef GEMM8
#undef GEMMI8
#undef MACT
#undef wev
#undef wod
#undef cnt
#undef xin
}

extern "C" void kernel_launch(void* const* d_in, const int* in_sizes, int n_in, void* d_out, int out_size, void* d_ws, size_t ws_size, hipStream_t stream) {
    static int grid = 0;
    if (grid == 0) {
        if (n_in != 22 || in_sizes[0] != NTOK * DM || out_size != NTOK * DM || ws_size < WS_END) { fprintf(stderr, "kernel_launch: unexpected shapes (n_in %d, in0 %d, out %d, ws %zu); nothing launched\n", n_in, n_in > 0 ? in_sizes[0] : -1, out_size, ws_size); grid = -1; return; }
        int dev = 0, cus = 0, per_cu = 0;
        if (hipGetDevice(&dev) != hipSuccess || hipDeviceGetAttribute(&cus, hipDeviceAttributeMultiprocessorCount, dev) != hipSuccess) { grid = -1; return; }
        if (hipFuncSetAttribute((const void*)fwd, hipFuncAttributeMaxDynamicSharedMemorySize, LDS_BYTES) != hipSuccess) { fprintf(stderr, "kernel_launch: hipFuncSetAttribute failed\n"); grid = -1; return; }
        if (hipOccupancyMaxActiveBlocksPerMultiprocessor(&per_cu, (const void*)fwd, NWAVES * 64, LDS_BYTES) != hipSuccess || per_cu < 1) { fprintf(stderr, "kernel_launch: occupancy query says %d blocks per CU\n", per_cu); }
        (void)hipGetLastError();
        grid = cus;
    }
    if (grid < 0) return;
    if (hipMemsetAsync((char*)d_ws + WS_CTL, 0, CTL_ZERO_BYTES, stream) != hipSuccess) return;
    Args a{};
    for (int i = 0; i < 22; ++i) a.in[i] = (const float*)d_in[i];
    a.out = (float*)d_out; a.ws = (unsigned char*)d_ws;
#if MK_MULTI
    for (int p = 0; p < NPH; ++p) { a.ph_lo = p; a.ph_hi = p + 1; hipLaunchKernelGGL(fwd, dim3(grid), dim3(NWAVES * 64), LDS_BYTES, stream, a); }
#else
    a.ph_lo = 0; a.ph_hi = NPH; hipLaunchKernelGGL(fwd, dim3(grid), dim3(NWAVES * 64), LDS_BYTES, stream, a);
#endif
}
```

```cpp
#include <hip/hip_runtime.h>
#include <cstdio>
#include <cstdint>
#define MK_MULTI 0
namespace pg8 {
#define PG8_LAS __attribute__((address_space(3)))
#define PG8_GAS __attribute__((address_space(1)))
typedef unsigned short bf16_t;
typedef short bf16x8 __attribute__((ext_vector_type(8)));
typedef float f32x4 __attribute__((ext_vector_type(4)));
typedef unsigned u32x4 __attribute__((ext_vector_type(4)));
typedef int v4i_t __attribute__((ext_vector_type(4)));
typedef int v8i_t __attribute__((ext_vector_type(8)));
constexpr int BM = 256, BK = 64, HALF = 128, HTB = HALF * BK * 2  , STAGE_BYTES = 8 * HTB, NXCD = 8, WGM = 8, EPI_SC_OFF = STAGE_BYTES + 1024  ;

__host__ __device__ __forceinline__ int lds_byte(int r, int c) { const int st = (r >> 4) * 2 + (c >> 5), rr = r & 15, cc = c & 31, ob = rr * 64 + cc * 2; return st * 1024 + (ob ^ (((ob >> 9) & 1) << 5)); }
__host__ __device__ __forceinline__ void stage_rc(int b, int& R, int& C) { const int st = b / 1024, sb = b % 1024, swz = sb ^ (((sb >> 9) & 1) << 5); R = (st >> 1) * 16 + swz / 64; C = (st & 1) * 32 + (swz % 64) / 2; }
__host__ __device__ __forceinline__ int perm32(int rho) { const int n = rho >> 4, i = rho & 15; return 8 * (i >> 2) + 4 * n + (i & 3); }

struct Unit { int pm, pn, pc; };
struct Gemm { const bf16_t* A; const bf16_t* Bt; int lda, ldb, K; };

struct StaticOrder {
    int nM, nN, nwg, G, c;
    __host__ __device__ void init(int M, int N, int G_, int c_) { nM = M / BM; nN = N / BM; nwg = nM * nN; G = G_; c = c_; }
    __host__ __device__ bool next(int i, Unit& u) const {
        const long L = (long)i * G + c; if (L >= nwg) return false;
        int wgid = (int)L; { const int q = nwg / NXCD, r = nwg % NXCD, xcd = wgid % NXCD, off = wgid / NXCD; wgid = (xcd < r ? xcd * (q + 1) : r * (q + 1) + (xcd - r) * q) + off; }
        const int nig = WGM * nN, gid = wgid / nig, fm = gid * WGM, gsz = (nM - fm) < WGM ? (nM - fm) : WGM;
        u.pm = fm + ((wgid % nig) % gsz); u.pn = (wgid % nig) / gsz; u.pc = u.pn; return true;
    }
    __device__ __forceinline__ void a_ready(const Unit&) const {}
    __device__ __forceinline__ void done(const Unit&) const {}
};
struct GroupedOrder {
    int t0, t1, t2, t3, t4, t5, t6, RT, nN, G, c;
    __device__ bool next(int i, Unit& u) const {
        const int nwg = RT * nN; const long L = (long)i * G + c; if (L >= nwg) return false;
        int wgid = (int)L; { const int q = nwg / NXCD, r = nwg % NXCD, xcd = wgid % NXCD, off = wgid / NXCD; wgid = (xcd < r ? xcd * (q + 1) : r * (q + 1) + (xcd - r) * q) + off; }
        const int nig = WGM * nN, gid = wgid / nig, fm = gid * WGM, gsz = (RT - fm) < WGM ? (RT - fm) : WGM, w = wgid - gid * nig;
        const int rt = fm + (w % gsz), j = w / gsz;
        const int e = (rt >= t0) + (rt >= t1) + (rt >= t2) + (rt >= t3) + (rt >= t4) + (rt >= t5) + (rt >= t6);
        u.pm = rt; u.pn = e * nN + j; u.pc = j; return true;
    }
    __device__ __forceinline__ void a_ready(const Unit&) const {}
    __device__ __forceinline__ void done(const Unit&) const {}
};

__device__ __forceinline__ unsigned cvt_pk_bf16(float lo, float hi) { unsigned r; asm volatile("v_cvt_pk_bf16_f32 %0, %1, %2" : "=v"(r) : "v"(lo), "v"(hi)); return r; }

struct EpiBf16 {
    static constexpr bool PERM = true, AFTER_DRAIN = false, PREFETCH = false;
    bf16_t* O; int ldc;
    __device__ __forceinline__ void operator()(const f32x4 (&acc)[2][2][4][2], const Unit& u, int wr, int wc, int fr, int fq) const {
        const int row0 = u.pm * BM + wr * 64 + fr, col0 = u.pc * BM + wc * 32 + 8 * fq;
#pragma unroll
        for (int ai = 0; ai < 2; ++ai)
#pragma unroll
            for (int m = 0; m < 4; ++m) { bf16_t* rowp = O + (size_t)(row0 + ai * HALF + m * 16) * ldc + col0;
#pragma unroll
                for (int bj = 0; bj < 2; ++bj) { const f32x4 v0 = acc[ai][bj][m][0], v1 = acc[ai][bj][m][1];
                    u32x4 w; w.x = cvt_pk_bf16(v0[0], v0[1]); w.y = cvt_pk_bf16(v0[2], v0[3]); w.z = cvt_pk_bf16(v1[0], v1[1]); w.w = cvt_pk_bf16(v1[2], v1[3]);
                    *(PG8_GAS u32x4*)(rowp + bj * HALF) = w; } }
    }
};
struct EpiSwiglu {
    static constexpr bool PERM = true, AFTER_DRAIN = false, PREFETCH = false;
    bf16_t* O; int ldc;
    __device__ __forceinline__ void operator()(const f32x4 (&acc)[2][2][4][2], const Unit& u, int wr, int wc, int fr, int fq) const {
        const int row0 = u.pm * BM + wr * 64 + fr, col0 = u.pc * HALF + wc * 32 + 8 * fq;
#pragma unroll
        for (int ai = 0; ai < 2; ++ai)
#pragma unroll
            for (int m = 0; m < 4; ++m) { bf16_t* rowp = O + (size_t)(row0 + ai * HALF + m * 16) * ldc + col0;
                float r[8];
#pragma unroll
                for (int n = 0; n < 2; ++n)
#pragma unroll
                    for (int k = 0; k < 4; ++k) { const float g = acc[ai][0][m][n][k], up = acc[ai][1][m][n][k];
                        r[n * 4 + k] = g * __builtin_amdgcn_rcpf(1.0f + __expf(-g)) * up; }
                u32x4 w; w.x = cvt_pk_bf16(r[0], r[1]); w.y = cvt_pk_bf16(r[2], r[3]); w.z = cvt_pk_bf16(r[4], r[5]); w.w = cvt_pk_bf16(r[6], r[7]);
                *(PG8_GAS u32x4*)rowp = w; }
    }
};
__device__ __forceinline__ unsigned cvt4_fp8(float a, float b, float c, float d) { int r = 0; r = __builtin_amdgcn_cvt_pk_fp8_f32(a, b, r, false); r = __builtin_amdgcn_cvt_pk_fp8_f32(c, d, r, true); return (unsigned)r; }
struct EpiSwigluF8 {
    static constexpr bool PERM = true, AFTER_DRAIN = false, PREFETCH = false;
    unsigned char* O; int ldc; float sc;
    __device__ __forceinline__ void operator()(const f32x4 (&acc)[2][2][4][2], const Unit& u, int wr, int wc, int fr, int fq) const {
        const int row0 = u.pm * BM + wr * 64 + fr, col0 = u.pc * HALF + wc * 32 + 8 * fq;
        const float c1 = -1.4426950408889634f * sc, k2 = 1.0f / (sc * sc);
#pragma unroll
        for (int ai = 0; ai < 2; ++ai)
#pragma unroll
            for (int m = 0; m < 4; ++m) { unsigned char* rowp = O + (size_t)(row0 + ai * HALF + m * 16) * ldc + col0;
                typedef unsigned u32x2_t __attribute__((ext_vector_type(2)));
                u32x2_t w;
#pragma unroll
                for (int n = 0; n < 2; ++n) { const f32x4 ag = acc[ai][0][m][n], au = acc[ai][1][m][n];
                    const f32x4 x = ag * c1; f32x4 tt;
#pragma unroll
                    for (int k = 0; k < 4; ++k) tt[k] = __builtin_amdgcn_exp2f(x[k]);
                    const f32x4 d = tt * k2 + k2; f32x4 r;
#pragma unroll
                    for (int k = 0; k < 4; ++k) r[k] = __builtin_amdgcn_rcpf(d[k]);
                    const f32x4 o = (ag * au) * r;
                    w[n] = cvt4_fp8(o[0], o[1], o[2], o[3]); }
                *(PG8_GAS u32x2_t*)rowp = w; }
    }
};
struct EpiBf16S {
    static constexpr bool PERM = true, AFTER_DRAIN = false, PREFETCH = false;
    bf16_t* O; int ldc; float sc;
    __device__ __forceinline__ void operator()(const f32x4 (&acc)[2][2][4][2], const Unit& u, int wr, int wc, int fr, int fq) const {
        const int row0 = u.pm * BM + wr * 64 + fr, col0 = u.pc * BM + wc * 32 + 8 * fq;
#pragma unroll
        for (int ai = 0; ai < 2; ++ai)
#pragma unroll
            for (int m = 0; m < 4; ++m) { bf16_t* rowp = O + (size_t)(row0 + ai * HALF + m * 16) * ldc + col0;
#pragma unroll
                for (int bj = 0; bj < 2; ++bj) { const f32x4 v0 = acc[ai][bj][m][0] * sc, v1 = acc[ai][bj][m][1] * sc;
                    u32x4 w; w.x = cvt_pk_bf16(v0[0], v0[1]); w.y = cvt_pk_bf16(v0[2], v0[3]); w.z = cvt_pk_bf16(v1[0], v1[1]); w.w = cvt_pk_bf16(v1[2], v1[3]);
                    *(PG8_GAS u32x4*)(rowp + bj * HALF) = w; } }
    }
};
struct EpiBf16I8 {
    static constexpr bool PERM = true, AFTER_DRAIN = false, PREFETCH = true;
    bf16_t* O; int ldc; const float* sa; const float* sb;
    __device__ __forceinline__ void prefetch(const Unit& u, PG8_LAS unsigned char* blk, int wid, int lane) const {
        const float* src = (wid < 4) ? sa + u.pm * BM + wid * 64 + lane : sb + u.pn * BM + (wid - 4) * 64 + lane;
        __builtin_amdgcn_global_load_lds((const unsigned*)src, (PG8_LAS unsigned*)(blk + wid * 256), 4, 0, 0);
    }
    __device__ __forceinline__ void run(const f32x4 (&acc)[2][2][4][2], const Unit& u, int wr, int wc, int fr, int fq, const PG8_LAS float* scl) const {
        const int row0 = u.pm * BM + wr * 64 + fr, col0 = u.pc * BM + wc * 32 + 8 * fq, lrow0 = wr * 64 + fr, bcol0 = 256 + wc * 32 + 8 * fq;
        f32x4 sc[2][2];
#pragma unroll
        for (int bj = 0; bj < 2; ++bj)
#pragma unroll
            for (int n = 0; n < 2; ++n) sc[bj][n] = *(const PG8_LAS f32x4*)(scl + bcol0 + bj * HALF + 4 * n);
#pragma unroll
        for (int ai = 0; ai < 2; ++ai)
#pragma unroll
            for (int m = 0; m < 4; ++m) { const int row = row0 + ai * HALF + m * 16; bf16_t* rowp = O + (size_t)row * ldc + col0; const float s = scl[lrow0 + ai * HALF + m * 16];
#pragma unroll
                for (int bj = 0; bj < 2; ++bj) { f32x4 v[2];
#pragma unroll
                    for (int n = 0; n < 2; ++n) { f32x4 fa;
#pragma unroll
                        for (int k = 0; k < 4; ++k) { const float f = acc[ai][bj][m][n][k]; fa[k] = (float)__builtin_bit_cast(int, f); }
                        v[n] = fa * (sc[bj][n] * s); }
                    u32x4 w; w.x = cvt_pk_bf16(v[0][0], v[0][1]); w.y = cvt_pk_bf16(v[0][2], v[0][3]); w.z = cvt_pk_bf16(v[1][0], v[1][1]); w.w = cvt_pk_bf16(v[1][2], v[1][3]);
                    *(PG8_GAS u32x4*)(rowp + bj * HALF) = w; } }
    }
};
struct EpiBf16I8H {
    static constexpr bool PERM = true, AFTER_DRAIN = false, PREFETCH = true;
    bf16_t* O; int nrows; const float* sa; const float* sb;
    __device__ __forceinline__ void prefetch(const Unit& u, PG8_LAS unsigned char* blk, int wid, int lane) const {
        const float* src = (wid < 4) ? sa + u.pm * BM + wid * 64 + lane : sb + u.pn * BM + (wid - 4) * 64 + lane;
        __builtin_amdgcn_global_load_lds((const unsigned*)src, (PG8_LAS unsigned*)(blk + wid * 256), 4, 0, 0);
    }
    __device__ __forceinline__ void run(const f32x4 (&acc)[2][2][4][2], const Unit& u, int wr, int wc, int fr, int fq, const PG8_LAS float* scl) const {
        const int row0 = u.pm * BM + wr * 64 + fr, col0 = u.pc * BM + wc * 32 + 8 * fq, lrow0 = wr * 64 + fr, bcol0 = 256 + wc * 32 + 8 * fq;
        f32x4 sc[2][2];
#pragma unroll
        for (int bj = 0; bj < 2; ++bj)
#pragma unroll
            for (int n = 0; n < 2; ++n) sc[bj][n] = *(const PG8_LAS f32x4*)(scl + bcol0 + bj * HALF + 4 * n);
#pragma unroll
        for (int ai = 0; ai < 2; ++ai)
#pragma unroll
            for (int m = 0; m < 4; ++m) { const int row = row0 + ai * HALF + m * 16; const float s = scl[lrow0 + ai * HALF + m * 16];
#pragma unroll
                for (int bj = 0; bj < 2; ++bj) { f32x4 v[2];
#pragma unroll
                    for (int n = 0; n < 2; ++n) { f32x4 fa;
#pragma unroll
                        for (int k = 0; k < 4; ++k) { const float f = acc[ai][bj][m][n][k]; fa[k] = (float)__builtin_bit_cast(int, f); }
                        v[n] = fa * (sc[bj][n] * s); }
                    u32x4 w; w.x = cvt_pk_bf16(v[0][0], v[0][1]); w.y = cvt_pk_bf16(v[0][2], v[0][3]); w.z = cvt_pk_bf16(v[1][0], v[1][1]); w.w = cvt_pk_bf16(v[1][2], v[1][3]);
                    const int cc = col0 + bj * HALF; *(PG8_GAS u32x4*)(O + ((size_t)(cc >> 6) * nrows + row) * 64 + (cc & 63)) = w; } }
    }
};
struct EpiSwigluI8 {
    static constexpr bool PERM = true, AFTER_DRAIN = false, PREFETCH = true;
    bf16_t* O; int ldc; const float* sa; const float* sb;
    __device__ __forceinline__ void prefetch(const Unit& u, PG8_LAS unsigned char* blk, int wid, int lane) const {
        const float* src = (wid < 4) ? sa + u.pm * BM + wid * 64 + lane : sb + u.pn * BM + (wid - 4) * 64 + lane;
        __builtin_amdgcn_global_load_lds((const unsigned*)src, (PG8_LAS unsigned*)(blk + wid * 256), 4, 0, 0);
    }
    __device__ __forceinline__ void run(const f32x4 (&acc)[2][2][4][2], const Unit& u, int wr, int wc, int fr, int fq, const PG8_LAS float* scl) const {
        const int row0 = u.pm * BM + wr * 64 + fr, col0 = u.pc * HALF + wc * 32 + 8 * fq, lrow0 = wr * 64 + fr, bcol0 = 256 + wc * 32 + 8 * fq;
        f32x4 c1[2], c2[2]; float one = 1.0f; asm volatile("" : "+v"(one));
#pragma unroll
        for (int n = 0; n < 2; ++n) { const f32x4 sg = *(const PG8_LAS f32x4*)(scl + bcol0 + 4 * n), su = *(const PG8_LAS f32x4*)(scl + bcol0 + HALF + 4 * n); c1[n] = sg * -1.4426950408889634f; c2[n] = sg * su; }
#pragma unroll
        for (int ai = 0; ai < 2; ++ai)
#pragma unroll
            for (int m = 0; m < 4; ++m) { const int row = row0 + ai * HALF + m * 16; bf16_t* rowp = O + (size_t)row * ldc + col0; const float s = scl[lrow0 + ai * HALF + m * 16], s2 = s * s;
                u32x4 w;
#pragma unroll
                for (int n = 0; n < 2; ++n) { f32x4 fa, fu;
#pragma unroll
                    for (int k = 0; k < 4; ++k) { const float fg = acc[ai][0][m][n][k], fv = acc[ai][1][m][n][k]; fa[k] = (float)__builtin_bit_cast(int, fg); fu[k] = (float)__builtin_bit_cast(int, fv); }
                    const f32x4 x = fa * (c1[n] * s); f32x4 tt, r;
#pragma unroll
                    for (int k = 0; k < 4; ++k) tt[k] = __builtin_amdgcn_exp2f(x[k]);
                    const f32x4 d = tt * one + one;
#pragma unroll
                    for (int k = 0; k < 4; ++k) r[k] = __builtin_amdgcn_rcpf(d[k]);
                    const f32x4 o = ((fa * fu) * (c2[n] * s2)) * r;
                    if (n == 0) { w.x = cvt_pk_bf16(o[0], o[1]); w.y = cvt_pk_bf16(o[2], o[3]); } else { w.z = cvt_pk_bf16(o[0], o[1]); w.w = cvt_pk_bf16(o[2], o[3]); } }
                *(PG8_GAS u32x4*)rowp = w; }
    }
};
struct EpiNull { static constexpr bool PERM = true, AFTER_DRAIN = false, PREFETCH = false; int dummy;
    __device__ __forceinline__ void operator()(const f32x4 (&acc)[2][2][4][2], const Unit& u, int wr, int wc, int fr, int fq) const { float s = 0.f;
#pragma unroll
        for (int a = 0; a < 2; ++a)
#pragma unroll
            for (int b = 0; b < 2; ++b)
#pragma unroll
                for (int m = 0; m < 4; ++m)
#pragma unroll
                    for (int n = 0; n < 2; ++n) s += acc[a][b][m][n][0] + acc[a][b][m][n][1] + acc[a][b][m][n][2] + acc[a][b][m][n][3];
        asm volatile("" :: "v"(s)); }
};
struct EpiResidB {
    static constexpr bool PERM = true, AFTER_DRAIN = false, PREFETCH = false;
    const bf16_t* base; bf16_t* out; int ldc;
    __device__ __forceinline__ void operator()(const f32x4 (&acc)[2][2][4][2], const Unit& u, int wr, int wc, int fr, int fq) const {
        const int row0 = u.pm * BM + wr * 64 + fr, col0 = u.pc * BM + wc * 32 + 8 * fq;
#pragma unroll
        for (int ai = 0; ai < 2; ++ai)
#pragma unroll
            for (int m = 0; m < 4; ++m) { const size_t ro = (size_t)(row0 + ai * HALF + m * 16) * ldc + col0;
#pragma unroll
                for (int bj = 0; bj < 2; ++bj) { const u32x4 b = *(const PG8_GAS u32x4*)(base + ro + bj * HALF); const f32x4 v0 = acc[ai][bj][m][0], v1 = acc[ai][bj][m][1];
                    u32x4 w; w.x = cvt_pk_bf16(v0[0] + __builtin_bit_cast(float, b.x << 16), v0[1] + __builtin_bit_cast(float, b.x & 0xffff0000u)); w.y = cvt_pk_bf16(v0[2] + __builtin_bit_cast(float, b.y << 16), v0[3] + __builtin_bit_cast(float, b.y & 0xffff0000u));
                    w.z = cvt_pk_bf16(v1[0] + __builtin_bit_cast(float, b.z << 16), v1[1] + __builtin_bit_cast(float, b.z & 0xffff0000u)); w.w = cvt_pk_bf16(v1[2] + __builtin_bit_cast(float, b.w << 16), v1[3] + __builtin_bit_cast(float, b.w & 0xffff0000u));
                    *(PG8_GAS u32x4*)(out + ro + bj * HALF) = w; } }
    }
};
struct EpiResid {
    static constexpr bool PERM = false, AFTER_DRAIN = false, PREFETCH = false;
    const float* base; float* out; int ldc;
    __device__ __forceinline__ void operator()(const f32x4 (&acc)[2][2][4][2], const Unit& u, int wr, int wc, int fr, int fq) const {
        const int row0 = u.pm * BM + wr * 64 + fr, col0 = u.pc * BM + wc * 32 + 4 * fq;
#pragma unroll
        for (int ai = 0; ai < 2; ++ai)
#pragma unroll
            for (int m = 0; m < 4; ++m) { const size_t ro = (size_t)(row0 + ai * HALF + m * 16) * ldc + col0;
#pragma unroll
                for (int bj = 0; bj < 2; ++bj)
#pragma unroll
                    for (int n = 0; n < 2; ++n) { const size_t o = ro + bj * HALF + n * 16;
                        const f32x4 b = *(const PG8_GAS f32x4*)(base + o); *(PG8_GAS f32x4*)(out + o) = b + acc[ai][bj][m][n]; } }
    }
};
template <class Epi, class Sched, bool ALIGN_EPI = false, bool SP2 = false, int DT = 0>
__device__ __forceinline__ void gemm_phase(PG8_LAS unsigned char* lds, const Gemm g, const Sched& S, const Epi& E, int tid_in) {
    int tid_ = tid_in; asm volatile("" : "+v"(tid_));
    const int tid = tid_, wid = __builtin_amdgcn_readfirstlane(tid >> 6), lane = tid & 63, wr = wid >> 2, wc = wid & 3, fr = lane & 15, fq = lane >> 4;
    const int K = g.K, nt = K / BK;
    unsigned voffA[2], voffB[2];
#pragma unroll
    for (int i = 0; i < 2; ++i) { int R, C; stage_rc(tid * 16 + i * 8192, R, C); const int Rb = Epi::PERM ? ((R & ~31) + perm32(R & 31)) : R;
        voffA[i] = (unsigned)(R * g.lda + C) * 2u; voffB[i] = (unsigned)(Rb * g.ldb + C) * 2u; }
    const size_t kstep = (size_t)(BK * 2);
    const size_t hstepA = (size_t)HALF * g.lda * 2, hstepB = (size_t)HALF * g.ldb * 2;
    const size_t tstepA = 2 * hstepA, tstepB = 2 * hstepB;
    const unsigned ldsw = (unsigned)wid * 1024u;
    const int aoff = lds_byte(wr * 64 + fr, fq * 8), boff = lds_byte(wc * 32 + fr, fq * 8);
#define PG8_SA(b, h) (((b) * 2 + (h)) * HTB)
#define PG8_SB(b, h) ((4 + (b) * 2 + (h)) * HTB)
#define PG8_STAGE(bufoff, gbase, voff) do { _Pragma("unroll") for (int _i = 0; _i < 2; ++_i) \
        __builtin_amdgcn_global_load_lds((const unsigned*)((const char*)(gbase) + (voff)[_i]), (PG8_LAS unsigned*)(lds + (bufoff) + ldsw + _i * 8192), 16, 0, 0); } while (0)
#define PG8_LD16(base, off) (*(const PG8_LAS v4i_t*)((base) + (off)))
#define PG8_LDA(dst, b, h) do { if constexpr (DT == 1) { _Pragma("unroll") for (int m = 0; m < 4; ++m) A8[m] = __builtin_shufflevector(PG8_LD16(abase8, ((b) * 2 + (h)) * HTB + m * 2048), PG8_LD16(abase8, ((b) * 2 + (h)) * HTB + m * 2048 + 1024), 0, 1, 2, 3, 4, 5, 6, 7); } \
        else { _Pragma("unroll") for (int m = 0; m < 4; ++m) _Pragma("unroll") for (int k = 0; k < 2; ++k) dst[m][k] = *(const PG8_LAS bf16x8*)(lds + PG8_SA(b, h) + aoff + m * 2048 + k * 1024); } } while (0)
#define PG8_LDB(dst, b, h) do { if constexpr (DT == 1) { _Pragma("unroll") for (int n = 0; n < 2; ++n) dst##8[n] = __builtin_shufflevector(PG8_LD16(bbase8, ((b) * 2 + (h)) * HTB + n * 2048), PG8_LD16(bbase8, ((b) * 2 + (h)) * HTB + n * 2048 + 1024), 0, 1, 2, 3, 4, 5, 6, 7); } \
        else { _Pragma("unroll") for (int n = 0; n < 2; ++n) _Pragma("unroll") for (int k = 0; k < 2; ++k) dst[n][k] = *(const PG8_LAS bf16x8*)(lds + PG8_SB(b, h) + boff + n * 2048 + k * 1024); } } while (0)
#define PG8_MMA(ai, bj, At, Bt, first) do { __builtin_amdgcn_s_setprio(1); \
        if constexpr (DT == 1) { if (first) { _Pragma("unroll") for (int m = 0; m < 4; ++m) _Pragma("unroll") for (int n = 0; n < 2; ++n) \
            asm volatile("v_mfma_f32_16x16x128_f8f6f4 %0, %1, %2, 0" : "=v"(acc[ai][bj][m][n]) : "v"(Bt##8[n]), "v"(A8[m])); } \
          else { _Pragma("unroll") for (int m = 0; m < 4; ++m) _Pragma("unroll") for (int n = 0; n < 2; ++n) \
            asm volatile("v_mfma_f32_16x16x128_f8f6f4 %0, %1, %2, %0" : "+v"(acc[ai][bj][m][n]) : "v"(Bt##8[n]), "v"(A8[m])); } } \
        else if constexpr (DT == 2) {   \
          if (first) { _Pragma("unroll") for (int m = 0; m < 4; ++m) _Pragma("unroll") for (int n = 0; n < 2; ++n) \
            asm volatile("v_mfma_i32_16x16x64_i8 %0, %1, %2, 0" : "=v"(acc[ai][bj][m][n]) : "v"(Bt[n][0]), "v"(At[m][0])); } \
          else { _Pragma("unroll") for (int m = 0; m < 4; ++m) _Pragma("unroll") for (int n = 0; n < 2; ++n) \
            asm volatile("v_mfma_i32_16x16x64_i8 %0, %1, %2, %0" : "+v"(acc[ai][bj][m][n]) : "v"(Bt[n][0]), "v"(At[m][0])); } \
          _Pragma("unroll") for (int m = 0; m < 4; ++m) _Pragma("unroll") for (int n = 0; n < 2; ++n) \
            asm volatile("v_mfma_i32_16x16x64_i8 %0, %1, %2, %0" : "+v"(acc[ai][bj][m][n]) : "v"(Bt[n][1]), "v"(At[m][1])); } \
        else { _Pragma("unroll") for (int m = 0; m < 4; ++m) _Pragma("unroll") for (int n = 0; n < 2; ++n) _Pragma("unroll") for (int k = 0; k < 2; ++k) \
            acc[ai][bj][m][n] = __builtin_amdgcn_mfma_f32_16x16x32_bf16(Bt[n][k], At[m][k], acc[ai][bj][m][n], 0, 0, 0); } \
        __builtin_amdgcn_s_setprio(0); } while (0)
#define PG8_WAIT_V(n) asm volatile("s_waitcnt vmcnt(" #n ")" ::: "memory")
#define PG8_WAIT_L(n) asm volatile("s_waitcnt lgkmcnt(" #n ")" ::: "memory")
#define PG8_BAR __builtin_amdgcn_s_barrier()
#define PG8_SCHED __builtin_amdgcn_sched_barrier(0)
    Unit cur, nxt; int ui = 0;
    if (!S.next(0, cur)) return;
    f32x4 acc[2][2][4][2];
    if constexpr (DT == 0) {
#pragma unroll
        for (int a = 0; a < 2; ++a)
#pragma unroll
            for (int b = 0; b < 2; ++b)
#pragma unroll
                for (int m = 0; m < 4; ++m)
#pragma unroll
                    for (int n = 0; n < 2; ++n) acc[a][b][m][n] = (f32x4){0.f, 0.f, 0.f, 0.f};
    }
    PG8_LAS unsigned char* abase8 = lds + aoff; PG8_LAS unsigned char* bbase8 = lds + 4 * HTB + boff; asm volatile("" : "+v"(abase8), "+v"(bbase8));
    bf16x8 At[4][2], B0[2][2], B1[2][2]; v8i_t A8[4], B08[2], B18[2];
    const char* cA = (const char*)g.A + (size_t)cur.pm * tstepA; const char* cB = (const char*)g.Bt + (size_t)cur.pn * tstepB;
    S.a_ready(cur);
    if constexpr (Epi::PREFETCH) E.prefetch(cur, lds + EPI_SC_OFF, wid, lane);
    if constexpr (SP2) {
        PG8_STAGE(PG8_SB(0, 0), cB, voffB); PG8_STAGE(PG8_SB(0, 1), cB + hstepB, voffB); PG8_STAGE(PG8_SA(0, 0), cA, voffA); PG8_STAGE(PG8_SA(0, 1), cA + hstepA, voffA);
        if (wr == 1) PG8_BAR;
        PG8_WAIT_V(2); PG8_BAR;
        PG8_STAGE(PG8_SB(1, 0), cB + kstep, voffB); PG8_STAGE(PG8_SA(1, 0), cA + kstep, voffA); PG8_STAGE(PG8_SB(1, 1), cB + hstepB + kstep, voffB);
        PG8_WAIT_V(6); PG8_BAR;
    } else {
        PG8_STAGE(PG8_SB(0, 0), cB, voffB); PG8_STAGE(PG8_SA(0, 0), cA, voffA); PG8_STAGE(PG8_SB(0, 1), cB + hstepB, voffB); PG8_STAGE(PG8_SA(0, 1), cA + hstepA, voffA);
        if (wr == 1) PG8_BAR;
        PG8_WAIT_V(4); PG8_BAR;
        PG8_STAGE(PG8_SB(1, 0), cB + kstep, voffB); PG8_STAGE(PG8_SA(1, 0), cA + kstep, voffA); PG8_STAGE(PG8_SB(1, 1), cB + hstepB + kstep, voffB);
        PG8_WAIT_V(6); PG8_BAR;
    }
    for (;;) {
        const bool has_next = S.next(ui + 1, nxt);
        const char* nA = has_next ? (const char*)g.A + (size_t)nxt.pm * tstepA : cA; const char* nB = has_next ? (const char*)g.Bt + (size_t)nxt.pn * tstepB : cB;
#define PG8_ITER(FIRST) \
            const bool last = (t == nt - 2); \
            const char* a1 = cA + (size_t)(t + 1) * kstep; \
            const char* a2 = last ? nA : cA + (size_t)(t + 2) * kstep; const char* b2 = last ? nB : cB + (size_t)(t + 2) * kstep; \
            const char* a3 = a2 + kstep; const char* b3 = b2 + kstep; \
            if (last && has_next) S.a_ready(nxt); \
            if constexpr (SP2) { \
            PG8_LDB(B0, 0, 0); PG8_LDB(B1, 0, 1); PG8_SCHED; PG8_LDA(At, 0, 0); PG8_STAGE(PG8_SA(1, 1), a1 + hstepA, voffA); \
            PG8_WAIT_V(8); PG8_WAIT_L(0); PG8_BAR; PG8_MMA(0, 0, At, B0, FIRST); PG8_MMA(0, 1, At, B1, FIRST); PG8_BAR; PG8_SCHED; \
            PG8_LDA(At, 0, 1); PG8_STAGE(PG8_SB(0, 0), b2, voffB); PG8_STAGE(PG8_SB(0, 1), b2 + hstepB, voffB); PG8_STAGE(PG8_SA(0, 0), a2, voffA); \
            PG8_WAIT_V(8); PG8_WAIT_L(0); PG8_BAR; PG8_MMA(1, 0, At, B0, FIRST); PG8_MMA(1, 1, At, B1, FIRST); PG8_BAR; PG8_SCHED; \
            PG8_LDB(B0, 1, 0); PG8_LDB(B1, 1, 1); PG8_SCHED; PG8_LDA(At, 1, 0); PG8_STAGE(PG8_SA(0, 1), a2 + hstepA, voffA); \
            PG8_WAIT_V(8); PG8_WAIT_L(0); PG8_BAR; PG8_MMA(0, 0, At, B0, false); PG8_MMA(0, 1, At, B1, false); PG8_BAR; PG8_SCHED; \
            PG8_LDA(At, 1, 1); PG8_STAGE(PG8_SB(1, 0), b3, voffB); PG8_STAGE(PG8_SB(1, 1), b3 + hstepB, voffB); PG8_STAGE(PG8_SA(1, 0), a3, voffA); \
            PG8_WAIT_V(8); PG8_WAIT_L(0); PG8_BAR; PG8_MMA(1, 0, At, B0, false); PG8_MMA(1, 1, At, B1, false); PG8_BAR; PG8_SCHED; \
            } else { \
            PG8_LDB(B0, 0, 0); PG8_SCHED; PG8_LDA(At, 0, 0); PG8_STAGE(PG8_SA(1, 1), a1 + hstepA, voffA); \
            PG8_WAIT_L(8); PG8_BAR; PG8_WAIT_L(0); PG8_MMA(0, 0, At, B0, FIRST); PG8_BAR; PG8_SCHED; \
            PG8_LDB(B1, 0, 1); PG8_STAGE(PG8_SB(0, 0), b2, voffB); \
            PG8_BAR; PG8_WAIT_L(0); PG8_MMA(0, 1, At, B1, FIRST); PG8_BAR; \
            PG8_LDA(At, 0, 1); PG8_STAGE(PG8_SA(0, 0), a2, voffA); \
            PG8_BAR; PG8_WAIT_L(0); PG8_MMA(1, 0, At, B0, FIRST); PG8_BAR; PG8_SCHED; \
            PG8_STAGE(PG8_SB(0, 1), b2 + hstepB, voffB); \
            PG8_WAIT_V(6); PG8_BAR; PG8_MMA(1, 1, At, B1, FIRST); PG8_BAR; \
            PG8_LDB(B0, 1, 0); PG8_SCHED; PG8_LDA(At, 1, 0); PG8_STAGE(PG8_SA(0, 1), a2 + hstepA, voffA); \
            PG8_WAIT_L(8); PG8_BAR; PG8_WAIT_L(0); PG8_MMA(0, 0, At, B0, false); PG8_BAR; PG8_SCHED; \
            PG8_LDB(B1, 1, 1); PG8_STAGE(PG8_SB(1, 0), b3, voffB); \
            PG8_BAR; PG8_WAIT_L(0); PG8_MMA(0, 1, At, B1, false); PG8_BAR; \
            PG8_LDA(At, 1, 1); PG8_STAGE(PG8_SA(1, 0), a3, voffA); \
            PG8_BAR; PG8_WAIT_L(0); PG8_MMA(1, 0, At, B0, false); PG8_BAR; PG8_SCHED; \
            PG8_STAGE(PG8_SB(1, 1), b3 + hstepB, voffB); \
            PG8_WAIT_V(6); PG8_BAR; PG8_MMA(1, 1, At, B1, false); PG8_BAR; \
            }
        int t = 0;
        if constexpr (DT != 0) { PG8_ITER(true) t = 2; }
#pragma clang loop unroll(disable)
        for (; t < nt; t += 2) {
            PG8_ITER(false)
        }
#undef PG8_ITER
        if constexpr (DT != 0) asm volatile("s_nop 15\n\ts_nop 15" ::: "memory");
        if constexpr (ALIGN_EPI) { if (wr == 0) PG8_BAR; }
        if constexpr (Epi::PREFETCH) { E.run(acc, cur, wr, wc, fr, fq, (const PG8_LAS float*)(lds + EPI_SC_OFF + (ui & 1) * 2048)); S.done(cur);
            if (has_next) E.prefetch(nxt, lds + EPI_SC_OFF + ((ui + 1) & 1) * 2048, wid, lane); }
        else if constexpr (!Epi::AFTER_DRAIN) { E(acc, cur, wr, wc, fr, fq); S.done(cur); }
        if (!has_next) break;
        if constexpr (DT == 0) {
#pragma unroll
        for (int a = 0; a < 2; ++a)
#pragma unroll
            for (int b = 0; b < 2; ++b)
#pragma unroll
                for (int m = 0; m < 4; ++m)
#pragma unroll
                    for (int n = 0; n < 2; ++n) acc[a][b][m][n] = (f32x4){0.f, 0.f, 0.f, 0.f};
        }
        cur = nxt; cA = nA; cB = nB; ++ui;
        if constexpr (ALIGN_EPI) { if (wr == 1) PG8_BAR; }
    }
    PG8_WAIT_V(0);
    if constexpr (!ALIGN_EPI) { if (wr == 0) PG8_BAR; }
    PG8_BAR;
    if constexpr (Epi::AFTER_DRAIN) { E.fused(acc, cur, wr, wc, fr, fq, lds, wid, lane); S.done(cur); }
#undef PG8_SA
#undef PG8_SB
#undef PG8_STAGE
#undef PG8_LD16
#undef PG8_LDA
#undef PG8_LDB
#undef PG8_MMA
#undef PG8_WAIT_V
#undef PG8_WAIT_L
#undef PG8_BAR
#undef PG8_SCHED
}
}
constexpr int NWAVES = 8;
constexpr int NB = 32, SEQ = 2048, DM = 1024, NTOK = NB * SEQ;
constexpr int IN_E = 1952, IN_E_PAD = 2048, DFF = 2816, DFFX = 3584, NEXP = 8;
constexpr int MOE_CHUNK = 15360, N_CHUNK = (NTOK + MOE_CHUNK - 1) / MOE_CHUNK, CHUNK_SLOTS = 2 * MOE_CHUNK + NEXP * 256;
constexpr float NORM_EPS = 1e-6f, LOG2E = 1.4426950408889634f;

constexpr size_t MiB = 1u << 20;
constexpr size_t WS_CTL = 0, CTL_ZERO_BYTES = 1 * MiB;
constexpr size_t WS_ROPE = 1 * MiB;
constexpr size_t WS_ROUTE_I = 2 * MiB;
constexpr size_t WS_ROUTE_W = 3 * MiB;
constexpr size_t WS_WEV = 4 * MiB, EV_STRIDE = 24 * MiB;
constexpr size_t EV_WIN = 0, EV_WUQ = 4 * MiB, EV_WUKV = 4 * MiB + 512 * 1024, EV_WOUT = 5 * MiB, EV_WGU = 7 * MiB, EV_WD = 18 * MiB;
constexpr size_t WS_WOD = 52 * MiB, OD_STRIDE = 8 * MiB;
constexpr size_t OD_WQKV = 0, OD_WO = 6 * MiB;
constexpr size_t WS_MWGU = 68 * MiB;
constexpr size_t WS_MWD = 180 * MiB;
constexpr size_t WS_H = 236 * MiB;
constexpr size_t WS_BIG = 364 * MiB;
constexpr size_t WS_PROJ = WS_BIG, WS_QM = WS_BIG + 256 * MiB, WS_KVM = WS_BIG + 352 * MiB, WS_KPE = WS_BIG + 480 * MiB;
constexpr size_t WS_ACT = WS_BIG;
constexpr size_t WS_QKV = WS_BIG;
constexpr size_t WS_YALL = WS_BIG, WS_HG8 = WS_BIG + 32 * MiB, WS_MACT = WS_BIG + 320 * MiB;
constexpr size_t WS_DP1 = 848 * MiB, WS_DP2 = 912 * MiB, WS_DL1 = 976 * MiB, WS_DL2 = 978 * MiB;
constexpr size_t WS_SA = 980 * MiB;
constexpr size_t WS_SB = 981 * MiB;
constexpr size_t WS_END = 982 * MiB;
static_assert(WS_MACT + 2 * (size_t)CHUNK_SLOTS * DFFX <= WS_DP1 + 132 * MiB && WS_KPE + (size_t)NTOK * 64 <= WS_DP1 && WS_YALL + (size_t)N_CHUNK * CHUNK_SLOTS * DM * 2 <= WS_MACT && (size_t)CHUNK_SLOTS * DM == 32 * MiB, "ws map");
constexpr int CW_BAR = 4096;
constexpr int CW_WMAX = 12288;
constexpr int CW_CNT = 16384;

constexpr int RING_BYTES = 131072, LDSCTL_OFF = RING_BYTES, MISC_OFF = LDSCTL_OFF + 320, LDS_BYTES = 163840, RPB_OFF = 132096;

#define GAS __attribute__((address_space(1)))
#define LAS __attribute__((address_space(3)))
typedef unsigned short bf16;
typedef unsigned v4u __attribute__((ext_vector_type(4)));
typedef unsigned v2u __attribute__((ext_vector_type(2)));
typedef int v4i __attribute__((ext_vector_type(4)));
typedef float f32x4 __attribute__((ext_vector_type(4)));
typedef float f32x2 __attribute__((ext_vector_type(2)));
#define LDS_WAIT() asm volatile("s_waitcnt lgkmcnt(0)" ::: "memory")
#define VM_WAIT() asm volatile("s_waitcnt vmcnt(0)" ::: "memory")
__device__ __forceinline__ unsigned f2bf(float f) { unsigned u = __builtin_bit_cast(unsigned, f); return (u + 0x7fffu + ((u >> 16) & 1u)) >> 16; }
#if defined(__HIP_DEVICE_COMPILE__)
#define GLOBAL_AS __attribute__((address_space(1)))
#else
#define GLOBAL_AS
#endif
__device__ __forceinline__ unsigned pk2(float lo, float hi) { return f2bf(lo) | (f2bf(hi) << 16); }
__device__ __forceinline__ float bflo(unsigned w) { return __builtin_bit_cast(float, w << 16); }
__device__ __forceinline__ float bfhi(unsigned w) { return __builtin_bit_cast(float, w & 0xffff0000u); }
template <int CTRL> __device__ __forceinline__ float dppf(float v) { return __builtin_bit_cast(float, __builtin_amdgcn_mov_dpp(__builtin_bit_cast(int, v), CTRL, 0xF, 0xF, true)); }
__device__ __forceinline__ void swap16(unsigned& a, unsigned& b) { asm("s_nop 1\n\tv_permlane16_swap_b32 %0, %1\n\ts_nop 1" : "+v"(a), "+v"(b)); }
__device__ __forceinline__ void swap32(unsigned& a, unsigned& b) { asm("s_nop 1\n\tv_permlane32_swap_b32 %0, %1\n\ts_nop 1" : "+v"(a), "+v"(b)); }
__device__ __forceinline__ float wsum_all(float v) {
    v += dppf<0xB1>(v); v += dppf<0x4E>(v); v += dppf<0x141>(v); v += dppf<0x140>(v);
    unsigned a = __builtin_bit_cast(unsigned, v), b = a; swap16(a, b); v = __builtin_bit_cast(float, a) + __builtin_bit_cast(float, b);
    a = __builtin_bit_cast(unsigned, v); b = a; swap32(a, b); return __builtin_bit_cast(float, a) + __builtin_bit_cast(float, b);
}
__device__ __forceinline__ float wmax_all(float v) {
    v = fmaxf(v, dppf<0xB1>(v)); v = fmaxf(v, dppf<0x4E>(v)); v = fmaxf(v, dppf<0x141>(v)); v = fmaxf(v, dppf<0x140>(v));
    unsigned a = __builtin_bit_cast(unsigned, v), b = a; swap16(a, b); v = fmaxf(__builtin_bit_cast(float, a), __builtin_bit_cast(float, b));
    a = __builtin_bit_cast(unsigned, v); b = a; swap32(a, b); return fmaxf(__builtin_bit_cast(float, a), __builtin_bit_cast(float, b));
}
constexpr int LDX = 2048;
__device__ __forceinline__ f32x4 ldx4(const bf16* row, int idx) { const v2u w = ((const GLOBAL_AS v2u*)row)[idx]; return (f32x4){bflo(w.x), bfhi(w.x), bflo(w.y), bfhi(w.y)}; }
__device__ __forceinline__ void stx4(bf16* row, int idx, f32x4 v) { v2u w; w.x = pk2(v.x, v.y); w.y = pk2(v.z, v.w); ((GLOBAL_AS v2u*)row)[idx] = w; }
__device__ __forceinline__ float ex2(float x) { return __builtin_amdgcn_exp2f(x); }

#define XB_TMO      128
#define XB_XCNT(j)  (256  + 64 * (j))
#define XB_XSUB(j)  (1280 + 64 * (j))
#define XB_XGEN(j)  (2304 + 64 * (j))
#define XB_TOP      3328
#define XB_TOPGEN   3392
#define XCD_BAR_WORDS 3456
#define XB_SPIN_CAP (1u << 22)

__device__ __forceinline__ unsigned xb_ld(unsigned* p)              { return __hip_atomic_load(p, __ATOMIC_RELAXED, __HIP_MEMORY_SCOPE_AGENT); }
__device__ __forceinline__ unsigned xb_add(unsigned* p, unsigned v) { return __hip_atomic_fetch_add(p, v, __ATOMIC_RELAXED, __HIP_MEMORY_SCOPE_AGENT); }
__device__ __forceinline__ unsigned xb_xcc_id() { return (unsigned)__builtin_amdgcn_s_getreg((3 << 11) | 20) & 0xFu; }
#define XB_SPIN(cond, bar) do { unsigned _sp = 0; while (cond) { __builtin_amdgcn_s_sleep(1); \
    if ((++_sp & 255u) == 0u) { if (xb_ld(&(bar)[XB_TMO])) break; if (_sp > XB_SPIN_CAP) { atomicAdd(&(bar)[XB_TMO], 1u); break; } } } } while (0)

struct XcdBarrier {
    unsigned* bar; unsigned x;
    volatile LAS unsigned* st;
};

__device__ __forceinline__ XcdBarrier xcd_barrier_post(unsigned* bar, volatile LAS unsigned* st) {
    XcdBarrier b; b.bar = bar; b.x = xb_xcc_id(); b.st = st;
    if (threadIdx.x == 0) (void)xb_add(&bar[XB_XCNT(b.x)], 1u);
    return b;
}
__device__ __forceinline__ void xcd_barrier_complete(unsigned* bar, unsigned x, unsigned& nloc, unsigned& nx) {
    const unsigned G = gridDim.x * gridDim.y * gridDim.z;
    unsigned sum, cnt, mine, sp = 0u;
    for (;;) {
        sum = 0u; cnt = 0u; mine = 0u;
#pragma unroll
        for (unsigned j = 0; j < 16; ++j) { const unsigned c = xb_ld(&bar[XB_XCNT(j)]); sum += c; cnt += (c > 0u) ? 1u : 0u; mine = (j == x) ? c : mine; }
        if (sum == G) break;
        __builtin_amdgcn_s_sleep(1);
        if ((++sp & 255u) == 0u) { if (xb_ld(&bar[XB_TMO])) break; if (sp > XB_SPIN_CAP) { atomicAdd(&bar[XB_TMO], 1u); break; } }
    }
    nloc = mine > 0u ? mine : 1u; nx = cnt > 0u ? cnt : 1u;
}

__device__ __forceinline__ void xcd_barrier(const XcdBarrier& b, int tid) {
    asm volatile("s_waitcnt vmcnt(0)" ::: "memory");
    __syncthreads();
    if (tid == 0) {
        unsigned* bar = b.bar;
        __builtin_amdgcn_s_waitcnt(0);
        unsigned nloc = b.st[0], nx = b.st[1];
        if (nloc == 0u) { xcd_barrier_complete(bar, b.x, nloc, nx); b.st[0] = nloc; b.st[1] = nx; }
        const unsigned old = xb_add(&bar[XB_XSUB(b.x)], 1u);
        const unsigned gen = old / nloc;
        if (old + 1u == (gen + 1u) * nloc) {
            __builtin_amdgcn_fence(__ATOMIC_RELEASE, "agent");
            asm volatile("s_waitcnt vmcnt(0)" ::: "memory");
            const unsigned og = xb_add(&bar[XB_TOP], 1u);
            const unsigned tg = og / nx;
            if (og + 1u == (tg + 1u) * nx) xb_add(&bar[XB_TOPGEN], 1u);
            else XB_SPIN(xb_ld(&bar[XB_TOPGEN]) == tg, bar);
            __builtin_amdgcn_fence(__ATOMIC_ACQUIRE, "agent");
            xb_add(&bar[XB_XGEN(b.x)], 1u);
            asm volatile("s_waitcnt vmcnt(0)" ::: "memory");
        } else {
            XB_SPIN(xb_ld(&bar[XB_XGEN(b.x)]) == gen, bar);
            __builtin_amdgcn_fence(__ATOMIC_ACQUIRE, "agent");
            asm volatile("s_waitcnt vmcnt(0)" ::: "memory");
        }
    }
    __syncthreads();
}
__device__ __forceinline__ float wave_sum(float v, int lane) {
#pragma unroll
    for (int o = 1; o < 64; o <<= 1) v += __builtin_bit_cast(float, __builtin_amdgcn_ds_bpermute((lane ^ o) << 2, __builtin_bit_cast(int, v)));
    return v;
}
__device__ __forceinline__ void cvt_item(const float* W, int N, bf16* WT, int ldo, int dst_row0, int k0, int n0, LAS float* scr, int lane) {
    float wv[32];
#pragma unroll
    for (int i = 0; i < 32; ++i) wv[i] = W[(size_t)(k0 + 2 * i + (lane >> 5)) * N + n0 + (lane & 31)];
#pragma unroll
    for (int i = 0; i < 32; ++i) scr[(2 * i + (lane >> 5)) * 33 + (lane & 31)] = wv[i];
    LDS_WAIT(); asm volatile("" ::: "memory");
    const int c = lane & 7;
#pragma unroll
    for (int j = 0; j < 4; ++j) { const int n = (lane >> 3) + 8 * j; const LAS float* s = scr + (8 * c) * 33 + n;
        v4u o; o.x = pk2(s[0 * 33], s[1 * 33]); o.y = pk2(s[2 * 33], s[3 * 33]); o.z = pk2(s[4 * 33], s[5 * 33]); o.w = pk2(s[6 * 33], s[7 * 33]);
        *(GLOBAL_AS v4u*)(WT + (size_t)(dst_row0 + n) * ldo + k0 + 8 * c) = o; }
    LDS_WAIT(); asm volatile("" ::: "memory");
}
__device__ __forceinline__ void cvt_item8(const float* W, int N, unsigned char* WT, int ldo, int dst_row0, int k0, int n0, LAS float* scr, int lane, float scale) {
    float wv[32];
#pragma unroll
    for (int i = 0; i < 32; ++i) wv[i] = W[(size_t)(k0 + 2 * i + (lane >> 5)) * N + n0 + (lane & 31)];
#pragma unroll
    for (int i = 0; i < 32; ++i) scr[(2 * i + (lane >> 5)) * 33 + (lane & 31)] = wv[i] * scale;
    LDS_WAIT(); asm volatile("" ::: "memory");
    const int c = lane & 3;
#pragma unroll
    for (int j = 0; j < 2; ++j) { const int n = (lane >> 2) + 16 * j; const LAS float* s = scr + (16 * c) * 33 + n;
        v4u o; o.x = pg8::cvt4_fp8(s[0 * 33], s[1 * 33], s[2 * 33], s[3 * 33]); o.y = pg8::cvt4_fp8(s[4 * 33], s[5 * 33], s[6 * 33], s[7 * 33]);
        o.z = pg8::cvt4_fp8(s[8 * 33], s[9 * 33], s[10 * 33], s[11 * 33]); o.w = pg8::cvt4_fp8(s[12 * 33], s[13 * 33], s[14 * 33], s[15 * 33]);
        *(GLOBAL_AS v4u*)(WT + (size_t)(dst_row0 + n) * ldo + k0 + 16 * c) = o; }
    LDS_WAIT(); asm volatile("" ::: "memory");
}
__device__ __forceinline__ void cvt_job8(const float* W, int K, int N, unsigned char* WT, int ldo, int rowmap, int item, LAS float* scr, int lane, float scale) {
    const int nblk = N / 32, kb = item / nblk, nb = item % nblk, n0 = 32 * nb;
    int dr = n0; if (rowmap) dr = (n0 >> 7) * 256 + (n0 & 127) + (rowmap == 2 ? 128 : 0);
    cvt_item8(W, N, WT, ldo, dr, 64 * kb, n0, scr, lane, scale);
}
__device__ __forceinline__ unsigned pack4_i8(float a, float b, float c, float d) {
    const int qa = (int)__builtin_rintf(a), qb = (int)__builtin_rintf(b), qc = (int)__builtin_rintf(c), qd = (int)__builtin_rintf(d);
    return (unsigned)(qa & 255) | ((unsigned)(qb & 255) << 8) | ((unsigned)(qc & 255) << 16) | ((unsigned)(qd & 255) << 24);
}
__device__ __forceinline__ void cvt_item_i8(const float* W, int N, unsigned char* WT, int ldo, int dst_row0, int k0, int n0, LAS float* scr, int lane, float inv) {
    float wv[32];
#pragma unroll
    for (int i = 0; i < 32; ++i) wv[i] = W[(size_t)(k0 + 2 * i + (lane >> 5)) * N + n0 + (lane & 31)];
#pragma unroll
    for (int i = 0; i < 32; ++i) scr[(2 * i + (lane >> 5)) * 33 + (lane & 31)] = __builtin_amdgcn_fmed3f(wv[i] * inv, -127.0f, 127.0f);
    LDS_WAIT(); asm volatile("" ::: "memory");
    const int c = lane & 3;
#pragma unroll
    for (int j = 0; j < 2; ++j) { const int n = (lane >> 2) + 16 * j; const LAS float* s = scr + (16 * c) * 33 + n;
        v4u o; o.x = pack4_i8(s[0 * 33], s[1 * 33], s[2 * 33], s[3 * 33]); o.y = pack4_i8(s[4 * 33], s[5 * 33], s[6 * 33], s[7 * 33]);
        o.z = pack4_i8(s[8 * 33], s[9 * 33], s[10 * 33], s[11 * 33]); o.w = pack4_i8(s[12 * 33], s[13 * 33], s[14 * 33], s[15 * 33]);
        *(GLOBAL_AS v4u*)(WT + (size_t)(dst_row0 + n) * ldo + k0 + 16 * c) = o; }
    LDS_WAIT(); asm volatile("" ::: "memory");
}
__device__ __forceinline__ void cvt_job_i8(const float* W, int K, int N, unsigned char* WT, int ldo, int item, LAS float* scr, int lane, float inv, int rowmap = 0) {
    const int nblk = N / 32, kb = item / nblk, nb = item % nblk, n0 = 32 * nb;
    int dr = n0; if (rowmap) dr = (n0 >> 7) * 256 + (n0 & 127) + (rowmap == 2 ? 128 : 0);
    cvt_item_i8(W, N, WT, ldo, dr, 64 * kb, n0, scr, lane, inv);
}
__device__ __forceinline__ void cvt_job(const float* W, int K, int N, bf16* WT, int ldo, int rowmap, int item, LAS float* scr, int lane) {
    const int nblk = N / 32, kb = item / nblk, nb = item % nblk, n0 = 32 * nb;
    int dr = n0; if (rowmap) dr = (n0 >> 7) * 256 + (n0 & 127) + (rowmap == 2 ? 128 : 0);
    cvt_item(W, N, WT, ldo, dr, 64 * kb, n0, scr, lane);
}
__device__ const double ROPE_F[16] = {0.15915494309189535, 0.08949940160889101, 0.050329212104487035, 0.0283021958306234, 0.015915494309189534, 0.008949940160889102, 0.005032921210448704, 0.00283021958306234,
    0.0015915494309189536, 0.0008949940160889102, 0.0005032921210448703, 0.00028302195830623395, 0.00015915494309189535, 8.949940160889102e-05, 5.0329212104487035e-05, 2.8302195830623396e-05};

struct Ctx {
    float* out; unsigned char* ws; LAS unsigned char* lds; int tid, lane, wave, G, gw, NGW;
};

__device__ __forceinline__ void cvt_strip_i8(const float* W, int K, int N, unsigned char* WT, int ldo, float* sb, int rowmap, int strip, LAS float* scr, int lane) {
    const int n0 = 32 * strip; int dr = n0; if (rowmap) dr = (n0 >> 7) * 256 + (n0 & 127) + (rowmap == 2 ? 128 : 0);
    const float* col = W + n0 + (lane & 31) + (size_t)(lane >> 5) * N;
    float mx = 0.f;
    for (int k0 = 0; k0 < K; k0 += 64) { float wv[32];
#pragma unroll
        for (int i = 0; i < 32; ++i) wv[i] = col[(size_t)(k0 + 2 * i) * N];
#pragma unroll
        for (int i = 0; i < 32; ++i) mx = fmaxf(mx, fabsf(wv[i])); }
    mx = fmaxf(mx, __builtin_bit_cast(float, __builtin_amdgcn_ds_bpermute((lane ^ 32) << 2, __builtin_bit_cast(int, mx))));
    mx = fmaxf(mx, 1e-30f); const float inv = 127.0f / mx;
    if (lane < 32) sb[dr + lane] = mx * (1.0f / 127.0f);
    for (int k0 = 0; k0 < K; k0 += 64) { float wv[32];
#pragma unroll
        for (int i = 0; i < 32; ++i) wv[i] = col[(size_t)(k0 + 2 * i) * N];
#pragma unroll
        for (int i = 0; i < 32; ++i) scr[(2 * i + (lane >> 5)) * 33 + (lane & 31)] = wv[i] * inv;
        LDS_WAIT(); asm volatile("" ::: "memory");
        const int c = lane & 3;
#pragma unroll
        for (int j = 0; j < 2; ++j) { const int n = (lane >> 2) + 16 * j; const LAS float* s = scr + (16 * c) * 33 + n;
            v4u o; o.x = pack4_i8(s[0 * 33], s[1 * 33], s[2 * 33], s[3 * 33]); o.y = pack4_i8(s[4 * 33], s[5 * 33], s[6 * 33], s[7 * 33]);
            o.z = pack4_i8(s[8 * 33], s[9 * 33], s[10 * 33], s[11 * 33]); o.w = pack4_i8(s[12 * 33], s[13 * 33], s[14 * 33], s[15 * 33]);
            *(GLOBAL_AS v4u*)(WT + (size_t)(dr + n) * ldo + k0 + 16 * c) = o; }
        LDS_WAIT(); asm volatile("" ::: "memory"); }
}
__device__ __forceinline__ void cvt_strip_i8_wg(const float* W, int N, unsigned char* WT, int ldo, float* sb, int rowmap, int strip, LAS unsigned char* lds, int wave, int lane) {
    const int n0 = 32 * strip; int dr = n0; if (rowmap) dr = (n0 >> 7) * 256 + (n0 & 127) + (rowmap == 2 ? 128 : 0);
    const float* col = W + n0 + (lane & 31) + (size_t)(lane >> 5) * N;
    LAS float* scr = (LAS float*)(lds + wave * 16384); LAS float* pm = (LAS float*)(lds + 12288);
    float wv[2][32]; float mx = 0.f;
#pragma unroll
    for (int c = 0; c < 2; ++c)
#pragma unroll
        for (int i = 0; i < 32; ++i) wv[c][i] = col[(size_t)(64 * (2 * wave + c) + 2 * i) * N];
#pragma unroll
    for (int c = 0; c < 2; ++c)
#pragma unroll
        for (int i = 0; i < 32; ++i) mx = fmaxf(mx, fabsf(wv[c][i]));
    mx = fmaxf(mx, __builtin_bit_cast(float, __builtin_amdgcn_ds_bpermute((lane ^ 32) << 2, __builtin_bit_cast(int, mx))));
    if (lane < 32) pm[wave * 32 + lane] = mx;
    __syncthreads();
    float g = 0.f;
#pragma unroll
    for (int w = 0; w < 8; ++w) g = fmaxf(g, pm[w * 32 + (lane & 31)]);
    g = fmaxf(g, 1e-30f); const float inv = 127.0f / g;
    if (wave == 0 && lane < 32) sb[dr + lane] = g * (1.0f / 127.0f);
#pragma unroll
    for (int c = 0; c < 2; ++c) { const int k0 = 64 * (2 * wave + c);
#pragma unroll
        for (int i = 0; i < 32; ++i) scr[(2 * i + (lane >> 5)) * 33 + (lane & 31)] = wv[c][i] * inv;
        LDS_WAIT(); asm volatile("" ::: "memory");
        const int cc = lane & 3;
#pragma unroll
        for (int j = 0; j < 2; ++j) { const int n = (lane >> 2) + 16 * j; const LAS float* s = scr + (16 * cc) * 33 + n;
            v4u o; o.x = pack4_i8(s[0 * 33], s[1 * 33], s[2 * 33], s[3 * 33]); o.y = pack4_i8(s[4 * 33], s[5 * 33], s[6 * 33], s[7 * 33]);
            o.z = pack4_i8(s[8 * 33], s[9 * 33], s[10 * 33], s[11 * 33]); o.w = pack4_i8(s[12 * 33], s[13 * 33], s[14 * 33], s[15 * 33]);
            *(GLOBAL_AS v4u*)(WT + (size_t)(dr + n) * ldo + k0 + 16 * cc) = o; }
        LDS_WAIT(); asm volatile("" ::: "memory"); }
    __syncthreads();
}
template <class A> __device__ __forceinline__ void p0_prologue(const Ctx& C, const A& IN) {
    LAS float* scr = (LAS float*)(C.lds + C.wave * 16384);
    GLOBAL_AS float* sball = (GLOBAL_AS float*)(C.ws + WS_SB);
    constexpr int S0 = IN_E / 32, S4 = DFF / 32, S7 = 3072 / 32, NSTRIPS = 2 * (S0 + 2 * S4 + S7);
    constexpr int I1 = 4 * 24, I2 = 2 * 32, I3 = 16 * 32, I6 = 44 * 32, I8 = 16 * 32;
    constexpr int NITEMS = 2 * (I1 + I2 + I3 + I6 + I8);
    for (int st = blockIdx.x; st < NSTRIPS; st += C.G) {
        int r = st;
        if (r < 2 * S0) { const int ly = r / S0, q = r % S0; cvt_strip_i8_wg(IN.in[2] + (size_t)ly * DM * IN_E, IN_E, C.ws + WS_WEV + ly * EV_STRIDE + EV_WIN, DM, sball + ly * 8192, 0, q, C.lds, C.wave, C.lane); continue; } r -= 2 * S0;
        if (r < 2 * S4) { const int ly = r / S4, q = r % S4; cvt_strip_i8_wg(IN.in[9] + (size_t)ly * DM * DFF, DFF, C.ws + WS_WEV + ly * EV_STRIDE + EV_WGU, DM, sball + ly * 8192 + 2048, 1, q, C.lds, C.wave, C.lane); continue; } r -= 2 * S4;
        if (r < 2 * S4) { const int ly = r / S4, q = r % S4; cvt_strip_i8_wg(IN.in[10] + (size_t)ly * DM * DFF, DFF, C.ws + WS_WEV + ly * EV_STRIDE + EV_WGU, DM, sball + ly * 8192 + 2048, 2, q, C.lds, C.wave, C.lane); continue; } r -= 2 * S4;
        { const int ly = r / S7, q = r % S7; cvt_strip_i8_wg(IN.in[13] + (size_t)ly * DM * 3072, 3072, C.ws + WS_WOD + ly * OD_STRIDE + OD_WQKV, DM, sball + 16384 + ly * 4096, 0, q, C.lds, C.wave, C.lane); }
    }
    for (int it = C.gw; it < NITEMS; it += C.NGW) {
        int r = it;
        if (r < 2 * I1) { const int ly = r / I1, q = r % I1; cvt_job(IN.in[4] + (size_t)ly * 256 * 768, 256, 768, (bf16*)(C.ws + WS_WEV + ly * EV_STRIDE + EV_WUQ), 256, 0, q, scr, C.lane); continue; } r -= 2 * I1;
        if (r < 2 * I2) { const int ly = r / I2, q = r % I2; cvt_job(IN.in[6] + (size_t)ly * 128 * 1024, 128, 1024, (bf16*)(C.ws + WS_WEV + ly * EV_STRIDE + EV_WUKV), 256, 0, q, scr, C.lane); continue; } r -= 2 * I2;
        if (r < 2 * I3) { const int ly = r / I3, q = r % I3; cvt_job(IN.in[7] + (size_t)ly * DM * DM, DM, DM, (bf16*)(C.ws + WS_WEV + ly * EV_STRIDE + EV_WOUT), DM, 0, q, scr, C.lane); continue; } r -= 2 * I3;
        if (r < 2 * I6) { const int ly = r / I6, q = r % I6; cvt_job(IN.in[11] + (size_t)ly * DFF * DM, DFF, DM, (bf16*)(C.ws + WS_WEV + ly * EV_STRIDE + EV_WD), DFF, 0, q, scr, C.lane); continue; } r -= 2 * I6;
        { const int ly = r / I8, q = r % I8; cvt_job(IN.in[15] + (size_t)ly * DM * DM, DM, DM, (bf16*)(C.ws + WS_WOD + ly * OD_STRIDE + OD_WO), DM, 0, q, scr, C.lane); }
    }
    const int gt = blockIdx.x * (NWAVES * 64) + C.tid, NGT = C.G * NWAVES * 64;
    for (int i = gt; i < 2 * 6144; i += NGT) { const int ly = i / 6144, q = i % 6144; ((GLOBAL_AS v4u*)(C.ws + WS_WEV + ly * EV_STRIDE + EV_WIN + (size_t)IN_E * DM))[q] = (v4u){0u, 0u, 0u, 0u}; }
    for (int i = gt; i < 2 * 96; i += NGT) ((GLOBAL_AS float*)(C.ws + WS_SB))[(i / 96) * 8192 + IN_E + (i % 96)] = 0.f;
    for (int i = gt; i < 2 * 16384; i += NGT) { const int ly = i / 16384, q = i % 16384, row = q >> 4, cc = q & 15; ((GLOBAL_AS v4u*)(C.ws + WS_WEV + ly * EV_STRIDE + EV_WUKV + (size_t)row * 512 + 256))[cc] = (v4u){0u, 0u, 0u, 0u}; }
    GLOBAL_AS float* rope = (GLOBAL_AS float*)(C.ws + WS_ROPE);
    for (int i = gt; i < SEQ * 16; i += NGT) { const int t = i >> 4, k = i & 15; double fr = (double)t * ROPE_F[k]; fr -= floor(fr); const float f = (float)fr;
        rope[2 * i] = __builtin_amdgcn_cosf(f); rope[2 * i + 1] = __builtin_amdgcn_sinf(f); }
}
template <class A> __device__ __forceinline__ void moe_weights(const Ctx& C, const A& IN, int j) {
    LAS float* scr = (LAS float*)(C.lds + C.wave * 16384);
    constexpr int IG = 16 * 112, ID = 56 * 32;
    constexpr int NITEMS = NEXP * (2 * IG + ID);
    for (int it = C.gw; it < NITEMS; it += C.NGW) {
        const int e = it / (2 * IG + ID); int r = it % (2 * IG + ID);
        const size_t eo = ((size_t)j * NEXP + e) * (size_t)DM * DFFX;
        if (r < IG) { cvt_job8(IN.in[18] + eo, DM, DFFX, C.ws + WS_MWGU + (size_t)e * 7168 * DM, DM, 1, r, scr, C.lane, 32.0f); continue; } r -= IG;
        if (r < IG) { cvt_job8(IN.in[19] + eo, DM, DFFX, C.ws + WS_MWGU + (size_t)e * 7168 * DM, DM, 2, r, scr, C.lane, 32.0f); continue; } r -= IG;
        cvt_job8(IN.in[20] + eo, DFFX, DM, C.ws + WS_MWD + (size_t)e * DM * DFFX, DFFX, 0, r, scr, C.lane, 32.0f);
    }
}
template <int OUT = 0, bool XF32 = false>
__device__ __forceinline__ void norm_phase(const Ctx& C, const void* x, const float* g, bf16* H, bf16* xb = nullptr) {
    constexpr int NR = 4;
    f32x4 gg[4];
#pragma unroll
    for (int j = 0; j < 4; ++j) gg[j] = ((const GLOBAL_AS f32x4*)g)[64 * j + C.lane];
    for (int m0 = C.gw; m0 < NTOK; m0 += NR * C.NGW) {
        f32x4 v[NR][4]; float s[NR];
#pragma unroll
        for (int r = 0; r < NR; ++r) { const int m = min(m0 + r * C.NGW, NTOK - 1);
            if (XF32) { const GLOBAL_AS f32x4* xr = (const GLOBAL_AS f32x4*)((const GLOBAL_AS float*)x + (size_t)m * DM) + C.lane;
#pragma unroll
                for (int j = 0; j < 4; ++j) v[r][j] = xr[64 * j]; }
            else { const bf16* xr = (const bf16*)x + (size_t)m * LDX;
#pragma unroll
                for (int j = 0; j < 4; ++j) v[r][j] = ldx4(xr, 64 * j + C.lane); } }
#pragma unroll
        for (int r = 0; r < NR; ++r) { float a = 0.f;
#pragma unroll
            for (int j = 0; j < 4; ++j) a += (v[r][j].x * v[r][j].x + v[r][j].y * v[r][j].y) + (v[r][j].z * v[r][j].z + v[r][j].w * v[r][j].w);
            s[r] = a; }
#pragma unroll
        for (int r = 0; r < NR; ++r) s[r] = wsum_all(s[r]);
#pragma unroll
        for (int r = 0; r < NR; ++r) { const int m = m0 + r * C.NGW; if (m < NTOK) { const float rstd = 1.0f / sqrtf(s[r] * (1.0f / DM) + NORM_EPS);
            if (XF32) {
#pragma unroll
                for (int j = 0; j < 4; ++j) stx4(xb + (size_t)m * LDX, 64 * j + C.lane, v[r][j]); }
            if (OUT == 2) { f32x4 y[4]; float am = 0.f;
#pragma unroll
                for (int j = 0; j < 4; ++j) { y[j] = v[r][j] * rstd * gg[j]; am = fmaxf(fmaxf(am, fmaxf(fabsf(y[j].x), fabsf(y[j].y))), fmaxf(fabsf(y[j].z), fabsf(y[j].w))); }
                am = fmaxf(wmax_all(am), 1e-20f); const float inv = 127.0f / am; GLOBAL_AS unsigned* o4 = (GLOBAL_AS unsigned*)((unsigned char*)H + (size_t)m * DM) + C.lane;
#pragma unroll
                for (int j = 0; j < 4; ++j) o4[64 * j] = pack4_i8(y[j].x * inv, y[j].y * inv, y[j].z * inv, y[j].w * inv);
                if (C.lane == 0) ((GLOBAL_AS float*)(C.ws + WS_SA))[m] = am * (1.0f / 127.0f); }
            else if (OUT == 1) { GLOBAL_AS unsigned* o4 = (GLOBAL_AS unsigned*)((unsigned char*)H + (size_t)m * DM) + C.lane;
#pragma unroll
                for (int j = 0; j < 4; ++j) { const f32x4 y = v[r][j] * rstd * gg[j]; o4[64 * j] = pg8::cvt4_fp8(y.x, y.y, y.z, y.w); } }
            else { GLOBAL_AS unsigned long long* o8 = (GLOBAL_AS unsigned long long*)(H + (size_t)m * DM) + C.lane;
#pragma unroll
                for (int j = 0; j < 4; ++j) { const f32x4 y = v[r][j] * rstd * gg[j]; o8[64 * j] = (unsigned long long)pk2(y.x, y.y) | ((unsigned long long)pk2(y.z, y.w) << 32); } } } }
    }
}
__device__ __forceinline__ void norm_phase_b(const Ctx& C, const bf16* x, const float* g, bf16* H) {
    f32x4 gg[4];
#pragma unroll
    for (int j = 0; j < 4; ++j) gg[j] = ((const GLOBAL_AS f32x4*)g)[64 * j + C.lane];
    for (int m0 = C.gw; m0 < NTOK; m0 += 8 * C.NGW) {
        v2u w[8][4]; float s[8];
#pragma unroll
        for (int r = 0; r < 8; ++r) { const int m = min(m0 + r * C.NGW, NTOK - 1); const GLOBAL_AS v2u* xr = (const GLOBAL_AS v2u*)(x + (size_t)m * LDX) + C.lane;
#pragma unroll
            for (int j = 0; j < 4; ++j) w[r][j] = xr[64 * j]; }
#pragma unroll
        for (int r = 0; r < 8; ++r) { float a = 0.f;
#pragma unroll
            for (int j = 0; j < 4; ++j) { const float e0 = bflo(w[r][j].x), e1 = bfhi(w[r][j].x), e2 = bflo(w[r][j].y), e3 = bfhi(w[r][j].y); a += (e0 * e0 + e1 * e1) + (e2 * e2 + e3 * e3); }
            s[r] = a; }
#pragma unroll
        for (int r = 0; r < 8; ++r) s[r] = wsum_all(s[r]);
#pragma unroll
        for (int r = 0; r < 8; ++r) { const int m = m0 + r * C.NGW; if (m < NTOK) { const float rstd = 1.0f / sqrtf(s[r] * (1.0f / DM) + NORM_EPS);
            f32x4 y[4]; float am = 0.f;
#pragma unroll
            for (int j = 0; j < 4; ++j) { const f32x4 v = (f32x4){bflo(w[r][j].x), bfhi(w[r][j].x), bflo(w[r][j].y), bfhi(w[r][j].y)}; y[j] = v * rstd * gg[j];
                am = fmaxf(fmaxf(am, fmaxf(fabsf(y[j].x), fabsf(y[j].y))), fmaxf(fabsf(y[j].z), fabsf(y[j].w))); }
            am = fmaxf(wmax_all(am), 1e-20f); const float inv = 127.0f / am; GLOBAL_AS unsigned* o4 = (GLOBAL_AS unsigned*)((unsigned char*)H + (size_t)m * DM) + C.lane;
#pragma unroll
            for (int j = 0; j < 4; ++j) o4[64 * j] = pack4_i8(y[j].x * inv, y[j].y * inv, y[j].z * inv, y[j].w * inv);
            if (C.lane == 0) ((GLOBAL_AS float*)(C.ws + WS_SA))[m] = am * (1.0f / 127.0f); } }
    }
}
__device__ __forceinline__ void final_norm_phase(const Ctx& C, float* x, const float* g) {
    f32x4 gg[4];
#pragma unroll
    for (int j = 0; j < 4; ++j) gg[j] = ((const GLOBAL_AS f32x4*)g)[64 * j + C.lane];
    for (int m = C.gw; m < NTOK; m += C.NGW) {
        GLOBAL_AS f32x4* xr = (GLOBAL_AS f32x4*)(x + (size_t)m * DM) + C.lane; f32x4 v[4]; float s = 0.f;
#pragma unroll
        for (int j = 0; j < 4; ++j) { v[j] = xr[64 * j]; s += (v[j].x * v[j].x + v[j].y * v[j].y) + (v[j].z * v[j].z + v[j].w * v[j].w); }
        const float rstd = 1.0f / sqrtf(wave_sum(s, C.lane) * (1.0f / DM) + NORM_EPS);
#pragma unroll
        for (int j = 0; j < 4; ++j) xr[64 * j] = v[j] * rstd * gg[j];
    }
}
__device__ __forceinline__ void mla_prep_phase(const Ctx& C, bf16* PROJ, const float* qn, const float* kvn, bf16* KPE) {
    const GLOBAL_AS float* rope = (const GLOBAL_AS float*)(C.ws + WS_ROPE);
    const f32x4 gq = ((const GLOBAL_AS f32x4*)qn)[C.lane]; const f32x2 gk = ((const GLOBAL_AS f32x2*)kvn)[C.lane];
    for (int m0 = C.gw; m0 < NTOK; m0 += 8 * C.NGW) {
        v2u w[8]; unsigned w2[8]; unsigned r1[8], r2[8]; float sq[8], sk[8];
#pragma unroll
        for (int r = 0; r < 8; ++r) { const int m = min(m0 + r * C.NGW, NTOK - 1); const bf16* row = PROJ + (size_t)m * IN_E_PAD;
            w[r] = ((const GLOBAL_AS v2u*)(row + 1536))[C.lane]; w2[r] = ((const GLOBAL_AS unsigned*)(row + 1792))[C.lane]; r1[r] = row[1920 + (C.lane & 15)]; r2[r] = row[1936 + (C.lane & 15)]; }
#pragma unroll
        for (int r = 0; r < 8; ++r) { const float a0 = bflo(w[r].x), a1 = bfhi(w[r].x), a2 = bflo(w[r].y), a3 = bfhi(w[r].y), b0 = bflo(w2[r]), b1 = bfhi(w2[r]);
            sq[r] = wsum_all((a0 * a0 + a1 * a1) + (a2 * a2 + a3 * a3)); sk[r] = wsum_all(b0 * b0 + b1 * b1); }
#pragma unroll
        for (int r = 0; r < 8; ++r) { const int m = m0 + r * C.NGW; if (m < NTOK) { bf16* row = PROJ + (size_t)m * IN_E_PAD;
            const float rq = 1.0f / sqrtf(sq[r] * (1.0f / 256) + NORM_EPS), rk = 1.0f / sqrtf(sk[r] * (1.0f / 128) + NORM_EPS);
            v2u o; o.x = pk2(bflo(w[r].x) * rq * gq.x, bfhi(w[r].x) * rq * gq.y); o.y = pk2(bflo(w[r].y) * rq * gq.z, bfhi(w[r].y) * rq * gq.w); ((GLOBAL_AS v2u*)(row + 1536))[C.lane] = o;
            ((GLOBAL_AS unsigned*)(row + 1792))[C.lane] = pk2(bflo(w2[r]) * rk * gk.x, bfhi(w2[r]) * rk * gk.y);
            if (C.lane < 16) { const int t = m & (SEQ - 1); const float x1 = bflo(r1[r]), x2 = bflo(r2[r]);
                const float cs = rope[(t * 16 + C.lane) * 2], sn = rope[(t * 16 + C.lane) * 2 + 1];
                KPE[(size_t)m * 32 + C.lane] = (bf16)f2bf(x1 * cs - x2 * sn); KPE[(size_t)m * 32 + 16 + C.lane] = (bf16)f2bf(x1 * sn + x2 * cs); } } }
    }
}
#define LD8(dst, off, p) do { const v4u w_ = *(const GLOBAL_AS v4u*)(p); dst[(off) + 0] = bflo(w_.x); dst[(off) + 1] = bfhi(w_.x); dst[(off) + 2] = bflo(w_.y); dst[(off) + 3] = bfhi(w_.y); \
    dst[(off) + 4] = bflo(w_.z); dst[(off) + 5] = bfhi(w_.z); dst[(off) + 6] = bflo(w_.w); dst[(off) + 7] = bfhi(w_.w); } while (0)
__device__ __forceinline__ float dot8(const float* q, const v4u w) {
    return ((q[0] * bflo(w.x) + q[1] * bfhi(w.x)) + (q[2] * bflo(w.y) + q[3] * bfhi(w.y))) + ((q[4] * bflo(w.z) + q[5] * bfhi(w.z)) + (q[6] * bflo(w.w) + q[7] * bfhi(w.w)));
}
__device__ __forceinline__ void fma8(float* o, float p, const v4u w) {
    o[0] += p * bflo(w.x); o[1] += p * bfhi(w.x); o[2] += p * bflo(w.y); o[3] += p * bfhi(w.y); o[4] += p * bflo(w.z); o[5] += p * bfhi(w.z); o[6] += p * bflo(w.w); o[7] += p * bfhi(w.w);
}
__device__ __forceinline__ void store_o64(bf16* dst, const float* o, float inv) {
#pragma unroll
    for (int c = 0; c < 8; ++c) { v4u w; w.x = pk2(o[8 * c] * inv, o[8 * c + 1] * inv); w.y = pk2(o[8 * c + 2] * inv, o[8 * c + 3] * inv); w.z = pk2(o[8 * c + 4] * inv, o[8 * c + 5] * inv); w.w = pk2(o[8 * c + 6] * inv, o[8 * c + 7] * inv);
        ((GLOBAL_AS v4u*)dst)[c] = w; }
}
__device__ __forceinline__ void dil_naive_item(const bf16* PROJ, bf16* OC, int item, int tid) {
    const int b = item >> 5, h = (item >> 2) & 7, t = (item & 3) * 512 + tid;
    const bf16* base = PROJ + (size_t)b * SEQ * IN_E_PAD;
    float q[64], o[64];
#pragma unroll
    for (int c = 0; c < 8; ++c) LD8(q, 8 * c, base + (size_t)t * IN_E_PAD + h * 64 + 8 * c);
#pragma unroll
    for (int d = 0; d < 64; ++d) { q[d] *= 0.125f * LOG2E; o[d] = 0.f; }
    const float slope = ex2(-(float)(h + 1)) * LOG2E;
    float m = -INFINITY, l = 0.f;
    for (int g = 0; g < 3; ++g) { const int dl = 1 << (2 * g);
        for (int j = -64; j <= 64; ++j) { const int s = t + j * dl; if (s < 0 || s >= SEQ) continue;
            const bf16* kr = base + (size_t)s * IN_E_PAD + 512 + h * 64;
            float sc = 0.f;
#pragma unroll
            for (int c = 0; c < 8; ++c) sc += dot8(q + 8 * c, ((const GLOBAL_AS v4u*)kr)[c]);
            sc -= slope * (float)((j < 0 ? -j : j) * dl);
            const float mn = fmaxf(m, sc), al = ex2(m - mn), p = ex2(sc - mn); m = mn; l = l * al + p;
#pragma unroll
            for (int d = 0; d < 64; ++d) o[d] *= al;
#pragma unroll
            for (int c = 0; c < 8; ++c) fma8(o + 8 * c, p, ((const GLOBAL_AS v4u*)(kr + 512))[c]);
        } }
    store_o64(OC + ((size_t)b * SEQ + t) * DM + h * 64, o, 1.0f / l);
}
__device__ __forceinline__ void mla_naive_item(const bf16* QM, const bf16* KVM, const bf16* KPE, const float* rope, bf16* OC, int item, int tid) {
    const int b = item >> 6, h = (item >> 3) & 7, vh = (item >> 2) & 1, t = (item & 3) * 512 + tid;
    const size_t row = (size_t)b * SEQ + t;
    float q[96], o[32];
#pragma unroll
    for (int c = 0; c < 12; ++c) LD8(q, 8 * c, QM + row * 768 + h * 96 + 8 * c);
#pragma unroll
    for (int i = 0; i < 16; ++i) { const float cs = rope[(t * 16 + i) * 2], sn = rope[(t * 16 + i) * 2 + 1], x1 = q[64 + i], x2 = q[80 + i]; q[64 + i] = x1 * cs - x2 * sn; q[80 + i] = x1 * sn + x2 * cs; }
    const float scl = 0.10206207261596575f * LOG2E;
#pragma unroll
    for (int d = 0; d < 96; ++d) q[d] *= scl;
#pragma unroll
    for (int d = 0; d < 32; ++d) o[d] = 0.f;
    float m = -INFINITY, l = 0.f;
    const bf16* kvb = KVM + (size_t)b * SEQ * 1024 + h * 128; const bf16* kpb = KPE + (size_t)b * SEQ * 32;
    for (int s = 0; s < SEQ; s += 2) {
        float sc[2];
#pragma unroll
        for (int kk = 0; kk < 2; ++kk) { const GLOBAL_AS v4u* kr = (const GLOBAL_AS v4u*)(kvb + (size_t)(s + kk) * 1024); const GLOBAL_AS v4u* pr = (const GLOBAL_AS v4u*)(kpb + (size_t)(s + kk) * 32); float a = 0.f;
#pragma unroll
            for (int c = 0; c < 8; ++c) a += dot8(q + 8 * c, kr[c]);
#pragma unroll
            for (int c = 0; c < 4; ++c) a += dot8(q + 64 + 8 * c, pr[c]);
            sc[kk] = a; }
        const float mn = fmaxf(m, fmaxf(sc[0], sc[1])), al = ex2(m - mn); m = mn; l *= al;
#pragma unroll
        for (int d = 0; d < 32; ++d) o[d] *= al;
#pragma unroll
        for (int kk = 0; kk < 2; ++kk) { const float p = ex2(sc[kk] - mn); l += p; const GLOBAL_AS v4u* vr = (const GLOBAL_AS v4u*)(kvb + (size_t)(s + kk) * 1024 + 64 + vh * 32);
#pragma unroll
            for (int c = 0; c < 4; ++c) fma8(o + 8 * c, p, vr[c]); }
    }
    const float inv = 1.0f / l; bf16* dst = OC + row * DM + 512 + h * 64 + vh * 32;
#pragma unroll
    for (int c = 0; c < 4; ++c) { v4u w; w.x = pk2(o[8 * c] * inv, o[8 * c + 1] * inv); w.y = pk2(o[8 * c + 2] * inv, o[8 * c + 3] * inv); w.z = pk2(o[8 * c + 4] * inv, o[8 * c + 5] * inv); w.w = pk2(o[8 * c + 6] * inv, o[8 * c + 7] * inv);
        ((GLOBAL_AS v4u*)dst)[c] = w; }
}
__device__ __forceinline__ void na_naive_item(const bf16* QKV, const float* rpb, bf16* O, int item, int tid) {
    const int b = item >> 6, h = (item >> 2) & 15, t = (item & 3) * 512 + tid;
    const int i = t >> 6, c0 = t & 63; const int rs = min(max(i - 4, 0), 24), cs = min(max(c0 - 8, 0), 48);
    const bf16* base = QKV + (size_t)b * SEQ * 3072 + h * 64;
    float q[64], o[64];
#pragma unroll
    for (int c = 0; c < 8; ++c) LD8(q, 8 * c, base + (size_t)t * 3072 + 8 * c);
#pragma unroll
    for (int d = 0; d < 64; ++d) { q[d] *= 0.125f * LOG2E; o[d] = 0.f; }
    float m = -INFINITY, l = 0.f;
    for (int r = 0; r < 8; ++r)
        for (int k = 0; k < 16; ++k) { const int kt = (rs + r) * 64 + cs + k;
            const bf16* kr = base + (size_t)kt * 3072 + 1024;
            float sc = rpb[(h * 15 + (rs + r - i + 7)) * 31 + (cs + k - c0 + 15)] * LOG2E;
#pragma unroll
            for (int c = 0; c < 8; ++c) sc += dot8(q + 8 * c, ((const GLOBAL_AS v4u*)kr)[c]);
            const float mn = fmaxf(m, sc), al = ex2(m - mn), p = ex2(sc - mn); m = mn; l = l * al + p;
#pragma unroll
            for (int d = 0; d < 64; ++d) o[d] *= al;
#pragma unroll
            for (int c = 0; c < 8; ++c) fma8(o + 8 * c, p, ((const GLOBAL_AS v4u*)(kr + 1024))[c]);
        }
    store_o64(O + ((size_t)b * SEQ + t) * DM + h * 64, o, 1.0f / l);
}
__device__ __forceinline__ void route_phase(const Ctx& C, const bf16* x, const float* g, const float* wr, unsigned char* H8, unsigned* cnt  ) {
    LAS float* wl = (LAS float*)C.lds;
    for (int i = C.tid; i < 8192; i += NWAVES * 64) wl[(i & 7) * 1024 + (i >> 3)] = wr[i];
    __syncthreads();
    GLOBAL_AS v4i* route_i = (GLOBAL_AS v4i*)(C.ws + WS_ROUTE_I); GLOBAL_AS f32x2* route_w = (GLOBAL_AS f32x2*)(C.ws + WS_ROUTE_W);
    f32x4 gg[4];
#pragma unroll
    for (int j = 0; j < 4; ++j) gg[j] = ((const GLOBAL_AS f32x4*)g)[64 * j + C.lane];
    for (int base = C.gw * 32; base < NTOK; base += C.NGW * 32) {
        int my_e0 = 0, my_e1 = 0; float my_w0 = 0.f, my_w1 = 0.f;
        for (int i = 0; i < 32; i += 4) {
            v2u xw[4][4]; float s[4]; float lg[4][8]; f32x4 y[4][4];
#pragma unroll
            for (int r = 0; r < 4; ++r) { const GLOBAL_AS v2u* xr = (const GLOBAL_AS v2u*)(x + (size_t)(base + i + r) * LDX) + C.lane;
#pragma unroll
                for (int j = 0; j < 4; ++j) xw[r][j] = xr[64 * j]; }
#pragma unroll
            for (int r = 0; r < 4; ++r) { float a = 0.f;
#pragma unroll
                for (int j = 0; j < 4; ++j) { const v2u c = xw[r][j]; y[r][j] = (f32x4){bflo(c.x), bfhi(c.x), bflo(c.y), bfhi(c.y)}; a += (y[r][j].x * y[r][j].x + y[r][j].y * y[r][j].y) + (y[r][j].z * y[r][j].z + y[r][j].w * y[r][j].w); }
                s[r] = a; }
#pragma unroll
            for (int r = 0; r < 4; ++r) s[r] = wsum_all(s[r]);
#pragma unroll
            for (int r = 0; r < 4; ++r) { const float rstd = 1.0f / sqrtf(s[r] * (1.0f / DM) + NORM_EPS);
                GLOBAL_AS unsigned* o4 = (GLOBAL_AS unsigned*)(H8 + (size_t)(base + i + r) * DM) + C.lane;
#pragma unroll
                for (int e = 0; e < 8; ++e) lg[r][e] = 0.f;
#pragma unroll
                for (int j = 0; j < 4; ++j) { y[r][j] = y[r][j] * rstd * gg[j]; o4[64 * j] = pg8::cvt4_fp8(y[r][j].x, y[r][j].y, y[r][j].z, y[r][j].w); } }
#pragma unroll
            for (int j = 0; j < 4; ++j)
#pragma unroll
                for (int e = 0; e < 8; ++e) { const f32x4 w = *(const LAS f32x4*)(wl + e * 1024 + 4 * (64 * j + C.lane));
#pragma unroll
                    for (int r = 0; r < 4; ++r) lg[r][e] += (y[r][j].x * w.x + y[r][j].y * w.y) + (y[r][j].z * w.z + y[r][j].w * w.w); }
#pragma unroll
            for (int r = 0; r < 4; ++r)
#pragma unroll
                for (int e = 0; e < 8; ++e) lg[r][e] = wsum_all(lg[r][e]);
#pragma unroll
            for (int r = 0; r < 4; ++r) {
                int e0 = 0; float v0 = lg[r][0];
#pragma unroll
                for (int e = 1; e < 8; ++e) if (lg[r][e] > v0) { v0 = lg[r][e]; e0 = e; }
                int e1 = -1; float v1 = -INFINITY;
#pragma unroll
                for (int e = 0; e < 8; ++e) if (e != e0 && (e1 < 0 || lg[r][e] > v1)) { v1 = lg[r][e]; e1 = e; }
                const float ex = __expf(v1 - v0), w0 = 1.0f / (1.0f + ex), w1 = ex * w0;
                if (C.lane == i + r) { my_e0 = e0; my_e1 = e1; my_w0 = w0; my_w1 = w1; } }
        }
        const int chunk = base / MOE_CHUNK; const bool act = C.lane < 32; int pos0 = 0, pos1 = 0;
        const unsigned long long lt = (1ull << C.lane) - 1ull;
#pragma unroll
        for (int e = 0; e < 8; ++e) {
            const unsigned long long m0 = __ballot(act && my_e0 == e), m1 = __ballot(act && my_e1 == e);
            const int n0 = __popcll(m0), n1 = __popcll(m1);
            unsigned bs = 0; if (C.lane == 0 && (n0 + n1) > 0) bs = atomicAdd(cnt + (chunk * 8 + e) * 64, (unsigned)(n0 + n1));
            bs = (unsigned)__builtin_amdgcn_readfirstlane((int)bs);
            if (act && my_e0 == e) pos0 = (int)bs + __popcll(m0 & lt);
            if (act && my_e1 == e) pos1 = (int)bs + n0 + __popcll(m1 & lt);
        }
        if (act) { route_i[base + C.lane] = (v4i){my_e0, my_e1, pos0, pos1}; route_w[base + C.lane] = (f32x2){my_w0, my_w1}; }
    }
}
__device__ __forceinline__ int seg_base(const unsigned* cnt, int chunk, int e) {
    int acc = 0;
#pragma unroll
    for (int k = 0; k < 8; ++k) { const int n = (int)__hip_atomic_load(cnt + (chunk * 8 + k) * 64, __ATOMIC_RELAXED, __HIP_MEMORY_SCOPE_AGENT); if (k < e) acc += (n + 255) >> 8; }
    return acc * 256;
}
__device__ __forceinline__ void gather_all_phase(const Ctx& C, const unsigned char* H8, unsigned char* HG8, const unsigned* cnt) {
    GLOBAL_AS v4i* route_i = (GLOBAL_AS v4i*)(C.ws + WS_ROUTE_I);
    LAS int* segt = (LAS int*)C.lds;
    if (C.tid < N_CHUNK * 8) segt[C.tid] = seg_base(cnt, C.tid >> 3, C.tid & 7);
    __syncthreads();
    for (int m0 = C.gw; m0 < NTOK; m0 += 8 * C.NGW) {
        v4i ri[8]; v4u a[8];
#pragma unroll
        for (int r = 0; r < 8; ++r) { const int m = min(m0 + r * C.NGW, NTOK - 1); ri[r] = route_i[m]; a[r] = ((const GLOBAL_AS v4u*)(H8 + (size_t)m * DM))[C.lane]; }
#pragma unroll
        for (int r = 0; r < 8; ++r) { const int m = m0 + r * C.NGW; if (m < NTOK) { const int ch = m / MOE_CHUNK;
            const int s0 = segt[ch * 8 + ri[r].x] + ri[r].z, s1 = segt[ch * 8 + ri[r].y] + ri[r].w;
            unsigned char* base = HG8 + (size_t)ch * 2 * CHUNK_SLOTS * DM;
            ((GLOBAL_AS v4u*)(base + (size_t)s0 * DM))[C.lane] = a[r]; ((GLOBAL_AS v4u*)(base + (size_t)s1 * DM))[C.lane] = a[r];
            if (C.lane == 0) { v4i o = ri[r]; o.z = s0; o.w = s1; route_i[m] = o; } } }
    }
}
template <bool LAST>
__device__ __forceinline__ void combine_all_phase(const Ctx& C, bf16* x, float* out, const bf16* Y, const float* g, bf16* Hn) {
    const GLOBAL_AS v4i* route_i = (const GLOBAL_AS v4i*)(C.ws + WS_ROUTE_I); const GLOBAL_AS f32x2* route_w = (const GLOBAL_AS f32x2*)(C.ws + WS_ROUTE_W);
    f32x4 gg[4];
#pragma unroll
    for (int j = 0; j < 4; ++j) gg[j] = ((const GLOBAL_AS f32x4*)g)[64 * j + C.lane];
    for (int m0 = C.gw; m0 < NTOK; m0 += 4 * C.NGW) {
        v4i ri[4]; f32x2 rw[4]; v2u ya[4][4], yb[4][4], xw[4][4]; float s[4];
#pragma unroll
        for (int r = 0; r < 4; ++r) { const int m = min(m0 + r * C.NGW, NTOK - 1); ri[r] = route_i[m]; rw[r] = route_w[m];
            const GLOBAL_AS v2u* xr = (const GLOBAL_AS v2u*)(x + (size_t)m * LDX) + C.lane;
#pragma unroll
            for (int j = 0; j < 4; ++j) xw[r][j] = xr[64 * j]; }
#pragma unroll
        for (int r = 0; r < 4; ++r) { const int m = min(m0 + r * C.NGW, NTOK - 1); const bf16* base = Y + (size_t)(m / MOE_CHUNK) * CHUNK_SLOTS * DM;
            const GLOBAL_AS v2u* y0 = (const GLOBAL_AS v2u*)(base + (size_t)ri[r].z * DM) + C.lane; const GLOBAL_AS v2u* y1 = (const GLOBAL_AS v2u*)(base + (size_t)ri[r].w * DM) + C.lane;
#pragma unroll
            for (int j = 0; j < 4; ++j) { ya[r][j] = y0[64 * j]; yb[r][j] = y1[64 * j]; } }
#pragma unroll
        for (int r = 0; r < 4; ++r) { const int m = m0 + r * C.NGW; f32x4 v[4]; float acc = 0.f;
#pragma unroll
            for (int j = 0; j < 4; ++j) { const v2u a = ya[r][j], b = yb[r][j], c = xw[r][j]; f32x4 t = (f32x4){bflo(c.x), bfhi(c.x), bflo(c.y), bfhi(c.y)};
                t.x += rw[r].x * bflo(a.x) + rw[r].y * bflo(b.x); t.y += rw[r].x * bfhi(a.x) + rw[r].y * bfhi(b.x); t.z += rw[r].x * bflo(a.y) + rw[r].y * bflo(b.y); t.w += rw[r].x * bfhi(a.y) + rw[r].y * bfhi(b.y);
                v[j] = t; acc += (t.x * t.x + t.y * t.y) + (t.z * t.z + t.w * t.w); }
            const float rstd = 1.0f / sqrtf(wsum_all(acc) * (1.0f / DM) + NORM_EPS);
            if (m < NTOK) {
                if (LAST) { GLOBAL_AS f32x4* xr = (GLOBAL_AS f32x4*)(out + (size_t)m * DM) + C.lane;
#pragma unroll
                    for (int j = 0; j < 4; ++j) xr[64 * j] = v[j] * rstd * gg[j];
                } else { f32x4 y[4]; float am = 0.f;
#pragma unroll
                    for (int j = 0; j < 4; ++j) { stx4(x + (size_t)m * LDX, 64 * j + C.lane, v[j]); y[j] = v[j] * rstd * gg[j]; am = fmaxf(fmaxf(am, fmaxf(fabsf(y[j].x), fabsf(y[j].y))), fmaxf(fabsf(y[j].z), fabsf(y[j].w))); }
                    am = fmaxf(wmax_all(am), 1e-20f); const float inv = 127.0f / am; GLOBAL_AS unsigned* o4 = (GLOBAL_AS unsigned*)((unsigned char*)Hn + (size_t)m * DM) + C.lane;
#pragma unroll
                    for (int j = 0; j < 4; ++j) o4[64 * j] = pack4_i8(y[j].x * inv, y[j].y * inv, y[j].z * inv, y[j].w * inv);
                    if (C.lane == 0) ((GLOBAL_AS float*)(C.ws + WS_SA))[m] = am * (1.0f / 127.0f);
                } } }
    }
}
__device__ __forceinline__ void grouped_order(pg8::GroupedOrder& S, const unsigned* cnt, int chunk, int nN, int G, int c) {
    int te[8]; int acc = 0;
#pragma unroll
    for (int k = 0; k < 8; ++k) { const int n = __builtin_amdgcn_readfirstlane((int)__hip_atomic_load(cnt + (chunk * 8 + k) * 64, __ATOMIC_RELAXED, __HIP_MEMORY_SCOPE_AGENT)); acc += (n + 255) >> 8; te[k] = acc; }
    S.t0 = te[0]; S.t1 = te[1]; S.t2 = te[2]; S.t3 = te[3]; S.t4 = te[4]; S.t5 = te[5]; S.t6 = te[6]; S.RT = te[7]; S.nN = nN; S.G = G; S.c = c;
}
namespace att {
typedef short bf16x8 __attribute__((ext_vector_type(8)));
typedef short s16x4 __attribute__((ext_vector_type(4)));
typedef short v4i16_t __attribute__((ext_vector_type(4)));
typedef float f32x16 __attribute__((ext_vector_type(16)));
typedef float f32x2_t __attribute__((ext_vector_type(2)));
typedef __bf16 bf16x2_t __attribute__((ext_vector_type(2)));
typedef unsigned u32x4 __attribute__((ext_vector_type(4)));
__device__ __forceinline__ unsigned cvtpk(float lo, float hi) { f32x2_t v = {lo, hi}; bf16x2_t b = __builtin_convertvector(v, bf16x2_t); return __builtin_bit_cast(unsigned, b); }
__device__ __forceinline__ s16x4 vtr(const LAS unsigned char* p) { return __builtin_bit_cast(s16x4, __builtin_amdgcn_ds_read_tr16_b64_v4i16((LAS v4i16_t*)p)); }
#define VTR_ISSUE(dst, addr, OFF) asm volatile("ds_read_b64_tr_b16 %0, %1 offset:%2" : "=&v"(dst) : "v"(addr), "i"(OFF))
__device__ __forceinline__ void vtr_wait8(s16x4& a, s16x4& b, s16x4& c, s16x4& d, s16x4& e, s16x4& f, s16x4& g, s16x4& h) {
    asm volatile("s_waitcnt lgkmcnt(0)" : "+v"(a), "+v"(b), "+v"(c), "+v"(d), "+v"(e), "+v"(f), "+v"(g), "+v"(h)); }
#define VTR_PACK(lo, hi) ((bf16x8){lo[0], lo[1], lo[2], lo[3], hi[0], hi[1], hi[2], hi[3]})
__device__ __forceinline__ void xhalf_swap(unsigned& a, unsigned& b) { asm volatile("s_nop 1\n\tv_permlane32_swap_b32 %0, %1\n\ts_nop 1" : "+v"(a), "+v"(b)); }
__device__ __forceinline__ float xhalf_max(float v) { unsigned a = __builtin_bit_cast(unsigned, v), b = a; xhalf_swap(a, b); return fmaxf(__builtin_bit_cast(float, a), __builtin_bit_cast(float, b)); }
__device__ __forceinline__ float xhalf_sum(float v) { unsigned a = __builtin_bit_cast(unsigned, v), b = a; xhalf_swap(a, b); return __builtin_bit_cast(float, a) + __builtin_bit_cast(float, b); }
#define ATT_MFMA(a, b, c) __builtin_amdgcn_mfma_f32_32x32x16_bf16((a), (b), (c), 0, 0, 0)
__device__ __forceinline__ void sm_step(const f32x16& s, float c, float& m, float& l, f32x16& o0, f32x16& o1, bf16x8& p0, bf16x8& p1) {
    float mx = fmaxf(fmaxf(fmaxf(s[0], s[1]), fmaxf(s[2], s[3])), fmaxf(fmaxf(s[4], s[5]), fmaxf(s[6], s[7])));
    mx = fmaxf(mx, fmaxf(fmaxf(fmaxf(s[8], s[9]), fmaxf(s[10], s[11])), fmaxf(fmaxf(s[12], s[13]), fmaxf(s[14], s[15]))));
    mx = xhalf_max(mx);
    const float mc = mx * c;
    if (__builtin_amdgcn_ballot_w64(mc > m + 8.0f) != 0) {
        const float mn = fmaxf(m, mc), al = ex2(m - mn); m = mn; l *= al;
#pragma unroll
        for (int i = 0; i < 16; ++i) { o0[i] *= al; o1[i] *= al; }
    }
    float pe[16]; float ls = 0.f;
#pragma unroll
    for (int i = 0; i < 16; ++i) { pe[i] = ex2(__builtin_fmaf(s[i], c, -m)); ls += pe[i]; }
    l += ls;
    u32x4 a, b; a.x = cvtpk(pe[0], pe[1]); a.y = cvtpk(pe[2], pe[3]); a.z = cvtpk(pe[4], pe[5]); a.w = cvtpk(pe[6], pe[7]);
    b.x = cvtpk(pe[8], pe[9]); b.y = cvtpk(pe[10], pe[11]); b.z = cvtpk(pe[12], pe[13]); b.w = cvtpk(pe[14], pe[15]);
    p0 = __builtin_bit_cast(bf16x8, a); p1 = __builtin_bit_cast(bf16x8, b);
}
constexpr int MLA_KB = 12 * 64 * 16, MLA_BUF = MLA_KB + 64 * 128;
__device__ __forceinline__ void mla_unit(const bf16* QM, const bf16* KVM, const bf16* KPE, const float* rope, bf16* OC, int unit, LAS unsigned char* lds, int tid) {
    const int lane = tid & 63, wave = __builtin_amdgcn_readfirstlane(tid >> 6), r32 = lane & 31, hh = lane >> 5;
    const int b = unit >> 5, h = (unit >> 2) & 7, qt = unit & 3, q0 = qt * 512 + wave * 64;
    const float c = 0.10206207261596575f * LOG2E;
    bf16x8 qf[2][6];
#pragma unroll
    for (int qb = 0; qb < 2; ++qb) { const int t = q0 + qb * 32 + r32; const bf16* src = QM + ((size_t)b * SEQ + t) * 768 + h * 96 + hh * 8;
#pragma unroll
        for (int ks = 0; ks < 6; ++ks) qf[qb][ks] = *(const bf16x8*)(src + 16 * ks);
        const f32x4* rp = (const f32x4*)(rope + (t * 16 + 8 * hh) * 2);
        bf16x8 a4 = qf[qb][4], a5 = qf[qb][5];
#pragma unroll
        for (int jj = 0; jj < 4; ++jj) { const f32x4 cs = rp[jj];
            const float x1a = bflo((unsigned)(unsigned short)a4[2 * jj]), x2a = bflo((unsigned)(unsigned short)a5[2 * jj]), x1b = bflo((unsigned)(unsigned short)a4[2 * jj + 1]), x2b = bflo((unsigned)(unsigned short)a5[2 * jj + 1]);
            a4[2 * jj] = (short)f2bf(x1a * cs.x - x2a * cs.y); a5[2 * jj] = (short)f2bf(x1a * cs.y + x2a * cs.x);
            a4[2 * jj + 1] = (short)f2bf(x1b * cs.z - x2b * cs.w); a5[2 * jj + 1] = (short)f2bf(x1b * cs.w + x2b * cs.z); }
        qf[qb][4] = a4; qf[qb][5] = a5; }
    f32x16 o[2][2];
#pragma unroll
    for (int i = 0; i < 16; ++i) { o[0][0][i] = 0.f; o[0][1][i] = 0.f; o[1][0][i] = 0.f; o[1][1][i] = 0.f; }
    float m0 = -INFINITY, m1 = -INFINITY, l0 = 0.f, l1 = 0.f;
    const bf16* kvb = KVM + (size_t)b * SEQ * 1024 + h * 128;
    const bf16* gk0 = kvb + (size_t)lane * 1024 + wave * 8;
    const bf16* gk1 = KPE + ((size_t)b * SEQ + lane) * 32 + (wave & 3) * 8;
    const int vkey = wave * 8 + (lane >> 3), vcc = (lane & 7) ^ (((vkey >> 1) & 1) << 2);
    const bf16* gv = kvb + (size_t)vkey * 1024 + 64 + vcc * 8;
    const bool two = wave < 4;
    const int lk0 = wave * 1024, lk1 = (8 + wave) * 1024, lv = MLA_KB + wave * 1024;
#define MLA_STAGE(bufp, jt) do { const size_t go_ = (size_t)(jt) * 64; \
        __builtin_amdgcn_global_load_lds((const unsigned*)(gk0 + go_ * 1024), (LAS unsigned*)((bufp) + lk0), 16, 0, 0); \
        if (two) __builtin_amdgcn_global_load_lds((const unsigned*)(gk1 + go_ * 32), (LAS unsigned*)((bufp) + lk1), 16, 0, 0); \
        __builtin_amdgcn_global_load_lds((const unsigned*)(gv + go_ * 1024), (LAS unsigned*)((bufp) + lv), 16, 0, 0); } while (0)
    const int ka = (hh * 64 + r32) * 16;
    const int i16 = lane & 15, q4 = i16 >> 2, p4 = i16 & 3, cb = (lane >> 4) & 1;
    const int vrow = (4 * hh + q4) * 128 + (p4 & 1) * 8;
    const int va0 = MLA_KB + vrow + (((0 ^ (q4 >> 1)) * 4 + cb * 2 + (p4 >> 1)) * 16), va1 = MLA_KB + vrow + (((1 ^ (q4 >> 1)) * 4 + cb * 2 + (p4 >> 1)) * 16);
    MLA_STAGE(lds, 0);
    asm volatile("s_waitcnt vmcnt(0)" ::: "memory");
    __syncthreads();
    for (int j = 0; j < SEQ / 64; ++j) {
        const LAS unsigned char* buf = lds + (j & 1) * MLA_BUF; LAS unsigned char* nbuf = lds + ((j + 1) & 1) * MLA_BUF;
        if ((j + 1) < SEQ / 64) MLA_STAGE(nbuf, j + 1);
#pragma unroll
        for (int kb = 0; kb < 2; ++kb) {
            bf16x8 p00, p01, p10, p11;
            { f32x16 s0, s1; bf16x8 kf[6];
#pragma unroll
              for (int ks = 0; ks < 6; ++ks) kf[ks] = *(const LAS bf16x8*)(buf + ka + ks * 2048 + kb * 512);
#pragma unroll
              for (int i = 0; i < 16; ++i) { s0[i] = 0.f; s1[i] = 0.f; }
#pragma unroll
              for (int ks = 0; ks < 6; ++ks) { s0 = ATT_MFMA(kf[ks], qf[0][ks], s0); s1 = ATT_MFMA(kf[ks], qf[1][ks], s1); }
              sm_step(s0, c, m0, l0, o[0][0], o[0][1], p00, p01);
              sm_step(s1, c, m1, l1, o[1][0], o[1][1], p10, p11); }
            { const unsigned a0 = (unsigned)(size_t)(buf + va0), a1 = (unsigned)(size_t)(buf + va1);
              s16x4 l00, h00, l01, h01, l10, h10, l11, h11;
              if (kb == 0) { VTR_ISSUE(l00, a0, 0); VTR_ISSUE(h00, a0, 1024); VTR_ISSUE(l01, a0, 2048); VTR_ISSUE(h01, a0, 3072); VTR_ISSUE(l10, a1, 0); VTR_ISSUE(h10, a1, 1024); VTR_ISSUE(l11, a1, 2048); VTR_ISSUE(h11, a1, 3072); }
              else         { VTR_ISSUE(l00, a0, 4096); VTR_ISSUE(h00, a0, 5120); VTR_ISSUE(l01, a0, 6144); VTR_ISSUE(h01, a0, 7168); VTR_ISSUE(l10, a1, 4096); VTR_ISSUE(h10, a1, 5120); VTR_ISSUE(l11, a1, 6144); VTR_ISSUE(h11, a1, 7168); }
              vtr_wait8(l00, h00, l01, h01, l10, h10, l11, h11);
              const bf16x8 v00 = VTR_PACK(l00, h00), v01 = VTR_PACK(l01, h01), v10 = VTR_PACK(l10, h10), v11 = VTR_PACK(l11, h11);
              o[0][0] = ATT_MFMA(v00, p00, o[0][0]); o[1][0] = ATT_MFMA(v00, p10, o[1][0]); o[0][1] = ATT_MFMA(v10, p00, o[0][1]); o[1][1] = ATT_MFMA(v10, p10, o[1][1]);
              o[0][0] = ATT_MFMA(v01, p01, o[0][0]); o[1][0] = ATT_MFMA(v01, p11, o[1][0]); o[0][1] = ATT_MFMA(v11, p01, o[0][1]); o[1][1] = ATT_MFMA(v11, p11, o[1][1]); }
        }
        asm volatile("s_waitcnt vmcnt(0)" ::: "memory");
        __syncthreads();
    }
#undef MLA_STAGE
    const float i0 = 1.0f / xhalf_sum(l0), i1 = 1.0f / xhalf_sum(l1);
#pragma unroll
    for (int qb = 0; qb < 2; ++qb) { const float inv = qb == 0 ? i0 : i1; bf16* dst = OC + ((size_t)b * SEQ + q0 + qb * 32 + r32) * DM + 512 + h * 64 + 4 * hh;
#pragma unroll
        for (int db = 0; db < 2; ++db)
#pragma unroll
            for (int g = 0; g < 4; ++g) { v2u w; w.x = cvtpk(o[qb][db][4 * g] * inv, o[qb][db][4 * g + 1] * inv); w.y = cvtpk(o[qb][db][4 * g + 2] * inv, o[qb][db][4 * g + 3] * inv);
                *(v2u*)(dst + db * 32 + 8 * g) = w; } }
}
__device__ __forceinline__ void stage32(LAS unsigned char* buf, const bf16* kp, const bf16* vp, size_t rs, int lane) {
    const bf16* v0 = vp + (size_t)(lane >> 3) * rs + ((lane & 7) ^ (((lane >> 4) & 1) << 2)) * 8;
#pragma unroll
    for (int i = 0; i < 4; ++i) { const int key = 8 * i + (lane >> 3); __builtin_amdgcn_global_load_lds((const unsigned*)(kp + (size_t)key * rs + ((lane & 7) ^ ((key >> 1) & 7)) * 8), (LAS unsigned*)(buf + i * 1024), 16, 0, 0); }
#pragma unroll
    for (int i = 0; i < 4; ++i) __builtin_amdgcn_global_load_lds((const unsigned*)(v0 + (size_t)(8 * i) * rs), (LAS unsigned*)(buf + 4096 + i * 1024), 16, 0, 0);
}
__device__ __forceinline__ void stageK(LAS unsigned char* kb, const bf16* kp, size_t rs, int lane) {
#pragma unroll
    for (int i = 0; i < 4; ++i) { const int key = 8 * i + (lane >> 3); __builtin_amdgcn_global_load_lds((const unsigned*)(kp + (size_t)key * rs + ((lane & 7) ^ ((key >> 1) & 7)) * 8), (LAS unsigned*)(kb + i * 1024), 16, 0, 0); }
}
__device__ __forceinline__ void stageV(LAS unsigned char* vb, const bf16* vp, size_t rs, int lane) {
    const bf16* v0 = vp + (size_t)(lane >> 3) * rs + ((lane & 7) ^ (((lane >> 4) & 1) << 2)) * 8;
#pragma unroll
    for (int i = 0; i < 4; ++i) __builtin_amdgcn_global_load_lds((const unsigned*)(v0 + (size_t)(8 * i) * rs), (LAS unsigned*)(vb + i * 1024), 16, 0, 0);
}
__device__ __forceinline__ f32x16 qk32(const LAS unsigned char* buf, const bf16x8 (&qf)[4], int r32, int hh) {
    f32x16 s; bf16x8 kf[4];
#pragma unroll
    for (int ks = 0; ks < 4; ++ks) kf[ks] = *(const LAS bf16x8*)(buf + r32 * 128 + (((2 * ks + hh) ^ ((r32 >> 1) & 7)) << 4));
#pragma unroll
    for (int i = 0; i < 16; ++i) s[i] = 0.f;
#pragma unroll
    for (int ks = 0; ks < 4; ++ks) s = ATT_MFMA(kf[ks], qf[ks], s);
    return s;
}
__device__ __forceinline__ void qk32x2(const LAS unsigned char* buf, const bf16x8 (&q0)[4], const bf16x8 (&q1)[4], f32x16& s0, f32x16& s1, int r32, int hh) {
    bf16x8 kf[4];
#pragma unroll
    for (int ks = 0; ks < 4; ++ks) kf[ks] = *(const LAS bf16x8*)(buf + r32 * 128 + (((2 * ks + hh) ^ ((r32 >> 1) & 7)) << 4));
#pragma unroll
    for (int i = 0; i < 16; ++i) { s0[i] = 0.f; s1[i] = 0.f; }
#pragma unroll
    for (int ks = 0; ks < 4; ++ks) { s0 = ATT_MFMA(kf[ks], q0[ks], s0); s1 = ATT_MFMA(kf[ks], q1[ks], s1); }
}
__device__ __forceinline__ void sm_step2(const float (&t)[16], float& m, float& l, f32x16& o0, f32x16& o1, bf16x8& p0, bf16x8& p1) {
    float mx = fmaxf(fmaxf(fmaxf(t[0], t[1]), fmaxf(t[2], t[3])), fmaxf(fmaxf(t[4], t[5]), fmaxf(t[6], t[7])));
    mx = fmaxf(mx, fmaxf(fmaxf(fmaxf(t[8], t[9]), fmaxf(t[10], t[11])), fmaxf(fmaxf(t[12], t[13]), fmaxf(t[14], t[15]))));
    mx = xhalf_max(mx);
    const float mn = fmaxf(m, mx), ms = (mn == -INFINITY) ? 0.f : mn, al = ex2(m - ms); m = mn;
    float pe[16]; float ls = 0.f;
#pragma unroll
    for (int i = 0; i < 16; ++i) { pe[i] = ex2(t[i] - ms); ls += pe[i]; }
    l = l * al + ls;
#pragma unroll
    for (int i = 0; i < 16; ++i) { o0[i] *= al; o1[i] *= al; }
    u32x4 a, b; a.x = cvtpk(pe[0], pe[1]); a.y = cvtpk(pe[2], pe[3]); a.z = cvtpk(pe[4], pe[5]); a.w = cvtpk(pe[6], pe[7]);
    b.x = cvtpk(pe[8], pe[9]); b.y = cvtpk(pe[10], pe[11]); b.z = cvtpk(pe[12], pe[13]); b.w = cvtpk(pe[14], pe[15]);
    p0 = __builtin_bit_cast(bf16x8, a); p1 = __builtin_bit_cast(bf16x8, b);
}
__device__ __forceinline__ void vfrag4(const LAS unsigned char* buf, int va0, int va1, bf16x8& v00, bf16x8& v01, bf16x8& v10, bf16x8& v11) {
    const unsigned a0 = (unsigned)(size_t)(buf + va0), a1 = (unsigned)(size_t)(buf + va1);
    s16x4 l00, h00, l01, h01, l10, h10, l11, h11;
    VTR_ISSUE(l00, a0, 0); VTR_ISSUE(h00, a0, 1024); VTR_ISSUE(l01, a0, 2048); VTR_ISSUE(h01, a0, 3072); VTR_ISSUE(l10, a1, 0); VTR_ISSUE(h10, a1, 1024); VTR_ISSUE(l11, a1, 2048); VTR_ISSUE(h11, a1, 3072);
    vtr_wait8(l00, h00, l01, h01, l10, h10, l11, h11);
    v00 = VTR_PACK(l00, h00); v01 = VTR_PACK(l01, h01); v10 = VTR_PACK(l10, h10); v11 = VTR_PACK(l11, h11);
}
#define ATT_VADDR() const int i16 = lane & 15, q4 = i16 >> 2, p4 = i16 & 3, cb = (lane >> 4) & 1; const int vrow = 4096 + (4 * hh + q4) * 128 + (p4 & 1) * 8; \
    const int va0 = vrow + (((0 ^ (q4 >> 1)) * 4 + cb * 2 + (p4 >> 1)) * 16), va1 = vrow + (((1 ^ (q4 >> 1)) * 4 + cb * 2 + (p4 >> 1)) * 16)
#define ATT_WAIT_V(n) asm volatile("s_waitcnt vmcnt(" #n ")" ::: "memory")

__device__ __forceinline__ void qrow_put(LAS unsigned char* tb, const v4u (&q)[4], int lane) {
#pragma unroll
    for (int i = 0; i < 4; ++i) { const int row = 8 * i + (lane >> 3); *(LAS v4u*)(tb + row * 128 + (((lane & 7) ^ ((row >> 1) & 7)) << 4)) = q[i]; }
}
__device__ __forceinline__ void qfrag_get(const LAS unsigned char* tb, bf16x8 (&qf)[4], int r32, int hh) {
#pragma unroll
    for (int ks = 0; ks < 4; ++ks) qf[ks] = *(const LAS bf16x8*)(tb + r32 * 128 + (((2 * ks + hh) ^ ((r32 >> 1) & 7)) << 4));
    asm volatile("s_waitcnt lgkmcnt(0)" : "+v"(qf[0]), "+v"(qf[1]), "+v"(qf[2]), "+v"(qf[3]) :: "memory");
}
__device__ __forceinline__ void ostage(LAS unsigned char* tb, const f32x16& o0, const f32x16& o1, float inv, int r32, int hh) {
#pragma unroll
    for (int db = 0; db < 2; ++db)
#pragma unroll
        for (int g = 0; g < 4; ++g) { const f32x16& o = db == 0 ? o0 : o1; v2u w; w.x = cvtpk(o[4 * g] * inv, o[4 * g + 1] * inv); w.y = cvtpk(o[4 * g + 2] * inv, o[4 * g + 3] * inv);
            *(LAS v2u*)(tb + r32 * 128 + (((db * 4 + g) ^ (r32 & 7)) << 4) + hh * 8) = w; }
}
__device__ __forceinline__ v4u orow(const LAS unsigned char* tb, int lane, int i) { return *(const LAS v4u*)(tb + i * 1024 + lane * 16); }
__device__ __forceinline__ int orow_chunk(int lane, int i) { return (lane & 7) ^ ((8 * i + (lane >> 3)) & 7); }
template <bool FINAL>
__device__ __forceinline__ void dil_tile(const bf16* PROJ, int dl, int idx, bf16* DPo, float* DLo, const bf16* DP1, const float* DL1, const bf16* DP2, const float* DL2, bf16* OC, LAS unsigned char* wl, int lane, const LAS float* tab  ) {
    const int r32 = lane & 31, hh = lane >> 5;
    const int L = SEQ / dl, nch = L >> 6, ich = idx % nch, rho = (idx / nch) % dl, bh = idx >> 5, h = bh & 7, b = bh >> 3, i0 = ich << 6;
    const bf16* base = PROJ + ((size_t)b * SEQ + rho) * IN_E_PAD + h * 64;
    const size_t rs = (size_t)dl * IN_E_PAD;
    bf16x8 qf[2][4]; v4u qraw[2][4];
#pragma unroll
    for (int qb = 0; qb < 2; ++qb)
#pragma unroll
        for (int i = 0; i < 4; ++i) qraw[qb][i] = *(const v4u*)(base + (size_t)(i0 + qb * 32 + 8 * i + (lane >> 3)) * rs + (lane & 7) * 8);
    ATT_VADDR();
    const float c = 0.125f * LOG2E; const LAS float* tabh = tab + h * 320 + 160;
    f32x16 o[2][2];
#pragma unroll
    for (int i = 0; i < 16; ++i) { o[0][0][i] = 0.f; o[0][1][i] = 0.f; o[1][0][i] = 0.f; o[1][1][i] = 0.f; }
    float m0 = -INFINITY, m1 = -INFINITY, l0 = 0.f, l1 = 0.f;
    const int klo = (i0 >= 64) ? 0 : 2, khi = (i0 + 128 <= L) ? 6 : 4;
    { const int ik0 = i0 - 64 + 32 * klo; stage32(wl, base + 512 + (size_t)ik0 * rs, base + 1024 + (size_t)ik0 * rs, rs, lane); }
    qrow_put(wl + 8192, qraw[0], lane); qrow_put(wl + 12288, qraw[1], lane); qfrag_get(wl + 8192, qf[0], r32, hh); qfrag_get(wl + 12288, qf[1], r32, hh);
    for (int kbi = klo; kbi < khi; ++kbi) {
        const LAS unsigned char* buf = wl + ((kbi - klo) & 1) * 8192;
        if (kbi + 1 < khi) { const int ik0 = i0 - 64 + 32 * (kbi + 1); stage32(wl + ((kbi + 1 - klo) & 1) * 8192, base + 512 + (size_t)ik0 * rs, base + 1024 + (size_t)ik0 * rs, rs, lane); ATT_WAIT_V(8); }
        else ATT_WAIT_V(0);
        const bool use0 = kbi <= 4, use1 = kbi >= 1;
        bf16x8 p00, p01, p10, p11;
        f32x16 sa, sb; qk32x2(buf, qf[0], qf[1], sa, sb, r32, hh);
        if (use0) { float t[16]; const LAS float* bp = tabh + ((32 * kbi - 64) + 4 * hh - r32);
#pragma unroll
            for (int i = 0; i < 16; ++i) t[i] = __builtin_fmaf(sa[i], c, bp[(i & 3) + 8 * (i >> 2)]);
            sm_step2(t, m0, l0, o[0][0], o[0][1], p00, p01); }
        if (use1) { float t[16]; const LAS float* bp = tabh + ((32 * kbi - 96) + 4 * hh - r32);
#pragma unroll
            for (int i = 0; i < 16; ++i) t[i] = __builtin_fmaf(sb[i], c, bp[(i & 3) + 8 * (i >> 2)]);
            sm_step2(t, m1, l1, o[1][0], o[1][1], p10, p11); }
        { bf16x8 v00, v01, v10, v11; vfrag4(buf, va0, va1, v00, v01, v10, v11);
          if (use0) { o[0][0] = ATT_MFMA(v00, p00, o[0][0]); o[0][1] = ATT_MFMA(v10, p00, o[0][1]); }
          if (use1) { o[1][0] = ATT_MFMA(v00, p10, o[1][0]); o[1][1] = ATT_MFMA(v10, p10, o[1][1]); }
          if (use0) { o[0][0] = ATT_MFMA(v01, p01, o[0][0]); o[0][1] = ATT_MFMA(v11, p01, o[0][1]); }
          if (use1) { o[1][0] = ATT_MFMA(v01, p11, o[1][0]); o[1][1] = ATT_MFMA(v11, p11, o[1][1]); } }
    }
    const float lt0 = xhalf_sum(l0), lt1 = xhalf_sum(l1);
#pragma unroll
    for (int qb = 0; qb < 2; ++qb) { const float lt = qb == 0 ? lt0 : lt1, mm = qb == 0 ? m0 : m1;
        const size_t tok = (size_t)b * SEQ + rho + (size_t)dl * (i0 + qb * 32 + r32);
        const float lse = mm + __builtin_amdgcn_logf(lt);
        if (!FINAL) {
            ostage(wl + qb * 4096, o[qb][0], o[qb][1], 1.0f / lt, r32, hh);
            if (hh == 0) DLo[(size_t)h * NTOK + tok] = lse;
        } else {
            const float a1 = DL1[(size_t)h * NTOK + tok], a2 = DL2[(size_t)h * NTOK + tok], mx = fmaxf(lse, fmaxf(a1, a2));
            const float e0 = ex2(lse - mx), e1 = ex2(a1 - mx), e2 = ex2(a2 - mx), es = 1.0f / (e0 + e1 + e2);
            ostage(wl + qb * 4096, o[qb][0], o[qb][1], e0 * es / lt, r32, hh);
            if (hh == 0) *(LAS f32x2*)(wl + 8192 + (qb * 32 + r32) * 8) = (f32x2){e1 * es, e2 * es};
        }
    }
    asm volatile("s_waitcnt lgkmcnt(0)" ::: "memory");
#pragma unroll
    for (int qb = 0; qb < 2; ++qb)
#pragma unroll
        for (int i = 0; i < 4; ++i) { const int r = 8 * i + (lane >> 3), ch = orow_chunk(lane, i);
            const size_t tok = (size_t)b * SEQ + rho + (size_t)dl * (i0 + qb * 32 + r);
            const v4u w = orow(wl + qb * 4096, lane, i);
            if (!FINAL) *(v4u*)(DPo + tok * 512 + h * 64 + ch * 8) = w;
            else { const f32x2 ww = *(const LAS f32x2*)(wl + 8192 + (qb * 32 + r) * 8);
                const v4u x1 = *(const v4u*)(DP1 + tok * 512 + h * 64 + ch * 8), x2 = *(const v4u*)(DP2 + tok * 512 + h * 64 + ch * 8);
                v4u y;
                y.x = cvtpk(bflo(w.x) + bflo(x1.x) * ww.x + bflo(x2.x) * ww.y, bfhi(w.x) + bfhi(x1.x) * ww.x + bfhi(x2.x) * ww.y);
                y.y = cvtpk(bflo(w.y) + bflo(x1.y) * ww.x + bflo(x2.y) * ww.y, bfhi(w.y) + bfhi(x1.y) * ww.x + bfhi(x2.y) * ww.y);
                y.z = cvtpk(bflo(w.z) + bflo(x1.z) * ww.x + bflo(x2.z) * ww.y, bfhi(w.z) + bfhi(x1.z) * ww.x + bfhi(x2.z) * ww.y);
                y.w = cvtpk(bflo(w.w) + bflo(x1.w) * ww.x + bflo(x2.w) * ww.y, bfhi(w.w) + bfhi(x1.w) * ww.x + bfhi(x2.w) * ww.y);
                *(v4u*)(OC + tok * DM + h * 64 + ch * 8) = y; } }
    asm volatile("s_waitcnt lgkmcnt(0)" ::: "memory");
}
__device__ __forceinline__ void na_tile(const bf16* QKV, const LAS float* rpb  , bf16* O, int idx, LAS unsigned char* wl, int lane) {
    asm volatile("" : "+v"(lane));
    const int r32 = lane & 31, hh = lane >> 5;
    const int cbk = idx & 3, iq = (idx >> 2) & 7, h = (idx >> 5) & 15, b = idx >> 9;
    const int qc = 16 * cbk + (r32 & 15), qr0 = 4 * iq + (r32 >> 4), qr1 = qr0 + 2;
    const bf16* qbase = QKV + ((size_t)h * NTOK + (size_t)b * SEQ) * 64; const bf16* kbase = qbase + (size_t)16 * NTOK * 64; const bf16* vbase = kbase + (size_t)16 * NTOK * 64;
    bf16x8 qf[2][4]; v4u qraw[2][4];
#pragma unroll
    for (int qb = 0; qb < 2; ++qb)
#pragma unroll
        for (int i = 0; i < 4; ++i) { const int r = 8 * i + (lane >> 3); qraw[qb][i] = *(const v4u*)(qbase + (size_t)((4 * iq + 2 * qb + (r >> 4)) * 64 + 16 * cbk + (r & 15)) * 64 + (lane & 7) * 8); }
    ATT_VADDR();
    const float c = 0.125f * LOG2E;
    const int csq = min(max(qc - 8, 0), 48), rs0 = min(max(qr0 - 4, 0), 24), rs1 = min(max(qr1 - 4, 0), 24);
    const int rA0 = min(max(4 * iq - 4, 0), 24), rB0 = min(max(4 * iq - 3, 0), 24) + 8, rA1 = min(max(4 * iq - 2, 0), 24), rB1 = min(max(4 * iq - 1, 0), 24) + 8;
    const int kc0 = min(max(16 * cbk - 8, 0), 32);
    const LAS float* rp = rpb + h * (15 * 31);
    f32x16 o[2][2];
#pragma unroll
    for (int i = 0; i < 16; ++i) { o[0][0][i] = 0.f; o[0][1][i] = 0.f; o[1][0][i] = 0.f; o[1][1][i] = 0.f; }
    float m0 = -INFINITY, m1 = -INFINITY, l0 = 0.f, l1 = 0.f;
    const int cd0 = kc0 + 4 * hh - csq, bc0 = kc0 + 4 * hh - qc + 15;
#define NA_ROW(kr_) ((size_t)((kr_) * 64 + kc0) * 64)
    stageK(wl, kbase + NA_ROW(rA0), 64, lane); stageV(wl + 8192, vbase + NA_ROW(rA0), 64, lane); stageK(wl + 4096, kbase + NA_ROW(rA0 + 1), 64, lane);
    qrow_put(wl + 12288, qraw[0], lane); qfrag_get(wl + 12288, qf[0], r32, hh); qrow_put(wl + 12288, qraw[1], lane); qfrag_get(wl + 12288, qf[1], r32, hh);
    ATT_WAIT_V(4);
    f32x16 sa, sb; qk32x2(wl, qf[0], qf[1], sa, sb, r32, hh);
    for (int kr = rA0; kr < rB1; ++kr) {
        const int j = kr - rA0; const bool n1 = kr + 1 < rB1, n2 = kr + 2 < rB1;
        if (n2) stageK(wl + (j & 1) * 4096, kbase + NA_ROW(kr + 2), 64, lane);
        if (n1) stageV(wl + 8192 + ((j + 1) & 1) * 4096, vbase + NA_ROW(kr + 1), 64, lane);
        if (n2) ATT_WAIT_V(8); else if (n1) ATT_WAIT_V(4); else ATT_WAIT_V(0);
        f32x16 na, nb;
        if (n1) qk32x2(wl + ((j + 1) & 1) * 4096, qf[0], qf[1], na, nb, r32, hh);
        const LAS unsigned char* buf = wl + 4096 + (j & 1) * 4096;
        const bool use0 = kr < rB0, use1 = kr >= rA1;
        bf16x8 p00, p01, p10, p11;
        if (use0) { float t[16]; const bool rok = (kr >= rs0) && (kr < rs0 + 8); const LAS float* bp = rp + (rok ? (kr - qr0 + 7) * 31 + bc0 : 0);
#pragma unroll
            for (int i = 0; i < 16; ++i) { const int dd = (i & 3) + 8 * (i >> 2); t[i] = bp[dd]; }
#pragma unroll
            for (int i = 0; i < 16; ++i) { const int dd = (i & 3) + 8 * (i >> 2); const bool ok = rok && ((unsigned)(cd0 + dd) < 16u); t[i] = ok ? __builtin_fmaf(sa[i], c, t[i]) : -INFINITY; }
            sm_step2(t, m0, l0, o[0][0], o[0][1], p00, p01); }
        if (use1) { float t[16]; const bool rok = (kr >= rs1) && (kr < rs1 + 8); const LAS float* bp = rp + (rok ? (kr - qr1 + 7) * 31 + bc0 : 0);
#pragma unroll
            for (int i = 0; i < 16; ++i) { const int dd = (i & 3) + 8 * (i >> 2); t[i] = bp[dd]; }
#pragma unroll
            for (int i = 0; i < 16; ++i) { const int dd = (i & 3) + 8 * (i >> 2); const bool ok = rok && ((unsigned)(cd0 + dd) < 16u); t[i] = ok ? __builtin_fmaf(sb[i], c, t[i]) : -INFINITY; }
            sm_step2(t, m1, l1, o[1][0], o[1][1], p10, p11); }
        { bf16x8 v00, v01, v10, v11; vfrag4(buf, va0, va1, v00, v01, v10, v11);
          if (use0) { o[0][0] = ATT_MFMA(v00, p00, o[0][0]); o[0][1] = ATT_MFMA(v10, p00, o[0][1]); }
          if (use1) { o[1][0] = ATT_MFMA(v00, p10, o[1][0]); o[1][1] = ATT_MFMA(v10, p10, o[1][1]); }
          if (use0) { o[0][0] = ATT_MFMA(v01, p01, o[0][0]); o[0][1] = ATT_MFMA(v11, p01, o[0][1]); }
          if (use1) { o[1][0] = ATT_MFMA(v01, p11, o[1][0]); o[1][1] = ATT_MFMA(v11, p11, o[1][1]); } }
        if (n1) { sa = na; sb = nb; }
    }
#undef NA_ROW
    const float i0 = 1.0f / xhalf_sum(l0), i1 = 1.0f / xhalf_sum(l1);
    ostage(wl, o[0][0], o[0][1], i0, r32, hh); ostage(wl + 4096, o[1][0], o[1][1], i1, r32, hh);
    asm volatile("s_waitcnt lgkmcnt(0)" ::: "memory");
#pragma unroll
    for (int qb = 0; qb < 2; ++qb)
#pragma unroll
        for (int i = 0; i < 4; ++i) { const int r = 8 * i + (lane >> 3);
            const v4u w = orow(wl + qb * 4096, lane, i);
            *(v4u*)(O + ((size_t)b * SEQ + (4 * iq + 2 * qb + (r >> 4)) * 64 + 16 * cbk + (r & 15)) * DM + h * 64 + orow_chunk(lane, i) * 8) = w; }
    asm volatile("s_waitcnt lgkmcnt(0)" ::: "memory");
}
}
#ifndef MK_MULTI
#define MK_MULTI 0
#endif
constexpr int NPH = 45;
struct Args { const float* in[22]; float* out; unsigned char* ws; int ph_lo, ph_hi; };
__global__ void __launch_bounds__(NWAVES * 64, 2) fwd(Args args) {
    extern __shared__ __attribute__((aligned(16))) unsigned char lds_raw[];
    Ctx C;
    C.out = args.out; C.ws = args.ws; C.lds = (LAS unsigned char*)lds_raw;
    C.tid = threadIdx.x; C.lane = C.tid & 63; C.wave = __builtin_amdgcn_readfirstlane(C.tid >> 6); C.G = gridDim.x; C.gw = blockIdx.x * NWAVES + C.wave; C.NGW = C.G * NWAVES;
    volatile LAS unsigned* MISC = (volatile LAS unsigned*)(C.lds + MISC_OFF);
    for (int u = C.tid; u < (LDS_BYTES - LDSCTL_OFF) / 4; u += NWAVES * 64) ((LAS unsigned*)(C.lds + LDSCTL_OFF))[u] = 0u;
    __syncthreads();
    XcdBarrier bar = xcd_barrier_post((unsigned*)(args.ws + WS_CTL) + CW_BAR, MISC + 8);
    const int lo = args.ph_lo, hi = args.ph_hi; int ph = 0; const int wave_s = C.wave;
#define PH_BEGIN { asm volatile("" : "+s"(ph)); const bool run_ = (ph >= lo && ph < hi); if (run_) { unsigned char* ws = args.ws; float* xo = args.out; int l_; asm volatile("v_mbcnt_lo_u32_b32 %0, -1, 0\n\tv_mbcnt_hi_u32_b32 %0, -1, %0" : "=v"(l_)); asm volatile("" : "+s"(ws), "+s"(xo)); \
        C.ws = ws; C.out = xo; C.lane = l_; C.wave = wave_s; C.tid = wave_s * 64 + l_; { int gw_ = blockIdx.x * NWAVES + wave_s, g_ = gridDim.x; asm volatile("" : "+s"(gw_), "+s"(g_)); C.gw = gw_; C.G = g_; C.NGW = g_ * NWAVES; } unsigned* ctl = (unsigned*)(ws + WS_CTL); (void)ctl;
#define PH_END } if (run_ && ph + 1 < hi) { XcdBarrier b2_ = bar; asm volatile("" : "+s"(b2_.bar)); int l2_; asm volatile("v_mbcnt_lo_u32_b32 %0, -1, 0\n\tv_mbcnt_hi_u32_b32 %0, -1, %0" : "=v"(l2_)); xcd_barrier(b2_, wave_s * 64 + l2_); } ++ph; }
#define H ((bf16*)(ws + WS_H))
#define XB ((bf16*)xo)
#define PROJ ((bf16*)(ws + WS_PROJ))
#define QM ((bf16*)(ws + WS_QM))
#define KVM ((bf16*)(ws + WS_KVM))
#define KPE ((bf16*)(ws + WS_KPE))
#define ACT ((bf16*)(ws + WS_ACT))
#define QKV ((bf16*)(ws + WS_QKV))
#define HG8 (ws + WS_HG8)
#define YALL ((bf16*)(ws + WS_YALL))
#define MACT (ws + WS_MACT)
#define wev (ws + WS_WEV + lp * EV_STRIDE)
#define wod (ws + WS_WOD + lp * OD_STRIDE)
#define cnt (ctl + CW_CNT + lp * N_CHUNK * 8 * 64)
#define xin (lp == 0 ? args.in[0] : (const float*)xo)
#define GEMM(EPI, ORD, g, S, E) pg8::gemm_phase<EPI, ORD, true, true, 0>(C.lds, g, S, E, C.tid)
#define GEMM8(EPI, ORD, g, S, E) pg8::gemm_phase<EPI, ORD, true, true, 1>(C.lds, g, S, E, C.tid)
#define GEMMI8(EPI, ORD, g, S, E) pg8::gemm_phase<EPI, ORD, true, true, 2>(C.lds, g, S, E, C.tid)

    PH_BEGIN p0_prologue(C, args); norm_phase<2, true>(C, args.in[0], args.in[1], H, XB); PH_END

    for (int lp = 0; lp < 2; ++lp) {
        PH_BEGIN { pg8::Gemm g{H, (const bf16*)(wev + EV_WIN), DM / 2, DM / 2, DM / 2}; pg8::StaticOrder S; S.init(NTOK, IN_E_PAD, C.G, (int)blockIdx.x); pg8::EpiBf16I8 E{PROJ, IN_E_PAD, (const float*)(ws + WS_SA), (const float*)(ws + WS_SB) + lp * 8192}; GEMMI8(pg8::EpiBf16I8, pg8::StaticOrder, g, S, E); } PH_END
        PH_BEGIN mla_prep_phase(C, PROJ, args.in[3] + lp * 256, args.in[5] + lp * 128, KPE); PH_END
        PH_BEGIN { { pg8::Gemm g{PROJ + 1536, (const bf16*)(wev + EV_WUQ), IN_E_PAD, 256, 256}; pg8::StaticOrder S; S.init(NTOK, 768, C.G, (int)blockIdx.x); pg8::EpiBf16 E{QM, 768}; GEMM(pg8::EpiBf16, pg8::StaticOrder, g, S, E); }
                   { pg8::Gemm g{PROJ + 1792, (const bf16*)(wev + EV_WUKV), IN_E_PAD, 256, 256}; pg8::StaticOrder S; S.init(NTOK, 1024, C.G, (int)blockIdx.x); pg8::EpiBf16 E{KVM, 1024}; GEMM(pg8::EpiBf16, pg8::StaticOrder, g, S, E); } } PH_END
#define ALIBI_TAB(off_, dl_) { LAS float* tb_ = (LAS float*)(C.lds + RPB_OFF + (off_)); for (int i = C.tid; i < 8 * 320; i += NWAVES * 64) { const int hd_ = i / 320, d_ = i % 320 - 160, ad_ = d_ < 0 ? -d_ : d_; \
            tb_[i] = ad_ <= 64 ? -(__builtin_amdgcn_exp2f(-(float)(hd_ + 1)) * LOG2E * (float)(dl_)) * (float)ad_ : -INFINITY; } }
        PH_BEGIN { const float* rope = (const float*)(ws + WS_ROPE);
                   ALIBI_TAB(0, 1) ALIBI_TAB(10240, 4)
                   __syncthreads();
                   for (int it = blockIdx.x; it < 1024; it += C.G) att::mla_unit(QM, KVM, KPE, rope, H, it, C.lds, C.tid);
                   LAS unsigned char* wl = C.lds + C.wave * 16384;
                   for (int it = C.gw; it < 8192; it += C.NGW) att::dil_tile<false>(PROJ, 1, it, (bf16*)(ws + WS_DP1), (float*)(ws + WS_DL1), nullptr, nullptr, nullptr, nullptr, nullptr, wl, C.lane, (const LAS float*)(C.lds + RPB_OFF));
                   for (int it = C.gw; it < 8192; it += C.NGW) att::dil_tile<false>(PROJ, 4, it, (bf16*)(ws + WS_DP2), (float*)(ws + WS_DL2), nullptr, nullptr, nullptr, nullptr, nullptr, wl, C.lane, (const LAS float*)(C.lds + RPB_OFF + 10240)); } PH_END
        PH_BEGIN { LAS unsigned char* wl = C.lds + C.wave * 16384;
                   ALIBI_TAB(0, 16)
                   __syncthreads();
                   for (int it = C.gw; it < 8192; it += C.NGW) att::dil_tile<true>(PROJ, 16, it, nullptr, nullptr, (const bf16*)(ws + WS_DP1), (const float*)(ws + WS_DL1), (const bf16*)(ws + WS_DP2), (const float*)(ws + WS_DL2), H, wl, C.lane, (const LAS float*)(C.lds + RPB_OFF)); } PH_END
#undef ALIBI_TAB
        PH_BEGIN { pg8::Gemm g{H, (const bf16*)(wev + EV_WOUT), DM, DM, DM}; pg8::StaticOrder S; S.init(NTOK, DM, C.G, (int)blockIdx.x); pg8::EpiResidB E{(const pg8::bf16_t*)XB, (pg8::bf16_t*)XB, LDX}; GEMM(pg8::EpiResidB, pg8::StaticOrder, g, S, E); } PH_END
        PH_BEGIN norm_phase_b(C, XB, args.in[8] + lp * DM, H); PH_END
        PH_BEGIN { pg8::Gemm g{H, (const bf16*)(wev + EV_WGU), DM / 2, DM / 2, DM / 2}; pg8::StaticOrder S; S.init(NTOK, 2 * DFF, C.G, (int)blockIdx.x); pg8::EpiSwigluI8 E{ACT, DFF, (const float*)(ws + WS_SA), (const float*)(ws + WS_SB) + lp * 8192 + 2048}; GEMMI8(pg8::EpiSwigluI8, pg8::StaticOrder, g, S, E); } PH_END
        PH_BEGIN { pg8::Gemm g{ACT, (const bf16*)(wev + EV_WD), DFF, DFF, DFF}; pg8::StaticOrder S; S.init(NTOK, DM, C.G, (int)blockIdx.x); pg8::EpiResidB E{(const pg8::bf16_t*)XB, (pg8::bf16_t*)XB, LDX}; GEMM(pg8::EpiResidB, pg8::StaticOrder, g, S, E); } PH_END

        PH_BEGIN norm_phase_b(C, XB, args.in[12] + lp * DM, H); moe_weights(C, args, lp); PH_END
        PH_BEGIN { pg8::Gemm g{H, (const bf16*)(wod + OD_WQKV), DM / 2, DM / 2, DM / 2}; pg8::StaticOrder S; S.init(NTOK, 3072, C.G, (int)blockIdx.x); pg8::EpiBf16I8H E{QKV, NTOK, (const float*)(ws + WS_SA), (const float*)(ws + WS_SB) + 16384 + lp * 4096}; GEMMI8(pg8::EpiBf16I8H, pg8::StaticOrder, g, S, E); } PH_END
        PH_BEGIN { const float* rpb = args.in[14] + lp * 16 * 15 * 31; LAS float* rl = (LAS float*)(C.lds + RPB_OFF);
                   for (int i = C.tid; i < 16 * 15 * 31; i += NWAVES * 64) rl[i] = rpb[i] * 1.4426950408889634f;
                   __syncthreads();
                   LAS unsigned char* wl = C.lds + C.wave * 16384;
                   for (int it = C.gw; it < 16384; it += C.NGW) att::na_tile(QKV, rl, H, it, wl, C.lane); } PH_END
        PH_BEGIN { pg8::Gemm g{H, (const bf16*)(wod + OD_WO), DM, DM, DM}; pg8::StaticOrder S; S.init(NTOK, DM, C.G, (int)blockIdx.x); pg8::EpiResidB E{(const pg8::bf16_t*)XB, (pg8::bf16_t*)XB, LDX}; GEMM(pg8::EpiResidB, pg8::StaticOrder, g, S, E); } PH_END
        PH_BEGIN route_phase(C, XB, args.in[16] + lp * DM, args.in[17] + lp * DM * NEXP, (unsigned char*)H, cnt); PH_END
        PH_BEGIN gather_all_phase(C, (const unsigned char*)H, HG8, cnt); PH_END
#define MOE_GU(ch_) { pg8::Gemm g{(const bf16*)(HG8 + (size_t)(ch_) * 2 * CHUNK_SLOTS * DM), (const bf16*)(ws + WS_MWGU), DM / 2, DM / 2, DM / 2}; pg8::GroupedOrder S; grouped_order(S, cnt, (ch_), 28, C.G, (int)blockIdx.x); \
            pg8::EpiSwigluF8 E{MACT + (size_t)((ch_) & 1) * CHUNK_SLOTS * DFFX, DFFX, 1.0f / 32.0f}; GEMM8(pg8::EpiSwigluF8, pg8::GroupedOrder, g, S, E); }
#define MOE_DOWN(ch_) { pg8::Gemm g{(const bf16*)(MACT + (size_t)((ch_) & 1) * CHUNK_SLOTS * DFFX), (const bf16*)(ws + WS_MWD), DFFX / 2, DFFX / 2, DFFX / 2}; pg8::GroupedOrder S; grouped_order(S, cnt, (ch_), 4, C.G, (int)blockIdx.x); \
            pg8::EpiBf16S E{YALL + (size_t)(ch_) * CHUNK_SLOTS * DM, DM, 1.0f / 32.0f}; GEMM8(pg8::EpiBf16S, pg8::GroupedOrder, g, S, E); }
        PH_BEGIN MOE_GU(0) PH_END
        for (int ch = 1; ch < N_CHUNK; ++ch) {
            PH_BEGIN MOE_DOWN(ch - 1) MOE_GU(ch) PH_END
        }
        PH_BEGIN MOE_DOWN(N_CHUNK - 1) PH_END
#undef MOE_GU
#undef MOE_DOWN
        PH_BEGIN { if (lp == 0) combine_all_phase<false>(C, XB, xo, YALL, args.in[1] + DM, H); else combine_all_phase<true>(C, XB, xo, YALL, args.in[21], H); } PH_END
    }
#undef PH_BEGIN
#undef PH_END
#undef GEMM
#undef XB
#undef H
#undef PROJ
#undef QM
#undef KVM
#undef KPE
#undef ACT
#undef QKV
#undef HG8
#undef YALL
#undef GEMM8
#undef GEMMI8
#undef MACT
#undef wev
#undef wod
#undef cnt
#undef xin
}

extern "C" void kernel_launch(void* const* d_in, const int* in_sizes, int n_in, void* d_out, int out_size, void* d_ws, size_t ws_size, hipStream_t stream) {
    static int grid = 0;
    if (grid == 0) {
        if (n_in != 22 || in_sizes[0] != NTOK * DM || out_size != NTOK * DM || ws_size < WS_END) { fprintf(stderr, "kernel_launch: unexpected shapes (n_in %d, in0 %d, out %d, ws %zu); nothing launched\n", n_in, n_in > 0 ? in_sizes[0] : -1, out_size, ws_size); grid = -1; return; }
        int dev = 0, cus = 0, per_cu = 0;
        if (hipGetDevice(&dev) != hipSuccess || hipDeviceGetAttribute(&cus, hipDeviceAttributeMultiprocessorCount, dev) != hipSuccess) { grid = -1; return; }
        if (hipFuncSetAttribute((const void*)fwd, hipFuncAttributeMaxDynamicSharedMemorySize, LDS_BYTES) != hipSuccess) { fprintf(stderr, "kernel_launch: hipFuncSetAttribute failed\n"); grid = -1; return; }
        if (hipOccupancyMaxActiveBlocksPerMultiprocessor(&per_cu, (const void*)fwd, NWAVES * 64, LDS_BYTES) != hipSuccess || per_cu < 1) { fprintf(stderr, "kernel_launch: occupancy query says %d blocks per CU\n", per_cu); }
        (void)hipGetLastError();
        grid = cus;
    }
    if (grid < 0) return;
    if (hipMemsetAsync((char*)d_ws + WS_CTL, 0, CTL_ZERO_BYTES, stream) != hipSuccess) return;
    Args a{};
    for (int i = 0; i < 22; ++i) a.in[i] = (const float*)d_in[i];
    a.out = (float*)d_out; a.ws = (unsigned char*)d_ws;
#if MK_MULTI
    for (int p = 0; p < NPH; ++p) { a.ph_lo = p; a.ph_hi = p + 1; hipLaunchKernelGGL(fwd, dim3(grid), dim3(NWAVES * 64), LDS_BYTES, stream, a); }
#else
    a.ph_lo = 0; a.ph_hi = NPH; hipLaunchKernelGGL(fwd, dim3(grid), dim3(NWAVES * 64), LDS_BYTES, stream, a);
#endif
}
```

```cpp
#include <hip/hip_runtime.h>
#include <cstdio>
#include <cstdint>
#define MK_MULTI 0
namespace pg8 {
#define PG8_LAS __attribute__((address_space(3)))
#define PG8_GAS __attribute__((address_space(1)))
typedef unsigned short bf16_t;
typedef short bf16x8 __attribute__((ext_vector_type(8)));
typedef float f32x4 __attribute__((ext_vector_type(4)));
typedef unsigned u32x4 __attribute__((ext_vector_type(4)));
typedef int v4i_t __attribute__((ext_vector_type(4)));
typedef int v8i_t __attribute__((ext_vector_type(8)));
constexpr int BM = 256, BK = 64, HALF = 128, HTB = HALF * BK * 2  , STAGE_BYTES = 8 * HTB, NXCD = 8, WGM = 8, EPI_SC_OFF = STAGE_BYTES + 1024  ;

__host__ __device__ __forceinline__ int lds_byte(int r, int c) { const int st = (r >> 4) * 2 + (c >> 5), rr = r & 15, cc = c & 31, ob = rr * 64 + cc * 2; return st * 1024 + (ob ^ (((ob >> 9) & 1) << 5)); }
__host__ __device__ __forceinline__ void stage_rc(int b, int& R, int& C) { const int st = b / 1024, sb = b % 1024, swz = sb ^ (((sb >> 9) & 1) << 5); R = (st >> 1) * 16 + swz / 64; C = (st & 1) * 32 + (swz % 64) / 2; }
__host__ __device__ __forceinline__ int perm32(int rho) { const int n = rho >> 4, i = rho & 15; return 8 * (i >> 2) + 4 * n + (i & 3); }

struct Unit { int pm, pn, pc; };
struct Gemm { const bf16_t* A; const bf16_t* Bt; int lda, ldb, K; };

struct StaticOrder {
    int nM, nN, nwg, G, c;
    __host__ __device__ void init(int M, int N, int G_, int c_) { nM = M / BM; nN = N / BM; nwg = nM * nN; G = G_; c = c_; }
    __host__ __device__ bool next(int i, Unit& u) const {
        const long L = (long)i * G + c; if (L >= nwg) return false;
        int wgid = (int)L; { const int q = nwg / NXCD, r = nwg % NXCD, xcd = wgid % NXCD, off = wgid / NXCD; wgid = (xcd < r ? xcd * (q + 1) : r * (q + 1) + (xcd - r) * q) + off; }
        const int nig = WGM * nN, gid = wgid / nig, fm = gid * WGM, gsz = (nM - fm) < WGM ? (nM - fm) : WGM;
        u.pm = fm + ((wgid % nig) % gsz); u.pn = (wgid % nig) / gsz; u.pc = u.pn; return true;
    }
    __device__ __forceinline__ void a_ready(const Unit&) const {}
    __device__ __forceinline__ void done(const Unit&) const {}
};
struct GroupedOrder {
    int t0, t1, t2, t3, t4, t5, t6, RT, nN, G, c;
    __device__ bool next(int i, Unit& u) const {
        const int nwg = RT * nN; const long L = (long)i * G + c; if (L >= nwg) return false;
        int wgid = (int)L; { const int q = nwg / NXCD, r = nwg % NXCD, xcd = wgid % NXCD, off = wgid / NXCD; wgid = (xcd < r ? xcd * (q + 1) : r * (q + 1) + (xcd - r) * q) + off; }
        const int nig = WGM * nN, gid = wgid / nig, fm = gid * WGM, gsz = (RT - fm) < WGM ? (RT - fm) : WGM, w = wgid - gid * nig;
        const int rt = fm + (w % gsz), j = w / gsz;
        const int e = (rt >= t0) + (rt >= t1) + (rt >= t2) + (rt >= t3) + (rt >= t4) + (rt >= t5) + (rt >= t6);
        u.pm = rt; u.pn = e * nN + j; u.pc = j; return true;
    }
    __device__ __forceinline__ void a_ready(const Unit&) const {}
    __device__ __forceinline__ void done(const Unit&) const {}
};

__device__ __forceinline__ unsigned cvt_pk_bf16(float lo, float hi) { unsigned r; asm volatile("v_cvt_pk_bf16_f32 %0, %1, %2" : "=v"(r) : "v"(lo), "v"(hi)); return r; }

struct EpiBf16 {
    static constexpr bool PERM = true, AFTER_DRAIN = false, PREFETCH = false;
    bf16_t* O; int ldc;
    __device__ __forceinline__ void operator()(const f32x4 (&acc)[2][2][4][2], const Unit& u, int wr, int wc, int fr, int fq) const {
        const int row0 = u.pm * BM + wr * 64 + fr, col0 = u.pc * BM + wc * 32 + 8 * fq;
#pragma unroll
        for (int ai = 0; ai < 2; ++ai)
#pragma unroll
            for (int m = 0; m < 4; ++m) { bf16_t* rowp = O + (size_t)(row0 + ai * HALF + m * 16) * ldc + col0;
#pragma unroll
                for (int bj = 0; bj < 2; ++bj) { const f32x4 v0 = acc[ai][bj][m][0], v1 = acc[ai][bj][m][1];
                    u32x4 w; w.x = cvt_pk_bf16(v0[0], v0[1]); w.y = cvt_pk_bf16(v0[2], v0[3]); w.z = cvt_pk_bf16(v1[0], v1[1]); w.w = cvt_pk_bf16(v1[2], v1[3]);
                    *(PG8_GAS u32x4*)(rowp + bj * HALF) = w; } }
    }
};
struct EpiSwiglu {
    static constexpr bool PERM = true, AFTER_DRAIN = false, PREFETCH = false;
    bf16_t* O; int ldc;
    __device__ __forceinline__ void operator()(const f32x4 (&acc)[2][2][4][2], const Unit& u, int wr, int wc, int fr, int fq) const {
        const int row0 = u.pm * BM + wr * 64 + fr, col0 = u.pc * HALF + wc * 32 + 8 * fq;
#pragma unroll
        for (int ai = 0; ai < 2; ++ai)
#pragma unroll
            for (int m = 0; m < 4; ++m) { bf16_t* rowp = O + (size_t)(row0 + ai * HALF + m * 16) * ldc + col0;
                float r[8];
#pragma unroll
                for (int n = 0; n < 2; ++n)
#pragma unroll
                    for (int k = 0; k < 4; ++k) { const float g = acc[ai][0][m][n][k], up = acc[ai][1][m][n][k];
                        r[n * 4 + k] = g * __builtin_amdgcn_rcpf(1.0f + __expf(-g)) * up; }
                u32x4 w; w.x = cvt_pk_bf16(r[0], r[1]); w.y = cvt_pk_bf16(r[2], r[3]); w.z = cvt_pk_bf16(r[4], r[5]); w.w = cvt_pk_bf16(r[6], r[7]);
                *(PG8_GAS u32x4*)rowp = w; }
    }
};
__device__ __forceinline__ unsigned cvt4_fp8(float a, float b, float c, float d) { int r = 0; r = __builtin_amdgcn_cvt_pk_fp8_f32(a, b, r, false); r = __builtin_amdgcn_cvt_pk_fp8_f32(c, d, r, true); return (unsigned)r; }
struct EpiSwigluF8 {
    static constexpr bool PERM = true, AFTER_DRAIN = false, PREFETCH = false;
    unsigned char* O; int ldc; float sc;
    __device__ __forceinline__ void operator()(const f32x4 (&acc)[2][2][4][2], const Unit& u, int wr, int wc, int fr, int fq) const {
        const int row0 = u.pm * BM + wr * 64 + fr, col0 = u.pc * HALF + wc * 32 + 8 * fq;
        const float c1 = -1.4426950408889634f * sc, k2 = 1.0f / (sc * sc);
#pragma unroll
        for (int ai = 0; ai < 2; ++ai)
#pragma unroll
            for (int m = 0; m < 4; ++m) { unsigned char* rowp = O + (size_t)(row0 + ai * HALF + m * 16) * ldc + col0;
                typedef unsigned u32x2_t __attribute__((ext_vector_type(2)));
                u32x2_t w;
#pragma unroll
                for (int n = 0; n < 2; ++n) { const f32x4 ag = acc[ai][0][m][n], au = acc[ai][1][m][n];
                    const f32x4 x = ag * c1; f32x4 tt;
#pragma unroll
                    for (int k = 0; k < 4; ++k) tt[k] = __builtin_amdgcn_exp2f(x[k]);
                    const f32x4 d = tt * k2 + k2; f32x4 r;
#pragma unroll
                    for (int k = 0; k < 4; ++k) r[k] = __builtin_amdgcn_rcpf(d[k]);
                    const f32x4 o = (ag * au) * r;
                    w[n] = cvt4_fp8(o[0], o[1], o[2], o[3]); }
                *(PG8_GAS u32x2_t*)rowp = w; }
    }
};
struct EpiBf16S {
    static constexpr bool PERM = true, AFTER_DRAIN = false, PREFETCH = false;
    bf16_t* O; int ldc; float sc;
    __device__ __forceinline__ void operator()(const f32x4 (&acc)[2][2][4][2], const Unit& u, int wr, int wc, int fr, int fq) const {
        const int row0 = u.pm * BM + wr * 64 + fr, col0 = u.pc * BM + wc * 32 + 8 * fq;
#pragma unroll
        for (int ai = 0; ai < 2; ++ai)
#pragma unroll
            for (int m = 0; m < 4; ++m) { bf16_t* rowp = O + (size_t)(row0 + ai * HALF + m * 16) * ldc + col0;
#pragma unroll
                for (int bj = 0; bj < 2; ++bj) { const f32x4 v0 = acc[ai][bj][m][0] * sc, v1 = acc[ai][bj][m][1] * sc;
                    u32x4 w; w.x = cvt_pk_bf16(v0[0], v0[1]); w.y = cvt_pk_bf16(v0[2], v0[3]); w.z = cvt_pk_bf16(v1[0], v1[1]); w.w = cvt_pk_bf16(v1[2], v1[3]);
                    *(PG8_GAS u32x4*)(rowp + bj * HALF) = w; } }
    }
};
struct EpiBf16I8 {
    static constexpr bool PERM = true, AFTER_DRAIN = false, PREFETCH = true;
    bf16_t* O; int ldc; const float* sa; const float* sb;
    __device__ __forceinline__ void prefetch(const Unit& u, PG8_LAS unsigned char* blk, int wid, int lane) const {
        const float* src = (wid < 4) ? sa + u.pm * BM + wid * 64 + lane : sb + u.pn * BM + (wid - 4) * 64 + lane;
        __builtin_amdgcn_global_load_lds((const unsigned*)src, (PG8_LAS unsigned*)(blk + wid * 256), 4, 0, 0);
    }
    __device__ __forceinline__ void run(const f32x4 (&acc)[2][2][4][2], const Unit& u, int wr, int wc, int fr, int fq, const PG8_LAS float* scl) const {
        const int row0 = u.pm * BM + wr * 64 + fr, col0 = u.pc * BM + wc * 32 + 8 * fq, lrow0 = wr * 64 + fr, bcol0 = 256 + wc * 32 + 8 * fq;
        f32x4 sc[2][2];
#pragma unroll
        for (int bj = 0; bj < 2; ++bj)
#pragma unroll
            for (int n = 0; n < 2; ++n) sc[bj][n] = *(const PG8_LAS f32x4*)(scl + bcol0 + bj * HALF + 4 * n);
#pragma unroll
        for (int ai = 0; ai < 2; ++ai)
#pragma unroll
            for (int m = 0; m < 4; ++m) { const int row = row0 + ai * HALF + m * 16; bf16_t* rowp = O + (size_t)row * ldc + col0; const float s = scl[lrow0 + ai * HALF + m * 16];
#pragma unroll
                for (int bj = 0; bj < 2; ++bj) { f32x4 v[2];
#pragma unroll
                    for (int n = 0; n < 2; ++n) { f32x4 fa;
#pragma unroll
                        for (int k = 0; k < 4; ++k) { const float f = acc[ai][bj][m][n][k]; fa[k] = (float)__builtin_bit_cast(int, f); }
                        v[n] = fa * (sc[bj][n] * s); }
                    u32x4 w; w.x = cvt_pk_bf16(v[0][0], v[0][1]); w.y = cvt_pk_bf16(v[0][2], v[0][3]); w.z = cvt_pk_bf16(v[1][0], v[1][1]); w.w = cvt_pk_bf16(v[1][2], v[1][3]);
                    *(PG8_GAS u32x4*)(rowp + bj * HALF) = w; } }
    }
};
struct EpiBf16I8H {
    static constexpr bool PERM = true, AFTER_DRAIN = false, PREFETCH = true;
    bf16_t* O; int nrows; const float* sa; const float* sb;
    __device__ __forceinline__ void prefetch(const Unit& u, PG8_LAS unsigned char* blk, int wid, int lane) const {
        const float* src = (wid < 4) ? sa + u.pm * BM + wid * 64 + lane : sb + u.pn * BM + (wid - 4) * 64 + lane;
        __builtin_amdgcn_global_load_lds((const unsigned*)src, (PG8_LAS unsigned*)(blk + wid * 256), 4, 0, 0);
    }
    __device__ __forceinline__ void run(const f32x4 (&acc)[2][2][4][2], const Unit& u, int wr, int wc, int fr, int fq, const PG8_LAS float* scl) const {
        const int row0 = u.pm * BM + wr * 64 + fr, col0 = u.pc * BM + wc * 32 + 8 * fq, lrow0 = wr * 64 + fr, bcol0 = 256 + wc * 32 + 8 * fq;
        f32x4 sc[2][2];
#pragma unroll
        for (int bj = 0; bj < 2; ++bj)
#pragma unroll
            for (int n = 0; n < 2; ++n) sc[bj][n] = *(const PG8_LAS f32x4*)(scl + bcol0 + bj * HALF + 4 * n);
#pragma unroll
        for (int ai = 0; ai < 2; ++ai)
#pragma unroll
            for (int m = 0; m < 4; ++m) { const int row = row0 + ai * HALF + m * 16; const float s = scl[lrow0 + ai * HALF + m * 16];
#pragma unroll
                for (int bj = 0; bj < 2; ++bj) { f32x4 v[2];
#pragma unroll
                    for (int n = 0; n < 2; ++n) { f32x4 fa;
#pragma unroll
                        for (int k = 0; k < 4; ++k) { const float f = acc[ai][bj][m][n][k]; fa[k] = (float)__builtin_bit_cast(int, f); }
                        v[n] = fa * (sc[bj][n] * s); }
                    u32x4 w; w.x = cvt_pk_bf16(v[0][0], v[0][1]); w.y = cvt_pk_bf16(v[0][2], v[0][3]); w.z = cvt_pk_bf16(v[1][0], v[1][1]); w.w = cvt_pk_bf16(v[1][2], v[1][3]);
                    const int cc = col0 + bj * HALF; *(PG8_GAS u32x4*)(O + ((size_t)(cc >> 6) * nrows + row) * 64 + (cc & 63)) = w; } }
    }
};
struct EpiSwigluI8 {
    static constexpr bool PERM = true, AFTER_DRAIN = false, PREFETCH = true;
    bf16_t* O; int ldc; const float* sa; const float* sb;
    __device__ __forceinline__ void prefetch(const Unit& u, PG8_LAS unsigned char* blk, int wid, int lane) const {
        const float* src = (wid < 4) ? sa + u.pm * BM + wid * 64 + lane : sb + u.pn * BM + (wid - 4) * 64 + lane;
        __builtin_amdgcn_global_load_lds((const unsigned*)src, (PG8_LAS unsigned*)(blk + wid * 256), 4, 0, 0);
    }
    __device__ __forceinline__ void run(const f32x4 (&acc)[2][2][4][2], const Unit& u, int wr, int wc, int fr, int fq, const PG8_LAS float* scl) const {
        const int row0 = u.pm * BM + wr * 64 + fr, col0 = u.pc * HALF + wc * 32 + 8 * fq, lrow0 = wr * 64 + fr, bcol0 = 256 + wc * 32 + 8 * fq;
        f32x4 c1[2], c2[2]; float one = 1.0f; asm volatile("" : "+v"(one));
#pragma unroll
        for (int n = 0; n < 2; ++n) { const f32x4 sg = *(const PG8_LAS f32x4*)(scl + bcol0 + 4 * n), su = *(const PG8_LAS f32x4*)(scl + bcol0 + HALF + 4 * n); c1[n] = sg * -1.4426950408889634f; c2[n] = sg * su; }
#pragma unroll
        for (int ai = 0; ai < 2; ++ai)
#pragma unroll
            for (int m = 0; m < 4; ++m) { const int row = row0 + ai * HALF + m * 16; bf16_t* rowp = O + (size_t)row * ldc + col0; const float s = scl[lrow0 + ai * HALF + m * 16], s2 = s * s;
                u32x4 w;
#pragma unroll
                for (int n = 0; n < 2; ++n) { f32x4 fa, fu;
#pragma unroll
                    for (int k = 0; k < 4; ++k) { const float fg = acc[ai][0][m][n][k], fv = acc[ai][1][m][n][k]; fa[k] = (float)__builtin_bit_cast(int, fg); fu[k] = (float)__builtin_bit_cast(int, fv); }
                    const f32x4 x = fa * (c1[n] * s); f32x4 tt, r;
#pragma unroll
                    for (int k = 0; k < 4; ++k) tt[k] = __builtin_amdgcn_exp2f(x[k]);
                    const f32x4 d = tt * one + one;
#pragma unroll
                    for (int k = 0; k < 4; ++k) r[k] = __builtin_amdgcn_rcpf(d[k]);
                    const f32x4 o = ((fa * fu) * (c2[n] * s2)) * r;
                    if (n == 0) { w.x = cvt_pk_bf16(o[0], o[1]); w.y = cvt_pk_bf16(o[2], o[3]); } else { w.z = cvt_pk_bf16(o[0], o[1]); w.w = cvt_pk_bf16(o[2], o[3]); } }
                *(PG8_GAS u32x4*)rowp = w; }
    }
};
struct EpiNull { static constexpr bool PERM = true, AFTER_DRAIN = false, PREFETCH = false; int dummy;
    __device__ __forceinline__ void operator()(const f32x4 (&acc)[2][2][4][2], const Unit& u, int wr, int wc, int fr, int fq) const { float s = 0.f;
#pragma unroll
        for (int a = 0; a < 2; ++a)
#pragma unroll
            for (int b = 0; b < 2; ++b)
#pragma unroll
                for (int m = 0; m < 4; ++m)
#pragma unroll
                    for (int n = 0; n < 2; ++n) s += acc[a][b][m][n][0] + acc[a][b][m][n][1] + acc[a][b][m][n][2] + acc[a][b][m][n][3];
        asm volatile("" :: "v"(s)); }
};
struct EpiResidB {
    static constexpr bool PERM = true, AFTER_DRAIN = false, PREFETCH = false;
    const bf16_t* base; bf16_t* out; int ldc;
    __device__ __forceinline__ void operator()(const f32x4 (&acc)[2][2][4][2], const Unit& u, int wr, int wc, int fr, int fq) const {
        const int row0 = u.pm * BM + wr * 64 + fr, col0 = u.pc * BM + wc * 32 + 8 * fq;
#pragma unroll
        for (int ai = 0; ai < 2; ++ai)
#pragma unroll
            for (int m = 0; m < 4; ++m) { const size_t ro = (size_t)(row0 + ai * HALF + m * 16) * ldc + col0;
#pragma unroll
                for (int bj = 0; bj < 2; ++bj) { const u32x4 b = *(const PG8_GAS u32x4*)(base + ro + bj * HALF); const f32x4 v0 = acc[ai][bj][m][0], v1 = acc[ai][bj][m][1];
                    u32x4 w; w.x = cvt_pk_bf16(v0[0] + __builtin_bit_cast(float, b.x << 16), v0[1] + __builtin_bit_cast(float, b.x & 0xffff0000u)); w.y = cvt_pk_bf16(v0[2] + __builtin_bit_cast(float, b.y << 16), v0[3] + __builtin_bit_cast(float, b.y & 0xffff0000u));
                    w.z = cvt_pk_bf16(v1[0] + __builtin_bit_cast(float, b.z << 16), v1[1] + __builtin_bit_cast(float, b.z & 0xffff0000u)); w.w = cvt_pk_bf16(v1[2] + __builtin_bit_cast(float, b.w << 16), v1[3] + __builtin_bit_cast(float, b.w & 0xffff0000u));
                    *(PG8_GAS u32x4*)(out + ro + bj * HALF) = w; } }
    }
};
struct EpiResid {
    static constexpr bool PERM = false, AFTER_DRAIN = false, PREFETCH = false;
    const float* base; float* out; int ldc;
    __device__ __forceinline__ void operator()(const f32x4 (&acc)[2][2][4][2], const Unit& u, int wr, int wc, int fr, int fq) const {
        const int row0 = u.pm * BM + wr * 64 + fr, col0 = u.pc * BM + wc * 32 + 4 * fq;
#pragma unroll
        for (int ai = 0; ai < 2; ++ai)
#pragma unroll
            for (int m = 0; m < 4; ++m) { const size_t ro = (size_t)(row0 + ai * HALF + m * 16) * ldc + col0;
#pragma unroll
                for (int bj = 0; bj < 2; ++bj)
#pragma unroll
                    for (int n = 0; n < 2; ++n) { const size_t o = ro + bj * HALF + n * 16;
                        const f32x4 b = *(const PG8_GAS f32x4*)(base + o); *(PG8_GAS f32x4*)(out + o) = b + acc[ai][bj][m][n]; } }
    }
};
template <class Epi, class Sched, bool ALIGN_EPI = false, bool SP2 = false, int DT = 0>
__device__ __forceinline__ void gemm_phase(PG8_LAS unsigned char* lds, const Gemm g, const Sched& S, const Epi& E, int tid_in) {
    int tid_ = tid_in; asm volatile("" : "+v"(tid_));
    const int tid = tid_, wid = __builtin_amdgcn_readfirstlane(tid >> 6), lane = tid & 63, wr = wid >> 2, wc = wid & 3, fr = lane & 15, fq = lane >> 4;
    const int K = g.K, nt = K / BK;
    unsigned voffA[2], voffB[2];
#pragma unroll
    for (int i = 0; i < 2; ++i) { int R, C; stage_rc(tid * 16 + i * 8192, R, C); const int Rb = Epi::PERM ? ((R & ~31) + perm32(R & 31)) : R;
        voffA[i] = (unsigned)(R * g.lda + C) * 2u; voffB[i] = (unsigned)(Rb * g.ldb + C) * 2u; }
    const size_t kstep = (size_t)(BK * 2);
    const size_t hstepA = (size_t)HALF * g.lda * 2, hstepB = (size_t)HALF * g.ldb * 2;
    const size_t tstepA = 2 * hstepA, tstepB = 2 * hstepB;
    const unsigned ldsw = (unsigned)wid * 1024u;
    const int aoff = lds_byte(wr * 64 + fr, fq * 8), boff = lds_byte(wc * 32 + fr, fq * 8);
#define PG8_SA(b, h) (((b) * 2 + (h)) * HTB)
#define PG8_SB(b, h) ((4 + (b) * 2 + (h)) * HTB)
#define PG8_STAGE(bufoff, gbase, voff) do { _Pragma("unroll") for (int _i = 0; _i < 2; ++_i) \
        __builtin_amdgcn_global_load_lds((const unsigned*)((const char*)(gbase) + (voff)[_i]), (PG8_LAS unsigned*)(lds + (bufoff) + ldsw + _i * 8192), 16, 0, 0); } while (0)
#define PG8_LD16(base, off) (*(const PG8_LAS v4i_t*)((base) + (off)))
#define PG8_LDA(dst, b, h) do { if constexpr (DT == 1) { _Pragma("unroll") for (int m = 0; m < 4; ++m) A8[m] = __builtin_shufflevector(PG8_LD16(abase8, ((b) * 2 + (h)) * HTB + m * 2048), PG8_LD16(abase8, ((b) * 2 + (h)) * HTB + m * 2048 + 1024), 0, 1, 2, 3, 4, 5, 6, 7); } \
        else { _Pragma("unroll") for (int m = 0; m < 4; ++m) _Pragma("unroll") for (int k = 0; k < 2; ++k) dst[m][k] = *(const PG8_LAS bf16x8*)(lds + PG8_SA(b, h) + aoff + m * 2048 + k * 1024); } } while (0)
#define PG8_LDB(dst, b, h) do { if constexpr (DT == 1) { _Pragma("unroll") for (int n = 0; n < 2; ++n) dst##8[n] = __builtin_shufflevector(PG8_LD16(bbase8, ((b) * 2 + (h)) * HTB + n * 2048), PG8_LD16(bbase8, ((b) * 2 + (h)) * HTB + n * 2048 + 1024), 0, 1, 2, 3, 4, 5, 6, 7); } \
        else { _Pragma("unroll") for (int n = 0; n < 2; ++n) _Pragma("unroll") for (int k = 0; k < 2; ++k) dst[n][k] = *(const PG8_LAS bf16x8*)(lds + PG8_SB(b, h) + boff + n * 2048 + k * 1024); } } while (0)
#define PG8_MMA(ai, bj, At, Bt, first) do { __builtin_amdgcn_s_setprio(1); \
        if constexpr (DT == 1) { if (first) { _Pragma("unroll") for (int m = 0; m < 4; ++m) _Pragma("unroll") for (int n = 0; n < 2; ++n) \
            asm volatile("v_mfma_f32_16x16x128_f8f6f4 %0, %1, %2, 0" : "=v"(acc[ai][bj][m][n]) : "v"(Bt##8[n]), "v"(A8[m])); } \
          else { _Pragma("unroll") for (int m = 0; m < 4; ++m) _Pragma("unroll") for (int n = 0; n < 2; ++n) \
            asm volatile("v_mfma_f32_16x16x128_f8f6f4 %0, %1, %2, %0" : "+v"(acc[ai][bj][m][n]) : "v"(Bt##8[n]), "v"(A8[m])); } } \
        else if constexpr (DT == 2) {   \
          if (first) { _Pragma("unroll") for (int m = 0; m < 4; ++m) _Pragma("unroll") for (int n = 0; n < 2; ++n) \
            asm volatile("v_mfma_i32_16x16x64_i8 %0, %1, %2, 0" : "=v"(acc[ai][bj][m][n]) : "v"(Bt[n][0]), "v"(At[m][0])); } \
          else { _Pragma("unroll") for (int m = 0; m < 4; ++m) _Pragma("unroll") for (int n = 0; n < 2; ++n) \
            asm volatile("v_mfma_i32_16x16x64_i8 %0, %1, %2, %0" : "+v"(acc[ai][bj][m][n]) : "v"(Bt[n][0]), "v"(At[m][0])); } \
          _Pragma("unroll") for (int m = 0; m < 4; ++m) _Pragma("unroll") for (int n = 0; n < 2; ++n) \
            asm volatile("v_mfma_i32_16x16x64_i8 %0, %1, %2, %0" : "+v"(acc[ai][bj][m][n]) : "v"(Bt[n][1]), "v"(At[m][1])); } \
        else { _Pragma("unroll") for (int m = 0; m < 4; ++m) _Pragma("unroll") for (int n = 0; n < 2; ++n) _Pragma("unroll") for (int k = 0; k < 2; ++k) \
            acc[ai][bj][m][n] = __builtin_amdgcn_mfma_f32_16x16x32_bf16(Bt[n][k], At[m][k], acc[ai][bj][m][n], 0, 0, 0); } \
        __builtin_amdgcn_s_setprio(0); } while (0)
#define PG8_WAIT_V(n) asm volatile("s_waitcnt vmcnt(" #n ")" ::: "memory")
#define PG8_WAIT_L(n) asm volatile("s_waitcnt lgkmcnt(" #n ")" ::: "memory")
#define PG8_BAR __builtin_amdgcn_s_barrier()
#define PG8_SCHED __builtin_amdgcn_sched_barrier(0)
    Unit cur, nxt; int ui = 0;
    if (!S.next(0, cur)) return;
    f32x4 acc[2][2][4][2];
    if constexpr (DT == 0) {
#pragma unroll
        for (int a = 0; a < 2; ++a)
#pragma unroll
            for (int b = 0; b < 2; ++b)
#pragma unroll
                for (int m = 0; m < 4; ++m)
#pragma unroll
                    for (int n = 0; n < 2; ++n) acc[a][b][m][n] = (f32x4){0.f, 0.f, 0.f, 0.f};
    }
    PG8_LAS unsigned char* abase8 = lds + aoff; PG8_LAS unsigned char* bbase8 = lds + 4 * HTB + boff; asm volatile("" : "+v"(abase8), "+v"(bbase8));
    bf16x8 At[4][2], B0[2][2], B1[2][2]; v8i_t A8[4], B08[2], B18[2];
    const char* cA = (const char*)g.A + (size_t)cur.pm * tstepA; const char* cB = (const char*)g.Bt + (size_t)cur.pn * tstepB;
    S.a_ready(cur);
    if constexpr (Epi::PREFETCH) E.prefetch(cur, lds + EPI_SC_OFF, wid, lane);
    if constexpr (SP2) {
        PG8_STAGE(PG8_SB(0, 0), cB, voffB); PG8_STAGE(PG8_SB(0, 1), cB + hstepB, voffB); PG8_STAGE(PG8_SA(0, 0), cA, voffA); PG8_STAGE(PG8_SA(0, 1), cA + hstepA, voffA);
        if (wr == 1) PG8_BAR;
        PG8_WAIT_V(2); PG8_BAR;
        PG8_STAGE(PG8_SB(1, 0), cB + kstep, voffB); PG8_STAGE(PG8_SA(1, 0), cA + kstep, voffA); PG8_STAGE(PG8_SB(1, 1), cB + hstepB + kstep, voffB);
        PG8_WAIT_V(6); PG8_BAR;
    } else {
        PG8_STAGE(PG8_SB(0, 0), cB, voffB); PG8_STAGE(PG8_SA(0, 0), cA, voffA); PG8_STAGE(PG8_SB(0, 1), cB + hstepB, voffB); PG8_STAGE(PG8_SA(0, 1), cA + hstepA, voffA);
        if (wr == 1) PG8_BAR;
        PG8_WAIT_V(4); PG8_BAR;
        PG8_STAGE(PG8_SB(1, 0), cB + kstep, voffB); PG8_STAGE(PG8_SA(1, 0), cA + kstep, voffA); PG8_STAGE(PG8_SB(1, 1), cB + hstepB + kstep, voffB);
        PG8_WAIT_V(6); PG8_BAR;
    }
    for (;;) {
        const bool has_next = S.next(ui + 1, nxt);
        const char* nA = has_next ? (const char*)g.A + (size_t)nxt.pm * tstepA : cA; const char* nB = has_next ? (const char*)g.Bt + (size_t)nxt.pn * tstepB : cB;
#define PG8_ITER(FIRST) \
            const bool last = (t == nt - 2); \
            const char* a1 = cA + (size_t)(t + 1) * kstep; \
            const char* a2 = last ? nA : cA + (size_t)(t + 2) * kstep; const char* b2 = last ? nB : cB + (size_t)(t + 2) * kstep; \
            const char* a3 = a2 + kstep; const char* b3 = b2 + kstep; \
            if (last && has_next) S.a_ready(nxt); \
            if constexpr (SP2) { \
            PG8_LDB(B0, 0, 0); PG8_LDB(B1, 0, 1); PG8_SCHED; PG8_LDA(At, 0, 0); PG8_STAGE(PG8_SA(1, 1), a1 + hstepA, voffA); \
            PG8_WAIT_V(8); PG8_WAIT_L(0); PG8_BAR; PG8_MMA(0, 0, At, B0, FIRST); PG8_MMA(0, 1, At, B1, FIRST); PG8_BAR; PG8_SCHED; \
            PG8_LDA(At, 0, 1); PG8_STAGE(PG8_SB(0, 0), b2, voffB); PG8_STAGE(PG8_SB(0, 1), b2 + hstepB, voffB); PG8_STAGE(PG8_SA(0, 0), a2, voffA); \
            PG8_WAIT_V(8); PG8_WAIT_L(0); PG8_BAR; PG8_MMA(1, 0, At, B0, FIRST); PG8_MMA(1, 1, At, B1, FIRST); PG8_BAR; PG8_SCHED; \
            PG8_LDB(B0, 1, 0); PG8_LDB(B1, 1, 1); PG8_SCHED; PG8_LDA(At, 1, 0); PG8_STAGE(PG8_SA(0, 1), a2 + hstepA, voffA); \
            PG8_WAIT_V(8); PG8_WAIT_L(0); PG8_BAR; PG8_MMA(0, 0, At, B0, false); PG8_MMA(0, 1, At, B1, false); PG8_BAR; PG8_SCHED; \
            PG8_LDA(At, 1, 1); PG8_STAGE(PG8_SB(1, 0), b3, voffB); PG8_STAGE(PG8_SB(1, 1), b3 + hstepB, voffB); PG8_STAGE(PG8_SA(1, 0), a3, voffA); \
            PG8_WAIT_V(8); PG8_WAIT_L(0); PG8_BAR; PG8_MMA(1, 0, At, B0, false); PG8_MMA(1, 1, At, B1, false); PG8_BAR; PG8_SCHED; \
            } else { \
            PG8_LDB(B0, 0, 0); PG8_SCHED; PG8_LDA(At, 0, 0); PG8_STAGE(PG8_SA(1, 1), a1 + hstepA, voffA); \
            PG8_WAIT_L(8); PG8_BAR; PG8_WAIT_L(0); PG8_MMA(0, 0, At, B0, FIRST); PG8_BAR; PG8_SCHED; \
            PG8_LDB(B1, 0, 1); PG8_STAGE(PG8_SB(0, 0), b2, voffB); \
            PG8_BAR; PG8_WAIT_L(0); PG8_MMA(0, 1, At, B1, FIRST); PG8_BAR; \
            PG8_LDA(At, 0, 1); PG8_STAGE(PG8_SA(0, 0), a2, voffA); \
            PG8_BAR; PG8_WAIT_L(0); PG8_MMA(1, 0, At, B0, FIRST); PG8_BAR; PG8_SCHED; \
            PG8_STAGE(PG8_SB(0, 1), b2 + hstepB, voffB); \
            PG8_WAIT_V(6); PG8_BAR; PG8_MMA(1, 1, At, B1, FIRST); PG8_BAR; \
            PG8_LDB(B0, 1, 0); PG8_SCHED; PG8_LDA(At, 1, 0); PG8_STAGE(PG8_SA(0, 1), a2 + hstepA, voffA); \
            PG8_WAIT_L(8); PG8_BAR; PG8_WAIT_L(0); PG8_MMA(0, 0, At, B0, false); PG8_BAR; PG8_SCHED; \
            PG8_LDB(B1, 1, 1); PG8_STAGE(PG8_SB(1, 0), b3, voffB); \
            PG8_BAR; PG8_WAIT_L(0); PG8_MMA(0, 1, At, B1, false); PG8_BAR; \
            PG8_LDA(At, 1, 1); PG8_STAGE(PG8_SA(1, 0), a3, voffA); \
            PG8_BAR; PG8_WAIT_L(0); PG8_MMA(1, 0, At, B0, false); PG8_BAR; PG8_SCHED; \
            PG8_STAGE(PG8_SB(1, 1), b3 + hstepB, voffB); \
            PG8_WAIT_V(6); PG8_BAR; PG8_MMA(1, 1, At, B1, false); PG8_BAR; \
            }
        int t = 0;
        if constexpr (DT != 0) { PG8_ITER(true) t = 2; }
#pragma clang loop unroll(disable)
        for (; t < nt; t += 2) {
            PG8_ITER(false)
        }
#undef PG8_ITER
        if constexpr (DT != 0) asm volatile("s_nop 15\n\ts_nop 15" ::: "memory");
        if constexpr (ALIGN_EPI) { if (wr == 0) PG8_BAR; }
        if constexpr (Epi::PREFETCH) { E.run(acc, cur, wr, wc, fr, fq, (const PG8_LAS float*)(lds + EPI_SC_OFF + (ui & 1) * 2048)); S.done(cur);
            if (has_next) E.prefetch(nxt, lds + EPI_SC_OFF + ((ui + 1) & 1) * 2048, wid, lane); }
        else if constexpr (!Epi::AFTER_DRAIN) { E(acc, cur, wr, wc, fr, fq); S.done(cur); }
        if (!has_next) break;
        if constexpr (DT == 0) {
#pragma unroll
        for (int a = 0; a < 2; ++a)
#pragma unroll
            for (int b = 0; b < 2; ++b)
#pragma unroll
                for (int m = 0; m < 4; ++m)
#pragma unroll
                    for (int n = 0; n < 2; ++n) acc[a][b][m][n] = (f32x4){0.f, 0.f, 0.f, 0.f};
        }
        cur = nxt; cA = nA; cB = nB; ++ui;
        if constexpr (ALIGN_EPI) { if (wr == 1) PG8_BAR; }
    }
    PG8_WAIT_V(0);
    if constexpr (!ALIGN_EPI) { if (wr == 0) PG8_BAR; }
    PG8_BAR;
    if constexpr (Epi::AFTER_DRAIN) { E.fused(acc, cur, wr, wc, fr, fq, lds, wid, lane); S.done(cur); }
#undef PG8_SA
#undef PG8_SB
#undef PG8_STAGE
#undef PG8_LD16
#undef PG8_LDA
#undef PG8_LDB
#undef PG8_MMA
#undef PG8_WAIT_V
#undef PG8_WAIT_L
#undef PG8_BAR
#undef PG8_SCHED
}
}
constexpr int NWAVES = 8;
constexpr int NB = 32, SEQ = 2048, DM = 1024, NTOK = NB * SEQ;
constexpr int IN_E = 1952, IN_E_PAD = 2048, DFF = 2816, DFFX = 3584, NEXP = 8;
constexpr int MOE_CHUNK = 15360, N_CHUNK = (NTOK + MOE_CHUNK - 1) / MOE_CHUNK, CHUNK_SLOTS = 2 * MOE_CHUNK + NEXP * 256;
constexpr float NORM_EPS = 1e-6f, LOG2E = 1.4426950408889634f;

constexpr size_t MiB = 1u << 20;
constexpr size_t WS_CTL = 0, CTL_ZERO_BYTES = 1 * MiB;
constexpr size_t WS_ROPE = 1 * MiB;
constexpr size_t WS_ROUTE_I = 2 * MiB;
constexpr size_t WS_ROUTE_W = 3 * MiB;
constexpr size_t WS_WEV = 4 * MiB, EV_STRIDE = 24 * MiB;
constexpr size_t EV_WIN = 0, EV_WUQ = 4 * MiB, EV_WUKV = 4 * MiB + 512 * 1024, EV_WOUT = 5 * MiB, EV_WGU = 7 * MiB, EV_WD = 18 * MiB;
constexpr size_t WS_WOD = 52 * MiB, OD_STRIDE = 8 * MiB;
constexpr size_t OD_WQKV = 0, OD_WO = 6 * MiB;
constexpr size_t WS_MWGU = 68 * MiB;
constexpr size_t WS_MWD = 180 * MiB;
constexpr size_t WS_H = 236 * MiB;
constexpr size_t WS_BIG = 364 * MiB;
constexpr size_t WS_PROJ = WS_BIG, WS_QM = WS_BIG + 256 * MiB, WS_KVM = WS_BIG + 352 * MiB, WS_KPE = WS_BIG + 480 * MiB;
constexpr size_t WS_ACT = WS_BIG;
constexpr size_t WS_QKV = WS_BIG;
constexpr size_t WS_YALL = WS_BIG, WS_HG8 = WS_BIG + 32 * MiB, WS_MACT = WS_BIG + 320 * MiB;
constexpr size_t WS_DP1 = 848 * MiB, WS_DP2 = 912 * MiB, WS_DL1 = 976 * MiB, WS_DL2 = 978 * MiB;
constexpr size_t WS_SA = 980 * MiB;
constexpr size_t WS_SB = 981 * MiB;
constexpr size_t WS_END = 982 * MiB;
static_assert(WS_MACT + 2 * (size_t)CHUNK_SLOTS * DFFX <= WS_DP1 + 132 * MiB && WS_KPE + (size_t)NTOK * 64 <= WS_DP1 && WS_YALL + (size_t)N_CHUNK * CHUNK_SLOTS * DM * 2 <= WS_MACT && (size_t)CHUNK_SLOTS * DM == 32 * MiB, "ws map");
constexpr int CW_BAR = 4096;
constexpr int CW_WMAX = 12288;
constexpr int CW_CNT = 16384;

constexpr int RING_BYTES = 131072, LDSCTL_OFF = RING_BYTES, MISC_OFF = LDSCTL_OFF + 320, LDS_BYTES = 163840, RPB_OFF = 132096;

#define GAS __attribute__((address_space(1)))
#define LAS __attribute__((address_space(3)))
typedef unsigned short bf16;
typedef unsigned v4u __attribute__((ext_vector_type(4)));
typedef unsigned v2u __attribute__((ext_vector_type(2)));
typedef int v4i __attribute__((ext_vector_type(4)));
typedef float f32x4 __attribute__((ext_vector_type(4)));
typedef float f32x2 __attribute__((ext_vector_type(2)));
#define LDS_WAIT() asm volatile("s_waitcnt lgkmcnt(0)" ::: "memory")
#define VM_WAIT() asm volatile("s_waitcnt vmcnt(0)" ::: "memory")
__device__ __forceinline__ unsigned f2bf(float f) { unsigned u = __builtin_bit_cast(unsigned, f); return (u + 0x7fffu + ((u >> 16) & 1u)) >> 16; }
#if defined(__HIP_DEVICE_COMPILE__)
#define GLOBAL_AS __attribute__((address_space(1)))
#else
#define GLOBAL_AS
#endif
__device__ __forceinline__ unsigned pk2(float lo, float hi) { return f2bf(lo) | (f2bf(hi) << 16); }
__device__ __forceinline__ float bflo(unsigned w) { return __builtin_bit_cast(float, w << 16); }
__device__ __forceinline__ float bfhi(unsigned w) { return __builtin_bit_cast(float, w & 0xffff0000u); }
template <int CTRL> __device__ __forceinline__ float dppf(float v) { return __builtin_bit_cast(float, __builtin_amdgcn_mov_dpp(__builtin_bit_cast(int, v), CTRL, 0xF, 0xF, true)); }
__device__ __forceinline__ void swap16(unsigned& a, unsigned& b) { asm("s_nop 1\n\tv_permlane16_swap_b32 %0, %1\n\ts_nop 1" : "+v"(a), "+v"(b)); }
__device__ __forceinline__ void swap32(unsigned& a, unsigned& b) { asm("s_nop 1\n\tv_permlane32_swap_b32 %0, %1\n\ts_nop 1" : "+v"(a), "+v"(b)); }
__device__ __forceinline__ float wsum_all(float v) {
    v += dppf<0xB1>(v); v += dppf<0x4E>(v); v += dppf<0x141>(v); v += dppf<0x140>(v);
    unsigned a = __builtin_bit_cast(unsigned, v), b = a; swap16(a, b); v = __builtin_bit_cast(float, a) + __builtin_bit_cast(float, b);
    a = __builtin_bit_cast(unsigned, v); b = a; swap32(a, b); return __builtin_bit_cast(float, a) + __builtin_bit_cast(float, b);
}
__device__ __forceinline__ float wmax_all(float v) {
    v = fmaxf(v, dppf<0xB1>(v)); v = fmaxf(v, dppf<0x4E>(v)); v = fmaxf(v, dppf<0x141>(v)); v = fmaxf(v, dppf<0x140>(v));
    unsigned a = __builtin_bit_cast(unsigned, v), b = a; swap16(a, b); v = fmaxf(__builtin_bit_cast(float, a), __builtin_bit_cast(float, b));
    a = __builtin_bit_cast(unsigned, v); b = a; swap32(a, b); return fmaxf(__builtin_bit_cast(float, a), __builtin_bit_cast(float, b));
}
constexpr int LDX = 2048;
__device__ __forceinline__ f32x4 ldx4(const bf16* row, int idx) { const v2u w = ((const GLOBAL_AS v2u*)row)[idx]; return (f32x4){bflo(w.x), bfhi(w.x), bflo(w.y), bfhi(w.y)}; }
__device__ __forceinline__ void stx4(bf16* row, int idx, f32x4 v) { v2u w; w.x = pk2(v.x, v.y); w.y = pk2(v.z, v.w); ((GLOBAL_AS v2u*)row)[idx] = w; }
__device__ __forceinline__ float ex2(float x) { return __builtin_amdgcn_exp2f(x); }

#define XB_TMO      128
#define XB_XCNT(j)  (256  + 64 * (j))
#define XB_XSUB(j)  (1280 + 64 * (j))
#define XB_XGEN(j)  (2304 + 64 * (j))
#define XB_TOP      3328
#define XB_TOPGEN   3392
#define XCD_BAR_WORDS 3456
#define XB_SPIN_CAP (1u << 22)

__device__ __forceinline__ unsigned xb_ld(unsigned* p)              { return __hip_atomic_load(p, __ATOMIC_RELAXED, __HIP_MEMORY_SCOPE_AGENT); }
__device__ __forceinline__ unsigned xb_add(unsigned* p, unsigned v) { return __hip_atomic_fetch_add(p, v, __ATOMIC_RELAXED, __HIP_MEMORY_SCOPE_AGENT); }
__device__ __forceinline__ unsigned xb_xcc_id() { return (unsigned)__builtin_amdgcn_s_getreg((3 << 11) | 20) & 0xFu; }
#define XB_SPIN(cond, bar) do { unsigned _sp = 0; while (cond) { __builtin_amdgcn_s_sleep(1); \
    if ((++_sp & 255u) == 0u) { if (xb_ld(&(bar)[XB_TMO])) break; if (_sp > XB_SPIN_CAP) { atomicAdd(&(bar)[XB_TMO], 1u); break; } } } } while (0)

struct XcdBarrier {
    unsigned* bar; unsigned x;
    volatile LAS unsigned* st;
};

__device__ __forceinline__ XcdBarrier xcd_barrier_post(unsigned* bar, volatile LAS unsigned* st) {
    XcdBarrier b; b.bar = bar; b.x = xb_xcc_id(); b.st = st;
    if (threadIdx.x == 0) (void)xb_add(&bar[XB_XCNT(b.x)], 1u);
    return b;
}
__device__ __forceinline__ void xcd_barrier_complete(unsigned* bar, unsigned x, unsigned& nloc, unsigned& nx) {
    const unsigned G = gridDim.x * gridDim.y * gridDim.z;
    unsigned sum, cnt, mine, sp = 0u;
    for (;;) {
        sum = 0u; cnt = 0u; mine = 0u;
#pragma unroll
        for (unsigned j = 0; j < 16; ++j) { const unsigned c = xb_ld(&bar[XB_XCNT(j)]); sum += c; cnt += (c > 0u) ? 1u : 0u; mine = (j == x) ? c : mine; }
        if (sum == G) break;
        __builtin_amdgcn_s_sleep(1);
        if ((++sp & 255u) == 0u) { if (xb_ld(&bar[XB_TMO])) break; if (sp > XB_SPIN_CAP) { atomicAdd(&bar[XB_TMO], 1u); break; } }
    }
    nloc = mine > 0u ? mine : 1u; nx = cnt > 0u ? cnt : 1u;
}

__device__ __forceinline__ void xcd_barrier(const XcdBarrier& b, int tid) {
    asm volatile("s_waitcnt vmcnt(0)" ::: "memory");
    __syncthreads();
    if (tid == 0) {
        unsigned* bar = b.bar;
        __builtin_amdgcn_s_waitcnt(0);
        unsigned nloc = b.st[0], nx = b.st[1];
        if (nloc == 0u) { xcd_barrier_complete(bar, b.x, nloc, nx); b.st[0] = nloc; b.st[1] = nx; }
        const unsigned old = xb_add(&bar[XB_XSUB(b.x)], 1u);
        const unsigned gen = old / nloc;
        if (old + 1u == (gen + 1u) * nloc) {
            __builtin_amdgcn_fence(__ATOMIC_RELEASE, "agent");
            asm volatile("s_waitcnt vmcnt(0)" ::: "memory");
            const unsigned og = xb_add(&bar[XB_TOP], 1u);
            const unsigned tg = og / nx;
            if (og + 1u == (tg + 1u) * nx) xb_add(&bar[XB_TOPGEN], 1u);
            else XB_SPIN(xb_ld(&bar[XB_TOPGEN]) == tg, bar);
            __builtin_amdgcn_fence(__ATOMIC_ACQUIRE, "agent");
            xb_add(&bar[XB_XGEN(b.x)], 1u);
            asm volatile("s_waitcnt vmcnt(0)" ::: "memory");
        } else {
            XB_SPIN(xb_ld(&bar[XB_XGEN(b.x)]) == gen, bar);
            __builtin_amdgcn_fence(__ATOMIC_ACQUIRE, "agent");
            asm volatile("s_waitcnt vmcnt(0)" ::: "memory");
        }
    }
    __syncthreads();
}
__device__ __forceinline__ float wave_sum(float v, int lane) {
#pragma unroll
    for (int o = 1; o < 64; o <<= 1) v += __builtin_bit_cast(float, __builtin_amdgcn_ds_bpermute((lane ^ o) << 2, __builtin_bit_cast(int, v)));
    return v;
}
__device__ __forceinline__ void cvt_item(const float* W, int N, bf16* WT, int ldo, int dst_row0, int k0, int n0, LAS float* scr, int lane) {
    float wv[32];
#pragma unroll
    for (int i = 0; i < 32; ++i) wv[i] = W[(size_t)(k0 + 2 * i + (lane >> 5)) * N + n0 + (lane & 31)];
#pragma unroll
    for (int i = 0; i < 32; ++i) scr[(2 * i + (lane >> 5)) * 33 + (lane & 31)] = wv[i];
    LDS_WAIT(); asm volatile("" ::: "memory");
    const int c = lane & 7;
#pragma unroll
    for (int j = 0; j < 4; ++j) { const int n = (lane >> 3) + 8 * j; const LAS float* s = scr + (8 * c) * 33 + n;
        v4u o; o.x = pk2(s[0 * 33], s[1 * 33]); o.y = pk2(s[2 * 33], s[3 * 33]); o.z = pk2(s[4 * 33], s[5 * 33]); o.w = pk2(s[6 * 33], s[7 * 33]);
        *(GLOBAL_AS v4u*)(WT + (size_t)(dst_row0 + n) * ldo + k0 + 8 * c) = o; }
    LDS_WAIT(); asm volatile("" ::: "memory");
}
__device__ __forceinline__ void cvt_item8(const float* W, int N, unsigned char* WT, int ldo, int dst_row0, int k0, int n0, LAS float* scr, int lane, float scale) {
    float wv[32];
#pragma unroll
    for (int i = 0; i < 32; ++i) wv[i] = W[(size_t)(k0 + 2 * i + (lane >> 5)) * N + n0 + (lane & 31)];
#pragma unroll
    for (int i = 0; i < 32; ++i) scr[(2 * i + (lane >> 5)) * 33 + (lane & 31)] = wv[i] * scale;
    LDS_WAIT(); asm volatile("" ::: "memory");
    const int c = lane & 3;
#pragma unroll
    for (int j = 0; j < 2; ++j) { const int n = (lane >> 2) + 16 * j; const LAS float* s = scr + (16 * c) * 33 + n;
        v4u o; o.x = pg8::cvt4_fp8(s[0 * 33], s[1 * 33], s[2 * 33], s[3 * 33]); o.y = pg8::cvt4_fp8(s[4 * 33], s[5 * 33], s[6 * 33], s[7 * 33]);
        o.z = pg8::cvt4_fp8(s[8 * 33], s[9 * 33], s[10 * 33], s[11 * 33]); o.w = pg8::cvt4_fp8(s[12 * 33], s[13 * 33], s[14 * 33], s[15 * 33]);
        *(GLOBAL_AS v4u*)(WT + (size_t)(dst_row0 + n) * ldo + k0 + 16 * c) = o; }
    LDS_WAIT(); asm volatile("" ::: "memory");
}
__device__ __forceinline__ void cvt_job8(const float* W, int K, int N, unsigned char* WT, int ldo, int rowmap, int item, LAS float* scr, int lane, float scale) {
    const int nblk = N / 32, kb = item / nblk, nb = item % nblk, n0 = 32 * nb;
    int dr = n0; if (rowmap) dr = (n0 >> 7) * 256 + (n0 & 127) + (rowmap == 2 ? 128 : 0);
    cvt_item8(W, N, WT, ldo, dr, 64 * kb, n0, scr, lane, scale);
}
__device__ __forceinline__ unsigned pack4_i8(float a, float b, float c, float d) {
    const int qa = (int)__builtin_rintf(a), qb = (int)__builtin_rintf(b), qc = (int)__builtin_rintf(c), qd = (int)__builtin_rintf(d);
    return (unsigned)(qa & 255) | ((unsigned)(qb & 255) << 8) | ((unsigned)(qc & 255) << 16) | ((unsigned)(qd & 255) << 24);
}
__device__ __forceinline__ void cvt_item_i8(const float* W, int N, unsigned char* WT, int ldo, int dst_row0, int k0, int n0, LAS float* scr, int lane, float inv) {
    float wv[32];
#pragma unroll
    for (int i = 0; i < 32; ++i) wv[i] = W[(size_t)(k0 + 2 * i + (lane >> 5)) * N + n0 + (lane & 31)];
#pragma unroll
    for (int i = 0; i < 32; ++i) scr[(2 * i + (lane >> 5)) * 33 + (lane & 31)] = __builtin_amdgcn_fmed3f(wv[i] * inv, -127.0f, 127.0f);
    LDS_WAIT(); asm volatile("" ::: "memory");
    const int c = lane & 3;
#pragma unroll
    for (int j = 0; j < 2; ++j) { const int n = (lane >> 2) + 16 * j; const LAS float* s = scr + (16 * c) * 33 + n;
        v4u o; o.x = pack4_i8(s[0 * 33], s[1 * 33], s[2 * 33], s[3 * 33]); o.y = pack4_i8(s[4 * 33], s[5 * 33], s[6 * 33], s[7 * 33]);
        o.z = pack4_i8(s[8 * 33], s[9 * 33], s[10 * 33], s[11 * 33]); o.w = pack4_i8(s[12 * 33], s[13 * 33], s[14 * 33], s[15 * 33]);
        *(GLOBAL_AS v4u*)(WT + (size_t)(dst_row0 + n) * ldo + k0 + 16 * c) = o; }
    LDS_WAIT(); asm volatile("" ::: "memory");
}
__device__ __forceinline__ void cvt_job_i8(const float* W, int K, int N, unsigned char* WT, int ldo, int item, LAS float* scr, int lane, float inv, int rowmap = 0) {
    const int nblk = N / 32, kb = item / nblk, nb = item % nblk, n0 = 32 * nb;
    int dr = n0; if (rowmap) dr = (n0 >> 7) * 256 + (n0 & 127) + (rowmap == 2 ? 128 : 0);
    cvt_item_i8(W, N, WT, ldo, dr, 64 * kb, n0, scr, lane, inv);
}
__device__ __forceinline__ void cvt_job(const float* W, int K, int N, bf16* WT, int ldo, int rowmap, int item, LAS float* scr, int lane) {
    const int nblk = N / 32, kb = item / nblk, nb = item % nblk, n0 = 32 * nb;
    int dr = n0; if (rowmap) dr = (n0 >> 7) * 256 + (n0 & 127) + (rowmap == 2 ? 128 : 0);
    cvt_item(W, N, WT, ldo, dr, 64 * kb, n0, scr, lane);
}
__device__ const double ROPE_F[16] = {0.15915494309189535, 0.08949940160889101, 0.050329212104487035, 0.0283021958306234, 0.015915494309189534, 0.008949940160889102, 0.005032921210448704, 0.00283021958306234,
    0.0015915494309189536, 0.0008949940160889102, 0.0005032921210448703, 0.00028302195830623395, 0.00015915494309189535, 8.949940160889102e-05, 5.0329212104487035e-05, 2.8302195830623396e-05};

struct Ctx {
    float* out; unsigned char* ws; LAS unsigned char* lds; int tid, lane, wave, G, gw, NGW;
};

__device__ __forceinline__ void cvt_strip_i8(const float* W, int K, int N, unsigned char* WT, int ldo, float* sb, int rowmap, int strip, LAS float* scr, int lane) {
    const int n0 = 32 * strip; int dr = n0; if (rowmap) dr = (n0 >> 7) * 256 + (n0 & 127) + (rowmap == 2 ? 128 : 0);
    const float* col = W + n0 + (lane & 31) + (size_t)(lane >> 5) * N;
    float mx = 0.f;
    for (int k0 = 0; k0 < K; k0 += 64) { float wv[32];
#pragma unroll
        for (int i = 0; i < 32; ++i) wv[i] = col[(size_t)(k0 + 2 * i) * N];
#pragma unroll
        for (int i = 0; i < 32; ++i) mx = fmaxf(mx, fabsf(wv[i])); }
    mx = fmaxf(mx, __builtin_bit_cast(float, __builtin_amdgcn_ds_bpermute((lane ^ 32) << 2, __builtin_bit_cast(int, mx))));
    mx = fmaxf(mx, 1e-30f); const float inv = 127.0f / mx;
    if (lane < 32) sb[dr + lane] = mx * (1.0f / 127.0f);
    for (int k0 = 0; k0 < K; k0 += 64) { float wv[32];
#pragma unroll
        for (int i = 0; i < 32; ++i) wv[i] = col[(size_t)(k0 + 2 * i) * N];
#pragma unroll
        for (int i = 0; i < 32; ++i) scr[(2 * i + (lane >> 5)) * 33 + (lane & 31)] = wv[i] * inv;
        LDS_WAIT(); asm volatile("" ::: "memory");
        const int c = lane & 3;
#pragma unroll
        for (int j = 0; j < 2; ++j) { const int n = (lane >> 2) + 16 * j; const LAS float* s = scr + (16 * c) * 33 + n;
            v4u o; o.x = pack4_i8(s[0 * 33], s[1 * 33], s[2 * 33], s[3 * 33]); o.y = pack4_i8(s[4 * 33], s[5 * 33], s[6 * 33], s[7 * 33]);
            o.z = pack4_i8(s[8 * 33], s[9 * 33], s[10 * 33], s[11 * 33]); o.w = pack4_i8(s[12 * 33], s[13 * 33], s[14 * 33], s[15 * 33]);
            *(GLOBAL_AS v4u*)(WT + (size_t)(dr + n) * ldo + k0 + 16 * c) = o; }
        LDS_WAIT(); asm volatile("" ::: "memory"); }
}
__device__ __forceinline__ void cvt_strip_i8_wg(const float* W, int N, unsigned char* WT, int ldo, float* sb, int rowmap, int strip, LAS unsigned char* lds, int wave, int lane) {
    const int n0 = 32 * strip; int dr = n0; if (rowmap) dr = (n0 >> 7) * 256 + (n0 & 127) + (rowmap == 2 ? 128 : 0);
    const float* col = W + n0 + (lane & 31) + (size_t)(lane >> 5) * N;
    LAS float* scr = (LAS float*)(lds + wave * 16384); LAS float* pm = (LAS float*)(lds + 12288);
    float wv[2][32]; float mx = 0.f;
#pragma unroll
    for (int c = 0; c < 2; ++c)
#pragma unroll
        for (int i = 0; i < 32; ++i) wv[c][i] = col[(size_t)(64 * (2 * wave + c) + 2 * i) * N];
#pragma unroll
    for (int c = 0; c < 2; ++c)
#pragma unroll
        for (int i = 0; i < 32; ++i) mx = fmaxf(mx, fabsf(wv[c][i]));
    mx = fmaxf(mx, __builtin_bit_cast(float, __builtin_amdgcn_ds_bpermute((lane ^ 32) << 2, __builtin_bit_cast(int, mx))));
    if (lane < 32) pm[wave * 32 + lane] = mx;
    __syncthreads();
    float g = 0.f;
#pragma unroll
    for (int w = 0; w < 8; ++w) g = fmaxf(g, pm[w * 32 + (lane & 31)]);
    g = fmaxf(g, 1e-30f); const float inv = 127.0f / g;
    if (wave == 0 && lane < 32) sb[dr + lane] = g * (1.0f / 127.0f);
#pragma unroll
    for (int c = 0; c < 2; ++c) { const int k0 = 64 * (2 * wave + c);
#pragma unroll
        for (int i = 0; i < 32; ++i) scr[(2 * i + (lane >> 5)) * 33 + (lane & 31)] = wv[c][i] * inv;
        LDS_WAIT(); asm volatile("" ::: "memory");
        const int cc = lane & 3;
#pragma unroll
        for (int j = 0; j < 2; ++j) { const int n = (lane >> 2) + 16 * j; const LAS float* s = scr + (16 * cc) * 33 + n;
            v4u o; o.x = pack4_i8(s[0 * 33], s[1 * 33], s[2 * 33], s[3 * 33]); o.y = pack4_i8(s[4 * 33], s[5 * 33], s[6 * 33], s[7 * 33]);
            o.z = pack4_i8(s[8 * 33], s[9 * 33], s[10 * 33], s[11 * 33]); o.w = pack4_i8(s[12 * 33], s[13 * 33], s[14 * 33], s[15 * 33]);
            *(GLOBAL_AS v4u*)(WT + (size_t)(dr + n) * ldo + k0 + 16 * cc) = o; }
        LDS_WAIT(); asm volatile("" ::: "memory"); }
    __syncthreads();
}
template <class A> __device__ __forceinline__ void p0_prologue(const Ctx& C, const A& IN) {
    LAS float* scr = (LAS float*)(C.lds + C.wave * 16384);
    GLOBAL_AS float* sball = (GLOBAL_AS float*)(C.ws + WS_SB);
    constexpr int S0 = IN_E / 32, S4 = DFF / 32, S7 = 3072 / 32, NSTRIPS = 2 * (S0 + 2 * S4 + S7);
    constexpr int I1 = 4 * 24, I2 = 2 * 32, I3 = 16 * 32, I6 = 44 * 32, I8 = 16 * 32;
    constexpr int NITEMS = 2 * (I1 + I2 + I3 + I6 + I8);
    for (int st = blockIdx.x; st < NSTRIPS; st += C.G) {
        int r = st;
        if (r < 2 * S0) { const int ly = r / S0, q = r % S0; cvt_strip_i8_wg(IN.in[2] + (size_t)ly * DM * IN_E, IN_E, C.ws + WS_WEV + ly * EV_STRIDE + EV_WIN, DM, sball + ly * 8192, 0, q, C.lds, C.wave, C.lane); continue; } r -= 2 * S0;
        if (r < 2 * S4) { const int ly = r / S4, q = r % S4; cvt_strip_i8_wg(IN.in[9] + (size_t)ly * DM * DFF, DFF, C.ws + WS_WEV + ly * EV_STRIDE + EV_WGU, DM, sball + ly * 8192 + 2048, 1, q, C.lds, C.wave, C.lane); continue; } r -= 2 * S4;
        if (r < 2 * S4) { const int ly = r / S4, q = r % S4; cvt_strip_i8_wg(IN.in[10] + (size_t)ly * DM * DFF, DFF, C.ws + WS_WEV + ly * EV_STRIDE + EV_WGU, DM, sball + ly * 8192 + 2048, 2, q, C.lds, C.wave, C.lane); continue; } r -= 2 * S4;
        { const int ly = r / S7, q = r % S7; cvt_strip_i8_wg(IN.in[13] + (size_t)ly * DM * 3072, 3072, C.ws + WS_WOD + ly * OD_STRIDE + OD_WQKV, DM, sball + 16384 + ly * 4096, 0, q, C.lds, C.wave, C.lane); }
    }
    for (int it = C.gw; it < NITEMS; it += C.NGW) {
        int r = it;
        if (r < 2 * I1) { const int ly = r / I1, q = r % I1; cvt_job(IN.in[4] + (size_t)ly * 256 * 768, 256, 768, (bf16*)(C.ws + WS_WEV + ly * EV_STRIDE + EV_WUQ), 256, 0, q, scr, C.lane); continue; } r -= 2 * I1;
        if (r < 2 * I2) { const int ly = r / I2, q = r % I2; cvt_job(IN.in[6] + (size_t)ly * 128 * 1024, 128, 1024, (bf16*)(C.ws + WS_WEV + ly * EV_STRIDE + EV_WUKV), 256, 0, q, scr, C.lane); continue; } r -= 2 * I2;
        if (r < 2 * I3) { const int ly = r / I3, q = r % I3; cvt_job(IN.in[7] + (size_t)ly * DM * DM, DM, DM, (bf16*)(C.ws + WS_WEV + ly * EV_STRIDE + EV_WOUT), DM, 0, q, scr, C.lane); continue; } r -= 2 * I3;
        if (r < 2 * I6) { const int ly = r / I6, q = r % I6; cvt_job(IN.in[11] + (size_t)ly * DFF * DM, DFF, DM, (bf16*)(C.ws + WS_WEV + ly * EV_STRIDE + EV_WD), DFF, 0, q, scr, C.lane); continue; } r -= 2 * I6;
        { const int ly = r / I8, q = r % I8; cvt_job(IN.in[15] + (size_t)ly * DM * DM, DM, DM, (bf16*)(C.ws + WS_WOD + ly * OD_STRIDE + OD_WO), DM, 0, q, scr, C.lane); }
    }
    const int gt = blockIdx.x * (NWAVES * 64) + C.tid, NGT = C.G * NWAVES * 64;
    for (int i = gt; i < 2 * 6144; i += NGT) { const int ly = i / 6144, q = i % 6144; ((GLOBAL_AS v4u*)(C.ws + WS_WEV + ly * EV_STRIDE + EV_WIN + (size_t)IN_E * DM))[q] = (v4u){0u, 0u, 0u, 0u}; }
    for (int i = gt; i < 2 * 96; i += NGT) ((GLOBAL_AS float*)(C.ws + WS_SB))[(i / 96) * 8192 + IN_E + (i % 96)] = 0.f;
    for (int i = gt; i < 2 * 16384; i += NGT) { const int ly = i / 16384, q = i % 16384, row = q >> 4, cc = q & 15; ((GLOBAL_AS v4u*)(C.ws + WS_WEV + ly * EV_STRIDE + EV_WUKV + (size_t)row * 512 + 256))[cc] = (v4u){0u, 0u, 0u, 0u}; }
    GLOBAL_AS float* rope = (GLOBAL_AS float*)(C.ws + WS_ROPE);
    for (int i = gt; i < SEQ * 16; i += NGT) { const int t = i >> 4, k = i & 15; double fr = (double)t * ROPE_F[k]; fr -= floor(fr); const float f = (float)fr;
        rope[2 * i] = __builtin_amdgcn_cosf(f); rope[2 * i + 1] = __builtin_amdgcn_sinf(f); }
}
template <class A> __device__ __forceinline__ void moe_weights(const Ctx& C, const A& IN, int j) {
    LAS float* scr = (LAS float*)(C.lds + C.wave * 16384);
    constexpr int IG = 16 * 112, ID = 56 * 32;
    constexpr int NITEMS = NEXP * (2 * IG + ID);
    for (int it = C.gw; it < NITEMS; it += C.NGW) {
        const int e = it / (2 * IG + ID); int r = it % (2 * IG + ID);
        const size_t eo = ((size_t)j * NEXP + e) * (size_t)DM * DFFX;
        if (r < IG) { cvt_job8(IN.in[18] + eo, DM, DFFX, C.ws + WS_MWGU + (size_t)e * 7168 * DM, DM, 1, r, scr, C.lane, 32.0f); continue; } r -= IG;
        if (r < IG) { cvt_job8(IN.in[19] + eo, DM, DFFX, C.ws + WS_MWGU + (size_t)e * 7168 * DM, DM, 2, r, scr, C.lane, 32.0f); continue; } r -= IG;
        cvt_job8(IN.in[20] + eo, DFFX, DM, C.ws + WS_MWD + (size_t)e * DM * DFFX, DFFX, 0, r, scr, C.lane, 32.0f);
    }
}
template <int OUT = 0, bool XF32 = false>
__device__ __forceinline__ void norm_phase(const Ctx& C, const void* x, const float* g, bf16* H, bf16* xb = nullptr) {
    constexpr int NR = 4;
    f32x4 gg[4];
#pragma unroll
    for (int j = 0; j < 4; ++j) gg[j] = ((const GLOBAL_AS f32x4*)g)[64 * j + C.lane];
    for (int m0 = C.gw; m0 < NTOK; m0 += NR * C.NGW) {
        f32x4 v[NR][4]; float s[NR];
#pragma unroll
        for (int r = 0; r < NR; ++r) { const int m = min(m0 + r * C.NGW, NTOK - 1);
            if (XF32) { const GLOBAL_AS f32x4* xr = (const GLOBAL_AS f32x4*)((const GLOBAL_AS float*)x + (size_t)m * DM) + C.lane;
#pragma unroll
                for (int j = 0; j < 4; ++j) v[r][j] = xr[64 * j]; }
            else { const bf16* xr = (const bf16*)x + (size_t)m * LDX;
#pragma unroll
                for (int j = 0; j < 4; ++j) v[r][j] = ldx4(xr, 64 * j + C.lane); } }
#pragma unroll
        for (int r = 0; r < NR; ++r) { float a = 0.f;
#pragma unroll
            for (int j = 0; j < 4; ++j) a += (v[r][j].x * v[r][j].x + v[r][j].y * v[r][j].y) + (v[r][j].z * v[r][j].z + v[r][j].w * v[r][j].w);
            s[r] = a; }
#pragma unroll
        for (int r = 0; r < NR; ++r) s[r] = wsum_all(s[r]);
#pragma unroll
        for (int r = 0; r < NR; ++r) { const int m = m0 + r * C.NGW; if (m < NTOK) { const float rstd = 1.0f / sqrtf(s[r] * (1.0f / DM) + NORM_EPS);
            if (XF32) {
#pragma unroll
                for (int j = 0; j < 4; ++j) stx4(xb + (size_t)m * LDX, 64 * j + C.lane, v[r][j]); }
            if (OUT == 2) { f32x4 y[4]; float am = 0.f;
#pragma unroll
                for (int j = 0; j < 4; ++j) { y[j] = v[r][j] * rstd * gg[j]; am = fmaxf(fmaxf(am, fmaxf(fabsf(y[j].x), fabsf(y[j].y))), fmaxf(fabsf(y[j].z), fabsf(y[j].w))); }
                am = fmaxf(wmax_all(am), 1e-20f); const float inv = 127.0f / am; GLOBAL_AS unsigned* o4 = (GLOBAL_AS unsigned*)((unsigned char*)H + (size_t)m * DM) + C.lane;
#pragma unroll
                for (int j = 0; j < 4; ++j) o4[64 * j] = pack4_i8(y[j].x * inv, y[j].y * inv, y[j].z * inv, y[j].w * inv);
                if (C.lane == 0) ((GLOBAL_AS float*)(C.ws + WS_SA))[m] = am * (1.0f / 127.0f); }
            else if (OUT == 1) { GLOBAL_AS unsigned* o4 = (GLOBAL_AS unsigned*)((unsigned char*)H + (size_t)m * DM) + C.lane;
#pragma unroll
                for (int j = 0; j < 4; ++j) { const f32x4 y = v[r][j] * rstd * gg[j]; o4[64 * j] = pg8::cvt4_fp8(y.x, y.y, y.z, y.w); } }
            else { GLOBAL_AS unsigned long long* o8 = (GLOBAL_AS unsigned long long*)(H + (size_t)m * DM) + C.lane;
#pragma unroll
                for (int j = 0; j < 4; ++j) { const f32x4 y = v[r][j] * rstd * gg[j]; o8[64 * j] = (unsigned long long)pk2(y.x, y.y) | ((unsigned long long)pk2(y.z, y.w) << 32); } } } }
    }
}
__device__ __forceinline__ void norm_phase_b(const Ctx& C, const bf16* x, const float* g, bf16* H) {
    f32x4 gg[4];
#pragma unroll
    for (int j = 0; j < 4; ++j) gg[j] = ((const GLOBAL_AS f32x4*)g)[64 * j + C.lane];
    for (int m0 = C.gw; m0 < NTOK; m0 += 8 * C.NGW) {
        v2u w[8][4]; float s[8];
#pragma unroll
        for (int r = 0; r < 8; ++r) { const int m = min(m0 + r * C.NGW, NTOK - 1); const GLOBAL_AS v2u* xr = (const GLOBAL_AS v2u*)(x + (size_t)m * LDX) + C.lane;
#pragma unroll
            for (int j = 0; j < 4; ++j) w[r][j] = xr[64 * j]; }
#pragma unroll
        for (int r = 0; r < 8; ++r) { float a = 0.f;
#pragma unroll
            for (int j = 0; j < 4; ++j) { const float e0 = bflo(w[r][j].x), e1 = bfhi(w[r][j].x), e2 = bflo(w[r][j].y), e3 = bfhi(w[r][j].y); a += (e0 * e0 + e1 * e1) + (e2 * e2 + e3 * e3); }
            s[r] = a; }
#pragma unroll
        for (int r = 0; r < 8; ++r) s[r] = wsum_all(s[r]);
#pragma unroll
        for (int r = 0; r < 8; ++r) { const int m = m0 + r * C.NGW; if (m < NTOK) { const float rstd = 1.0f / sqrtf(s[r] * (1.0f / DM) + NORM_EPS);
            f32x4 y[4]; float am = 0.f;
#pragma unroll
            for (int j = 0; j < 4; ++j) { const f32x4 v = (f32x4){bflo(w[r][j].x), bfhi(w[r][j].x), bflo(w[r][j].y), bfhi(w[r][j].y)}; y[j] = v * rstd * gg[j];
                am = fmaxf(fmaxf(am, fmaxf(fabsf(y[j].x), fabsf(y[j].y))), fmaxf(fabsf(y[j].z), fabsf(y[j].w))); }
            am = fmaxf(wmax_all(am), 1e-20f); const float inv = 127.0f / am; GLOBAL_AS unsigned* o4 = (GLOBAL_AS unsigned*)((unsigned char*)H + (size_t)m * DM) + C.lane;
#pragma unroll
            for (int j = 0; j < 4; ++j) o4[64 * j] = pack4_i8(y[j].x * inv, y[j].y * inv, y[j].z * inv, y[j].w * inv);
            if (C.lane == 0) ((GLOBAL_AS float*)(C.ws + WS_SA))[m] = am * (1.0f / 127.0f); } }
    }
}
__device__ __forceinline__ void final_norm_phase(const Ctx& C, float* x, const float* g) {
    f32x4 gg[4];
#pragma unroll
    for (int j = 0; j < 4; ++j) gg[j] = ((const GLOBAL_AS f32x4*)g)[64 * j + C.lane];
    for (int m = C.gw; m < NTOK; m += C.NGW) {
        GLOBAL_AS f32x4* xr = (GLOBAL_AS f32x4*)(x + (size_t)m * DM) + C.lane; f32x4 v[4]; float s = 0.f;
#pragma unroll
        for (int j = 0; j < 4; ++j) { v[j] = xr[64 * j]; s += (v[j].x * v[j].x + v[j].y * v[j].y) + (v[j].z * v[j].z + v[j].w * v[j].w); }
        const float rstd = 1.0f / sqrtf(wave_sum(s, C.lane) * (1.0f / DM) + NORM_EPS);
#pragma unroll
        for (int j = 0; j < 4; ++j) xr[64 * j] = v[j] * rstd * gg[j];
    }
}
__device__ __forceinline__ void mla_prep_phase(const Ctx& C, bf16* PROJ, const float* qn, const float* kvn, bf16* KPE) {
    const GLOBAL_AS float* rope = (const GLOBAL_AS float*)(C.ws + WS_ROPE);
    const f32x4 gq = ((const GLOBAL_AS f32x4*)qn)[C.lane]; const f32x2 gk = ((const GLOBAL_AS f32x2*)kvn)[C.lane];
    for (int m0 = C.gw; m0 < NTOK; m0 += 8 * C.NGW) {
        v2u w[8]; unsigned w2[8]; unsigned r1[8], r2[8]; float sq[8], sk[8];
#pragma unroll
        for (int r = 0; r < 8; ++r) { const int m = min(m0 + r * C.NGW, NTOK - 1); const bf16* row = PROJ + (size_t)m * IN_E_PAD;
            w[r] = ((const GLOBAL_AS v2u*)(row + 1536))[C.lane]; w2[r] = ((const GLOBAL_AS unsigned*)(row + 1792))[C.lane]; r1[r] = row[1920 + (C.lane & 15)]; r2[r] = row[1936 + (C.lane & 15)]; }
#pragma unroll
        for (int r = 0; r < 8; ++r) { const float a0 = bflo(w[r].x), a1 = bfhi(w[r].x), a2 = bflo(w[r].y), a3 = bfhi(w[r].y), b0 = bflo(w2[r]), b1 = bfhi(w2[r]);
            sq[r] = wsum_all((a0 * a0 + a1 * a1) + (a2 * a2 + a3 * a3)); sk[r] = wsum_all(b0 * b0 + b1 * b1); }
#pragma unroll
        for (int r = 0; r < 8; ++r) { const int m = m0 + r * C.NGW; if (m < NTOK) { bf16* row = PROJ + (size_t)m * IN_E_PAD;
            const float rq = 1.0f / sqrtf(sq[r] * (1.0f / 256) + NORM_EPS), rk = 1.0f / sqrtf(sk[r] * (1.0f / 128) + NORM_EPS);
            v2u o; o.x = pk2(bflo(w[r].x) * rq * gq.x, bfhi(w[r].x) * rq * gq.y); o.y = pk2(bflo(w[r].y) * rq * gq.z, bfhi(w[r].y) * rq * gq.w); ((GLOBAL_AS v2u*)(row + 1536))[C.lane] = o;
            ((GLOBAL_AS unsigned*)(row + 1792))[C.lane] = pk2(bflo(w2[r]) * rk * gk.x, bfhi(w2[r]) * rk * gk.y);
            if (C.lane < 16) { const int t = m & (SEQ - 1); const float x1 = bflo(r1[r]), x2 = bflo(r2[r]);
                const float cs = rope[(t * 16 + C.lane) * 2], sn = rope[(t * 16 + C.lane) * 2 + 1];
                KPE[(size_t)m * 32 + C.lane] = (bf16)f2bf(x1 * cs - x2 * sn); KPE[(size_t)m * 32 + 16 + C.lane] = (bf16)f2bf(x1 * sn + x2 * cs); } } }
    }
}
#define LD8(dst, off, p) do { const v4u w_ = *(const GLOBAL_AS v4u*)(p); dst[(off) + 0] = bflo(w_.x); dst[(off) + 1] = bfhi(w_.x); dst[(off) + 2] = bflo(w_.y); dst[(off) + 3] = bfhi(w_.y); \
    dst[(off) + 4] = bflo(w_.z); dst[(off) + 5] = bfhi(w_.z); dst[(off) + 6] = bflo(w_.w); dst[(off) + 7] = bfhi(w_.w); } while (0)
__device__ __forceinline__ float dot8(const float* q, const v4u w) {
    return ((q[0] * bflo(w.x) + q[1] * bfhi(w.x)) + (q[2] * bflo(w.y) + q[3] * bfhi(w.y))) + ((q[4] * bflo(w.z) + q[5] * bfhi(w.z)) + (q[6] * bflo(w.w) + q[7] * bfhi(w.w)));
}
__device__ __forceinline__ void fma8(float* o, float p, const v4u w) {
    o[0] += p * bflo(w.x); o[1] += p * bfhi(w.x); o[2] += p * bflo(w.y); o[3] += p * bfhi(w.y); o[4] += p * bflo(w.z); o[5] += p * bfhi(w.z); o[6] += p * bflo(w.w); o[7] += p * bfhi(w.w);
}
__device__ __forceinline__ void store_o64(bf16* dst, const float* o, float inv) {
#pragma unroll
    for (int c = 0; c < 8; ++c) { v4u w; w.x = pk2(o[8 * c] * inv, o[8 * c + 1] * inv); w.y = pk2(o[8 * c + 2] * inv, o[8 * c + 3] * inv); w.z = pk2(o[8 * c + 4] * inv, o[8 * c + 5] * inv); w.w = pk2(o[8 * c + 6] * inv, o[8 * c + 7] * inv);
        ((GLOBAL_AS v4u*)dst)[c] = w; }
}
__device__ __forceinline__ void dil_naive_item(const bf16* PROJ, bf16* OC, int item, int tid) {
    const int b = item >> 5, h = (item >> 2) & 7, t = (item & 3) * 512 + tid;
    const bf16* base = PROJ + (size_t)b * SEQ * IN_E_PAD;
    float q[64], o[64];
#pragma unroll
    for (int c = 0; c < 8; ++c) LD8(q, 8 * c, base + (size_t)t * IN_E_PAD + h * 64 + 8 * c);
#pragma unroll
    for (int d = 0; d < 64; ++d) { q[d] *= 0.125f * LOG2E; o[d] = 0.f; }
    const float slope = ex2(-(float)(h + 1)) * LOG2E;
    float m = -INFINITY, l = 0.f;
    for (int g = 0; g < 3; ++g) { const int dl = 1 << (2 * g);
        for (int j = -64; j <= 64; ++j) { const int s = t + j * dl; if (s < 0 || s >= SEQ) continue;
            const bf16* kr = base + (size_t)s * IN_E_PAD + 512 + h * 64;
            float sc = 0.f;
#pragma unroll
            for (int c = 0; c < 8; ++c) sc += dot8(q + 8 * c, ((const GLOBAL_AS v4u*)kr)[c]);
            sc -= slope * (float)((j < 0 ? -j : j) * dl);
            const float mn = fmaxf(m, sc), al = ex2(m - mn), p = ex2(sc - mn); m = mn; l = l * al + p;
#pragma unroll
            for (int d = 0; d < 64; ++d) o[d] *= al;
#pragma unroll
            for (int c = 0; c < 8; ++c) fma8(o + 8 * c, p, ((const GLOBAL_AS v4u*)(kr + 512))[c]);
        } }
    store_o64(OC + ((size_t)b * SEQ + t) * DM + h * 64, o, 1.0f / l);
}
__device__ __forceinline__ void mla_naive_item(const bf16* QM, const bf16* KVM, const bf16* KPE, const float* rope, bf16* OC, int item, int tid) {
    const int b = item >> 6, h = (item >> 3) & 7, vh = (item >> 2) & 1, t = (item & 3) * 512 + tid;
    const size_t row = (size_t)b * SEQ + t;
    float q[96], o[32];
#pragma unroll
    for (int c = 0; c < 12; ++c) LD8(q, 8 * c, QM + row * 768 + h * 96 + 8 * c);
#pragma unroll
    for (int i = 0; i < 16; ++i) { const float cs = rope[(t * 16 + i) * 2], sn = rope[(t * 16 + i) * 2 + 1], x1 = q[64 + i], x2 = q[80 + i]; q[64 + i] = x1 * cs - x2 * sn; q[80 + i] = x1 * sn + x2 * cs; }
    const float scl = 0.10206207261596575f * LOG2E;
#pragma unroll
    for (int d = 0; d < 96; ++d) q[d] *= scl;
#pragma unroll
    for (int d = 0; d < 32; ++d) o[d] = 0.f;
    float m = -INFINITY, l = 0.f;
    const bf16* kvb = KVM + (size_t)b * SEQ * 1024 + h * 128; const bf16* kpb = KPE + (size_t)b * SEQ * 32;
    for (int s = 0; s < SEQ; s += 2) {
        float sc[2];
#pragma unroll
        for (int kk = 0; kk < 2; ++kk) { const GLOBAL_AS v4u* kr = (const GLOBAL_AS v4u*)(kvb + (size_t)(s + kk) * 1024); const GLOBAL_AS v4u* pr = (const GLOBAL_AS v4u*)(kpb + (size_t)(s + kk) * 32); float a = 0.f;
#pragma unroll
            for (int c = 0; c < 8; ++c) a += dot8(q + 8 * c, kr[c]);
#pragma unroll
            for (int c = 0; c < 4; ++c) a += dot8(q + 64 + 8 * c, pr[c]);
            sc[kk] = a; }
        const float mn = fmaxf(m, fmaxf(sc[0], sc[1])), al = ex2(m - mn); m = mn; l *= al;
#pragma unroll
        for (int d = 0; d < 32; ++d) o[d] *= al;
#pragma unroll
        for (int kk = 0; kk < 2; ++kk) { const float p = ex2(sc[kk] - mn); l += p; const GLOBAL_AS v4u* vr = (const GLOBAL_AS v4u*)(kvb + (size_t)(s + kk) * 1024 + 64 + vh * 32);
#pragma unroll
            for (int c = 0; c < 4; ++c) fma8(o + 8 * c, p, vr[c]); }
    }
    const float inv = 1.0f / l; bf16* dst = OC + row * DM + 512 + h * 64 + vh * 32;
#pragma unroll
    for (int c = 0; c < 4; ++c) { v4u w; w.x = pk2(o[8 * c] * inv, o[8 * c + 1] * inv); w.y = pk2(o[8 * c + 2] * inv, o[8 * c + 3] * inv); w.z = pk2(o[8 * c + 4] * inv, o[8 * c + 5] * inv); w.w = pk2(o[8 * c + 6] * inv, o[8 * c + 7] * inv);
        ((GLOBAL_AS v4u*)dst)[c] = w; }
}
__device__ __forceinline__ void na_naive_item(const bf16* QKV, const float* rpb, bf16* O, int item, int tid) {
    const int b = item >> 6, h = (item >> 2) & 15, t = (item & 3) * 512 + tid;
    const int i = t >> 6, c0 = t & 63; const int rs = min(max(i - 4, 0), 24), cs = min(max(c0 - 8, 0), 48);
    const bf16* base = QKV + (size_t)b * SEQ * 3072 + h * 64;
    float q[64], o[64];
#pragma unroll
    for (int c = 0; c < 8; ++c) LD8(q, 8 * c, base + (size_t)t * 3072 + 8 * c);
#pragma unroll
    for (int d = 0; d < 64; ++d) { q[d] *= 0.125f * LOG2E; o[d] = 0.f; }
    float m = -INFINITY, l = 0.f;
    for (int r = 0; r < 8; ++r)
        for (int k = 0; k < 16; ++k) { const int kt = (rs + r) * 64 + cs + k;
            const bf16* kr = base + (size_t)kt * 3072 + 1024;
            float sc = rpb[(h * 15 + (rs + r - i + 7)) * 31 + (cs + k - c0 + 15)] * LOG2E;
#pragma unroll
            for (int c = 0; c < 8; ++c) sc += dot8(q + 8 * c, ((const GLOBAL_AS v4u*)kr)[c]);
            const float mn = fmaxf(m, sc), al = ex2(m - mn), p = ex2(sc - mn); m = mn; l = l * al + p;
#pragma unroll
            for (int d = 0; d < 64; ++d) o[d] *= al;
#pragma unroll
            for (int c = 0; c < 8; ++c) fma8(o + 8 * c, p, ((const GLOBAL_AS v4u*)(kr + 1024))[c]);
        }
    store_o64(O + ((size_t)b * SEQ + t) * DM + h * 64, o, 1.0f / l);
}
__device__ __forceinline__ void route_phase(const Ctx& C, const bf16* x, const float* g, const float* wr, unsigned char* H8, unsigned* cnt  ) {
    LAS float* wl = (LAS float*)C.lds;
    for (int i = C.tid; i < 8192; i += NWAVES * 64) wl[(i & 7) * 1024 + (i >> 3)] = wr[i];
    __syncthreads();
    GLOBAL_AS v4i* route_i = (GLOBAL_AS v4i*)(C.ws + WS_ROUTE_I); GLOBAL_AS f32x2* route_w = (GLOBAL_AS f32x2*)(C.ws + WS_ROUTE_W);
    f32x4 gg[4];
#pragma unroll
    for (int j = 0; j < 4; ++j) gg[j] = ((const GLOBAL_AS f32x4*)g)[64 * j + C.lane];
    for (int base = C.gw * 32; base < NTOK; base += C.NGW * 32) {
        int my_e0 = 0, my_e1 = 0; float my_w0 = 0.f, my_w1 = 0.f;
        for (int i = 0; i < 32; i += 4) {
            v2u xw[4][4]; float s[4]; float lg[4][8]; f32x4 y[4][4];
#pragma unroll
            for (int r = 0; r < 4; ++r) { const GLOBAL_AS v2u* xr = (const GLOBAL_AS v2u*)(x + (size_t)(base + i + r) * LDX) + C.lane;
#pragma unroll
                for (int j = 0; j < 4; ++j) xw[r][j] = xr[64 * j]; }
#pragma unroll
            for (int r = 0; r < 4; ++r) { float a = 0.f;
#pragma unroll
                for (int j = 0; j < 4; ++j) { const v2u c = xw[r][j]; y[r][j] = (f32x4){bflo(c.x), bfhi(c.x), bflo(c.y), bfhi(c.y)}; a += (y[r][j].x * y[r][j].x + y[r][j].y * y[r][j].y) + (y[r][j].z * y[r][j].z + y[r][j].w * y[r][j].w); }
                s[r] = a; }
#pragma unroll
            for (int r = 0; r < 4; ++r) s[r] = wsum_all(s[r]);
#pragma unroll
            for (int r = 0; r < 4; ++r) { const float rstd = 1.0f / sqrtf(s[r] * (1.0f / DM) + NORM_EPS);
                GLOBAL_AS unsigned* o4 = (GLOBAL_AS unsigned*)(H8 + (size_t)(base + i + r) * DM) + C.lane;
#pragma unroll
                for (int e = 0; e < 8; ++e) lg[r][e] = 0.f;
#pragma unroll
                for (int j = 0; j < 4; ++j) { y[r][j] = y[r][j] * rstd * gg[j]; o4[64 * j] = pg8::cvt4_fp8(y[r][j].x, y[r][j].y, y[r][j].z, y[r][j].w); } }
#pragma unroll
            for (int j = 0; j < 4; ++j)
#pragma unroll
                for (int e = 0; e < 8; ++e) { const f32x4 w = *(const LAS f32x4*)(wl + e * 1024 + 4 * (64 * j + C.lane));
#pragma unroll
                    for (int r = 0; r < 4; ++r) lg[r][e] += (y[r][j].x * w.x + y[r][j].y * w.y) + (y[r][j].z * w.z + y[r][j].w * w.w); }
#pragma unroll
            for (int r = 0; r < 4; ++r)
#pragma unroll
                for (int e = 0; e < 8; ++e) lg[r][e] = wsum_all(lg[r][e]);
#pragma unroll
            for (int r = 0; r < 4; ++r) {
                int e0 = 0; float v0 = lg[r][0];
#pragma unroll
                for (int e = 1; e < 8; ++e) if (lg[r][e] > v0) { v0 = lg[r][e]; e0 = e; }
                int e1 = -1; float v1 = -INFINITY;
#pragma unroll
                for (int e = 0; e < 8; ++e) if (e != e0 && (e1 < 0 || lg[r][e] > v1)) { v1 = lg[r][e]; e1 = e; }
                const float ex = __expf(v1 - v0), w0 = 1.0f / (1.0f + ex), w1 = ex * w0;
                if (C.lane == i + r) { my_e0 = e0; my_e1 = e1; my_w0 = w0; my_w1 = w1; } }
        }
        const int chunk = base / MOE_CHUNK; const bool act = C.lane < 32; int pos0 = 0, pos1 = 0;
        const unsigned long long lt = (1ull << C.lane) - 1ull;
#pragma unroll
        for (int e = 0; e < 8; ++e) {
            const unsigned long long m0 = __ballot(act && my_e0 == e), m1 = __ballot(act && my_e1 == e);
            const int n0 = __popcll(m0), n1 = __popcll(m1);
            unsigned bs = 0; if (C.lane == 0 && (n0 + n1) > 0) bs = atomicAdd(cnt + (chunk * 8 + e) * 64, (unsigned)(n0 + n1));
            bs = (unsigned)__builtin_amdgcn_readfirstlane((int)bs);
            if (act && my_e0 == e) pos0 = (int)bs + __popcll(m0 & lt);
            if (act && my_e1 == e) pos1 = (int)bs + n0 + __popcll(m1 & lt);
        }
        if (act) { route_i[base + C.lane] = (v4i){my_e0, my_e1, pos0, pos1}; route_w[base + C.lane] = (f32x2){my_w0, my_w1}; }
    }
}
__device__ __forceinline__ int seg_base(const unsigned* cnt, int chunk, int e) {
    int acc = 0;
#pragma unroll
    for (int k = 0; k < 8; ++k) { const int n = (int)__hip_atomic_load(cnt + (chunk * 8 + k) * 64, __ATOMIC_RELAXED, __HIP_MEMORY_SCOPE_AGENT); if (k < e) acc += (n + 255) >> 8; }
    return acc * 256;
}
__device__ __forceinline__ void gather_all_phase(const Ctx& C, const unsigned char* H8, unsigned char* HG8, const unsigned* cnt) {
    GLOBAL_AS v4i* route_i = (GLOBAL_AS v4i*)(C.ws + WS_ROUTE_I);
    LAS int* segt = (LAS int*)C.lds;
    if (C.tid < N_CHUNK * 8) segt[C.tid] = seg_base(cnt, C.tid >> 3, C.tid & 7);
    __syncthreads();
    for (int m0 = C.gw; m0 < NTOK; m0 += 8 * C.NGW) {
        v4i ri[8]; v4u a[8];
#pragma unroll
        for (int r = 0; r < 8; ++r) { const int m = min(m0 + r * C.NGW, NTOK - 1); ri[r] = route_i[m]; a[r] = ((const GLOBAL_AS v4u*)(H8 + (size_t)m * DM))[C.lane]; }
#pragma unroll
        for (int r = 0; r < 8; ++r) { const int m = m0 + r * C.NGW; if (m < NTOK) { const int ch = m / MOE_CHUNK;
            const int s0 = segt[ch * 8 + ri[r].x] + ri[r].z, s1 = segt[ch * 8 + ri[r].y] + ri[r].w;
            unsigned char* base = HG8 + (size_t)ch * 2 * CHUNK_SLOTS * DM;
            ((GLOBAL_AS v4u*)(base + (size_t)s0 * DM))[C.lane] = a[r]; ((GLOBAL_AS v4u*)(base + (size_t)s1 * DM))[C.lane] = a[r];
            if (C.lane == 0) { v4i o = ri[r]; o.z = s0; o.w = s1; route_i[m] = o; } } }
    }
}
template <bool LAST>
__device__ __forceinline__ void combine_all_phase(const Ctx& C, bf16* x, float* out, const bf16* Y, const float* g, bf16* Hn) {
    const GLOBAL_AS v4i* route_i = (const GLOBAL_AS v4i*)(C.ws + WS_ROUTE_I); const GLOBAL_AS f32x2* route_w = (const GLOBAL_AS f32x2*)(C.ws + WS_ROUTE_W);
    f32x4 gg[4];
#pragma unroll
    for (int j = 0; j < 4; ++j) gg[j] = ((const GLOBAL_AS f32x4*)g)[64 * j + C.lane];
    for (int m0 = C.gw; m0 < NTOK; m0 += 4 * C.NGW) {
        v4i ri[4]; f32x2 rw[4]; v2u ya[4][4], yb[4][4], xw[4][4]; float s[4];
#pragma unroll
        for (int r = 0; r < 4; ++r) { const int m = min(m0 + r * C.NGW, NTOK - 1); ri[r] = route_i[m]; rw[r] = route_w[m];
            const GLOBAL_AS v2u* xr = (const GLOBAL_AS v2u*)(x + (size_t)m * LDX) + C.lane;
#pragma unroll
            for (int j = 0; j < 4; ++j) xw[r][j] = xr[64 * j]; }
#pragma unroll
        for (int r = 0; r < 4; ++r) { const int m = min(m0 + r * C.NGW, NTOK - 1); const bf16* base = Y + (size_t)(m / MOE_CHUNK) * CHUNK_SLOTS * DM;
            const GLOBAL_AS v2u* y0 = (const GLOBAL_AS v2u*)(base + (size_t)ri[r].z * DM) + C.lane; const GLOBAL_AS v2u* y1 = (const GLOBAL_AS v2u*)(base + (size_t)ri[r].w * DM) + C.lane;
#pragma unroll
            for (int j = 0; j < 4; ++j) { ya[r][j] = y0[64 * j]; yb[r][j] = y1[64 * j]; } }
#pragma unroll
        for (int r = 0; r < 4; ++r) { const int m = m0 + r * C.NGW; f32x4 v[4]; float acc = 0.f;
#pragma unroll
            for (int j = 0; j < 4; ++j) { const v2u a = ya[r][j], b = yb[r][j], c = xw[r][j]; f32x4 t = (f32x4){bflo(c.x), bfhi(c.x), bflo(c.y), bfhi(c.y)};
                t.x += rw[r].x * bflo(a.x) + rw[r].y * bflo(b.x); t.y += rw[r].x * bfhi(a.x) + rw[r].y * bfhi(b.x); t.z += rw[r].x * bflo(a.y) + rw[r].y * bflo(b.y); t.w += rw[r].x * bfhi(a.y) + rw[r].y * bfhi(b.y);
                v[j] = t; acc += (t.x * t.x + t.y * t.y) + (t.z * t.z + t.w * t.w); }
            const float rstd = 1.0f / sqrtf(wsum_all(acc) * (1.0f / DM) + NORM_EPS);
            if (m < NTOK) {
                if (LAST) { GLOBAL_AS f32x4* xr = (GLOBAL_AS f32x4*)(out + (size_t)m * DM) + C.lane;
#pragma unroll
                    for (int j = 0; j < 4; ++j) xr[64 * j] = v[j] * rstd * gg[j];
                } else { f32x4 y[4]; float am = 0.f;
#pragma unroll
                    for (int j = 0; j < 4; ++j) { stx4(x + (size_t)m * LDX, 64 * j + C.lane, v[j]); y[j] = v[j] * rstd * gg[j]; am = fmaxf(fmaxf(am, fmaxf(fabsf(y[j].x), fabsf(y[j].y))), fmaxf(fabsf(y[j].z), fabsf(y[j].w))); }
                    am = fmaxf(wmax_all(am), 1e-20f); const float inv = 127.0f / am; GLOBAL_AS unsigned* o4 = (GLOBAL_AS unsigned*)((unsigned char*)Hn + (size_t)m * DM) + C.lane;
#pragma unroll
                    for (int j = 0; j < 4; ++j) o4[64 * j] = pack4_i8(y[j].x * inv, y[j].y * inv, y[j].z * inv, y[j].w * inv);
                    if (C.lane == 0) ((GLOBAL_AS float*)(C.ws + WS_SA))[m] = am * (1.0f / 127.0f);
                } } }
    }
}
__device__ __forceinline__ void grouped_order(pg8::GroupedOrder& S, const unsigned* cnt, int chunk, int nN, int G, int c) {
    int te[8]; int acc = 0;
#pragma unroll
    for (int k = 0; k < 8; ++k) { const int n = __builtin_amdgcn_readfirstlane((int)__hip_atomic_load(cnt + (chunk * 8 + k) * 64, __ATOMIC_RELAXED, __HIP_MEMORY_SCOPE_AGENT)); acc += (n + 255) >> 8; te[k] = acc; }
    S.t0 = te[0]; S.t1 = te[1]; S.t2 = te[2]; S.t3 = te[3]; S.t4 = te[4]; S.t5 = te[5]; S.t6 = te[6]; S.RT = te[7]; S.nN = nN; S.G = G; S.c = c;
}
namespace att {
typedef short bf16x8 __attribute__((ext_vector_type(8)));
typedef short s16x4 __attribute__((ext_vector_type(4)));
typedef short v4i16_t __attribute__((ext_vector_type(4)));
typedef float f32x16 __attribute__((ext_vector_type(16)));
typedef float f32x2_t __attribute__((ext_vector_type(2)));
typedef __bf16 bf16x2_t __attribute__((ext_vector_type(2)));
typedef unsigned u32x4 __attribute__((ext_vector_type(4)));
__device__ __forceinline__ unsigned cvtpk(float lo, float hi) { f32x2_t v = {lo, hi}; bf16x2_t b = __builtin_convertvector(v, bf16x2_t); return __builtin_bit_cast(unsigned, b); }
__device__ __forceinline__ s16x4 vtr(const LAS unsigned char* p) { return __builtin_bit_cast(s16x4, __builtin_amdgcn_ds_read_tr16_b64_v4i16((LAS v4i16_t*)p)); }
#define VTR_ISSUE(dst, addr, OFF) asm volatile("ds_read_b64_tr_b16 %0, %1 offset:%2" : "=&v"(dst) : "v"(addr), "i"(OFF))
__device__ __forceinline__ void vtr_wait8(s16x4& a, s16x4& b, s16x4& c, s16x4& d, s16x4& e, s16x4& f, s16x4& g, s16x4& h) {
    asm volatile("s_waitcnt lgkmcnt(0)" : "+v"(a), "+v"(b), "+v"(c), "+v"(d), "+v"(e), "+v"(f), "+v"(g), "+v"(h)); }
#define VTR_PACK(lo, hi) ((bf16x8){lo[0], lo[1], lo[2], lo[3], hi[0], hi[1], hi[2], hi[3]})
__device__ __forceinline__ void xhalf_swap(unsigned& a, unsigned& b) { asm volatile("s_nop 1\n\tv_permlane32_swap_b32 %0, %1\n\ts_nop 1" : "+v"(a), "+v"(b)); }
__device__ __forceinline__ float xhalf_max(float v) { unsigned a = __builtin_bit_cast(unsigned, v), b = a; xhalf_swap(a, b); return fmaxf(__builtin_bit_cast(float, a), __builtin_bit_cast(float, b)); }
__device__ __forceinline__ float xhalf_sum(float v) { unsigned a = __builtin_bit_cast(unsigned, v), b = a; xhalf_swap(a, b); return __builtin_bit_cast(float, a) + __builtin_bit_cast(float, b); }
#define ATT_MFMA(a, b, c) __builtin_amdgcn_mfma_f32_32x32x16_bf16((a), (b), (c), 0, 0, 0)
__device__ __forceinline__ void sm_step(const f32x16& s, float c, float& m, float& l, f32x16& o0, f32x16& o1, bf16x8& p0, bf16x8& p1) {
    float mx = fmaxf(fmaxf(fmaxf(s[0], s[1]), fmaxf(s[2], s[3])), fmaxf(fmaxf(s[4], s[5]), fmaxf(s[6], s[7])));
    mx = fmaxf(mx, fmaxf(fmaxf(fmaxf(s[8], s[9]), fmaxf(s[10], s[11])), fmaxf(fmaxf(s[12], s[13]), fmaxf(s[14], s[15]))));
    mx = xhalf_max(mx);
    const float mc = mx * c;
    if (__builtin_amdgcn_ballot_w64(mc > m + 8.0f) != 0) {
        const float mn = fmaxf(m, mc), al = ex2(m - mn); m = mn; l *= al;
#pragma unroll
        for (int i = 0; i < 16; ++i) { o0[i] *= al; o1[i] *= al; }
    }
    float pe[16]; float ls = 0.f;
#pragma unroll
    for (int i = 0; i < 16; ++i) { pe[i] = ex2(__builtin_fmaf(s[i], c, -m)); ls += pe[i]; }
    l += ls;
    u32x4 a, b; a.x = cvtpk(pe[0], pe[1]); a.y = cvtpk(pe[2], pe[3]); a.z = cvtpk(pe[4], pe[5]); a.w = cvtpk(pe[6], pe[7]);
    b.x = cvtpk(pe[8], pe[9]); b.y = cvtpk(pe[10], pe[11]); b.z = cvtpk(pe[12], pe[13]); b.w = cvtpk(pe[14], pe[15]);
    p0 = __builtin_bit_cast(bf16x8, a); p1 = __builtin_bit_cast(bf16x8, b);
}
constexpr int MLA_KB = 12 * 64 * 16, MLA_BUF = MLA_KB + 64 * 128;
__device__ __forceinline__ void mla_unit(const bf16* QM, const bf16* KVM, const bf16* KPE, const float* rope, bf16* OC, int unit, LAS unsigned char* lds, int tid) {
    const int lane = tid & 63, wave = __builtin_amdgcn_readfirstlane(tid >> 6), r32 = lane & 31, hh = lane >> 5;
    const int b = unit >> 5, h = (unit >> 2) & 7, qt = unit & 3, q0 = qt * 512 + wave * 64;
    const float c = 0.10206207261596575f * LOG2E;
    bf16x8 qf[2][6];
#pragma unroll
    for (int qb = 0; qb < 2; ++qb) { const int t = q0 + qb * 32 + r32; const bf16* src = QM + ((size_t)b * SEQ + t) * 768 + h * 96 + hh * 8;
#pragma unroll
        for (int ks = 0; ks < 6; ++ks) qf[qb][ks] = *(const bf16x8*)(src + 16 * ks);
        const f32x4* rp = (const f32x4*)(rope + (t * 16 + 8 * hh) * 2);
        bf16x8 a4 = qf[qb][4], a5 = qf[qb][5];
#pragma unroll
        for (int jj = 0; jj < 4; ++jj) { const f32x4 cs = rp[jj];
            const float x1a = bflo((unsigned)(unsigned short)a4[2 * jj]), x2a = bflo((unsigned)(unsigned short)a5[2 * jj]), x1b = bflo((unsigned)(unsigned short)a4[2 * jj + 1]), x2b = bflo((unsigned)(unsigned short)a5[2 * jj + 1]);
            a4[2 * jj] = (short)f2bf(x1a * cs.x - x2a * cs.y); a5[2 * jj] = (short)f2bf(x1a * cs.y + x2a * cs.x);
            a4[2 * jj + 1] = (short)f2bf(x1b * cs.z - x2b * cs.w); a5[2 * jj + 1] = (short)f2bf(x1b * cs.w + x2b * cs.z); }
        qf[qb][4] = a4; qf[qb][5] = a5; }
    f32x16 o[2][2];
#pragma unroll
    for (int i = 0; i < 16; ++i) { o[0][0][i] = 0.f; o[0][1][i] = 0.f; o[1][0][i] = 0.f; o[1][1][i] = 0.f; }
    float m0 = -INFINITY, m1 = -INFINITY, l0 = 0.f, l1 = 0.f;
    const bf16* kvb = KVM + (size_t)b * SEQ * 1024 + h * 128;
    const bf16* gk0 = kvb + (size_t)lane * 1024 + wave * 8;
    const bf16* gk1 = KPE + ((size_t)b * SEQ + lane) * 32 + (wave & 3) * 8;
    const int vkey = wave * 8 + (lane >> 3), vcc = (lane & 7) ^ (((vkey >> 1) & 1) << 2);
    const bf16* gv = kvb + (size_t)vkey * 1024 + 64 + vcc * 8;
    const bool two = wave < 4;
    const int lk0 = wave * 1024, lk1 = (8 + wave) * 1024, lv = MLA_KB + wave * 1024;
#define MLA_STAGE(bufp, jt) do { const size_t go_ = (size_t)(jt) * 64; \
        __builtin_amdgcn_global_load_lds((const unsigned*)(gk0 + go_ * 1024), (LAS unsigned*)((bufp) + lk0), 16, 0, 0); \
        if (two) __builtin_amdgcn_global_load_lds((const unsigned*)(gk1 + go_ * 32), (LAS unsigned*)((bufp) + lk1), 16, 0, 0); \
        __builtin_amdgcn_global_load_lds((const unsigned*)(gv + go_ * 1024), (LAS unsigned*)((bufp) + lv), 16, 0, 0); } while (0)
    const int ka = (hh * 64 + r32) * 16;
    const int i16 = lane & 15, q4 = i16 >> 2, p4 = i16 & 3, cb = (lane >> 4) & 1;
    const int vrow = (4 * hh + q4) * 128 + (p4 & 1) * 8;
    const int va0 = MLA_KB + vrow + (((0 ^ (q4 >> 1)) * 4 + cb * 2 + (p4 >> 1)) * 16), va1 = MLA_KB + vrow + (((1 ^ (q4 >> 1)) * 4 + cb * 2 + (p4 >> 1)) * 16);
    MLA_STAGE(lds, 0);
    asm volatile("s_waitcnt vmcnt(0)" ::: "memory");
    __syncthreads();
    for (int j = 0; j < SEQ / 64; ++j) {
        const LAS unsigned char* buf = lds + (j & 1) * MLA_BUF; LAS unsigned char* nbuf = lds + ((j + 1) & 1) * MLA_BUF;
        if ((j + 1) < SEQ / 64) MLA_STAGE(nbuf, j + 1);
#pragma unroll
        for (int kb = 0; kb < 2; ++kb) {
            bf16x8 p00, p01, p10, p11;
            { f32x16 s0, s1; bf16x8 kf[6];
#pragma unroll
              for (int ks = 0; ks < 6; ++ks) kf[ks] = *(const LAS bf16x8*)(buf + ka + ks * 2048 + kb * 512);
#pragma unroll
              for (int i = 0; i < 16; ++i) { s0[i] = 0.f; s1[i] = 0.f; }
#pragma unroll
              for (int ks = 0; ks < 6; ++ks) { s0 = ATT_MFMA(kf[ks], qf[0][ks], s0); s1 = ATT_MFMA(kf[ks], qf[1][ks], s1); }
              sm_step(s0, c, m0, l0, o[0][0], o[0][1], p00, p01);
              sm_step(s1, c, m1, l1, o[1][0], o[1][1], p10, p11); }
            { const unsigned a0 = (unsigned)(size_t)(buf + va0), a1 = (unsigned)(size_t)(buf + va1);
              s16x4 l00, h00, l01, h01, l10, h10, l11, h11;
              if (kb == 0) { VTR_ISSUE(l00, a0, 0); VTR_ISSUE(h00, a0, 1024); VTR_ISSUE(l01, a0, 2048); VTR_ISSUE(h01, a0, 3072); VTR_ISSUE(l10, a1, 0); VTR_ISSUE(h10, a1, 1024); VTR_ISSUE(l11, a1, 2048); VTR_ISSUE(h11, a1, 3072); }
              else         { VTR_ISSUE(l00, a0, 4096); VTR_ISSUE(h00, a0, 5120); VTR_ISSUE(l01, a0, 6144); VTR_ISSUE(h01, a0, 7168); VTR_ISSUE(l10, a1, 4096); VTR_ISSUE(h10, a1, 5120); VTR_ISSUE(l11, a1, 6144); VTR_ISSUE(h11, a1, 7168); }
              vtr_wait8(l00, h00, l01, h01, l10, h10, l11, h11);
              const bf16x8 v00 = VTR_PACK(l00, h00), v01 = VTR_PACK(l01, h01), v10 = VTR_PACK(l10, h10), v11 = VTR_PACK(l11, h11);
              o[0][0] = ATT_MFMA(v00, p00, o[0][0]); o[1][0] = ATT_MFMA(v00, p10, o[1][0]); o[0][1] = ATT_MFMA(v10, p00, o[0][1]); o[1][1] = ATT_MFMA(v10, p10, o[1][1]);
              o[0][0] = ATT_MFMA(v01, p01, o[0][0]); o[1][0] = ATT_MFMA(v01, p11, o[1][0]); o[0][1] = ATT_MFMA(v11, p01, o[0][1]); o[1][1] = ATT_MFMA(v11, p11, o[1][1]); }
        }
        asm volatile("s_waitcnt vmcnt(0)" ::: "memory");
        __syncthreads();
    }
#undef MLA_STAGE
    const float i0 = 1.0f / xhalf_sum(l0), i1 = 1.0f / xhalf_sum(l1);
#pragma unroll
    for (int qb = 0; qb < 2; ++qb) { const float inv = qb == 0 ? i0 : i1; bf16* dst = OC + ((size_t)b * SEQ + q0 + qb * 32 + r32) * DM + 512 + h * 64 + 4 * hh;
#pragma unroll
        for (int db = 0; db < 2; ++db)
#pragma unroll
            for (int g = 0; g < 4; ++g) { v2u w; w.x = cvtpk(o[qb][db][4 * g] * inv, o[qb][db][4 * g + 1] * inv); w.y = cvtpk(o[qb][db][4 * g + 2] * inv, o[qb][db][4 * g + 3] * inv);
                *(v2u*)(dst + db * 32 + 8 * g) = w; } }
}
__device__ __forceinline__ void stage32(LAS unsigned char* buf, const bf16* kp, const bf16* vp, size_t rs, int lane) {
    const bf16* v0 = vp + (size_t)(lane >> 3) * rs + ((lane & 7) ^ (((lane >> 4) & 1) << 2)) * 8;
#pragma unroll
    for (int i = 0; i < 4; ++i) { const int key = 8 * i + (lane >> 3); __builtin_amdgcn_global_load_lds((const unsigned*)(kp + (size_t)key * rs + ((lane & 7) ^ ((key >> 1) & 7)) * 8), (LAS unsigned*)(buf + i * 1024), 16, 0, 0); }
#pragma unroll
    for (int i = 0; i < 4; ++i) __builtin_amdgcn_global_load_lds((const unsigned*)(v0 + (size_t)(8 * i) * rs), (LAS unsigned*)(buf + 4096 + i * 1024), 16, 0, 0);
}
__device__ __forceinline__ void stageK(LAS unsigned char* kb, const bf16* kp, size_t rs, int lane) {
#pragma unroll
    for (int i = 0; i < 4; ++i) { const int key = 8 * i + (lane >> 3); __builtin_amdgcn_global_load_lds((const unsigned*)(kp + (size_t)key * rs + ((lane & 7) ^ ((key >> 1) & 7)) * 8), (LAS unsigned*)(kb + i * 1024), 16, 0, 0); }
}
__device__ __forceinline__ void stageV(LAS unsigned char* vb, const bf16* vp, size_t rs, int lane) {
    const bf16* v0 = vp + (size_t)(lane >> 3) * rs + ((lane & 7) ^ (((lane >> 4) & 1) << 2)) * 8;
#pragma unroll
    for (int i = 0; i < 4; ++i) __builtin_amdgcn_global_load_lds((const unsigned*)(v0 + (size_t)(8 * i) * rs), (LAS unsigned*)(vb + i * 1024), 16, 0, 0);
}
__device__ __forceinline__ f32x16 qk32(const LAS unsigned char* buf, const bf16x8 (&qf)[4], int r32, int hh) {
    f32x16 s; bf16x8 kf[4];
#pragma unroll
    for (int ks = 0; ks < 4; ++ks) kf[ks] = *(const LAS bf16x8*)(buf + r32 * 128 + (((2 * ks + hh) ^ ((r32 >> 1) & 7)) << 4));
#pragma unroll
    for (int i = 0; i < 16; ++i) s[i] = 0.f;
#pragma unroll
    for (int ks = 0; ks < 4; ++ks) s = ATT_MFMA(kf[ks], qf[ks], s);
    return s;
}
__device__ __forceinline__ void qk32x2(const LAS unsigned char* buf, const bf16x8 (&q0)[4], const bf16x8 (&q1)[4], f32x16& s0, f32x16& s1, int r32, int hh) {
    bf16x8 kf[4];
#pragma unroll
    for (int ks = 0; ks < 4; ++ks) kf[ks] = *(const LAS bf16x8*)(buf + r32 * 128 + (((2 * ks + hh) ^ ((r32 >> 1) & 7)) << 4));
#pragma unroll
    for (int i = 0; i < 16; ++i) { s0[i] = 0.f; s1[i] = 0.f; }
#pragma unroll
    for (int ks = 0; ks < 4; ++ks) { s0 = ATT_MFMA(kf[ks], q0[ks], s0); s1 = ATT_MFMA(kf[ks], q1[ks], s1); }
}
__device__ __forceinline__ void sm_step2(const float (&t)[16], float& m, float& l, f32x16& o0, f32x16& o1, bf16x8& p0, bf16x8& p1) {
    float mx = fmaxf(fmaxf(fmaxf(t[0], t[1]), fmaxf(t[2], t[3])), fmaxf(fmaxf(t[4], t[5]), fmaxf(t[6], t[7])));
    mx = fmaxf(mx, fmaxf(fmaxf(fmaxf(t[8], t[9]), fmaxf(t[10], t[11])), fmaxf(fmaxf(t[12], t[13]), fmaxf(t[14], t[15]))));
    mx = xhalf_max(mx);
    if (__builtin_amdgcn_ballot_w64(mx > m + 8.0f) != 0) {
        const float mn = fmaxf(m, mx), ms = (mn == -INFINITY) ? 0.f : mn, al = ex2(m - ms); m = mn; l *= al;
#pragma unroll
        for (int i = 0; i < 16; ++i) { o0[i] *= al; o1[i] *= al; }
    }
    const float ref = (m == -INFINITY) ? 0.f : m;
    float pe[16]; float ls = 0.f;
#pragma unroll
    for (int i = 0; i < 16; ++i) { pe[i] = ex2(t[i] - ref); ls += pe[i]; }
    l += ls;
    u32x4 a, b; a.x = cvtpk(pe[0], pe[1]); a.y = cvtpk(pe[2], pe[3]); a.z = cvtpk(pe[4], pe[5]); a.w = cvtpk(pe[6], pe[7]);
    b.x = cvtpk(pe[8], pe[9]); b.y = cvtpk(pe[10], pe[11]); b.z = cvtpk(pe[12], pe[13]); b.w = cvtpk(pe[14], pe[15]);
    p0 = __builtin_bit_cast(bf16x8, a); p1 = __builtin_bit_cast(bf16x8, b);
}
__device__ __forceinline__ void vfrag4(const LAS unsigned char* buf, int va0, int va1, bf16x8& v00, bf16x8& v01, bf16x8& v10, bf16x8& v11) {
    const unsigned a0 = (unsigned)(size_t)(buf + va0), a1 = (unsigned)(size_t)(buf + va1);
    s16x4 l00, h00, l01, h01, l10, h10, l11, h11;
    VTR_ISSUE(l00, a0, 0); VTR_ISSUE(h00, a0, 1024); VTR_ISSUE(l01, a0, 2048); VTR_ISSUE(h01, a0, 3072); VTR_ISSUE(l10, a1, 0); VTR_ISSUE(h10, a1, 1024); VTR_ISSUE(l11, a1, 2048); VTR_ISSUE(h11, a1, 3072);
    vtr_wait8(l00, h00, l01, h01, l10, h10, l11, h11);
    v00 = VTR_PACK(l00, h00); v01 = VTR_PACK(l01, h01); v10 = VTR_PACK(l10, h10); v11 = VTR_PACK(l11, h11);
}
#define ATT_VADDR() const int i16 = lane & 15, q4 = i16 >> 2, p4 = i16 & 3, cb = (lane >> 4) & 1; const int vrow = 4096 + (4 * hh + q4) * 128 + (p4 & 1) * 8; \
    const int va0 = vrow + (((0 ^ (q4 >> 1)) * 4 + cb * 2 + (p4 >> 1)) * 16), va1 = vrow + (((1 ^ (q4 >> 1)) * 4 + cb * 2 + (p4 >> 1)) * 16)
#define ATT_WAIT_V(n) asm volatile("s_waitcnt vmcnt(" #n ")" ::: "memory")

__device__ __forceinline__ void qrow_put(LAS unsigned char* tb, const v4u (&q)[4], int lane) {
#pragma unroll
    for (int i = 0; i < 4; ++i) { const int row = 8 * i + (lane >> 3); *(LAS v4u*)(tb + row * 128 + (((lane & 7) ^ ((row >> 1) & 7)) << 4)) = q[i]; }
}
__device__ __forceinline__ void qfrag_get(const LAS unsigned char* tb, bf16x8 (&qf)[4], int r32, int hh) {
#pragma unroll
    for (int ks = 0; ks < 4; ++ks) qf[ks] = *(const LAS bf16x8*)(tb + r32 * 128 + (((2 * ks + hh) ^ ((r32 >> 1) & 7)) << 4));
    asm volatile("s_waitcnt lgkmcnt(0)" : "+v"(qf[0]), "+v"(qf[1]), "+v"(qf[2]), "+v"(qf[3]) :: "memory");
}
__device__ __forceinline__ void ostage(LAS unsigned char* tb, const f32x16& o0, const f32x16& o1, float inv, int r32, int hh) {
#pragma unroll
    for (int db = 0; db < 2; ++db)
#pragma unroll
        for (int g = 0; g < 4; ++g) { const f32x16& o = db == 0 ? o0 : o1; v2u w; w.x = cvtpk(o[4 * g] * inv, o[4 * g + 1] * inv); w.y = cvtpk(o[4 * g + 2] * inv, o[4 * g + 3] * inv);
            *(LAS v2u*)(tb + r32 * 128 + (((db * 4 + g) ^ (r32 & 7)) << 4) + hh * 8) = w; }
}
__device__ __forceinline__ v4u orow(const LAS unsigned char* tb, int lane, int i) { return *(const LAS v4u*)(tb + i * 1024 + lane * 16); }
__device__ __forceinline__ int orow_chunk(int lane, int i) { return (lane & 7) ^ ((8 * i + (lane >> 3)) & 7); }
template <bool FINAL>
__device__ __forceinline__ void dil_tile(const bf16* PROJ, int dl, int idx, bf16* DPo, float* DLo, const bf16* DP1, const float* DL1, const bf16* DP2, const float* DL2, bf16* OC, LAS unsigned char* wl, int lane) {
    const int r32 = lane & 31, hh = lane >> 5;
    const int L = SEQ / dl, nch = L >> 6, ich = idx % nch, rho = (idx / nch) % dl, bh = idx >> 5, h = bh & 7, b = bh >> 3, i0 = ich << 6;
    const bf16* base = PROJ + ((size_t)b * SEQ + rho) * IN_E_PAD + h * 64;
    const size_t rs = (size_t)dl * IN_E_PAD;
    bf16x8 qf[2][4]; v4u qraw[2][4];
#pragma unroll
    for (int qb = 0; qb < 2; ++qb)
#pragma unroll
        for (int i = 0; i < 4; ++i) qraw[qb][i] = *(const v4u*)(base + (size_t)(i0 + qb * 32 + 8 * i + (lane >> 3)) * rs + (lane & 7) * 8);
    ATT_VADDR();
    const float c = 0.125f * LOG2E, sl = ex2(-(float)(h + 1)) * LOG2E * (float)dl;
    f32x16 o[2][2];
#pragma unroll
    for (int i = 0; i < 16; ++i) { o[0][0][i] = 0.f; o[0][1][i] = 0.f; o[1][0][i] = 0.f; o[1][1][i] = 0.f; }
    float m0 = -INFINITY, m1 = -INFINITY, l0 = 0.f, l1 = 0.f;
    const int klo = (i0 >= 64) ? 0 : 2, khi = (i0 + 128 <= L) ? 6 : 4;
    { const int ik0 = i0 - 64 + 32 * klo; stage32(wl, base + 512 + (size_t)ik0 * rs, base + 1024 + (size_t)ik0 * rs, rs, lane); }
    qrow_put(wl + 8192, qraw[0], lane); qrow_put(wl + 12288, qraw[1], lane); qfrag_get(wl + 8192, qf[0], r32, hh); qfrag_get(wl + 12288, qf[1], r32, hh);
    for (int kbi = klo; kbi < khi; ++kbi) {
        const LAS unsigned char* buf = wl + ((kbi - klo) & 1) * 8192;
        if (kbi + 1 < khi) { const int ik0 = i0 - 64 + 32 * (kbi + 1); stage32(wl + ((kbi + 1 - klo) & 1) * 8192, base + 512 + (size_t)ik0 * rs, base + 1024 + (size_t)ik0 * rs, rs, lane); ATT_WAIT_V(8); }
        else ATT_WAIT_V(0);
        const bool use0 = kbi <= 4, use1 = kbi >= 1;
        bf16x8 p00, p01, p10, p11;
        f32x16 sa, sb; qk32x2(buf, qf[0], qf[1], sa, sb, r32, hh);
        if (use0) { float t[16]; const float e0 = (float)((32 * kbi - 64) + 4 * hh - r32);
#pragma unroll
            for (int i = 0; i < 16; ++i) { const float ad = __builtin_fabsf(e0 + (float)((i & 3) + 8 * (i >> 2))); t[i] = ad <= 64.0f ? __builtin_fmaf(sa[i], c, -sl * ad) : -INFINITY; }
            sm_step2(t, m0, l0, o[0][0], o[0][1], p00, p01); }
        if (use1) { float t[16]; const float e0 = (float)((32 * kbi - 96) + 4 * hh - r32);
#pragma unroll
            for (int i = 0; i < 16; ++i) { const float ad = __builtin_fabsf(e0 + (float)((i & 3) + 8 * (i >> 2))); t[i] = ad <= 64.0f ? __builtin_fmaf(sb[i], c, -sl * ad) : -INFINITY; }
            sm_step2(t, m1, l1, o[1][0], o[1][1], p10, p11); }
        { bf16x8 v00, v01, v10, v11; vfrag4(buf, va0, va1, v00, v01, v10, v11);
          if (use0) { o[0][0] = ATT_MFMA(v00, p00, o[0][0]); o[0][1] = ATT_MFMA(v10, p00, o[0][1]); }
          if (use1) { o[1][0] = ATT_MFMA(v00, p10, o[1][0]); o[1][1] = ATT_MFMA(v10, p10, o[1][1]); }
          if (use0) { o[0][0] = ATT_MFMA(v01, p01, o[0][0]); o[0][1] = ATT_MFMA(v11, p01, o[0][1]); }
          if (use1) { o[1][0] = ATT_MFMA(v01, p11, o[1][0]); o[1][1] = ATT_MFMA(v11, p11, o[1][1]); } }
    }
    const float lt0 = xhalf_sum(l0), lt1 = xhalf_sum(l1);
#pragma unroll
    for (int qb = 0; qb < 2; ++qb) { const float lt = qb == 0 ? lt0 : lt1, mm = qb == 0 ? m0 : m1;
        const size_t tok = (size_t)b * SEQ + rho + (size_t)dl * (i0 + qb * 32 + r32);
        const float lse = mm + __builtin_amdgcn_logf(lt);
        if (!FINAL) {
            ostage(wl + qb * 4096, o[qb][0], o[qb][1], 1.0f / lt, r32, hh);
            if (hh == 0) DLo[(size_t)h * NTOK + tok] = lse;
        } else {
            const float a1 = DL1[(size_t)h * NTOK + tok], a2 = DL2[(size_t)h * NTOK + tok], mx = fmaxf(lse, fmaxf(a1, a2));
            const float e0 = ex2(lse - mx), e1 = ex2(a1 - mx), e2 = ex2(a2 - mx), es = 1.0f / (e0 + e1 + e2);
            ostage(wl + qb * 4096, o[qb][0], o[qb][1], e0 * es / lt, r32, hh);
            if (hh == 0) *(LAS f32x2*)(wl + 8192 + (qb * 32 + r32) * 8) = (f32x2){e1 * es, e2 * es};
        }
    }
    asm volatile("s_waitcnt lgkmcnt(0)" ::: "memory");
#pragma unroll
    for (int qb = 0; qb < 2; ++qb)
#pragma unroll
        for (int i = 0; i < 4; ++i) { const int r = 8 * i + (lane >> 3), ch = orow_chunk(lane, i);
            const size_t tok = (size_t)b * SEQ + rho + (size_t)dl * (i0 + qb * 32 + r);
            const v4u w = orow(wl + qb * 4096, lane, i);
            if (!FINAL) *(v4u*)(DPo + tok * 512 + h * 64 + ch * 8) = w;
            else { const f32x2 ww = *(const LAS f32x2*)(wl + 8192 + (qb * 32 + r) * 8);
                const v4u x1 = *(const v4u*)(DP1 + tok * 512 + h * 64 + ch * 8), x2 = *(const v4u*)(DP2 + tok * 512 + h * 64 + ch * 8);
                v4u y;
                y.x = cvtpk(bflo(w.x) + bflo(x1.x) * ww.x + bflo(x2.x) * ww.y, bfhi(w.x) + bfhi(x1.x) * ww.x + bfhi(x2.x) * ww.y);
                y.y = cvtpk(bflo(w.y) + bflo(x1.y) * ww.x + bflo(x2.y) * ww.y, bfhi(w.y) + bfhi(x1.y) * ww.x + bfhi(x2.y) * ww.y);
                y.z = cvtpk(bflo(w.z) + bflo(x1.z) * ww.x + bflo(x2.z) * ww.y, bfhi(w.z) + bfhi(x1.z) * ww.x + bfhi(x2.z) * ww.y);
                y.w = cvtpk(bflo(w.w) + bflo(x1.w) * ww.x + bflo(x2.w) * ww.y, bfhi(w.w) + bfhi(x1.w) * ww.x + bfhi(x2.w) * ww.y);
                *(v4u*)(OC + tok * DM + h * 64 + ch * 8) = y; } }
    asm volatile("s_waitcnt lgkmcnt(0)" ::: "memory");
}
__device__ __forceinline__ void na_tile(const bf16* QKV, const LAS float* rpb  , bf16* O, int idx, LAS unsigned char* wl, int lane) {
    asm volatile("" : "+v"(lane));
    const int r32 = lane & 31, hh = lane >> 5;
    const int cbk = idx & 3, iq = (idx >> 2) & 7, h = (idx >> 5) & 15, b = idx >> 9;
    const int qc = 16 * cbk + (r32 & 15), qr0 = 4 * iq + (r32 >> 4), qr1 = qr0 + 2;
    const bf16* qbase = QKV + ((size_t)h * NTOK + (size_t)b * SEQ) * 64; const bf16* kbase = qbase + (size_t)16 * NTOK * 64; const bf16* vbase = kbase + (size_t)16 * NTOK * 64;
    bf16x8 qf[2][4]; v4u qraw[2][4];
#pragma unroll
    for (int qb = 0; qb < 2; ++qb)
#pragma unroll
        for (int i = 0; i < 4; ++i) { const int r = 8 * i + (lane >> 3); qraw[qb][i] = *(const v4u*)(qbase + (size_t)((4 * iq + 2 * qb + (r >> 4)) * 64 + 16 * cbk + (r & 15)) * 64 + (lane & 7) * 8); }
    ATT_VADDR();
    const float c = 0.125f * LOG2E;
    const int csq = min(max(qc - 8, 0), 48), rs0 = min(max(qr0 - 4, 0), 24), rs1 = min(max(qr1 - 4, 0), 24);
    const int rA0 = min(max(4 * iq - 4, 0), 24), rB0 = min(max(4 * iq - 3, 0), 24) + 8, rA1 = min(max(4 * iq - 2, 0), 24), rB1 = min(max(4 * iq - 1, 0), 24) + 8;
    const int kc0 = min(max(16 * cbk - 8, 0), 32);
    const LAS float* rp = rpb + h * (15 * 31);
    f32x16 o[2][2];
#pragma unroll
    for (int i = 0; i < 16; ++i) { o[0][0][i] = 0.f; o[0][1][i] = 0.f; o[1][0][i] = 0.f; o[1][1][i] = 0.f; }
    float m0 = -INFINITY, m1 = -INFINITY, l0 = 0.f, l1 = 0.f;
    const int cd0 = kc0 + 4 * hh - csq, bc0 = kc0 + 4 * hh - qc + 15;
#define NA_ROW(kr_) ((size_t)((kr_) * 64 + kc0) * 64)
    stageK(wl, kbase + NA_ROW(rA0), 64, lane); stageV(wl + 8192, vbase + NA_ROW(rA0), 64, lane); stageK(wl + 4096, kbase + NA_ROW(rA0 + 1), 64, lane);
    qrow_put(wl + 12288, qraw[0], lane); qfrag_get(wl + 12288, qf[0], r32, hh); qrow_put(wl + 12288, qraw[1], lane); qfrag_get(wl + 12288, qf[1], r32, hh);
    ATT_WAIT_V(4);
    f32x16 sa, sb; qk32x2(wl, qf[0], qf[1], sa, sb, r32, hh);
    for (int kr = rA0; kr < rB1; ++kr) {
        const int j = kr - rA0; const bool n1 = kr + 1 < rB1, n2 = kr + 2 < rB1;
        if (n2) stageK(wl + (j & 1) * 4096, kbase + NA_ROW(kr + 2), 64, lane);
        if (n1) stageV(wl + 8192 + ((j + 1) & 1) * 4096, vbase + NA_ROW(kr + 1), 64, lane);
        if (n2) ATT_WAIT_V(8); else if (n1) ATT_WAIT_V(4); else ATT_WAIT_V(0);
        f32x16 na, nb;
        if (n1) qk32x2(wl + ((j + 1) & 1) * 4096, qf[0], qf[1], na, nb, r32, hh);
        const LAS unsigned char* buf = wl + 4096 + (j & 1) * 4096;
        const bool use0 = kr < rB0, use1 = kr >= rA1;
        bf16x8 p00, p01, p10, p11;
        if (use0) { float t[16]; const bool rok = (kr >= rs0) && (kr < rs0 + 8); const LAS float* bp = rp + (rok ? (kr - qr0 + 7) * 31 + bc0 : 0);
#pragma unroll
            for (int i = 0; i < 16; ++i) { const int dd = (i & 3) + 8 * (i >> 2); t[i] = bp[dd]; }
#pragma unroll
            for (int i = 0; i < 16; ++i) { const int dd = (i & 3) + 8 * (i >> 2); const bool ok = rok && ((unsigned)(cd0 + dd) < 16u); t[i] = ok ? __builtin_fmaf(sa[i], c, t[i]) : -INFINITY; }
            sm_step2(t, m0, l0, o[0][0], o[0][1], p00, p01); }
        if (use1) { float t[16]; const bool rok = (kr >= rs1) && (kr < rs1 + 8); const LAS float* bp = rp + (rok ? (kr - qr1 + 7) * 31 + bc0 : 0);
#pragma unroll
            for (int i = 0; i < 16; ++i) { const int dd = (i & 3) + 8 * (i >> 2); t[i] = bp[dd]; }
#pragma unroll
            for (int i = 0; i < 16; ++i) { const int dd = (i & 3) + 8 * (i >> 2); const bool ok = rok && ((unsigned)(cd0 + dd) < 16u); t[i] = ok ? __builtin_fmaf(sb[i], c, t[i]) : -INFINITY; }
            sm_step2(t, m1, l1, o[1][0], o[1][1], p10, p11); }
        { bf16x8 v00, v01, v10, v11; vfrag4(buf, va0, va1, v00, v01, v10, v11);
          if (use0) { o[0][0] = ATT_MFMA(v00, p00, o[0][0]); o[0][1] = ATT_MFMA(v10, p00, o[0][1]); }
          if (use1) { o[1][0] = ATT_MFMA(v00, p10, o[1][0]); o[1][1] = ATT_MFMA(v10, p10, o[1][1]); }
          if (use0) { o[0][0] = ATT_MFMA(v01, p01, o[0][0]); o[0][1] = ATT_MFMA(v11, p01, o[0][1]); }
          if (use1) { o[1][0] = ATT_MFMA(v01, p11, o[1][0]); o[1][1] = ATT_MFMA(v11, p11, o[1][1]); } }
        if (n1) { sa = na; sb = nb; }
    }
#undef NA_ROW
    const float i0 = 1.0f / xhalf_sum(l0), i1 = 1.0f / xhalf_sum(l1);
    ostage(wl, o[0][0], o[0][1], i0, r32, hh); ostage(wl + 4096, o[1][0], o[1][1], i1, r32, hh);
    asm volatile("s_waitcnt lgkmcnt(0)" ::: "memory");
#pragma unroll
    for (int qb = 0; qb < 2; ++qb)
#pragma unroll
        for (int i = 0; i < 4; ++i) { const int r = 8 * i + (lane >> 3);
            const v4u w = orow(wl + qb * 4096, lane, i);
            *(v4u*)(O + ((size_t)b * SEQ + (4 * iq + 2 * qb + (r >> 4)) * 64 + 16 * cbk + (r & 15)) * DM + h * 64 + orow_chunk(lane, i) * 8) = w; }
    asm volatile("s_waitcnt lgkmcnt(0)" ::: "memory");
}
}
#ifndef MK_MULTI
#define MK_MULTI 0
#endif
constexpr int NPH = 45;
struct Args { const float* in[22]; float* out; unsigned char* ws; int ph_lo, ph_hi; };
__global__ void __launch_bounds__(NWAVES * 64, 2) fwd(Args args) {
    extern __shared__ __attribute__((aligned(16))) unsigned char lds_raw[];
    Ctx C;
    C.out = args.out; C.ws = args.ws; C.lds = (LAS unsigned char*)lds_raw;
    C.tid = threadIdx.x; C.lane = C.tid & 63; C.wave = __builtin_amdgcn_readfirstlane(C.tid >> 6); C.G = gridDim.x; C.gw = blockIdx.x * NWAVES + C.wave; C.NGW = C.G * NWAVES;
    volatile LAS unsigned* MISC = (volatile LAS unsigned*)(C.lds + MISC_OFF);
    for (int u = C.tid; u < (LDS_BYTES - LDSCTL_OFF) / 4; u += NWAVES * 64) ((LAS unsigned*)(C.lds + LDSCTL_OFF))[u] = 0u;
    __syncthreads();
    XcdBarrier bar = xcd_barrier_post((unsigned*)(args.ws + WS_CTL) + CW_BAR, MISC + 8);
    const int lo = args.ph_lo, hi = args.ph_hi; int ph = 0; const int wave_s = C.wave;
#define PH_BEGIN { asm volatile("" : "+s"(ph)); const bool run_ = (ph >= lo && ph < hi); if (run_) { unsigned char* ws = args.ws; float* xo = args.out; int l_; asm volatile("v_mbcnt_lo_u32_b32 %0, -1, 0\n\tv_mbcnt_hi_u32_b32 %0, -1, %0" : "=v"(l_)); asm volatile("" : "+s"(ws), "+s"(xo)); \
        C.ws = ws; C.out = xo; C.lane = l_; C.wave = wave_s; C.tid = wave_s * 64 + l_; { int gw_ = blockIdx.x * NWAVES + wave_s, g_ = gridDim.x; asm volatile("" : "+s"(gw_), "+s"(g_)); C.gw = gw_; C.G = g_; C.NGW = g_ * NWAVES; } unsigned* ctl = (unsigned*)(ws + WS_CTL); (void)ctl;
#define PH_END } if (run_ && ph + 1 < hi) { XcdBarrier b2_ = bar; asm volatile("" : "+s"(b2_.bar)); int l2_; asm volatile("v_mbcnt_lo_u32_b32 %0, -1, 0\n\tv_mbcnt_hi_u32_b32 %0, -1, %0" : "=v"(l2_)); xcd_barrier(b2_, wave_s * 64 + l2_); } ++ph; }
#define H ((bf16*)(ws + WS_H))
#define XB ((bf16*)xo)
#define PROJ ((bf16*)(ws + WS_PROJ))
#define QM ((bf16*)(ws + WS_QM))
#define KVM ((bf16*)(ws + WS_KVM))
#define KPE ((bf16*)(ws + WS_KPE))
#define ACT ((bf16*)(ws + WS_ACT))
#define QKV ((bf16*)(ws + WS_QKV))
#define HG8 (ws + WS_HG8)
#define YALL ((bf16*)(ws + WS_YALL))
#define MACT (ws + WS_MACT)
#define wev (ws + WS_WEV + lp * EV_STRIDE)
#define wod (ws + WS_WOD + lp * OD_STRIDE)
#define cnt (ctl + CW_CNT + lp * N_CHUNK * 8 * 64)
#define xin (lp == 0 ? args.in[0] : (const float*)xo)
#define GEMM(EPI, ORD, g, S, E) pg8::gemm_phase<EPI, ORD, true, true, 0>(C.lds, g, S, E, C.tid)
#define GEMM8(EPI, ORD, g, S, E) pg8::gemm_phase<EPI, ORD, true, true, 1>(C.lds, g, S, E, C.tid)
#define GEMMI8(EPI, ORD, g, S, E) pg8::gemm_phase<EPI, ORD, true, true, 2>(C.lds, g, S, E, C.tid)

    PH_BEGIN p0_prologue(C, args); norm_phase<2, true>(C, args.in[0], args.in[1], H, XB); PH_END

    for (int lp = 0; lp < 2; ++lp) {
        PH_BEGIN { pg8::Gemm g{H, (const bf16*)(wev + EV_WIN), DM / 2, DM / 2, DM / 2}; pg8::StaticOrder S; S.init(NTOK, IN_E_PAD, C.G, (int)blockIdx.x); pg8::EpiBf16I8 E{PROJ, IN_E_PAD, (const float*)(ws + WS_SA), (const float*)(ws + WS_SB) + lp * 8192}; GEMMI8(pg8::EpiBf16I8, pg8::StaticOrder, g, S, E); } PH_END
        PH_BEGIN mla_prep_phase(C, PROJ, args.in[3] + lp * 256, args.in[5] + lp * 128, KPE); PH_END
        PH_BEGIN { { pg8::Gemm g{PROJ + 1536, (const bf16*)(wev + EV_WUQ), IN_E_PAD, 256, 256}; pg8::StaticOrder S; S.init(NTOK, 768, C.G, (int)blockIdx.x); pg8::EpiBf16 E{QM, 768}; GEMM(pg8::EpiBf16, pg8::StaticOrder, g, S, E); }
                   { pg8::Gemm g{PROJ + 1792, (const bf16*)(wev + EV_WUKV), IN_E_PAD, 256, 256}; pg8::StaticOrder S; S.init(NTOK, 1024, C.G, (int)blockIdx.x); pg8::EpiBf16 E{KVM, 1024}; GEMM(pg8::EpiBf16, pg8::StaticOrder, g, S, E); } } PH_END
        PH_BEGIN { const float* rope = (const float*)(ws + WS_ROPE);
                   for (int it = blockIdx.x; it < 1024; it += C.G) att::mla_unit(QM, KVM, KPE, rope, H, it, C.lds, C.tid);
                   LAS unsigned char* wl = C.lds + C.wave * 16384;
                   for (int it = C.gw; it < 8192; it += C.NGW) att::dil_tile<false>(PROJ, 1, it, (bf16*)(ws + WS_DP1), (float*)(ws + WS_DL1), nullptr, nullptr, nullptr, nullptr, nullptr, wl, C.lane);
                   for (int it = C.gw; it < 8192; it += C.NGW) att::dil_tile<false>(PROJ, 4, it, (bf16*)(ws + WS_DP2), (float*)(ws + WS_DL2), nullptr, nullptr, nullptr, nullptr, nullptr, wl, C.lane); } PH_END
        PH_BEGIN { LAS unsigned char* wl = C.lds + C.wave * 16384;
                   for (int it = C.gw; it < 8192; it += C.NGW) att::dil_tile<true>(PROJ, 16, it, nullptr, nullptr, (const bf16*)(ws + WS_DP1), (const float*)(ws + WS_DL1), (const bf16*)(ws + WS_DP2), (const float*)(ws + WS_DL2), H, wl, C.lane); } PH_END
        PH_BEGIN { pg8::Gemm g{H, (const bf16*)(wev + EV_WOUT), DM, DM, DM}; pg8::StaticOrder S; S.init(NTOK, DM, C.G, (int)blockIdx.x); pg8::EpiResidB E{(const pg8::bf16_t*)XB, (pg8::bf16_t*)XB, LDX}; GEMM(pg8::EpiResidB, pg8::StaticOrder, g, S, E); } PH_END
        PH_BEGIN norm_phase_b(C, XB, args.in[8] + lp * DM, H); PH_END
        PH_BEGIN { pg8::Gemm g{H, (const bf16*)(wev + EV_WGU), DM / 2, DM / 2, DM / 2}; pg8::StaticOrder S; S.init(NTOK, 2 * DFF, C.G, (int)blockIdx.x); pg8::EpiSwigluI8 E{ACT, DFF, (const float*)(ws + WS_SA), (const float*)(ws + WS_SB) + lp * 8192 + 2048}; GEMMI8(pg8::EpiSwigluI8, pg8::StaticOrder, g, S, E); } PH_END
        PH_BEGIN { pg8::Gemm g{ACT, (const bf16*)(wev + EV_WD), DFF, DFF, DFF}; pg8::StaticOrder S; S.init(NTOK, DM, C.G, (int)blockIdx.x); pg8::EpiResidB E{(const pg8::bf16_t*)XB, (pg8::bf16_t*)XB, LDX}; GEMM(pg8::EpiResidB, pg8::StaticOrder, g, S, E); } PH_END

        PH_BEGIN norm_phase_b(C, XB, args.in[12] + lp * DM, H); moe_weights(C, args, lp); PH_END
        PH_BEGIN { pg8::Gemm g{H, (const bf16*)(wod + OD_WQKV), DM / 2, DM / 2, DM / 2}; pg8::StaticOrder S; S.init(NTOK, 3072, C.G, (int)blockIdx.x); pg8::EpiBf16I8H E{QKV, NTOK, (const float*)(ws + WS_SA), (const float*)(ws + WS_SB) + 16384 + lp * 4096}; GEMMI8(pg8::EpiBf16I8H, pg8::StaticOrder, g, S, E); } PH_END
        PH_BEGIN { const float* rpb = args.in[14] + lp * 16 * 15 * 31; LAS float* rl = (LAS float*)(C.lds + RPB_OFF);
                   for (int i = C.tid; i < 16 * 15 * 31; i += NWAVES * 64) rl[i] = rpb[i] * 1.4426950408889634f;
                   __syncthreads();
                   LAS unsigned char* wl = C.lds + C.wave * 16384;
                   for (int it = C.gw; it < 16384; it += C.NGW) att::na_tile(QKV, rl, H, it, wl, C.lane); } PH_END
        PH_BEGIN { pg8::Gemm g{H, (const bf16*)(wod + OD_WO), DM, DM, DM}; pg8::StaticOrder S; S.init(NTOK, DM, C.G, (int)blockIdx.x); pg8::EpiResidB E{(const pg8::bf16_t*)XB, (pg8::bf16_t*)XB, LDX}; GEMM(pg8::EpiResidB, pg8::StaticOrder, g, S, E); } PH_END
        PH_BEGIN route_phase(C, XB, args.in[16] + lp * DM, args.in[17] + lp * DM * NEXP, (unsigned char*)H, cnt); PH_END
        PH_BEGIN gather_all_phase(C, (const unsigned char*)H, HG8, cnt); PH_END
#define MOE_GU(ch_) { pg8::Gemm g{(const bf16*)(HG8 + (size_t)(ch_) * 2 * CHUNK_SLOTS * DM), (const bf16*)(ws + WS_MWGU), DM / 2, DM / 2, DM / 2}; pg8::GroupedOrder S; grouped_order(S, cnt, (ch_), 28, C.G, (int)blockIdx.x); \
            pg8::EpiSwigluF8 E{MACT + (size_t)((ch_) & 1) * CHUNK_SLOTS * DFFX, DFFX, 1.0f / 32.0f}; GEMM8(pg8::EpiSwigluF8, pg8::GroupedOrder, g, S, E); }
#define MOE_DOWN(ch_) { pg8::Gemm g{(const bf16*)(MACT + (size_t)((ch_) & 1) * CHUNK_SLOTS * DFFX), (const bf16*)(ws + WS_MWD), DFFX / 2, DFFX / 2, DFFX / 2}; pg8::GroupedOrder S; grouped_order(S, cnt, (ch_), 4, C.G, (int)blockIdx.x); \
            pg8::EpiBf16S E{YALL + (size_t)(ch_) * CHUNK_SLOTS * DM, DM, 1.0f / 32.0f}; GEMM8(pg8::EpiBf16S, pg8::GroupedOrder, g, S, E); }
        PH_BEGIN MOE_GU(0) PH_END
        for (int ch = 1; ch < N_CHUNK; ++ch) {
            PH_BEGIN MOE_DOWN(ch - 1) MOE_GU(ch) PH_END
        }
        PH_BEGIN MOE_DOWN(N_CHUNK - 1) PH_END
#undef MOE_GU
#undef MOE_DOWN
        PH_BEGIN { if (lp == 0) combine_all_phase<false>(C, XB, xo, YALL, args.in[1] + DM, H); else combine_all_phase<true>(C, XB, xo, YALL, args.in[21], H); } PH_END
    }
#undef PH_BEGIN
#undef PH_END
#undef GEMM
#undef XB
#undef H
#undef PROJ
#undef QM
#undef KVM
#undef KPE
#undef ACT
#undef QKV
#undef HG8
#undef YALL
#undef GEMM8
#undef GEMMI8
#undef MACT
#undef wev
#undef wod
#undef cnt
#undef xin
}

extern "C" void kernel_launch(void* const* d_in, const int* in_sizes, int n_in, void* d_out, int out_size, void* d_ws, size_t ws_size, hipStream_t stream) {
    static int grid = 0;
    if (grid == 0) {
        if (n_in != 22 || in_sizes[0] != NTOK * DM || out_size != NTOK * DM || ws_size < WS_END) { fprintf(stderr, "kernel_launch: unexpected shapes (n_in %d, in0 %d, out %d, ws %zu); nothing launched\n", n_in, n_in > 0 ? in_sizes[0] : -1, out_size, ws_size); grid = -1; return; }
        int dev = 0, cus = 0, per_cu = 0;
        if (hipGetDevice(&dev) != hipSuccess || hipDeviceGetAttribute(&cus, hipDeviceAttributeMultiprocessorCount, dev) != hipSuccess) { grid = -1; return; }
        if (hipFuncSetAttribute((const void*)fwd, hipFuncAttributeMaxDynamicSharedMemorySize, LDS_BYTES) != hipSuccess) { fprintf(stderr, "kernel_launch: hipFuncSetAttribute failed\n"); grid = -1; return; }
        if (hipOccupancyMaxActiveBlocksPerMultiprocessor(&per_cu, (const void*)fwd, NWAVES * 64, LDS_BYTES) != hipSuccess || per_cu < 1) { fprintf(stderr, "kernel_launch: occupancy query says %d blocks per CU\n", per_cu); }
        (void)hipGetLastError();
        grid = cus;
    }
    if (grid < 0) return;
    if (hipMemsetAsync((char*)d_ws + WS_CTL, 0, CTL_ZERO_BYTES, stream) != hipSuccess) return;
    Args a{};
    for (int i = 0; i < 22; ++i) a.in[i] = (const float*)d_in[i];
    a.out = (float*)d_out; a.ws = (unsigned char*)d_ws;
#if MK_MULTI
    for (int p = 0; p < NPH; ++p) { a.ph_lo = p; a.ph_hi = p + 1; hipLaunchKernelGGL(fwd, dim3(grid), dim3(NWAVES * 64), LDS_BYTES, stream, a); }
#else
    a.ph_lo = 0; a.ph_hi = NPH; hipLaunchKernelGGL(fwd, dim3(grid), dim3(NWAVES * 64), LDS_BYTES, stream, a);
#endif
}
```
